# Optimizing an MI355X kernel written in HIP

```python
import math
import jax, jax.numpy as jnp
from jax import lax
import numpy as np

D_MODEL = 2048
BATCH = 4
SEQ = 4096
DEPTH = 1

N_META = 16
BLOCK = 128
PAD = BLOCK - N_META
HEAD_DIM = 128
N_FOX_HEADS = 8
N_RET_HEADS = 8
FOX_WIDTH = N_FOX_HEADS * HEAD_DIM
RET_WIDTH = N_RET_HEADS * HEAD_DIM
MIX_WIDTH = FOX_WIDTH + RET_WIDTH
SPLITS = (FOX_WIDTH, FOX_WIDTH, FOX_WIDTH, N_FOX_HEADS, RET_WIDTH, RET_WIDTH, RET_WIDTH, RET_WIDTH)
IN_COLS = sum(SPLITS)
RET_ROPE_BASE = 10000.0
N_GROUPS = 4
EXPERTS_PER_GROUP = 4
N_EXPERTS = N_GROUPS * EXPERTS_PER_GROUP
TOP_K = 2
D_EXPERT = 1024
EPS = 1e-6
MASK_VALUE = -1e30

kernel_name = "hymba_fox_retnet_hmoe"


def rmsnorm(x, g):
    xf = x.astype(jnp.float32)
    y = xf * lax.rsqrt(jnp.mean(xf * xf, axis=-1, keepdims=True) + EPS)
    return (y * g.astype(jnp.float32)).astype(x.dtype)


def to_heads(t, n_heads):
    b, p, _ = t.shape
    return t.reshape(b, p, n_heads, HEAD_DIM).transpose(0, 2, 1, 3)


def rotate_every_two(x):
    x1 = x[..., ::2]
    x2 = x[..., 1::2]
    return jnp.stack((-x2, x1), axis=-1).reshape(x.shape)


def forgetting_attention(q, k, v, log_f, key_valid):
    b, h, p, dh = q.shape
    nblk = p // BLOCK
    cum = jnp.cumsum(log_f, axis=-1)
    scale = HEAD_DIM ** -0.5
    kpos = jnp.arange(p)
    qb = q.reshape(b, h, nblk, BLOCK, dh).transpose(2, 0, 1, 3, 4)
    cb = cum.reshape(b, h, nblk, BLOCK).transpose(2, 0, 1, 3)

    def one_block(args):
        i, q_i, c_i = args
        s = jnp.einsum('bhqd,bhkd->bhqk', q_i, k).astype(jnp.float32) * scale
        s = s + c_i[..., :, None] - cum[:, :, None, :]
        qpos = i * BLOCK + jnp.arange(BLOCK)
        mask = (kpos[None, :] <= qpos[:, None]) & key_valid[None, :]
        s = jnp.where(mask[None, None], s, MASK_VALUE)
        pr = jax.nn.softmax(s, axis=-1)
        return jnp.einsum('bhqk,bhkd->bhqd', pr.astype(v.dtype), v)

    out = lax.map(one_block, (jnp.arange(nblk), qb, cb))
    return out.transpose(1, 2, 0, 3, 4).reshape(b, h, p, dh)


def retention_chunkwise(q, k, v, log_gamma):
    b, h, p, dh = q.shape
    n = p // BLOCK
    dt = q.dtype
    qc = q.reshape(b, h, n, BLOCK, dh)
    kc = k.reshape(b, h, n, BLOCK, dh)
    vc = v.reshape(b, h, n, BLOCK, dh)
    idx = jnp.arange(BLOCK, dtype=jnp.float32)
    lg = log_gamma[:, None]
    diff = idx[:, None] - idx[None, :]
    dmask = jnp.where(diff[None] >= 0, jnp.exp(lg[:, :, None] * jnp.maximum(diff, 0.0)[None]), 0.0)
    scores = jnp.einsum('bhnid,bhnjd->bhnij', qc, kc) * dmask[None, :, None].astype(dt)
    inner = jnp.einsum('bhnij,bhnje->bhnie', scores, vc)
    zeta = jnp.exp(lg * (BLOCK - 1 - idx)).astype(dt)
    kv = jnp.einsum('bhnjd,bhnje->bhnde', kc * zeta[None, :, None, :, None], vc)
    chunk_decay = jnp.exp(log_gamma * BLOCK).astype(dt)

    def step(state, kv_n):
        return state * chunk_decay[None, :, None, None] + kv_n, state

    _, prev = lax.scan(step, jnp.zeros((b, h, dh, dh), dt), kv.transpose(2, 0, 1, 3, 4))
    prev = prev.transpose(1, 2, 0, 3, 4)
    xi = jnp.exp(lg * (idx + 1.0)).astype(dt)
    cross = jnp.einsum('bhnid,bhnde->bhnie', qc * xi[None, :, None, :, None], prev)
    return (inner + cross).reshape(b, h, p, dh)


def hierarchical_moe(hn, w_rg, b_rg, w_re, b_re, w_gate, w_up, w_down):
    b, p, d = hn.shape
    t = hn.reshape(b * p, d)
    gl = (t @ w_rg).astype(jnp.float32) + b_rg.astype(jnp.float32)
    gp = jax.nn.softmax(gl, axis=-1)
    _, g_star = lax.top_k(gl, 1)
    p_group = jnp.take_along_axis(gp, g_star, axis=1)[:, 0]
    el = ((t @ w_re).astype(jnp.float32) + b_re.astype(jnp.float32)).reshape(-1, N_GROUPS, EXPERTS_PER_GROUP)
    el_sel = jnp.take_along_axis(el, g_star[:, :, None], axis=1)[:, 0]
    top_v, top_i = lax.top_k(el_sel, TOP_K)
    w_local = jax.nn.softmax(top_v, axis=-1) * p_group[:, None]
    gidx = g_star * EXPERTS_PER_GROUP + top_i
    combine = jnp.sum(jax.nn.one_hot(gidx, N_EXPERTS, dtype=jnp.float32) * w_local[..., None], axis=1)
    combine = combine.astype(t.dtype)
    y = jnp.zeros_like(t)
    for e in range(N_EXPERTS):
        a = jax.nn.silu(t @ w_gate[e]) * (t @ w_up[e])
        y = y + combine[:, e:e + 1] * (a @ w_down[e])
    return y.reshape(b, p, d)


def setup_inputs(seed: int = 0) -> dict:
    key = jax.random.key(seed)
    ks = jax.random.split(key, 20)
    f32 = jnp.float32
    nrm = lambda k, shape, s: jax.random.normal(k, shape, f32) * s
    gain = lambda k, shape: 1.0 + 0.02 * jax.random.normal(k, shape, f32)
    b_forget = jnp.linspace(1.0, 5.0, N_FOX_HEADS, dtype=f32)[None, :] + nrm(ks[4], (DEPTH, N_FOX_HEADS), 0.1)
    return {
        "x": nrm(ks[0], (BATCH, SEQ, D_MODEL), 1.0),
        "meta_tokens": nrm(ks[1], (N_META, D_MODEL), 1.0),
        "attn_norm_g": gain(ks[2], (DEPTH, D_MODEL)),
        "w_in": nrm(ks[3], (DEPTH, D_MODEL, IN_COLS), D_MODEL ** -0.5),
        "b_forget": b_forget,
        "fox_out_g": gain(ks[5], (DEPTH, FOX_WIDTH)),
        "ret_out_g": gain(ks[6], (DEPTH, RET_WIDTH)),
        "w_out": nrm(ks[7], (DEPTH, MIX_WIDTH, D_MODEL), MIX_WIDTH ** -0.5),
        "ffn_norm_g": gain(ks[8], (DEPTH, D_MODEL)),
        "w_router_group": nrm(ks[9], (DEPTH, D_MODEL, N_GROUPS), D_MODEL ** -0.5),
        "b_router_group": nrm(ks[10], (DEPTH, N_GROUPS), 0.01),
        "w_router_expert": nrm(ks[11], (DEPTH, D_MODEL, N_EXPERTS), D_MODEL ** -0.5),
        "b_router_expert": nrm(ks[12], (DEPTH, N_EXPERTS), 0.01),
        "w_gate": nrm(ks[13], (DEPTH, N_EXPERTS, D_MODEL, D_EXPERT), D_MODEL ** -0.5),
        "w_up": nrm(ks[14], (DEPTH, N_EXPERTS, D_MODEL, D_EXPERT), D_MODEL ** -0.5),
        "w_down": nrm(ks[15], (DEPTH, N_EXPERTS, D_EXPERT, D_MODEL), D_EXPERT ** -0.5),
        "final_norm_g": gain(ks[16], (D_MODEL,)),
    }


def reference(x, meta_tokens, attn_norm_g, w_in, b_forget, fox_out_g, ret_out_g, w_out,
              ffn_norm_g, w_router_group, b_router_group, w_router_expert, b_router_expert,
              w_gate, w_up, w_down, final_norm_g):
    b = x.shape[0]
    dt = x.dtype
    h = jnp.concatenate([
        jnp.zeros((b, PAD, D_MODEL), dt),
        jnp.broadcast_to(meta_tokens.astype(dt)[None], (b, N_META, D_MODEL)),
        x], axis=1)
    p = h.shape[1]
    pos = jnp.arange(p)
    valid = pos >= PAD
    log_gamma = jnp.log(1.0 - 2.0 ** (-5.0 - jnp.arange(N_RET_HEADS, dtype=jnp.float32)))
    angle = 1.0 / (RET_ROPE_BASE ** jnp.linspace(0.0, 1.0, HEAD_DIM // 2, dtype=jnp.float32))
    angle = jnp.repeat(angle, 2)
    phase = (pos - PAD).astype(jnp.float32)[:, None] * angle[None, :]
    sin = jnp.sin(phase).astype(dt)
    cos = jnp.cos(phase).astype(dt)
    offsets = list(np.cumsum(SPLITS)[:-1])

    for l in range(DEPTH):
        hn = rmsnorm(h, attn_norm_g[l])
        u = hn @ w_in[l]
        fq, fk, fv, flog, rq, rk, rv, rg = jnp.split(u, offsets, axis=-1)
        log_f = jax.nn.log_sigmoid(flog.astype(jnp.float32) + b_forget[l].astype(jnp.float32))
        log_f = log_f.transpose(0, 2, 1)
        o_fox = forgetting_attention(to_heads(fq, N_FOX_HEADS), to_heads(fk, N_FOX_HEADS),
                                     to_heads(fv, N_FOX_HEADS), log_f, valid)
        o_fox = rmsnorm(o_fox.transpose(0, 2, 1, 3).reshape(b, p, FOX_WIDTH), fox_out_g[l])
        qr = to_heads(rq, N_RET_HEADS)
        kr = to_heads(rk, N_RET_HEADS) * (HEAD_DIM ** -0.5)
        qr = qr * cos + rotate_every_two(qr) * sin
        kr = (kr * cos + rotate_every_two(kr) * sin) * valid[None, None, :, None].astype(dt)
        o_ret = retention_chunkwise(qr, kr, to_heads(rv, N_RET_HEADS), log_gamma)
        of = o_ret.astype(jnp.float32)
        mu = jnp.mean(of, axis=-1, keepdims=True)
        var = jnp.mean(jnp.square(of - mu), axis=-1, keepdims=True)
        of = (of - mu) * lax.rsqrt(var + EPS)
        of = of.transpose(0, 2, 1, 3).reshape(b, p, RET_WIDTH) * ret_out_g[l].astype(jnp.float32)
        o_ret = (of.astype(dt) * jax.nn.silu(rg))
        h = h + jnp.concatenate([o_fox, o_ret], axis=-1) @ w_out[l]
        hn2 = rmsnorm(h, ffn_norm_g[l])
        h = h + hierarchical_moe(hn2, w_router_group[l], b_router_group[l], w_router_expert[l],
                                 b_router_expert[l], w_gate[l], w_up[l], w_down[l])

    h = rmsnorm(h, final_norm_g)
    return h[:, BLOCK:, :]
```

```cpp
#include <hip/hip_runtime.h>
#include <cstdio>
#include <cstdint>

#define LAS __attribute__((address_space(3)))
#define GAS __attribute__((address_space(1)))
typedef unsigned short bf16;
typedef short bf16x8 __attribute__((ext_vector_type(8)));
typedef float f32x4 __attribute__((ext_vector_type(4)));
typedef float f32x2 __attribute__((ext_vector_type(2)));
typedef unsigned u32x4 __attribute__((ext_vector_type(4)));
typedef unsigned u32x2 __attribute__((ext_vector_type(2)));

constexpr int NB = 4, SEQ = 4096, DM = 2048, PADN = 112, NMETA = 16, PP = SEQ + 128, HD = 128, NH = 8;
constexpr int MTOK = NB * SEQ;
constexpr int INC = 7176;
constexpr int NIN = 7168;
constexpr int NEXP = 16, DE = 1024, NCLS = 24, CLS_CAP = 16384;
constexpr float EPS = 1e-6f;
constexpr float SCALE = 0.08838834764831845f;

constexpr size_t MiB = 1u << 20;
constexpr size_t WS_CTL = 0, CTL_ZERO_BYTES = 1 * MiB;
constexpr size_t WS_LOGF = 1 * MiB;
constexpr size_t WS_CUM = WS_LOGF + 1 * MiB;
constexpr size_t WS_SSQ = WS_CUM + 1 * MiB;
constexpr size_t WS_ROPE = WS_SSQ + 1 * MiB;
constexpr size_t WS_WRT = WS_ROPE + 3 * MiB;
constexpr size_t WS_HNMETA = WS_WRT + 1 * MiB;
constexpr size_t WS_TOK = WS_HNMETA + 1 * MiB;
constexpr size_t WS_WLO = WS_TOK + 2 * MiB;
constexpr size_t WS_WHI = WS_WLO + 2 * MiB;
constexpr size_t WS_WINT = 16 * MiB;
constexpr size_t WS_WOUTT = 44 * MiB;
constexpr size_t WS_WGU = 52 * MiB;
constexpr size_t WS_WD = 180 * MiB;
constexpr size_t WS_HN = 244 * MiB;
constexpr size_t WS_U = 308 * MiB;
constexpr size_t USTR = (size_t)NB * PP * 1024;
constexpr size_t WS_END = WS_U + 7 * 33 * MiB;
static_assert(WS_WHI + 2 * MiB <= WS_WINT && USTR * 2 == 33 * MiB, "ws map");
constexpr int CW_BAR = 4096;
constexpr int CW_CNT = 16384;

constexpr int RING_BYTES = 131072;
constexpr int MISC_OFF = RING_BYTES + 320;
constexpr int TBL_OFF = RING_BYTES + 1024;
constexpr int LDS_BYTES = 147456;
constexpr int NWAVES = 8;

__device__ __forceinline__ unsigned cvt_pk_bf16(float lo, float hi) { unsigned r; asm volatile("v_cvt_pk_bf16_f32 %0, %1, %2" : "=v"(r) : "v"(lo), "v"(hi)); return r; }
__device__ __forceinline__ float bf_lo(unsigned w) { return __uint_as_float(w << 16); }
__device__ __forceinline__ float bf_hi(unsigned w) { return __uint_as_float(w & 0xffff0000u); }
__device__ __forceinline__ float wave_sum(float v) {
#pragma unroll
    for (int o = 1; o < 64; o <<= 1) v += __shfl_xor(v, o);
    return v;
}
__device__ __forceinline__ float wave_max(float v) {
#pragma unroll
    for (int o = 1; o < 64; o <<= 1) v = fmaxf(v, __shfl_xor(v, o));
    return v;
}
#define LDS_WAIT() asm volatile("s_waitcnt lgkmcnt(0)" ::: "memory")
#define VM_WAIT() asm volatile("s_waitcnt vmcnt(0)" ::: "memory")

#define XB_TMO      128
#define XB_XCNT(j)  (256  + 64 * (j))
#define XB_XSUB(j)  (1280 + 64 * (j))
#define XB_XGEN(j)  (2304 + 64 * (j))
#define XB_TOP      3328
#define XB_TOPGEN   3392
#define XCD_BAR_WORDS 3456
#define XB_SPIN_CAP (1u << 21)
__device__ __forceinline__ unsigned xb_ld(unsigned* p)              { return __hip_atomic_load(p, __ATOMIC_RELAXED, __HIP_MEMORY_SCOPE_AGENT); }
__device__ __forceinline__ unsigned xb_add(unsigned* p, unsigned v) { return __hip_atomic_fetch_add(p, v, __ATOMIC_RELAXED, __HIP_MEMORY_SCOPE_AGENT); }
__device__ __forceinline__ unsigned xb_xcc_id() { return (unsigned)__builtin_amdgcn_s_getreg((3 << 11) | 20) & 0xFu; }
#define XB_SPIN(cond, bar) do { unsigned _sp = 0; while (cond) { __builtin_amdgcn_s_sleep(1); \
    if ((++_sp & 255u) == 0u) { if (xb_ld(&(bar)[XB_TMO])) break; if (_sp > XB_SPIN_CAP) { atomicAdd(&(bar)[XB_TMO], 1u); break; } } } } while (0)
struct XcdBarrier { unsigned* bar; unsigned x; volatile LAS unsigned* st; };
__device__ __forceinline__ XcdBarrier xcd_barrier_post(unsigned* bar, volatile LAS unsigned* st) {
    XcdBarrier b; b.bar = bar; b.x = xb_xcc_id(); b.st = st;
    if (threadIdx.x == 0) (void)xb_add(&bar[XB_XCNT(b.x)], 1u);
    return b;
}
__device__ __forceinline__ void xcd_barrier_complete(unsigned* bar, unsigned x, unsigned& nloc, unsigned& nx) {
    const unsigned G = gridDim.x * gridDim.y * gridDim.z;
    unsigned sum, cnt, mine, sp = 0u;
    for (;;) {
        sum = 0u; cnt = 0u; mine = 0u;
#pragma unroll
        for (unsigned j = 0; j < 16; ++j) { const unsigned c = xb_ld(&bar[XB_XCNT(j)]); sum += c; cnt += (c > 0u) ? 1u : 0u; mine = (j == x) ? c : mine; }
        if (sum == G) break;
        __builtin_amdgcn_s_sleep(1);
        if ((++sp & 255u) == 0u) { if (xb_ld(&bar[XB_TMO])) break; if (sp > XB_SPIN_CAP) { atomicAdd(&bar[XB_TMO], 1u); break; } }
    }
    nloc = mine > 0u ? mine : 1u; nx = cnt > 0u ? cnt : 1u;
}
__device__ __forceinline__ void xcd_barrier(const XcdBarrier& b) {
    asm volatile("s_waitcnt vmcnt(0)" ::: "memory");
    __syncthreads();
    if (threadIdx.x == 0) {
        unsigned* bar = b.bar;
        __builtin_amdgcn_s_waitcnt(0);
        unsigned nloc = b.st[0], nx = b.st[1];
        if (nloc == 0u) { xcd_barrier_complete(bar, b.x, nloc, nx); b.st[0] = nloc; b.st[1] = nx; }
        const unsigned old = xb_add(&bar[XB_XSUB(b.x)], 1u);
        const unsigned gen = old / nloc;
        if (old + 1u == (gen + 1u) * nloc) {
            __builtin_amdgcn_fence(__ATOMIC_RELEASE, "agent");
            asm volatile("s_waitcnt vmcnt(0)" ::: "memory");
            const unsigned og = xb_add(&bar[XB_TOP], 1u);
            const unsigned tg = og / nx;
            if (og + 1u == (tg + 1u) * nx) xb_add(&bar[XB_TOPGEN], 1u);
            else XB_SPIN(xb_ld(&bar[XB_TOPGEN]) == tg, bar);
            __builtin_amdgcn_fence(__ATOMIC_ACQUIRE, "agent");
            xb_add(&bar[XB_XGEN(b.x)], 1u);
            asm volatile("s_waitcnt vmcnt(0)" ::: "memory");
        } else {
            XB_SPIN(xb_ld(&bar[XB_XGEN(b.x)]) == gen, bar);
            __builtin_amdgcn_fence(__ATOMIC_ACQUIRE, "agent");
            asm volatile("s_waitcnt vmcnt(0)" ::: "memory");
        }
    }
    __syncthreads();
}

namespace g8 {
constexpr int BM = 256, BK = 64, HALF = 128, HTB = HALF * BK * 2, NXCD = 8, WGM = 8;
__device__ __forceinline__ int lds_byte(int r, int c) { const int st = (r >> 4) * 2 + (c >> 5), rr = r & 15, cc = c & 31, ob = rr * 64 + cc * 2; return st * 1024 + (ob ^ (((ob >> 9) & 1) << 5)); }
__device__ __forceinline__ void stage_rc(int b, int& R, int& C) { const int st = b / 1024, sb = b % 1024, swz = sb ^ (((sb >> 9) & 1) << 5); R = (st >> 1) * 16 + swz / 64; C = (st & 1) * 32 + (swz % 64) / 2; }
__device__ __forceinline__ int perm32(int rho) { const int n = rho >> 4, i = rho & 15; return 8 * (i >> 2) + 4 * n + (i & 3); }

struct Unit { int pm, pn, a0, a1, a2, a3; };

struct StaticOrder {
    int nM, nN, nwg, G, c;
    __device__ void init(int M, int N, int G_, int c_) { nM = M / BM; nN = N / BM; nwg = nM * nN; G = G_; c = c_; }
    __device__ bool next(int i, Unit& u) const {
        const long L = (long)i * G + c; if (L >= nwg) return false;
        int wgid = (int)L; { const int q = nwg / NXCD, r = nwg % NXCD, xcd = wgid % NXCD, off = wgid / NXCD; wgid = (xcd < r ? xcd * (q + 1) : r * (q + 1) + (xcd - r) * q) + off; }
        const int nig = WGM * nN, gid = wgid / nig, fm = gid * WGM, gsz = (nM - fm) < WGM ? (nM - fm) : WGM;
        u.pm = fm + ((wgid % nig) % gsz); u.pn = (wgid % nig) / gsz; u.a0 = u.a1 = u.a2 = u.a3 = 0; return true;
    }
};

template <class P, class Sched, bool ALIGN_EPI>
__device__ __forceinline__ void gemm_phase(LAS unsigned char* lds, const P& p, const Sched& S) {
    const int tid = threadIdx.x, wid = __builtin_amdgcn_readfirstlane(tid >> 6), lane = tid & 63, wr = wid >> 2, wc = wid & 3, fr = lane & 15, fq = lane >> 4;
    const int nt = p.nt;
    int Rr[2], Cc[2]; unsigned voffB[2];
#pragma unroll
    for (int i = 0; i < 2; ++i) { int R, C; stage_rc(tid * 16 + i * 8192, R, C); Rr[i] = R; Cc[i] = C; const int Rb = P::PERM ? ((R & ~31) + perm32(R & 31)) : R;
        voffB[i] = (unsigned)Rb * p.ldb2 + (unsigned)C * 2u; }
    const size_t hstepB = (size_t)HALF * p.ldb2;
    const unsigned ldsw = (unsigned)wid * 1024u;
    const int aoff = lds_byte(wr * 64 + fr, fq * 8), boff = lds_byte(wc * 32 + fr, fq * 8);
#define PG8_SA(b, h) (((b) * 2 + (h)) * HTB)
#define PG8_SB(b, h) ((4 + (b) * 2 + (h)) * HTB)
#define PG8_STAGE(bufoff, gbase, v0, v1) do { \
        __builtin_amdgcn_global_load_lds((const unsigned*)((const char*)(gbase) + (v0)), (LAS unsigned*)(lds + (bufoff) + ldsw), 16, 0, 0); \
        __builtin_amdgcn_global_load_lds((const unsigned*)((const char*)(gbase) + (v1)), (LAS unsigned*)(lds + (bufoff) + ldsw + 8192), 16, 0, 0); } while (0)
#define PG8_LDA(dst, b, h) do { _Pragma("unroll") for (int m = 0; m < 4; ++m) _Pragma("unroll") for (int k = 0; k < 2; ++k) dst[m][k] = *(const LAS bf16x8*)(lds + PG8_SA(b, h) + aoff + m * 2048 + k * 1024); } while (0)
#define PG8_LDB(dst, b, h) do { _Pragma("unroll") for (int n = 0; n < 2; ++n) _Pragma("unroll") for (int k = 0; k < 2; ++k) dst[n][k] = *(const LAS bf16x8*)(lds + PG8_SB(b, h) + boff + n * 2048 + k * 1024); } while (0)
#define PG8_MMA(ai, bj, At, Bt) do { __builtin_amdgcn_s_setprio(1); _Pragma("unroll") for (int m = 0; m < 4; ++m) _Pragma("unroll") for (int n = 0; n < 2; ++n) _Pragma("unroll") for (int k = 0; k < 2; ++k) \
        acc[ai][bj][m][n] = __builtin_amdgcn_mfma_f32_16x16x32_bf16(Bt[n][k], At[m][k], acc[ai][bj][m][n], 0, 0, 0); __builtin_amdgcn_s_setprio(0); } while (0)
#define PG8_WAIT_V(n) asm volatile("s_waitcnt vmcnt(" #n ")" ::: "memory")
#define PG8_WAIT_L(n) asm volatile("s_waitcnt lgkmcnt(" #n ")" ::: "memory")
#define PG8_BAR __builtin_amdgcn_s_barrier()
#define PG8_SCHED __builtin_amdgcn_sched_barrier(0)
    Unit cur, nxt; int ui = 0;
    if (!S.next(0, cur)) return;
    f32x4 acc[2][2][4][2];
#pragma unroll
    for (int a = 0; a < 2; ++a)
#pragma unroll
        for (int b = 0; b < 2; ++b)
#pragma unroll
            for (int m = 0; m < 4; ++m)
#pragma unroll
                for (int n = 0; n < 2; ++n) acc[a][b][m][n] = (f32x4){0.f, 0.f, 0.f, 0.f};
    bf16x8 At[4][2], B0[2][2], B1[2][2];
    unsigned oc[2][2], on[2][2];
    p.a_offs(cur, Rr, Cc, oc);
    const char* const A0 = p.Abase;
    {
        const char* b0 = p.b_tile(cur, 0); const char* b1 = p.b_tile(cur, 1);
        PG8_STAGE(PG8_SB(0, 0), b0, voffB[0], voffB[1]); PG8_STAGE(PG8_SB(0, 1), b0 + hstepB, voffB[0], voffB[1]);
        PG8_STAGE(PG8_SA(0, 0), A0, oc[0][0], oc[0][1]); PG8_STAGE(PG8_SA(0, 1), A0, oc[1][0], oc[1][1]);
        if (wr == 1) PG8_BAR;
        PG8_WAIT_V(2); PG8_BAR;
        PG8_STAGE(PG8_SB(1, 0), b1, voffB[0], voffB[1]); PG8_STAGE(PG8_SA(1, 0), A0 + 128, oc[0][0], oc[0][1]); PG8_STAGE(PG8_SB(1, 1), b1 + hstepB, voffB[0], voffB[1]);
        PG8_WAIT_V(6); PG8_BAR;
    }
    for (;;) {
        const bool has_next = S.next(ui + 1, nxt);
        if (has_next) p.a_offs(nxt, Rr, Cc, on);
        else { on[0][0] = oc[0][0]; on[0][1] = oc[0][1]; on[1][0] = oc[1][0]; on[1][1] = oc[1][1]; nxt = cur; }
        for (int t = 0; t < nt; t += 2) {
            const bool last = (t == nt - 2);
            if constexpr (P::HAS_MID) { if (t == (nt >> 1)) p.mid(acc, cur, wr, wc, fr, fq); }
            const char* a1 = A0 + (size_t)(t + 1) * 128;
            const char* a2 = last ? A0 : A0 + (size_t)(t + 2) * 128; const char* a3 = a2 + 128;
            const unsigned o200 = last ? on[0][0] : oc[0][0], o201 = last ? on[0][1] : oc[0][1], o210 = last ? on[1][0] : oc[1][0], o211 = last ? on[1][1] : oc[1][1];
            const char* b2 = last ? p.b_tile(nxt, 0) : p.b_tile(cur, t + 2); const char* b3 = last ? p.b_tile(nxt, 1) : p.b_tile(cur, t + 3);
            PG8_LDB(B0, 0, 0); PG8_LDB(B1, 0, 1); PG8_SCHED; PG8_LDA(At, 0, 0); PG8_STAGE(PG8_SA(1, 1), a1, oc[1][0], oc[1][1]);
            PG8_WAIT_V(8); PG8_WAIT_L(0); PG8_BAR; PG8_MMA(0, 0, At, B0); PG8_MMA(0, 1, At, B1); PG8_BAR; PG8_SCHED;
            PG8_LDA(At, 0, 1); PG8_STAGE(PG8_SB(0, 0), b2, voffB[0], voffB[1]); PG8_STAGE(PG8_SB(0, 1), b2 + hstepB, voffB[0], voffB[1]); PG8_STAGE(PG8_SA(0, 0), a2, o200, o201);
            PG8_WAIT_V(8); PG8_WAIT_L(0); PG8_BAR; PG8_MMA(1, 0, At, B0); PG8_MMA(1, 1, At, B1); PG8_BAR; PG8_SCHED;
            PG8_LDB(B0, 1, 0); PG8_LDB(B1, 1, 1); PG8_SCHED; PG8_LDA(At, 1, 0); PG8_STAGE(PG8_SA(0, 1), a2, o210, o211);
            PG8_WAIT_V(8); PG8_WAIT_L(0); PG8_BAR; PG8_MMA(0, 0, At, B0); PG8_MMA(0, 1, At, B1); PG8_BAR; PG8_SCHED;
            PG8_LDA(At, 1, 1); PG8_STAGE(PG8_SB(1, 0), b3, voffB[0], voffB[1]); PG8_STAGE(PG8_SB(1, 1), b3 + hstepB, voffB[0], voffB[1]); PG8_STAGE(PG8_SA(1, 0), a3, o200, o201);
            PG8_WAIT_V(8); PG8_WAIT_L(0); PG8_BAR; PG8_MMA(1, 0, At, B0); PG8_MMA(1, 1, At, B1); PG8_BAR; PG8_SCHED;
        }
        if constexpr (ALIGN_EPI) { if (wr == 0) PG8_BAR; }
        p.epi(acc, cur, wr, wc, fr, fq);
        if (!has_next) break;
#pragma unroll
        for (int a = 0; a < 2; ++a)
#pragma unroll
            for (int b = 0; b < 2; ++b)
#pragma unroll
                for (int m = 0; m < 4; ++m)
#pragma unroll
                    for (int n = 0; n < 2; ++n) acc[a][b][m][n] = (f32x4){0.f, 0.f, 0.f, 0.f};
        cur = nxt; oc[0][0] = on[0][0]; oc[0][1] = on[0][1]; oc[1][0] = on[1][0]; oc[1][1] = on[1][1]; ++ui;
        if constexpr (ALIGN_EPI) { if (wr == 1) PG8_BAR; }
    }
    PG8_WAIT_V(0);
    if constexpr (!ALIGN_EPI) { if (wr == 0) PG8_BAR; }
    PG8_BAR;
#undef PG8_SA
#undef PG8_SB
#undef PG8_STAGE
#undef PG8_LDA
#undef PG8_LDB
#undef PG8_MMA
#undef PG8_WAIT_V
#undef PG8_WAIT_L
#undef PG8_BAR
#undef PG8_SCHED
}
}

struct Frame {
    LAS unsigned char* lds;
    volatile LAS unsigned* MISC;
    unsigned* ctl;
    int tid, lane, wave, vcu, G;
    const float* in[17];
    float* out;
    unsigned char* ws;
};

__device__ __forceinline__ void p0_transpose_item(const float* W, int ldw, int K, bf16* WT, int k0, int scol0, int drow0, const float* kscale, LAS float* scr, int lane) {
#pragma unroll 8
    for (int i = 0; i < 32; ++i) { const int kk = 2 * i + (lane >> 5); float v = W[(size_t)(k0 + kk) * ldw + scol0 + (lane & 31)]; if (kscale) v *= kscale[k0 + kk]; scr[kk * 33 + (lane & 31)] = v; }
    LDS_WAIT(); asm volatile("" ::: "memory");
    const int c = lane & 7;
#pragma unroll
    for (int j = 0; j < 4; ++j) { const int n = (lane >> 3) + 8 * j; const LAS float* s = scr + (8 * c) * 33 + n;
        u32x4 o; o.x = cvt_pk_bf16(s[0 * 33], s[1 * 33]); o.y = cvt_pk_bf16(s[2 * 33], s[3 * 33]); o.z = cvt_pk_bf16(s[4 * 33], s[5 * 33]); o.w = cvt_pk_bf16(s[6 * 33], s[7 * 33]);
        *(u32x4*)(WT + (size_t)(drow0 + n) * K + k0 + 8 * c) = o; }
    LDS_WAIT(); asm volatile("" ::: "memory");
}

__device__ __forceinline__ float log_sigmoid(float x) { return fminf(x, 0.f) - log1pf(__expf(-fabsf(x))); }

__device__ __forceinline__ void p0_prologue(Frame& F) {
    const int gw = F.vcu * NWAVES + F.wave, NGW = F.G * NWAVES, lane = F.lane;
    const int gt = F.vcu * 512 + F.tid, NGT = F.G * 512;
    {
        LAS float* scr = (LAS float*)(F.lds + F.wave * 16384);
        const float* w_in = F.in[3]; const float* w_out = F.in[7]; const float* w_gate = F.in[13]; const float* w_up = F.in[14]; const float* w_down = F.in[15];
        bf16* WINT = (bf16*)(F.ws + WS_WINT); bf16* WOUTT = (bf16*)(F.ws + WS_WOUTT); bf16* WGU = (bf16*)(F.ws + WS_WGU); bf16* WD = (bf16*)(F.ws + WS_WD);
        constexpr int I_IN = 32 * 224, I_OUT = 32 * 64, I_G = 16 * 32 * 32, I_D = 16 * 16 * 64;
        constexpr int NITEMS = I_IN + I_OUT + 2 * I_G + I_D;
        for (int it = gw; it < NITEMS; it += NGW) {
            int r = it;
            if (r < I_IN) { const int kb = r / 224, nb = r % 224, n0 = nb * 32; p0_transpose_item(w_in, INC, DM, WINT, kb * 64, n0 + (n0 >= 3072 ? 8 : 0), n0, nullptr, scr, lane); continue; } r -= I_IN;
            if (r < I_OUT) { const int kb = r / 64, nb = r % 64; const float* ks = (kb < 16) ? F.in[5] : (F.in[6] - 1024); p0_transpose_item(w_out, DM, DM, WOUTT, kb * 64, nb * 32, nb * 32, ks, scr, lane); continue; } r -= I_OUT;
            if (r < 2 * I_G) { const int up = r >= I_G; if (up) r -= I_G; const int e = r / 1024, q = r % 1024, kb = q / 32, nb = q % 32, n0 = nb * 32;
                p0_transpose_item((up ? w_up : w_gate) + (size_t)e * DM * DE, DE, DM, WGU + (size_t)e * 2048 * DM, kb * 64, n0, (n0 >> 7) * 256 + up * 128 + (n0 & 127), nullptr, scr, lane); continue; } r -= 2 * I_G;
            { const int e = r / 1024, q = r % 1024, kb = q / 64, nb = q % 64; p0_transpose_item(w_down + (size_t)e * DE * DM, DM, DE, WD + (size_t)e * DM * DE, kb * 64, nb * 32, nb * 32, nullptr, scr, lane); }
        }
    }
    {
        float* WRT = (float*)(F.ws + WS_WRT); const float* g2 = F.in[8]; const float* wrg = F.in[9]; const float* wre = F.in[11];
        for (int i = gt; i < 20 * DM; i += NGT) { const int j = i / DM, k = i % DM; WRT[i] = g2[k] * (j < 4 ? wrg[k * 4 + j] : wre[k * 16 + (j - 4)]); }
        f32x2* ROPE = (f32x2*)(F.ws + WS_ROPE);
        for (int i = gt; i < 4112 * 64; i += NGT) { const int pos = i >> 6, k = i & 63;
            const float lin = (float)k * (1.0f / 63.0f); const float ang = 1.0f / exp2f(lin * 13.287712379549449f);
            const float ph = (float)pos * ang; const double rev = (double)ph * 0.15915494309189535; const float fr = (float)(rev - floor(rev));
            ROPE[i] = (f32x2){__builtin_amdgcn_cosf(fr), __builtin_amdgcn_sinf(fr)}; }
        bf16* U = (bf16*)(F.ws + WS_U);
        for (int i = gt; i < 4 * NB * PADN * 128; i += NGT) { const int c8 = i & 127, row = (i >> 7) % PADN, bb = ((i >> 7) / PADN) % NB, cl = (i >> 7) / (PADN * NB);
            const int cls = (cl == 0) ? 1 : (cl == 1) ? 2 : (cl == 2) ? 4 : 5;
            *(u32x4*)(U + cls * USTR + ((size_t)(bb * PP + row)) * 1024 + c8 * 8) = (u32x4){0u, 0u, 0u, 0u}; }
        float* LOGF = (float*)(F.ws + WS_LOGF);
        for (int i = gt; i < 32 * PADN; i += NGT) LOGF[(i / PADN) * PP + (i % PADN)] = 0.f;
    }
    __syncthreads();
    {
        LAS float* WF = (LAS float*)F.lds; const float* w_in = F.in[3]; const float* g1 = F.in[2];
        for (int i = F.tid; i < 8 * DM; i += 512) { const int k = i >> 3, h = i & 7; WF[h * DM + k] = g1[k] * w_in[(size_t)k * INC + 3072 + h]; }
        __syncthreads();
        f32x4 gv[8];
#pragma unroll
        for (int j = 0; j < 8; ++j) gv[j] = *((const f32x4*)g1 + lane + 64 * j);
        bf16* HN = (bf16*)(F.ws + WS_HN); bf16* HNMETA = (bf16*)(F.ws + WS_HNMETA); float* LOGF = (float*)(F.ws + WS_LOGF); const float* bfv = F.in[4];
        for (int row = gw; row < MTOK + NMETA; row += NGW) {
            const bool meta = row >= MTOK; const int mj = row - MTOK;
            const float* xr = meta ? (F.in[1] + (size_t)mj * DM) : (F.in[0] + (size_t)row * DM);
            f32x4 v[8]; float ss = 0.f;
#pragma unroll
            for (int j = 0; j < 8; ++j) { v[j] = *((const f32x4*)xr + lane + 64 * j); ss += (v[j].x * v[j].x + v[j].y * v[j].y) + (v[j].z * v[j].z + v[j].w * v[j].w); }
            const float rs = 1.0f / sqrtf(wave_sum(ss) * (1.0f / DM) + EPS);
            float fl[8];
#pragma unroll
            for (int h = 0; h < 8; ++h) { float s = 0.f;
#pragma unroll
                for (int j = 0; j < 8; ++j) { const f32x4 w = *((const LAS f32x4*)(WF + h * DM) + lane + 64 * j); s += (v[j].x * w.x + v[j].y * w.y) + (v[j].z * w.z + v[j].w * w.w); }
                fl[h] = wave_sum(s) * rs; }
            bf16* orow = meta ? (HNMETA + (size_t)mj * DM) : (HN + (size_t)row * DM);
#pragma unroll
            for (int j = 0; j < 8; ++j) { const f32x4 y = v[j] * rs * gv[j]; u32x2 w; w.x = cvt_pk_bf16(y.x, y.y); w.y = cvt_pk_bf16(y.z, y.w); *((u32x2*)orow + lane + 64 * j) = w; }
            if (lane < 8) { float f = fl[0];
#pragma unroll
                for (int h = 1; h < 8; ++h) f = (lane == h) ? fl[h] : f;
                const float lf = log_sigmoid(f + bfv[lane]);
                if (meta) { for (int bb = 0; bb < NB; ++bb) LOGF[(bb * NH + lane) * PP + PADN + mj] = lf; }
                else { const int bb = row >> 12, t = row & 4095; LOGF[(bb * NH + lane) * PP + 128 + t] = lf; } }
        }
    }
}

__device__ __forceinline__ void p1_cumsum(Frame& F) {
    const int gw = F.vcu * NWAVES + F.wave, NGW = F.G * NWAVES, lane = F.lane;
    const float* LOGF = (const float*)(F.ws + WS_LOGF); float* CUM = (float*)(F.ws + WS_CUM);
    for (int s = gw; s < NB * NH; s += NGW) {
        const float* src = LOGF + (size_t)s * PP + lane * 66; float* dst = CUM + (size_t)s * PP + lane * 66;
        float loc = 0.f; for (int i = 0; i < 66; ++i) loc += src[i];
        float inc = loc;
#pragma unroll
        for (int o = 1; o < 64; o <<= 1) { const float t = __shfl_up(inc, o); if (lane >= o) inc += t; }
        float run = inc - loc;
        for (int i = 0; i < 66; ++i) { run += src[i]; dst[i] = run; }
    }
}
__device__ __forceinline__ void p1_meta_kv(Frame& F) {
    const int lane = F.lane, w = F.wave;
    const bf16* HNMETA = (const bf16*)(F.ws + WS_HNMETA); const bf16* WINT = (const bf16*)(F.ws + WS_WINT); bf16* U = (bf16*)(F.ws + WS_U);
    const f32x2* ROPE = (const f32x2*)(F.ws + WS_ROPE);
    LAS float* red = (LAS float*)F.lds;
    for (int blk = blockIdx.x; blk < 256; blk += F.G) {
        const int kv0 = blk * 16, q = kv0 >> 10, col0 = kv0 & 1023;
        const int cls = (q == 0) ? 1 : (q == 1) ? 2 : (q == 2) ? 4 : 5;
        const int nrow0 = ((q == 0) ? 1024 : (q == 1) ? 2048 : (q == 2) ? 4096 : 5120) + col0;
        f32x4 acc = (f32x4){0.f, 0.f, 0.f, 0.f};
#pragma unroll
        for (int s = 0; s < 8; ++s) { const int k0 = w * 256 + s * 32 + 8 * (lane >> 4);
            const bf16x8 a = *(const bf16x8*)(HNMETA + (size_t)(lane & 15) * DM + k0);
            const bf16x8 b = *(const bf16x8*)(WINT + (size_t)(nrow0 + (lane & 15)) * DM + k0);
            acc = __builtin_amdgcn_mfma_f32_16x16x32_bf16(a, b, acc, 0, 0, 0); }
#pragma unroll
        for (int r = 0; r < 4; ++r) red[w * 256 + ((lane >> 4) * 4 + r) * 16 + (lane & 15)] = acc[r];
        __syncthreads();
        if (F.tid < 256) { const int row = F.tid >> 4, col = F.tid & 15;
            float v = 0.f, vp = 0.f;
#pragma unroll
            for (int ww = 0; ww < 8; ++ww) { v += red[ww * 256 + row * 16 + col]; vp += red[ww * 256 + row * 16 + (col ^ 1)]; }
            float o = v;
            if (q == 2) { const int d = (col0 + col) & 127; const f32x2 cs = ROPE[row * 64 + (d >> 1)];
                o = ((col & 1) ? (v * cs.x + vp * cs.y) : (v * cs.x - vp * cs.y)) * SCALE; }
            const unsigned short ob = (unsigned short)(cvt_pk_bf16(o, 0.f) & 0xffffu);
            for (int bb = 0; bb < NB; ++bb) U[cls * USTR + ((size_t)(bb * PP + PADN + row)) * 1024 + col0 + col] = ob; }
        __syncthreads();
    }
}

struct PInProj {
    static constexpr bool PERM = true, HAS_MID = false;
    int nt; const char* Abase; unsigned ldb2; const char* Bt; bf16* U; const f32x2* ROPE;
    __device__ __forceinline__ void a_offs(const g8::Unit& u, const int (&R)[2], const int (&C)[2], unsigned (&o)[2][2]) const {
#pragma unroll
        for (int h = 0; h < 2; ++h)
#pragma unroll
            for (int i = 0; i < 2; ++i) o[h][i] = (unsigned)(((u.pm * 256 + h * 128 + R[i]) * DM + C[i]) * 2);
    }
    __device__ __forceinline__ const char* b_tile(const g8::Unit& u, int t) const { return Bt + (size_t)u.pn * 256 * ldb2 + (size_t)t * 128; }
    __device__ __forceinline__ void mid(f32x4 (&)[2][2][4][2], const g8::Unit&, int, int, int, int) const {}
    __device__ __forceinline__ void epi(const f32x4 (&acc)[2][2][4][2], const g8::Unit& u, int wr, int wc, int fr, int fq) const {
        const int cls = u.pn >> 2;
        bf16* base = U + (size_t)cls * USTR;
        const int ccol0 = (u.pn & 3) * 256 + wc * 32 + 8 * fq;
        const int bb = u.pm >> 4;
#pragma unroll
        for (int ai = 0; ai < 2; ++ai)
#pragma unroll
            for (int m = 0; m < 4; ++m) {
                const int t = ((u.pm & 15) << 8) + ai * 128 + wr * 64 + m * 16 + fr;
                bf16* rowp = base + ((size_t)(bb * PP + 128 + t)) * 1024 + ccol0;
                f32x4 c0 = (f32x4){1.f, 0.f, 1.f, 0.f}, c1 = c0;
                if (cls == 3 || cls == 4) { const f32x4* rp = (const f32x4*)(ROPE + (size_t)(t + 16) * 64 + wc * 16 + fq * 4); c0 = rp[0]; c1 = rp[1]; }
#pragma unroll
                for (int bj = 0; bj < 2; ++bj) {
                    f32x4 v0 = acc[ai][bj][m][0], v1 = acc[ai][bj][m][1];
                    if (cls == 3 || cls == 4) {
                        f32x4 r0, r1;
                        r0.x = v0.x * c0.x - v0.y * c0.y; r0.y = v0.y * c0.x + v0.x * c0.y; r0.z = v0.z * c0.z - v0.w * c0.w; r0.w = v0.w * c0.z + v0.z * c0.w;
                        r1.x = v1.x * c1.x - v1.y * c1.y; r1.y = v1.y * c1.x + v1.x * c1.y; r1.z = v1.z * c1.z - v1.w * c1.w; r1.w = v1.w * c1.z + v1.z * c1.w;
                        const float sc = (cls == 4) ? SCALE : 1.f; v0 = r0 * sc; v1 = r1 * sc;
                    } else if (cls == 6) {
#pragma unroll
                        for (int e = 0; e < 4; ++e) { v0[e] = v0[e] / (1.f + __expf(-v0[e])); v1[e] = v1[e] / (1.f + __expf(-v1[e])); }
                    }
                    u32x4 w; w.x = cvt_pk_bf16(v0[0], v0[1]); w.y = cvt_pk_bf16(v0[2], v0[3]); w.z = cvt_pk_bf16(v1[0], v1[1]); w.w = cvt_pk_bf16(v1[2], v1[3]);
                    *(u32x4*)(rowp + bj * 128) = w;
                }
            }
    }
};

template <bool RET>
__device__ __forceinline__ void attn_simple(Frame& F) {
    const int gw = F.vcu * NWAVES + F.wave, NGW = F.G * NWAVES, lane = F.lane;
    LAS float* wl = (LAS float*)(F.lds + F.wave * 1024);
    const bf16* U = (const bf16*)(F.ws + WS_U); const float* CUM = (const float*)(F.ws + WS_CUM);
    bf16* OA = (bf16*)(F.ws + WS_HN); float* SSQ = (float*)(F.ws + WS_SSQ);
    for (int row = gw; row < NB * NH * SEQ; row += NGW) {
        const int t = row & 4095, bh = row >> 12, b = bh >> 3, h = bh & 7, p = 128 + t, m = b * SEQ + t;
        const bf16* Qb = U + (RET ? 3 : 0) * USTR + ((size_t)(b * PP + p)) * 1024 + h * 128;
        const bf16* Kb = U + (RET ? 4 : 1) * USTR + ((size_t)b * PP) * 1024 + h * 128;
        const bf16* Vb = U + (RET ? 5 : 2) * USTR + ((size_t)b * PP) * 1024 + h * 128;
        { const unsigned qw = *(const unsigned*)(Qb + 2 * lane); wl[2 * lane] = bf_lo(qw); wl[2 * lane + 1] = bf_hi(qw); }
        LDS_WAIT(); asm volatile("" ::: "memory");
        float m_run = -1e30f, l_run = 0.f, o0 = 0.f, o1 = 0.f;
        const float ct = RET ? 0.f : CUM[(size_t)bh * PP + p];
        const float lg2 = RET ? log2f(1.0f - exp2f(-5.0f - (float)h)) : 0.f;
        for (int s0 = 64; s0 <= p; s0 += 64) {
            const int s = s0 + lane;
            const bf16* kr = Kb + (size_t)s * 1024;
            float sc = 0.f;
#pragma unroll
            for (int c = 0; c < 16; ++c) { const u32x4 kv = *(const u32x4*)(kr + 8 * c); const f32x4 qa = *(const LAS f32x4*)(wl + 8 * c), qb = *(const LAS f32x4*)(wl + 8 * c + 4);
                sc += bf_lo(kv.x) * qa.x + bf_hi(kv.x) * qa.y + bf_lo(kv.y) * qa.z + bf_hi(kv.y) * qa.w + bf_lo(kv.z) * qb.x + bf_hi(kv.z) * qb.y + bf_lo(kv.w) * qb.z + bf_hi(kv.w) * qb.w; }
            const bool valid = (s <= p) && (s >= PADN);
            float pw;
            if constexpr (RET) { pw = valid ? sc * exp2f((float)(p - s) * lg2) : 0.f; }
            else {
                const float lg = valid ? (sc * SCALE + (ct - CUM[(size_t)bh * PP + s])) : -__builtin_inff();
                const float mn = fmaxf(m_run, wave_max(lg)); const float alpha = __expf(m_run - mn);
                pw = valid ? __expf(lg - mn) : 0.f;
                l_run = l_run * alpha + wave_sum(pw); o0 *= alpha; o1 *= alpha; m_run = mn;
            }
            asm volatile("" ::: "memory");
            wl[128 + lane] = pw;
            LDS_WAIT(); asm volatile("" ::: "memory");
#pragma unroll 8
            for (int k = 0; k < 64; ++k) { const float pk = wl[128 + k]; const unsigned vw = *(const unsigned*)(Vb + (size_t)(s0 + k) * 1024 + 2 * lane); o0 += pk * bf_lo(vw); o1 += pk * bf_hi(vw); }
            LDS_WAIT(); asm volatile("" ::: "memory");
        }
        if constexpr (RET) {
            const float mu = wave_sum(o0 + o1) * (1.0f / HD); const float d0 = o0 - mu, d1 = o1 - mu;
            const float var = wave_sum(d0 * d0 + d1 * d1) * (1.0f / HD); const float r = 1.0f / sqrtf(var + EPS);
            const unsigned gw2 = *(const unsigned*)(U + 6 * USTR + ((size_t)(b * PP + p)) * 1024 + h * 128 + 2 * lane);
            *(unsigned*)(OA + (size_t)m * DM + 1024 + h * 128 + 2 * lane) = cvt_pk_bf16(d0 * r * bf_lo(gw2), d1 * r * bf_hi(gw2));
        } else {
            const float il = 1.0f / l_run; o0 *= il; o1 *= il;
            *(unsigned*)(OA + (size_t)m * DM + h * 128 + 2 * lane) = cvt_pk_bf16(o0, o1);
            const float sq = wave_sum(o0 * o0 + o1 * o1); if (lane == 0) SSQ[(size_t)m * 8 + h] = sq;
        }
        asm volatile("" ::: "memory");
    }
}

struct POutProj {
    static constexpr bool PERM = false, HAS_MID = true;
    int nt; const char* Abase; unsigned ldb2; const char* Bt; const float* x; float* out; const float* SSQ;
    __device__ __forceinline__ void a_offs(const g8::Unit& u, const int (&R)[2], const int (&C)[2], unsigned (&o)[2][2]) const {
#pragma unroll
        for (int h = 0; h < 2; ++h)
#pragma unroll
            for (int i = 0; i < 2; ++i) o[h][i] = (unsigned)(((u.pm * 256 + h * 128 + R[i]) * DM + C[i]) * 2);
    }
    __device__ __forceinline__ const char* b_tile(const g8::Unit& u, int t) const { return Bt + (size_t)u.pn * 256 * ldb2 + (size_t)t * 128; }
    __device__ __forceinline__ void mid(f32x4 (&acc)[2][2][4][2], const g8::Unit& u, int wr, int wc, int fr, int fq) const {
#pragma unroll
        for (int ai = 0; ai < 2; ++ai)
#pragma unroll
            for (int m = 0; m < 4; ++m) { const int r = u.pm * 256 + ai * 128 + wr * 64 + m * 16 + fr;
                const f32x4 s0 = *(const f32x4*)(SSQ + (size_t)r * 8), s1 = *(const f32x4*)(SSQ + (size_t)r * 8 + 4);
                const float rs = 1.0f / sqrtf(((s0.x + s0.y) + (s0.z + s0.w) + (s1.x + s1.y) + (s1.z + s1.w)) * (1.0f / 1024.0f) + EPS);
#pragma unroll
                for (int bj = 0; bj < 2; ++bj)
#pragma unroll
                    for (int n = 0; n < 2; ++n) acc[ai][bj][m][n] = acc[ai][bj][m][n] * rs; }
    }
    __device__ __forceinline__ void epi(const f32x4 (&acc)[2][2][4][2], const g8::Unit& u, int wr, int wc, int fr, int fq) const {
        const int row0 = u.pm * 256 + wr * 64 + fr, col0 = u.pn * 256 + wc * 32 + 4 * fq;
#pragma unroll
        for (int ai = 0; ai < 2; ++ai)
#pragma unroll
            for (int m = 0; m < 4; ++m) { const size_t off = (size_t)(row0 + ai * 128 + m * 16) * DM + col0;
#pragma unroll
                for (int bj = 0; bj < 2; ++bj)
#pragma unroll
                    for (int n = 0; n < 2; ++n) *(f32x4*)(out + off + bj * 128 + n * 16) = *(const f32x4*)(x + off + bj * 128 + n * 16) + acc[ai][bj][m][n]; }
    }
};

__device__ __forceinline__ void p4_router(Frame& F) {
    const int gw = F.vcu * NWAVES + F.wave, NGW = F.G * NWAVES, lane = F.lane;
    const float* H1 = F.out; const float* g2 = F.in[8]; const float* WRT = (const float*)(F.ws + WS_WRT);
    const float* brg = F.in[10]; const float* bre = F.in[12];
    bf16* HN2 = (bf16*)(F.ws + WS_HN); int* TOK = (int*)(F.ws + WS_TOK); float* WLO = (float*)(F.ws + WS_WLO); float* WHI = (float*)(F.ws + WS_WHI);
    for (int row = gw; row < MTOK; row += NGW) {
        const float* xr = H1 + (size_t)row * DM;
        f32x4 v[8]; float ss = 0.f;
#pragma unroll
        for (int j = 0; j < 8; ++j) { v[j] = *((const f32x4*)xr + lane + 64 * j); ss += (v[j].x * v[j].x + v[j].y * v[j].y) + (v[j].z * v[j].z + v[j].w * v[j].w); }
        const float rs = 1.0f / sqrtf(wave_sum(ss) * (1.0f / DM) + EPS);
        float mylg = 0.f;
#pragma unroll 1
        for (int jj = 0; jj < 20; ++jj) { float s = 0.f;
#pragma unroll
            for (int j = 0; j < 8; ++j) { const f32x4 w = *((const f32x4*)(WRT + jj * DM) + lane + 64 * j); s += (v[j].x * w.x + v[j].y * w.y) + (v[j].z * w.z + v[j].w * w.w); }
            const float tot = wave_sum(s) * rs + (jj < 4 ? brg[jj] : bre[jj - 4]); mylg = (lane == jj) ? tot : mylg; }
        float lgt[20];
#pragma unroll
        for (int jj = 0; jj < 20; ++jj) lgt[jj] = __shfl(mylg, jj);
        bf16* orow = HN2 + (size_t)row * DM;
#pragma unroll
        for (int j = 0; j < 8; ++j) { const f32x4 g = *((const f32x4*)g2 + lane + 64 * j); const f32x4 y = v[j] * rs * g; u32x2 w; w.x = cvt_pk_bf16(y.x, y.y); w.y = cvt_pk_bf16(y.z, y.w); *((u32x2*)orow + lane + 64 * j) = w; }
        int gs = 0; float gm = lgt[0];
#pragma unroll
        for (int i = 1; i < 4; ++i) if (lgt[i] > gm) { gm = lgt[i]; gs = i; }
        float den = 0.f;
#pragma unroll
        for (int i = 0; i < 4; ++i) den += __expf(lgt[i] - gm);
        const float pg = 1.0f / den;
        float e4[4];
#pragma unroll
        for (int i = 0; i < 4; ++i) { float a = lgt[4 + i];
#pragma unroll
            for (int g = 1; g < 4; ++g) a = (gs == g) ? lgt[4 + 4 * g + i] : a;
            e4[i] = a; }
        int i1 = 0; float v1 = e4[0];
#pragma unroll
        for (int i = 1; i < 4; ++i) if (e4[i] > v1) { v1 = e4[i]; i1 = i; }
        int i2 = -1; float v2 = -__builtin_inff();
#pragma unroll
        for (int i = 0; i < 4; ++i) if (i != i1 && e4[i] > v2) { v2 = e4[i]; i2 = i; }
        const float ex = __expf(v2 - v1); const float w1 = pg / (1.f + ex), w2 = pg * ex / (1.f + ex);
        const int lo = i1 < i2 ? i1 : i2, hi = i1 < i2 ? i2 : i1; const float wlo = i1 < i2 ? w1 : w2, whi = i1 < i2 ? w2 : w1;
        const int pair = (lo == 0) ? (hi - 1) : (lo == 1) ? (hi + 1) : 5;
        const int cls = gs * 6 + pair;
        if (lane == 0) { const unsigned pos = atomicAdd(F.ctl + CW_CNT + 64 * cls, 1u);
            TOK[cls * CLS_CAP + pos] = row; WLO[cls * CLS_CAP + pos] = wlo; WHI[cls * CLS_CAP + pos] = whi; }
    }
}

__device__ __forceinline__ void cls_experts(int cls, int& elo, int& ehi) { const int g = cls / 6, pr = cls % 6; const int lo = pr < 3 ? 0 : (pr < 5 ? 1 : 2), hi = pr < 3 ? pr + 1 : (pr < 5 ? pr - 1 : 3); elo = 4 * g + lo; ehi = 4 * g + hi; }
__device__ __forceinline__ void moe_tables(Frame& F) {
    volatile LAS int* T = (volatile LAS int*)(F.lds + TBL_OFF);
    if (F.tid == 0) {
        int base = 0;
        for (int c = 0; c < NCLS; ++c) { int n = (int)__hip_atomic_load(F.ctl + CW_CNT + 64 * c, __ATOMIC_RELAXED, __HIP_MEMORY_SCOPE_AGENT); if (n > CLS_CAP) n = CLS_CAP; T[c] = n; T[32 + c] = base; const int nt = (n + 255) >> 8;
            for (int i = 0; i < nt; ++i) T[96 + base + i] = c; base += nt; }
        T[64] = base;
        int ne = 0;
        for (int e = 0; e < NEXP; ++e) { T[72 + e] = ne;
            for (int c = (e >> 2) * 6; c < (e >> 2) * 6 + 6; ++c) { int elo, ehi; cls_experts(c, elo, ehi); if (elo != e && ehi != e) continue; const int slot = (ehi == e) ? 1 : 0;
                const int nt = (T[c] + 255) >> 8; for (int i = 0; i < nt; ++i) { T[192 + ne] = (T[32 + c] + i) | (slot << 8) | (c << 16) | (i << 24); ++ne; } } }
        T[72 + NEXP] = ne; T[65] = ne;
    }
    __syncthreads();
}
struct SchedGU {
    const LAS int* T; int G, c;
    __device__ bool next(int i, g8::Unit& u) const {
        const int L = i * G + c; const int ne = __builtin_amdgcn_readfirstlane(T[65]); if (L >= ne * 8) return false;
        int e = 0;
#pragma unroll
        for (int k = 1; k < NEXP; ++k) { const int o = __builtin_amdgcn_readfirstlane(T[72 + k]); if (L >= o * 8) e = k; }
        const int e0 = __builtin_amdgcn_readfirstlane(T[72 + e]), e1 = __builtin_amdgcn_readfirstlane(T[72 + e + 1]); const int cnt = e1 - e0, loc = L - e0 * 8;
        const int ntile = loc / cnt, mt = loc - ntile * cnt; const int ent = __builtin_amdgcn_readfirstlane(T[192 + e0 + mt]);
        u.pm = ent & 0xff; u.pn = ntile; u.a0 = e; u.a1 = (ent >> 8) & 1; u.a2 = (ent >> 16) & 0xff; u.a3 = (ent >> 24) & 0xff; return true;
    }
};
struct SchedDown {
    const LAS int* T; int G, c;
    __device__ bool next(int i, g8::Unit& u) const {
        const int L = i * G + c; const int NT = __builtin_amdgcn_readfirstlane(T[64]); if (L >= NT * 8) return false;
        const int tl = L >> 3; const int cls = __builtin_amdgcn_readfirstlane(T[96 + tl]); const int tb = __builtin_amdgcn_readfirstlane(T[32 + cls]);
        int elo, ehi; cls_experts(cls, elo, ehi);
        u.pm = tl; u.pn = L & 7; u.a0 = elo; u.a1 = ehi; u.a2 = cls; u.a3 = tl - tb; return true;
    }
};

struct PGateUp {
    static constexpr bool PERM = true, HAS_MID = false;
    int nt; const char* Abase; unsigned ldb2; const char* WGU; const int* TOK; const float* WLO; const float* WHI; const LAS int* T; bf16* ACT;
    __device__ __forceinline__ void a_offs(const g8::Unit& u, const int (&R)[2], const int (&C)[2], unsigned (&o)[2][2]) const {
        const int cnt = T[u.a2];
#pragma unroll
        for (int h = 0; h < 2; ++h)
#pragma unroll
            for (int i = 0; i < 2; ++i) { int pos = u.a3 * 256 + h * 128 + R[i]; if (pos >= cnt) pos = 0; const int tok = TOK[u.a2 * CLS_CAP + pos]; o[h][i] = (unsigned)((tok * DM + C[i]) * 2); }
    }
    __device__ __forceinline__ const char* b_tile(const g8::Unit& u, int t) const { return WGU + ((size_t)u.a0 * 2048 + (size_t)u.pn * 256) * ldb2 + (size_t)t * 128; }
    __device__ __forceinline__ void mid(f32x4 (&)[2][2][4][2], const g8::Unit&, int, int, int, int) const {}
    __device__ __forceinline__ void epi(const f32x4 (&acc)[2][2][4][2], const g8::Unit& u, int wr, int wc, int fr, int fq) const {
        const int cnt = T[u.a2]; const float* WS = u.a1 ? WHI : WLO;
#pragma unroll
        for (int ai = 0; ai < 2; ++ai)
#pragma unroll
            for (int m = 0; m < 4; ++m) { const int rl = ai * 128 + wr * 64 + m * 16 + fr; const int pos = u.a3 * 256 + rl;
                const float w = (pos < cnt) ? WS[u.a2 * CLS_CAP + pos] : 0.f;
                const f32x4 g0 = acc[ai][0][m][0], g1 = acc[ai][0][m][1], u0 = acc[ai][1][m][0], u1 = acc[ai][1][m][1];
                f32x4 a0, a1;
#pragma unroll
                for (int e = 0; e < 4; ++e) { a0[e] = g0[e] / (1.f + __expf(-g0[e])) * u0[e] * w; a1[e] = g1[e] / (1.f + __expf(-g1[e])) * u1[e] * w; }
                u32x4 o; o.x = cvt_pk_bf16(a0[0], a0[1]); o.y = cvt_pk_bf16(a0[2], a0[3]); o.z = cvt_pk_bf16(a1[0], a1[1]); o.w = cvt_pk_bf16(a1[2], a1[3]);
                *(u32x4*)(ACT + ((size_t)u.pm * 256 + rl) * 2048 + u.a1 * 1024 + u.pn * 128 + wc * 32 + 8 * fq) = o; }
    }
};
struct PDown {
    static constexpr bool PERM = false, HAS_MID = false;
    int nt; const char* Abase; unsigned ldb2; const char* WD; const int* TOK; const LAS int* T; float* out;
    __device__ __forceinline__ void a_offs(const g8::Unit& u, const int (&R)[2], const int (&C)[2], unsigned (&o)[2][2]) const {
#pragma unroll
        for (int h = 0; h < 2; ++h)
#pragma unroll
            for (int i = 0; i < 2; ++i) o[h][i] = (unsigned)(((u.pm * 256 + h * 128 + R[i]) * 2048 + C[i]) * 2);
    }
    __device__ __forceinline__ const char* b_tile(const g8::Unit& u, int t) const { const int e = (t < 16) ? u.a0 : u.a1; return WD + ((size_t)e * 2048 + (size_t)u.pn * 256) * ldb2 + (size_t)(t & 15) * 128; }
    __device__ __forceinline__ void mid(f32x4 (&)[2][2][4][2], const g8::Unit&, int, int, int, int) const {}
    __device__ __forceinline__ void epi(const f32x4 (&acc)[2][2][4][2], const g8::Unit& u, int wr, int wc, int fr, int fq) const {
        const int cnt = T[u.a2]; const int col0 = u.pn * 256 + wc * 32 + 4 * fq;
#pragma unroll
        for (int ai = 0; ai < 2; ++ai)
#pragma unroll
            for (int m = 0; m < 4; ++m) { const int pos = u.a3 * 256 + ai * 128 + wr * 64 + m * 16 + fr;
                if (pos < cnt) { const int tok = TOK[u.a2 * CLS_CAP + pos]; float* rowp = out + (size_t)tok * DM + col0;
#pragma unroll
                    for (int bj = 0; bj < 2; ++bj)
#pragma unroll
                        for (int n = 0; n < 2; ++n) { f32x4* q = (f32x4*)(rowp + bj * 128 + n * 16); *q = *q + acc[ai][bj][m][n]; } } }
    }
};

__device__ __forceinline__ void p7_final(Frame& F) {
    const int gw = F.vcu * NWAVES + F.wave, NGW = F.G * NWAVES, lane = F.lane; const float* gf = F.in[16];
    f32x4 gv[8];
#pragma unroll
    for (int j = 0; j < 8; ++j) gv[j] = *((const f32x4*)gf + lane + 64 * j);
    for (int row = gw; row < MTOK; row += NGW) {
        float* xr = F.out + (size_t)row * DM; f32x4 v[8]; float ss = 0.f;
#pragma unroll
        for (int j = 0; j < 8; ++j) { v[j] = *((const f32x4*)xr + lane + 64 * j); ss += (v[j].x * v[j].x + v[j].y * v[j].y) + (v[j].z * v[j].z + v[j].w * v[j].w); }
        const float rs = 1.0f / sqrtf(wave_sum(ss) * (1.0f / DM) + EPS);
#pragma unroll
        for (int j = 0; j < 8; ++j) *((f32x4*)xr + lane + 64 * j) = v[j] * rs * gv[j];
    }
}

struct Args { const float* in[17]; float* out; unsigned char* ws; int ph_lo, ph_hi; };
__global__ void __launch_bounds__(NWAVES * 64, 2) fwd_kernel(Args args) {
    extern __shared__ __attribute__((aligned(16))) unsigned char lds[];
    Frame F;
    F.lds = (LAS unsigned char*)lds;
    F.MISC = (volatile LAS unsigned*)(F.lds + MISC_OFF);
    F.tid = threadIdx.x; F.lane = F.tid & 63; F.wave = __builtin_amdgcn_readfirstlane(F.tid >> 6);
    F.G = gridDim.x; { const int bx = blockIdx.x; F.vcu = (F.G % 8 == 0) ? (bx % 8) * (F.G / 8) + bx / 8 : bx; }
#pragma unroll
    for (int i = 0; i < 17; ++i) F.in[i] = args.in[i];
    F.out = args.out; F.ws = args.ws; F.ctl = (unsigned*)(args.ws + WS_CTL);
    for (int u = F.tid; u < (LDS_BYTES - RING_BYTES) / 4; u += NWAVES * 64) ((LAS unsigned*)(F.lds + RING_BYTES))[u] = 0u;
    __syncthreads();
    XcdBarrier bar = xcd_barrier_post(F.ctl + CW_BAR, F.MISC + 8);
    const int lo = args.ph_lo, hi = args.ph_hi;
#define IN(k) (lo <= (k) && (k) < hi)
#define GRID_BAR(k) do { if (IN(k) && IN((k) + 1)) xcd_barrier(bar); } while (0)
    bf16* U = (bf16*)(F.ws + WS_U);
    if (IN(0)) { p0_prologue(F); } GRID_BAR(0);
    if (IN(1)) {
        p1_cumsum(F); p1_meta_kv(F);
        PInProj p{DM / 64, (const char*)(F.ws + WS_HN), (unsigned)(DM * 2), (const char*)(F.ws + WS_WINT), U, (const f32x2*)(F.ws + WS_ROPE)};
        g8::StaticOrder S; S.init(MTOK, NIN, F.G, (int)blockIdx.x);
        g8::gemm_phase<PInProj, g8::StaticOrder, true>(F.lds, p, S);
    } GRID_BAR(1);
    if (IN(2)) { attn_simple<true>(F); attn_simple<false>(F); } GRID_BAR(2);
    if (IN(3)) {
        POutProj p{DM / 64, (const char*)(F.ws + WS_HN), (unsigned)(DM * 2), (const char*)(F.ws + WS_WOUTT), F.in[0], F.out, (const float*)(F.ws + WS_SSQ)};
        g8::StaticOrder S; S.init(MTOK, DM, F.G, (int)blockIdx.x);
        g8::gemm_phase<POutProj, g8::StaticOrder, true>(F.lds, p, S);
    } GRID_BAR(3);
    if (IN(4)) { p4_router(F); } GRID_BAR(4);
    if (IN(5)) {
        moe_tables(F);
        PGateUp p{DM / 64, (const char*)(F.ws + WS_HN), (unsigned)(DM * 2), (const char*)(F.ws + WS_WGU), (const int*)(F.ws + WS_TOK), (const float*)(F.ws + WS_WLO), (const float*)(F.ws + WS_WHI),
                  (const LAS int*)(F.lds + TBL_OFF), U};
        SchedGU S{(const LAS int*)(F.lds + TBL_OFF), F.G, F.vcu};
        g8::gemm_phase<PGateUp, SchedGU, true>(F.lds, p, S);
    } GRID_BAR(5);
    if (IN(6)) {
        if (!IN(5)) moe_tables(F);
        PDown p{2048 / 64, (const char*)U, (unsigned)(DE * 2), (const char*)(F.ws + WS_WD), (const int*)(F.ws + WS_TOK), (const LAS int*)(F.lds + TBL_OFF), F.out};
        SchedDown S{(const LAS int*)(F.lds + TBL_OFF), F.G, F.vcu};
        g8::gemm_phase<PDown, SchedDown, true>(F.lds, p, S);
    } GRID_BAR(6);
    if (IN(7)) { p7_final(F); }
#undef IN
#undef GRID_BAR
}

extern "C" void kernel_launch(void* const* d_in, const int* in_sizes, int n_in, void* d_out, int out_size, void* d_ws, size_t ws_size, hipStream_t stream) {
    static int grid = 0;
    if (grid == 0) {
        if (n_in != 17 || out_size != MTOK * DM || ws_size < WS_END) { fprintf(stderr, "kernel_launch: unexpected shapes (n_in %d out %d ws %zu)\n", n_in, out_size, ws_size); grid = -1; return; }
        int dev = 0, cus = 0, per_cu = 0;
        if (hipGetDevice(&dev) != hipSuccess || hipDeviceGetAttribute(&cus, hipDeviceAttributeMultiprocessorCount, dev) != hipSuccess) { grid = -1; return; }
        if (hipFuncSetAttribute((const void*)fwd_kernel, hipFuncAttributeMaxDynamicSharedMemorySize, LDS_BYTES) != hipSuccess) { fprintf(stderr, "kernel_launch: hipFuncSetAttribute failed\n"); grid = -1; return; }
        if (hipOccupancyMaxActiveBlocksPerMultiprocessor(&per_cu, (const void*)fwd_kernel, NWAVES * 64, LDS_BYTES) != hipSuccess || per_cu < 1) fprintf(stderr, "kernel_launch: occupancy query says %d\n", per_cu);
        (void)hipGetLastError();
        grid = cus;
    }
    if (grid < 0) return;
    (void)hipMemsetAsync((char*)d_ws + WS_CTL, 0, CTL_ZERO_BYTES, stream);
    Args a{};
    for (int i = 0; i < 17; ++i) a.in[i] = (const float*)d_in[i];
    a.out = (float*)d_out; a.ws = (unsigned char*)d_ws; a.ph_lo = 0; a.ph_hi = 8;
    hipLaunchKernelGGL(fwd_kernel, dim3(grid), dim3(NWAVES * 64), LDS_BYTES, stream, a);
}
```

```cpp
#include <hip/hip_runtime.h>
#include <cstdio>
#include <cstdint>

#define LAS __attribute__((address_space(3)))
#define GAS __attribute__((address_space(1)))
typedef unsigned short bf16;
typedef short bf16x8 __attribute__((ext_vector_type(8)));
typedef float f32x4 __attribute__((ext_vector_type(4)));
typedef float f32x2 __attribute__((ext_vector_type(2)));
typedef unsigned u32x4 __attribute__((ext_vector_type(4)));
typedef unsigned u32x2 __attribute__((ext_vector_type(2)));

constexpr int NB = 4, SEQ = 4096, DM = 2048, PADN = 112, NMETA = 16, PP = SEQ + 128, HD = 128, NH = 8;
constexpr int MTOK = NB * SEQ;
constexpr int INC = 7176;
constexpr int NIN = 7168;
constexpr int NEXP = 16, DE = 1024, NCLS = 24, CLS_CAP = 16384;
constexpr float EPS = 1e-6f;
constexpr float SCALE = 0.08838834764831845f;

constexpr size_t MiB = 1u << 20;
constexpr size_t WS_CTL = 0, CTL_ZERO_BYTES = 1 * MiB;
constexpr size_t WS_LOGF = 1 * MiB;
constexpr size_t WS_CUM = WS_LOGF + 1 * MiB;
constexpr size_t WS_SSQ = WS_CUM + 1 * MiB;
constexpr size_t WS_ROPE = WS_SSQ + 1 * MiB;
constexpr size_t WS_WRT = WS_ROPE + 3 * MiB;
constexpr size_t WS_HNMETA = WS_WRT + 1 * MiB;
constexpr size_t WS_TOK = WS_HNMETA + 1 * MiB;
constexpr size_t WS_WLO = WS_TOK + 2 * MiB;
constexpr size_t WS_WHI = WS_WLO + 2 * MiB;
constexpr size_t WS_WINT = 16 * MiB;
constexpr size_t WS_WOUTT = 44 * MiB;
constexpr size_t WS_WGU = 52 * MiB;
constexpr size_t WS_WD = 180 * MiB;
constexpr size_t WS_HN = 244 * MiB;
constexpr size_t WS_U = 308 * MiB;
constexpr size_t USTR = (size_t)NB * PP * 1024;
constexpr size_t WS_ST = WS_U + 7 * 33 * MiB;
constexpr size_t WS_END = WS_ST + 32 * MiB;
static_assert(WS_WHI + 2 * MiB <= WS_WINT && USTR * 2 == 33 * MiB, "ws map");
constexpr int CW_BAR = 4096;
constexpr int CW_CNT = 16384;

constexpr int RING_BYTES = 131072;
constexpr int MISC_OFF = RING_BYTES + 320;
constexpr int TBL_OFF = RING_BYTES + 1024;
constexpr int LDS_BYTES = 147456;
constexpr int NWAVES = 8;

__device__ __forceinline__ unsigned cvt_pk_bf16(float lo, float hi) { unsigned r; asm volatile("v_cvt_pk_bf16_f32 %0, %1, %2" : "=v"(r) : "v"(lo), "v"(hi)); return r; }
__device__ __forceinline__ float bf_lo(unsigned w) { return __uint_as_float(w << 16); }
__device__ __forceinline__ float bf_hi(unsigned w) { return __uint_as_float(w & 0xffff0000u); }
__device__ __forceinline__ float wave_sum(float v) {
#pragma unroll
    for (int o = 1; o < 64; o <<= 1) v += __shfl_xor(v, o);
    return v;
}
__device__ __forceinline__ float wave_max(float v) {
#pragma unroll
    for (int o = 1; o < 64; o <<= 1) v = fmaxf(v, __shfl_xor(v, o));
    return v;
}
#define LDS_WAIT() asm volatile("s_waitcnt lgkmcnt(0)" ::: "memory")
#define VM_WAIT() asm volatile("s_waitcnt vmcnt(0)" ::: "memory")

#define XB_TMO      128
#define XB_XCNT(j)  (256  + 64 * (j))
#define XB_XSUB(j)  (1280 + 64 * (j))
#define XB_XGEN(j)  (2304 + 64 * (j))
#define XB_TOP      3328
#define XB_TOPGEN   3392
#define XCD_BAR_WORDS 3456
#define XB_SPIN_CAP (1u << 21)
__device__ __forceinline__ unsigned xb_ld(unsigned* p)              { return __hip_atomic_load(p, __ATOMIC_RELAXED, __HIP_MEMORY_SCOPE_AGENT); }
__device__ __forceinline__ unsigned xb_add(unsigned* p, unsigned v) { return __hip_atomic_fetch_add(p, v, __ATOMIC_RELAXED, __HIP_MEMORY_SCOPE_AGENT); }
__device__ __forceinline__ unsigned xb_xcc_id() { return (unsigned)__builtin_amdgcn_s_getreg((3 << 11) | 20) & 0xFu; }
#define XB_SPIN(cond, bar) do { unsigned _sp = 0; while (cond) { __builtin_amdgcn_s_sleep(1); \
    if ((++_sp & 255u) == 0u) { if (xb_ld(&(bar)[XB_TMO])) break; if (_sp > XB_SPIN_CAP) { atomicAdd(&(bar)[XB_TMO], 1u); break; } } } } while (0)
struct XcdBarrier { unsigned* bar; unsigned x; volatile LAS unsigned* st; };
__device__ __forceinline__ XcdBarrier xcd_barrier_post(unsigned* bar, volatile LAS unsigned* st) {
    XcdBarrier b; b.bar = bar; b.x = xb_xcc_id(); b.st = st;
    if (threadIdx.x == 0) (void)xb_add(&bar[XB_XCNT(b.x)], 1u);
    return b;
}
__device__ __forceinline__ void xcd_barrier_complete(unsigned* bar, unsigned x, unsigned& nloc, unsigned& nx) {
    const unsigned G = gridDim.x * gridDim.y * gridDim.z;
    unsigned sum, cnt, mine, sp = 0u;
    for (;;) {
        sum = 0u; cnt = 0u; mine = 0u;
#pragma unroll
        for (unsigned j = 0; j < 16; ++j) { const unsigned c = xb_ld(&bar[XB_XCNT(j)]); sum += c; cnt += (c > 0u) ? 1u : 0u; mine = (j == x) ? c : mine; }
        if (sum == G) break;
        __builtin_amdgcn_s_sleep(1);
        if ((++sp & 255u) == 0u) { if (xb_ld(&bar[XB_TMO])) break; if (sp > XB_SPIN_CAP) { atomicAdd(&bar[XB_TMO], 1u); break; } }
    }
    nloc = mine > 0u ? mine : 1u; nx = cnt > 0u ? cnt : 1u;
}
__device__ __forceinline__ void xcd_barrier(const XcdBarrier& b) {
    asm volatile("s_waitcnt vmcnt(0)" ::: "memory");
    __syncthreads();
    if (threadIdx.x == 0) {
        unsigned* bar = b.bar;
        __builtin_amdgcn_s_waitcnt(0);
        unsigned nloc = b.st[0], nx = b.st[1];
        if (nloc == 0u) { xcd_barrier_complete(bar, b.x, nloc, nx); b.st[0] = nloc; b.st[1] = nx; }
        const unsigned old = xb_add(&bar[XB_XSUB(b.x)], 1u);
        const unsigned gen = old / nloc;
        if (old + 1u == (gen + 1u) * nloc) {
            __builtin_amdgcn_fence(__ATOMIC_RELEASE, "agent");
            asm volatile("s_waitcnt vmcnt(0)" ::: "memory");
            const unsigned og = xb_add(&bar[XB_TOP], 1u);
            const unsigned tg = og / nx;
            if (og + 1u == (tg + 1u) * nx) xb_add(&bar[XB_TOPGEN], 1u);
            else XB_SPIN(xb_ld(&bar[XB_TOPGEN]) == tg, bar);
            __builtin_amdgcn_fence(__ATOMIC_ACQUIRE, "agent");
            xb_add(&bar[XB_XGEN(b.x)], 1u);
            asm volatile("s_waitcnt vmcnt(0)" ::: "memory");
        } else {
            XB_SPIN(xb_ld(&bar[XB_XGEN(b.x)]) == gen, bar);
            __builtin_amdgcn_fence(__ATOMIC_ACQUIRE, "agent");
            asm volatile("s_waitcnt vmcnt(0)" ::: "memory");
        }
    }
    __syncthreads();
}

namespace g8 {
constexpr int BM = 256, BK = 64, HALF = 128, HTB = HALF * BK * 2, NXCD = 8, WGM = 8;
__device__ __forceinline__ int lds_byte(int r, int c) { const int st = (r >> 4) * 2 + (c >> 5), rr = r & 15, cc = c & 31, ob = rr * 64 + cc * 2; return st * 1024 + (ob ^ (((ob >> 9) & 1) << 5)); }
__device__ __forceinline__ void stage_rc(int b, int& R, int& C) { const int st = b / 1024, sb = b % 1024, swz = sb ^ (((sb >> 9) & 1) << 5); R = (st >> 1) * 16 + swz / 64; C = (st & 1) * 32 + (swz % 64) / 2; }
__device__ __forceinline__ int perm32(int rho) { const int n = rho >> 4, i = rho & 15; return 8 * (i >> 2) + 4 * n + (i & 3); }

struct Unit { int pm, pn, a0, a1, a2, a3; };

struct StaticOrder {
    int nM, nN, nwg, G, c;
    __device__ void init(int M, int N, int G_, int c_) { nM = M / BM; nN = N / BM; nwg = nM * nN; G = G_; c = c_; }
    __device__ bool next(int i, Unit& u) const {
        const long L = (long)i * G + c; if (L >= nwg) return false;
        int wgid = (int)L; { const int q = nwg / NXCD, r = nwg % NXCD, xcd = wgid % NXCD, off = wgid / NXCD; wgid = (xcd < r ? xcd * (q + 1) : r * (q + 1) + (xcd - r) * q) + off; }
        const int nig = WGM * nN, gid = wgid / nig, fm = gid * WGM, gsz = (nM - fm) < WGM ? (nM - fm) : WGM;
        u.pm = fm + ((wgid % nig) % gsz); u.pn = (wgid % nig) / gsz; u.a0 = u.a1 = u.a2 = u.a3 = 0; return true;
    }
};

template <class P, class Sched, bool ALIGN_EPI>
__device__ __forceinline__ void gemm_phase(LAS unsigned char* lds, const P& p, const Sched& S) {
    const int tid = threadIdx.x, wid = __builtin_amdgcn_readfirstlane(tid >> 6), lane = tid & 63, wr = wid >> 2, wc = wid & 3, fr = lane & 15, fq = lane >> 4;
    const int nt = p.nt;
    int Rr[2], Cc[2]; unsigned voffB[2];
#pragma unroll
    for (int i = 0; i < 2; ++i) { int R, C; stage_rc(tid * 16 + i * 8192, R, C); Rr[i] = R; Cc[i] = C; const int Rb = P::PERM ? ((R & ~31) + perm32(R & 31)) : R;
        voffB[i] = (unsigned)Rb * p.ldb2 + (unsigned)C * 2u; }
    const size_t hstepB = (size_t)HALF * p.ldb2;
    const unsigned ldsw = (unsigned)wid * 1024u;
    const int aoff = lds_byte(wr * 64 + fr, fq * 8), boff = lds_byte(wc * 32 + fr, fq * 8);
#define PG8_SA(b, h) (((b) * 2 + (h)) * HTB)
#define PG8_SB(b, h) ((4 + (b) * 2 + (h)) * HTB)
#define PG8_STAGE(bufoff, gbase, v0, v1) do { \
        __builtin_amdgcn_global_load_lds((const unsigned*)((const char*)(gbase) + (v0)), (LAS unsigned*)(lds + (bufoff) + ldsw), 16, 0, 0); \
        __builtin_amdgcn_global_load_lds((const unsigned*)((const char*)(gbase) + (v1)), (LAS unsigned*)(lds + (bufoff) + ldsw + 8192), 16, 0, 0); } while (0)
#define PG8_LDA(dst, b, h) do { _Pragma("unroll") for (int m = 0; m < 4; ++m) _Pragma("unroll") for (int k = 0; k < 2; ++k) dst[m][k] = *(const LAS bf16x8*)(lds + PG8_SA(b, h) + aoff + m * 2048 + k * 1024); } while (0)
#define PG8_LDB(dst, b, h) do { _Pragma("unroll") for (int n = 0; n < 2; ++n) _Pragma("unroll") for (int k = 0; k < 2; ++k) dst[n][k] = *(const LAS bf16x8*)(lds + PG8_SB(b, h) + boff + n * 2048 + k * 1024); } while (0)
#define PG8_MMA(ai, bj, At, Bt) do { __builtin_amdgcn_s_setprio(1); _Pragma("unroll") for (int m = 0; m < 4; ++m) _Pragma("unroll") for (int n = 0; n < 2; ++n) _Pragma("unroll") for (int k = 0; k < 2; ++k) \
        acc[ai][bj][m][n] = __builtin_amdgcn_mfma_f32_16x16x32_bf16(Bt[n][k], At[m][k], acc[ai][bj][m][n], 0, 0, 0); __builtin_amdgcn_s_setprio(0); } while (0)
#define PG8_WAIT_V(n) asm volatile("s_waitcnt vmcnt(" #n ")" ::: "memory")
#define PG8_WAIT_L(n) asm volatile("s_waitcnt lgkmcnt(" #n ")" ::: "memory")
#define PG8_BAR __builtin_amdgcn_s_barrier()
#define PG8_SCHED __builtin_amdgcn_sched_barrier(0)
    Unit cur, nxt; int ui = 0;
    if (!S.next(0, cur)) return;
    f32x4 acc[2][2][4][2];
#pragma unroll
    for (int a = 0; a < 2; ++a)
#pragma unroll
        for (int b = 0; b < 2; ++b)
#pragma unroll
            for (int m = 0; m < 4; ++m)
#pragma unroll
                for (int n = 0; n < 2; ++n) acc[a][b][m][n] = (f32x4){0.f, 0.f, 0.f, 0.f};
    bf16x8 At[4][2], B0[2][2], B1[2][2];
    unsigned oc[2][2], on[2][2];
    p.a_offs(cur, Rr, Cc, oc);
    const char* const A0 = p.Abase;
    {
        const char* b0 = p.b_tile(cur, 0); const char* b1 = p.b_tile(cur, 1);
        PG8_STAGE(PG8_SB(0, 0), b0, voffB[0], voffB[1]); PG8_STAGE(PG8_SB(0, 1), b0 + hstepB, voffB[0], voffB[1]);
        PG8_STAGE(PG8_SA(0, 0), A0, oc[0][0], oc[0][1]); PG8_STAGE(PG8_SA(0, 1), A0, oc[1][0], oc[1][1]);
        if (wr == 1) PG8_BAR;
        PG8_WAIT_V(2); PG8_BAR;
        PG8_STAGE(PG8_SB(1, 0), b1, voffB[0], voffB[1]); PG8_STAGE(PG8_SA(1, 0), A0 + 128, oc[0][0], oc[0][1]); PG8_STAGE(PG8_SB(1, 1), b1 + hstepB, voffB[0], voffB[1]);
        PG8_WAIT_V(6); PG8_BAR;
    }
    for (;;) {
        const bool has_next = S.next(ui + 1, nxt);
        if (has_next) p.a_offs(nxt, Rr, Cc, on);
        else { on[0][0] = oc[0][0]; on[0][1] = oc[0][1]; on[1][0] = oc[1][0]; on[1][1] = oc[1][1]; nxt = cur; }
        for (int t = 0; t < nt; t += 2) {
            const bool last = (t == nt - 2);
            if constexpr (P::HAS_MID) { if (t == (nt >> 1)) p.mid(acc, cur, wr, wc, fr, fq); }
            const char* a1 = A0 + (size_t)(t + 1) * 128;
            const char* a2 = last ? A0 : A0 + (size_t)(t + 2) * 128; const char* a3 = a2 + 128;
            const unsigned o200 = last ? on[0][0] : oc[0][0], o201 = last ? on[0][1] : oc[0][1], o210 = last ? on[1][0] : oc[1][0], o211 = last ? on[1][1] : oc[1][1];
            const char* b2 = last ? p.b_tile(nxt, 0) : p.b_tile(cur, t + 2); const char* b3 = last ? p.b_tile(nxt, 1) : p.b_tile(cur, t + 3);
            PG8_LDB(B0, 0, 0); PG8_LDB(B1, 0, 1); PG8_SCHED; PG8_LDA(At, 0, 0); PG8_STAGE(PG8_SA(1, 1), a1, oc[1][0], oc[1][1]);
            PG8_WAIT_V(8); PG8_WAIT_L(0); PG8_BAR; PG8_MMA(0, 0, At, B0); PG8_MMA(0, 1, At, B1); PG8_BAR; PG8_SCHED;
            PG8_LDA(At, 0, 1); PG8_STAGE(PG8_SB(0, 0), b2, voffB[0], voffB[1]); PG8_STAGE(PG8_SB(0, 1), b2 + hstepB, voffB[0], voffB[1]); PG8_STAGE(PG8_SA(0, 0), a2, o200, o201);
            PG8_WAIT_V(8); PG8_WAIT_L(0); PG8_BAR; PG8_MMA(1, 0, At, B0); PG8_MMA(1, 1, At, B1); PG8_BAR; PG8_SCHED;
            PG8_LDB(B0, 1, 0); PG8_LDB(B1, 1, 1); PG8_SCHED; PG8_LDA(At, 1, 0); PG8_STAGE(PG8_SA(0, 1), a2, o210, o211);
            PG8_WAIT_V(8); PG8_WAIT_L(0); PG8_BAR; PG8_MMA(0, 0, At, B0); PG8_MMA(0, 1, At, B1); PG8_BAR; PG8_SCHED;
            PG8_LDA(At, 1, 1); PG8_STAGE(PG8_SB(1, 0), b3, voffB[0], voffB[1]); PG8_STAGE(PG8_SB(1, 1), b3 + hstepB, voffB[0], voffB[1]); PG8_STAGE(PG8_SA(1, 0), a3, o200, o201);
            PG8_WAIT_V(8); PG8_WAIT_L(0); PG8_BAR; PG8_MMA(1, 0, At, B0); PG8_MMA(1, 1, At, B1); PG8_BAR; PG8_SCHED;
        }
        if constexpr (ALIGN_EPI) { if (wr == 0) PG8_BAR; }
        p.epi(acc, cur, wr, wc, fr, fq);
        if (!has_next) break;
#pragma unroll
        for (int a = 0; a < 2; ++a)
#pragma unroll
            for (int b = 0; b < 2; ++b)
#pragma unroll
                for (int m = 0; m < 4; ++m)
#pragma unroll
                    for (int n = 0; n < 2; ++n) acc[a][b][m][n] = (f32x4){0.f, 0.f, 0.f, 0.f};
        cur = nxt; oc[0][0] = on[0][0]; oc[0][1] = on[0][1]; oc[1][0] = on[1][0]; oc[1][1] = on[1][1]; ++ui;
        if constexpr (ALIGN_EPI) { if (wr == 1) PG8_BAR; }
    }
    PG8_WAIT_V(0);
    if constexpr (!ALIGN_EPI) { if (wr == 0) PG8_BAR; }
    PG8_BAR;
#undef PG8_SA
#undef PG8_SB
#undef PG8_STAGE
#undef PG8_LDA
#undef PG8_LDB
#undef PG8_MMA
#undef PG8_WAIT_V
#undef PG8_WAIT_L
#undef PG8_BAR
#undef PG8_SCHED
}
}

struct Frame {
    LAS unsigned char* lds;
    volatile LAS unsigned* MISC;
    unsigned* ctl;
    int tid, lane, wave, vcu, G;
    const float* in[17];
    float* out;
    unsigned char* ws;
};

__device__ __forceinline__ void p0_transpose_item(const float* W, int ldw, int K, bf16* WT, int k0, int scol0, int drow0, const float* kscale, LAS float* scr, int lane) {
#pragma unroll 8
    for (int i = 0; i < 32; ++i) { const int kk = 2 * i + (lane >> 5); float v = W[(size_t)(k0 + kk) * ldw + scol0 + (lane & 31)]; if (kscale) v *= kscale[k0 + kk]; scr[kk * 33 + (lane & 31)] = v; }
    LDS_WAIT(); asm volatile("" ::: "memory");
    const int c = lane & 7;
#pragma unroll
    for (int j = 0; j < 4; ++j) { const int n = (lane >> 3) + 8 * j; const LAS float* s = scr + (8 * c) * 33 + n;
        u32x4 o; o.x = cvt_pk_bf16(s[0 * 33], s[1 * 33]); o.y = cvt_pk_bf16(s[2 * 33], s[3 * 33]); o.z = cvt_pk_bf16(s[4 * 33], s[5 * 33]); o.w = cvt_pk_bf16(s[6 * 33], s[7 * 33]);
        *(u32x4*)(WT + (size_t)(drow0 + n) * K + k0 + 8 * c) = o; }
    LDS_WAIT(); asm volatile("" ::: "memory");
}

__device__ __forceinline__ float log_sigmoid(float x) { return fminf(x, 0.f) - log1pf(__expf(-fabsf(x))); }

__device__ __forceinline__ void p0_prologue(Frame& F) {
    const int gw = F.vcu * NWAVES + F.wave, NGW = F.G * NWAVES, lane = F.lane;
    const int gt = F.vcu * 512 + F.tid, NGT = F.G * 512;
    {
        LAS float* scr = (LAS float*)(F.lds + F.wave * 16384);
        const float* w_in = F.in[3]; const float* w_out = F.in[7]; const float* w_gate = F.in[13]; const float* w_up = F.in[14]; const float* w_down = F.in[15];
        bf16* WINT = (bf16*)(F.ws + WS_WINT); bf16* WOUTT = (bf16*)(F.ws + WS_WOUTT); bf16* WGU = (bf16*)(F.ws + WS_WGU); bf16* WD = (bf16*)(F.ws + WS_WD);
        constexpr int I_IN = 32 * 224, I_OUT = 32 * 64, I_G = 16 * 32 * 32, I_D = 16 * 16 * 64;
        constexpr int NITEMS = I_IN + I_OUT + 2 * I_G + I_D;
        for (int it = gw; it < NITEMS; it += NGW) {
            int r = it;
            if (r < I_IN) { const int kb = r / 224, nb = r % 224, n0 = nb * 32; p0_transpose_item(w_in, INC, DM, WINT, kb * 64, n0 + (n0 >= 3072 ? 8 : 0), n0, nullptr, scr, lane); continue; } r -= I_IN;
            if (r < I_OUT) { const int kb = r / 64, nb = r % 64; const float* ks = (kb < 16) ? F.in[5] : (F.in[6] - 1024); p0_transpose_item(w_out, DM, DM, WOUTT, kb * 64, nb * 32, nb * 32, ks, scr, lane); continue; } r -= I_OUT;
            if (r < 2 * I_G) { const int up = r >= I_G; if (up) r -= I_G; const int e = r / 1024, q = r % 1024, kb = q / 32, nb = q % 32, n0 = nb * 32;
                p0_transpose_item((up ? w_up : w_gate) + (size_t)e * DM * DE, DE, DM, WGU + (size_t)e * 2048 * DM, kb * 64, n0, (n0 >> 7) * 256 + up * 128 + (n0 & 127), nullptr, scr, lane); continue; } r -= 2 * I_G;
            { const int e = r / 1024, q = r % 1024, kb = q / 64, nb = q % 64; p0_transpose_item(w_down + (size_t)e * DE * DM, DM, DE, WD + (size_t)e * DM * DE, kb * 64, nb * 32, nb * 32, nullptr, scr, lane); }
        }
    }
    {
        float* WRT = (float*)(F.ws + WS_WRT); const float* g2 = F.in[8]; const float* wrg = F.in[9]; const float* wre = F.in[11];
        for (int i = gt; i < 20 * DM; i += NGT) { const int j = i / DM, k = i % DM; WRT[i] = g2[k] * (j < 4 ? wrg[k * 4 + j] : wre[k * 16 + (j - 4)]); }
        f32x2* ROPE = (f32x2*)(F.ws + WS_ROPE);
        for (int i = gt; i < 4112 * 64; i += NGT) { const int pos = i >> 6, k = i & 63;
            const float lin = (float)k * (1.0f / 63.0f); const float ang = 1.0f / exp2f(lin * 13.287712379549449f);
            const float ph = (float)pos * ang; const double rev = (double)ph * 0.15915494309189535; const float fr = (float)(rev - floor(rev));
            ROPE[i] = (f32x2){__builtin_amdgcn_cosf(fr), __builtin_amdgcn_sinf(fr)}; }
        bf16* U = (bf16*)(F.ws + WS_U);
        for (int i = gt; i < 4 * NB * PADN * 128; i += NGT) { const int c8 = i & 127, row = (i >> 7) % PADN, bb = ((i >> 7) / PADN) % NB, cl = (i >> 7) / (PADN * NB);
            const int cls = (cl == 0) ? 1 : (cl == 1) ? 2 : (cl == 2) ? 4 : 5;
            *(u32x4*)(U + cls * USTR + ((size_t)(bb * PP + row)) * 1024 + c8 * 8) = (u32x4){0u, 0u, 0u, 0u}; }
        float* LOGF = (float*)(F.ws + WS_LOGF);
        for (int i = gt; i < 32 * PADN; i += NGT) LOGF[(i / PADN) * PP + (i % PADN)] = 0.f;
    }
    __syncthreads();
    {
        LAS float* WF = (LAS float*)F.lds; const float* w_in = F.in[3]; const float* g1 = F.in[2];
        for (int i = F.tid; i < 8 * DM; i += 512) { const int k = i >> 3, h = i & 7; WF[h * DM + k] = g1[k] * w_in[(size_t)k * INC + 3072 + h]; }
        __syncthreads();
        f32x4 gv[8];
#pragma unroll
        for (int j = 0; j < 8; ++j) gv[j] = *((const f32x4*)g1 + lane + 64 * j);
        bf16* HN = (bf16*)(F.ws + WS_HN); bf16* HNMETA = (bf16*)(F.ws + WS_HNMETA); float* LOGF = (float*)(F.ws + WS_LOGF); const float* bfv = F.in[4];
        for (int row = gw; row < MTOK + NMETA; row += NGW) {
            const bool meta = row >= MTOK; const int mj = row - MTOK;
            const float* xr = meta ? (F.in[1] + (size_t)mj * DM) : (F.in[0] + (size_t)row * DM);
            f32x4 v[8]; float ss = 0.f;
#pragma unroll
            for (int j = 0; j < 8; ++j) { v[j] = *((const f32x4*)xr + lane + 64 * j); ss += (v[j].x * v[j].x + v[j].y * v[j].y) + (v[j].z * v[j].z + v[j].w * v[j].w); }
            const float rs = 1.0f / sqrtf(wave_sum(ss) * (1.0f / DM) + EPS);
            float fl[8];
#pragma unroll
            for (int h = 0; h < 8; ++h) { float s = 0.f;
#pragma unroll
                for (int j = 0; j < 8; ++j) { const f32x4 w = *((const LAS f32x4*)(WF + h * DM) + lane + 64 * j); s += (v[j].x * w.x + v[j].y * w.y) + (v[j].z * w.z + v[j].w * w.w); }
                fl[h] = wave_sum(s) * rs; }
            bf16* orow = meta ? (HNMETA + (size_t)mj * DM) : (HN + (size_t)row * DM);
#pragma unroll
            for (int j = 0; j < 8; ++j) { const f32x4 y = v[j] * rs * gv[j]; u32x2 w; w.x = cvt_pk_bf16(y.x, y.y); w.y = cvt_pk_bf16(y.z, y.w); *((u32x2*)orow + lane + 64 * j) = w; }
            if (lane < 8) { float f = fl[0];
#pragma unroll
                for (int h = 1; h < 8; ++h) f = (lane == h) ? fl[h] : f;
                const float lf = log_sigmoid(f + bfv[lane]);
                if (meta) { for (int bb = 0; bb < NB; ++bb) LOGF[(bb * NH + lane) * PP + PADN + mj] = lf; }
                else { const int bb = row >> 12, t = row & 4095; LOGF[(bb * NH + lane) * PP + 128 + t] = lf; } }
        }
    }
}

__device__ __forceinline__ void p1_cumsum(Frame& F) {
    const int gw = F.vcu * NWAVES + F.wave, NGW = F.G * NWAVES, lane = F.lane;
    const float* LOGF = (const float*)(F.ws + WS_LOGF); float* CUM = (float*)(F.ws + WS_CUM);
    for (int s = gw; s < NB * NH; s += NGW) {
        const float* src = LOGF + (size_t)s * PP + lane * 66; float* dst = CUM + (size_t)s * PP + lane * 66;
        float loc = 0.f; for (int i = 0; i < 66; ++i) loc += src[i];
        float inc = loc;
#pragma unroll
        for (int o = 1; o < 64; o <<= 1) { const float t = __shfl_up(inc, o); if (lane >= o) inc += t; }
        float run = inc - loc;
        for (int i = 0; i < 66; ++i) { run += src[i]; dst[i] = run; }
    }
}
__device__ __forceinline__ void p1_meta_kv(Frame& F) {
    const int lane = F.lane, w = F.wave;
    const bf16* HNMETA = (const bf16*)(F.ws + WS_HNMETA); const bf16* WINT = (const bf16*)(F.ws + WS_WINT); bf16* U = (bf16*)(F.ws + WS_U);
    const f32x2* ROPE = (const f32x2*)(F.ws + WS_ROPE);
    LAS float* red = (LAS float*)F.lds;
    for (int blk = blockIdx.x; blk < 256; blk += F.G) {
        const int kv0 = blk * 16, q = kv0 >> 10, col0 = kv0 & 1023;
        const int cls = (q == 0) ? 1 : (q == 1) ? 2 : (q == 2) ? 4 : 5;
        const int nrow0 = ((q == 0) ? 1024 : (q == 1) ? 2048 : (q == 2) ? 4096 : 5120) + col0;
        f32x4 acc = (f32x4){0.f, 0.f, 0.f, 0.f};
#pragma unroll
        for (int s = 0; s < 8; ++s) { const int k0 = w * 256 + s * 32 + 8 * (lane >> 4);
            const bf16x8 a = *(const bf16x8*)(HNMETA + (size_t)(lane & 15) * DM + k0);
            const bf16x8 b = *(const bf16x8*)(WINT + (size_t)(nrow0 + (lane & 15)) * DM + k0);
            acc = __builtin_amdgcn_mfma_f32_16x16x32_bf16(a, b, acc, 0, 0, 0); }
#pragma unroll
        for (int r = 0; r < 4; ++r) red[w * 256 + ((lane >> 4) * 4 + r) * 16 + (lane & 15)] = acc[r];
        __syncthreads();
        if (F.tid < 256) { const int row = F.tid >> 4, col = F.tid & 15;
            float v = 0.f, vp = 0.f;
#pragma unroll
            for (int ww = 0; ww < 8; ++ww) { v += red[ww * 256 + row * 16 + col]; vp += red[ww * 256 + row * 16 + (col ^ 1)]; }
            float o = v;
            if (q == 2) { const int d = (col0 + col) & 127; const f32x2 cs = ROPE[row * 64 + (d >> 1)];
                const int hh = (col0 + col) >> 7; const float lg2h = log2f(1.0f - exp2f(-5.0f - (float)hh));
                o = ((col & 1) ? (v * cs.x + vp * cs.y) : (v * cs.x - vp * cs.y)) * SCALE * exp2f(-(float)(PADN + row + 1) * lg2h); }
            const unsigned short ob = (unsigned short)(cvt_pk_bf16(o, 0.f) & 0xffffu);
            for (int bb = 0; bb < NB; ++bb) U[cls * USTR + ((size_t)(bb * PP + PADN + row)) * 1024 + col0 + col] = ob; }
        __syncthreads();
    }
}

struct PInProj {
    static constexpr bool PERM = true, HAS_MID = false;
    int nt; const char* Abase; unsigned ldb2; const char* Bt; bf16* U; const f32x2* ROPE;
    __device__ __forceinline__ void a_offs(const g8::Unit& u, const int (&R)[2], const int (&C)[2], unsigned (&o)[2][2]) const {
#pragma unroll
        for (int h = 0; h < 2; ++h)
#pragma unroll
            for (int i = 0; i < 2; ++i) o[h][i] = (unsigned)(((u.pm * 256 + h * 128 + R[i]) * DM + C[i]) * 2);
    }
    __device__ __forceinline__ const char* b_tile(const g8::Unit& u, int t) const { return Bt + (size_t)u.pn * 256 * ldb2 + (size_t)t * 128; }
    __device__ __forceinline__ void mid(f32x4 (&)[2][2][4][2], const g8::Unit&, int, int, int, int) const {}
    __device__ __forceinline__ void epi(const f32x4 (&acc)[2][2][4][2], const g8::Unit& u, int wr, int wc, int fr, int fq) const {
        const int cls = u.pn >> 2;
        bf16* base = U + (size_t)cls * USTR;
        const int ccol0 = (u.pn & 3) * 256 + wc * 32 + 8 * fq;
        const int bb = u.pm >> 4;
#pragma unroll
        for (int ai = 0; ai < 2; ++ai)
#pragma unroll
            for (int m = 0; m < 4; ++m) {
                const int t = ((u.pm & 15) << 8) + ai * 128 + wr * 64 + m * 16 + fr;
                bf16* rowp = base + ((size_t)(bb * PP + 128 + t)) * 1024 + ccol0;
                f32x4 c0 = (f32x4){1.f, 0.f, 1.f, 0.f}, c1 = c0;
                if (cls == 3 || cls == 4) { const f32x4* rp = (const f32x4*)(ROPE + (size_t)(t + 16) * 64 + wc * 16 + fq * 4); c0 = rp[0]; c1 = rp[1]; }
#pragma unroll
                for (int bj = 0; bj < 2; ++bj) {
                    f32x4 v0 = acc[ai][bj][m][0], v1 = acc[ai][bj][m][1];
                    if (cls == 3 || cls == 4) {
                        f32x4 r0, r1;
                        r0.x = v0.x * c0.x - v0.y * c0.y; r0.y = v0.y * c0.x + v0.x * c0.y; r0.z = v0.z * c0.z - v0.w * c0.w; r0.w = v0.w * c0.z + v0.z * c0.w;
                        r1.x = v1.x * c1.x - v1.y * c1.y; r1.y = v1.y * c1.x + v1.x * c1.y; r1.z = v1.z * c1.z - v1.w * c1.w; r1.w = v1.w * c1.z + v1.z * c1.w;
                        const int hh = (u.pn & 3) * 2 + bj; const float lg2h = log2f(1.0f - exp2f(-5.0f - (float)hh)); const float ip1 = (float)((t & 127) + 1);
                        const float sc = (cls == 4) ? SCALE * exp2f(-ip1 * lg2h) : exp2f(ip1 * lg2h); v0 = r0 * sc; v1 = r1 * sc;
                    } else if (cls == 6) {
#pragma unroll
                        for (int e = 0; e < 4; ++e) { v0[e] = v0[e] / (1.f + __expf(-v0[e])); v1[e] = v1[e] / (1.f + __expf(-v1[e])); }
                    }
                    u32x4 w; w.x = cvt_pk_bf16(v0[0], v0[1]); w.y = cvt_pk_bf16(v0[2], v0[3]); w.z = cvt_pk_bf16(v1[0], v1[1]); w.w = cvt_pk_bf16(v1[2], v1[3]);
                    *(u32x4*)(rowp + bj * 128) = w;
                }
            }
    }
};

template <bool RET>
__device__ __forceinline__ void attn_simple(Frame& F) {
    const int gw = F.vcu * NWAVES + F.wave, NGW = F.G * NWAVES, lane = F.lane;
    LAS float* wl = (LAS float*)(F.lds + F.wave * 1024);
    const bf16* U = (const bf16*)(F.ws + WS_U); const float* CUM = (const float*)(F.ws + WS_CUM);
    bf16* OA = (bf16*)(F.ws + WS_HN); float* SSQ = (float*)(F.ws + WS_SSQ);
    for (int row = gw; row < NB * NH * SEQ; row += NGW) {
        const int t = row & 4095, bh = row >> 12, b = bh >> 3, h = bh & 7, p = 128 + t, m = b * SEQ + t;
        const bf16* Qb = U + (RET ? 3 : 0) * USTR + ((size_t)(b * PP + p)) * 1024 + h * 128;
        const bf16* Kb = U + (RET ? 4 : 1) * USTR + ((size_t)b * PP) * 1024 + h * 128;
        const bf16* Vb = U + (RET ? 5 : 2) * USTR + ((size_t)b * PP) * 1024 + h * 128;
        { const unsigned qw = *(const unsigned*)(Qb + 2 * lane); wl[2 * lane] = bf_lo(qw); wl[2 * lane + 1] = bf_hi(qw); }
        LDS_WAIT(); asm volatile("" ::: "memory");
        float m_run = -1e30f, l_run = 0.f, o0 = 0.f, o1 = 0.f;
        const float ct = RET ? 0.f : CUM[(size_t)bh * PP + p];
        const float lg2 = RET ? log2f(1.0f - exp2f(-5.0f - (float)h)) : 0.f;
        for (int s0 = 64; s0 <= p; s0 += 64) {
            const int s = s0 + lane;
            const bf16* kr = Kb + (size_t)s * 1024;
            float sc = 0.f;
#pragma unroll
            for (int c = 0; c < 16; ++c) { const u32x4 kv = *(const u32x4*)(kr + 8 * c); const f32x4 qa = *(const LAS f32x4*)(wl + 8 * c), qb = *(const LAS f32x4*)(wl + 8 * c + 4);
                sc += bf_lo(kv.x) * qa.x + bf_hi(kv.x) * qa.y + bf_lo(kv.y) * qa.z + bf_hi(kv.y) * qa.w + bf_lo(kv.z) * qb.x + bf_hi(kv.z) * qb.y + bf_lo(kv.w) * qb.z + bf_hi(kv.w) * qb.w; }
            const bool valid = (s <= p) && (s >= PADN);
            float pw;
            if constexpr (RET) { pw = valid ? sc * exp2f((float)(((p >> 7) - (s >> 7)) * 128) * lg2) : 0.f; }
            else {
                const float lg = valid ? (sc * SCALE + (ct - CUM[(size_t)bh * PP + s])) : -__builtin_inff();
                const float mn = fmaxf(m_run, wave_max(lg)); const float alpha = __expf(m_run - mn);
                pw = valid ? __expf(lg - mn) : 0.f;
                l_run = l_run * alpha + wave_sum(pw); o0 *= alpha; o1 *= alpha; m_run = mn;
            }
            asm volatile("" ::: "memory");
            wl[128 + lane] = pw;
            LDS_WAIT(); asm volatile("" ::: "memory");
#pragma unroll 8
            for (int k = 0; k < 64; ++k) { const float pk = wl[128 + k]; const unsigned vw = *(const unsigned*)(Vb + (size_t)(s0 + k) * 1024 + 2 * lane); o0 += pk * bf_lo(vw); o1 += pk * bf_hi(vw); }
            LDS_WAIT(); asm volatile("" ::: "memory");
        }
        if constexpr (RET) {
            const float mu = wave_sum(o0 + o1) * (1.0f / HD); const float d0 = o0 - mu, d1 = o1 - mu;
            const float var = wave_sum(d0 * d0 + d1 * d1) * (1.0f / HD); const float r = 1.0f / sqrtf(var + EPS);
            const unsigned gw2 = *(const unsigned*)(U + 6 * USTR + ((size_t)(b * PP + p)) * 1024 + h * 128 + 2 * lane);
            *(unsigned*)(OA + (size_t)m * DM + 1024 + h * 128 + 2 * lane) = cvt_pk_bf16(d0 * r * bf_lo(gw2), d1 * r * bf_hi(gw2));
        } else {
            const float il = 1.0f / l_run; o0 *= il; o1 *= il;
            *(unsigned*)(OA + (size_t)m * DM + h * 128 + 2 * lane) = cvt_pk_bf16(o0, o1);
            const float sq = wave_sum(o0 * o0 + o1 * o1); if (lane == 0) SSQ[(size_t)m * 8 + h] = sq;
        }
        asm volatile("" ::: "memory");
    }
}


namespace fox {
constexpr int NW = 8, QBLK = 32, KVBLK = 64, QB = 256, D = 128, LDQ = 1024, LDO = 2048;
constexpr int SHM_V = KVBLK * D * 2, SHM_K = KVBLK * D * 2;
constexpr int OFF_WS = 2 * SHM_V + 2 * SHM_K, OFF_CUM = OFF_WS + 2048, LDS_NEED = OFF_CUM + PP * 4;
static_assert(LDS_NEED <= RING_BYTES, "fox lds");
constexpr float THR = 8.f;
constexpr float INVS = 11.313708498984761f;
typedef float f32x16 __attribute__((ext_vector_type(16)));
typedef short s16x4 __attribute__((ext_vector_type(4)));
#define KSWZ(row, colB) ((row) * 256 + ((colB) ^ (((row) & 7) << 4)))
#define SBAR() __builtin_amdgcn_sched_barrier(0)
__device__ __forceinline__ int v_st(int k, int c) { const int kk = (k & ~0xC) | ((k & 4) << 1) | ((k & 8) >> 1); return ((kk >> 3) * 4 + (c >> 5)) * 512 + ((kk & 7) * 32 + (c & 31)) * 2; }
__device__ __forceinline__ int v_rd_base(int lane) { return ((lane & 3) << 3) | (((lane >> 2) & 3) << 6) | (((lane >> 4) & 1) << 5) | (((lane >> 5) & 1) << 8); }
constexpr int v_rd_off(int d0, int ks, int half) { return d0 * 512 + ks * 4096 + half * 2048; }
__device__ __forceinline__ int crow(int r, int hi) { return (r & 3) + 8 * (r >> 2) + 4 * hi; }
__device__ __forceinline__ unsigned cvtpk(float lo, float hi) { unsigned r; asm volatile("v_cvt_pk_bf16_f32 %0, %1, %2" : "=v"(r) : "v"(lo), "v"(hi)); return r; }
__device__ __forceinline__ bf16x8 load8(const bf16* p) { return *reinterpret_cast<const bf16x8*>(p); }
__device__ __forceinline__ void mask_causal(f32x16& p0, f32x16& p1, int dq) {
    const float NEG = -__builtin_inff();
#pragma unroll
    for (int r = 0; r < 16; ++r) { const int c = (r & 3) + 8 * (r >> 2); if (dq - c < 0) p0[r] = NEG; if (dq - c - 32 < 0) p1[r] = NEG; }
}
__device__ __forceinline__ void mask_pad(f32x16& p0, f32x16& p1, int hi) {
    const float NEG = -__builtin_inff();
#pragma unroll
    for (int r = 0; r < 16; ++r) { const int c = (r & 3) + 8 * (r >> 2); p0[r] = NEG; if (c + 4 * hi < 16) p1[r] = NEG; }
}
__device__ __forceinline__ void partialSM(f32x16& p0, f32x16& p1, float& m_reg, float& mn, float& alpha) {
    float pmax = p0[0]; for (int r = 1; r < 16; ++r) pmax = fmaxf(pmax, p0[r]); for (int r = 0; r < 16; ++r) pmax = fmaxf(pmax, p1[r]);
    { auto rr = __builtin_amdgcn_permlane32_swap(__float_as_uint(pmax), __float_as_uint(pmax), false, false);
      pmax = fmaxf(__uint_as_float(rr[0]), __uint_as_float(rr[1])); }
    constexpr float C2 = 1.4426950408889634f * SCALE;
    if (__builtin_expect(__all((pmax - m_reg) * SCALE <= THR), 1)) { mn = m_reg; alpha = 1.f; }
    else { mn = fmaxf(m_reg, pmax); alpha = __builtin_amdgcn_exp2f((m_reg - mn) * C2); m_reg = mn; }
    const float mnL = -mn * C2;
    for (int r = 0; r < 16; ++r) p0[r] = fmaf(p0[r], C2, mnL); for (int r = 0; r < 16; ++r) p1[r] = fmaf(p1[r], C2, mnL);
    for (int r = 0; r < 16; ++r) p0[r] = __builtin_amdgcn_exp2f(p0[r]);
}
__device__ __forceinline__ void finishSM(f32x16& p0, f32x16& p1, float alpha, float& l_reg, bf16x8& pa0, bf16x8& pa1, bf16x8& pa2, bf16x8& pa3) {
    for (int r = 0; r < 16; ++r) p1[r] = __builtin_amdgcn_exp2f(p1[r]);
    float ps = 0; for (int r = 0; r < 16; ++r) ps += p0[r]; for (int r = 0; r < 16; ++r) ps += p1[r];
    { auto rr = __builtin_amdgcn_permlane32_swap(__float_as_uint(ps), __float_as_uint(ps), false, false);
      ps = __uint_as_float(rr[0]) + __uint_as_float(rr[1]); }
    l_reg = l_reg * alpha + ps;
#define PK4(P, B_, OUT) do { unsigned a0 = cvtpk(P[B_+0], P[B_+1]), a1 = cvtpk(P[B_+2], P[B_+3]);                          \
        unsigned b0 = cvtpk(P[B_+4], P[B_+5]), b1 = cvtpk(P[B_+6], P[B_+7]);                                             \
        auto r0 = __builtin_amdgcn_permlane32_swap(a0, b0, false, false); auto r1 = __builtin_amdgcn_permlane32_swap(a1, b1, false, false); \
        u32x4 w = {r0[0], r1[0], r0[1], r1[1]}; OUT = *reinterpret_cast<bf16x8*>(&w); } while (0)
    PK4(p0, 0, pa0); PK4(p0, 8, pa1); PK4(p1, 0, pa2); PK4(p1, 8, pa3);
#undef PK4
}
template <int KB>
__device__ __forceinline__ void qkt(f32x16& p0, f32x16& p1, const LAS char* K_lds, int r32, int hi, const bf16x8* qr, const LAS float* cs) {
#pragma unroll
    for (int g = 0; g < 4; ++g) { const f32x4 a = *(const LAS f32x4*)(cs + 8 * g), b = *(const LAS f32x4*)(cs + 32 + 8 * g);
        p0[4 * g] = a[0]; p0[4 * g + 1] = a[1]; p0[4 * g + 2] = a[2]; p0[4 * g + 3] = a[3]; p1[4 * g] = b[0]; p1[4 * g + 1] = b[1]; p1[4 * g + 2] = b[2]; p1[4 * g + 3] = b[3]; }
    const LAS char* kb[4];
#pragma unroll
    for (int dd = 0; dd < 4; ++dd) kb[dd] = K_lds + KB * SHM_K + KSWZ(r32, (dd * 16 + hi * 8) * 2);
#pragma unroll
    for (int d0 = 0; d0 < 8; ++d0) { const LAS char* a = kb[d0 & 3] + (d0 >> 2) * 128;
        bf16x8 b0 = *reinterpret_cast<const LAS bf16x8*>(a);
        bf16x8 b1 = *reinterpret_cast<const LAS bf16x8*>(a + 32 * 256);
        p0 = __builtin_amdgcn_mfma_f32_32x32x16_bf16(b0, qr[d0], p0, 0, 0, 0);
        p1 = __builtin_amdgcn_mfma_f32_32x32x16_bf16(b1, qr[d0], p1, 0, 0, 0); }
}
template <int VB>
__device__ __forceinline__ void pv_tile(f32x16* o, int vb0, bf16x8 pa0, bf16x8 pa1, bf16x8 pa2, bf16x8 pa3) {
#define TRRD(dst, off) asm volatile("ds_read_b64_tr_b16 %0, %1 offset:%2" : "=&v"(dst) : "v"(vb0), "i"(off) : "memory")
#define PV_D0(d0) do { s16x4 l0, l1, l2, l3, h0, h1, h2, h3; constexpr int b_ = VB * SHM_V + v_rd_off(d0, 0, 0); \
        TRRD(l0, b_); TRRD(h0, b_ + 2048); TRRD(l1, b_ + 4096); TRRD(h1, b_ + 6144); TRRD(l2, b_ + 8192); TRRD(h2, b_ + 10240); TRRD(l3, b_ + 12288); TRRD(h3, b_ + 14336); \
        asm volatile("s_waitcnt lgkmcnt(0)" ::: "memory"); SBAR();   \
        o[d0] = __builtin_amdgcn_mfma_f32_32x32x16_bf16(pa0, (bf16x8){l0[0], l0[1], l0[2], l0[3], h0[0], h0[1], h0[2], h0[3]}, o[d0], 0, 0, 0);   \
        o[d0] = __builtin_amdgcn_mfma_f32_32x32x16_bf16(pa1, (bf16x8){l1[0], l1[1], l1[2], l1[3], h1[0], h1[1], h1[2], h1[3]}, o[d0], 0, 0, 0);   \
        o[d0] = __builtin_amdgcn_mfma_f32_32x32x16_bf16(pa2, (bf16x8){l2[0], l2[1], l2[2], l2[3], h2[0], h2[1], h2[2], h2[3]}, o[d0], 0, 0, 0);   \
        o[d0] = __builtin_amdgcn_mfma_f32_32x32x16_bf16(pa3, (bf16x8){l3[0], l3[1], l3[2], l3[3], h3[0], h3[1], h3[2], h3[3]}, o[d0], 0, 0, 0); } while (0)
    PV_D0(0); PV_D0(1); PV_D0(2); PV_D0(3);
#undef PV_D0
#undef TRRD
}
struct BlockRef { int bh, qb; };
struct Bases { const bf16* U; bf16* OA; float* SSQ; const float* CUM; };
__device__ __forceinline__ int blk_p0(const BlockRef& r) { return 128 + r.qb * 256; }
__device__ __forceinline__ const bf16* blk_q(const Bases& B, const BlockRef& r) { return B.U + ((size_t)((r.bh >> 3) * PP + blk_p0(r))) * 1024 + (r.bh & 7) * 128; }
__device__ __forceinline__ const bf16* blk_k(const Bases& B, const BlockRef& r) { return B.U + 1 * USTR + ((size_t)(r.bh >> 3) * PP) * 1024 + (r.bh & 7) * 128; }
__device__ __forceinline__ const bf16* blk_v(const Bases& B, const BlockRef& r) { return B.U + 2 * USTR + ((size_t)(r.bh >> 3) * PP) * 1024 + (r.bh & 7) * 128; }
struct Seam { bf16x8 qr[8]; bf16x8 st_v0, st_v1, st_k0, st_k1; };
#define ROW(p, k0, rr) ((p) + (size_t)((k0) + (rr)) * LDQ + sc)
#define VMW() asm volatile("s_waitcnt vmcnt(0)" ::: "memory")
#define VMWN(n) asm volatile("s_waitcnt vmcnt(%0)" :: "i"(n) : "memory")
#define SLOAD_H(Kp, Vp, k0) do { S.st_v0 = load8(ROW(Vp, k0, sr)); S.st_v1 = load8(ROW(Vp, k0, 32 + sr));              \
                         S.st_k0 = load8(ROW(Kp, k0, sr)); S.st_k1 = load8(ROW(Kp, k0, 32 + sr)); } while (0)
#define SWRITE_HK(bf) do { *(LAS bf16x8*)(K_lds + (bf) * SHM_K + kws) = S.st_k0; *(LAS bf16x8*)(K_lds + (bf) * SHM_K + kws + 32 * 256) = S.st_k1; } while (0)
#define SWRITE_HV(bf) do { *(LAS bf16x8*)(V_lds + (bf) * SHM_V + vst0) = S.st_v0; *(LAS bf16x8*)(V_lds + (bf) * SHM_V + vst1) = S.st_v1; } while (0)
#define SWRITE_H(bf) do { SWRITE_HV(bf); SWRITE_HK(bf); } while (0)
__device__ __forceinline__ void prime(const Bases& B, const BlockRef& cur, LAS char* lds, Seam& S) {
    const int tid = threadIdx.x, wid = __builtin_amdgcn_readfirstlane(tid >> 6), lane = tid & 63, r32 = lane & 31, hi = lane >> 5;
    const int sr = tid >> 4, sc = (tid & 15) * 8, kws = KSWZ(sr, sc * 2); LAS char* K_lds = lds + 2 * SHM_V;
    const int kb0 = KVBLK;
#pragma unroll
    for (int d0 = 0; d0 < 8; ++d0) S.qr[d0] = load8(blk_q(B, cur) + (size_t)(wid * QBLK + r32) * LDQ + d0 * 16 + hi * 8);
    { const bf16* Kp = blk_k(B, cur); const bf16* Vp = blk_v(B, cur); SLOAD_H(Kp, Vp, kb0); } VMW(); SWRITE_HK(0);
    __syncthreads();
}
__device__ __forceinline__ void block(const Bases& B, const BlockRef& cur, const BlockRef& nxt, LAS char* lds, Seam& S) {
    const int tid = threadIdx.x, wid = __builtin_amdgcn_readfirstlane(tid >> 6), lane = tid & 63, r32 = lane & 31, hi = lane >> 5;
    const int P0 = blk_p0(cur);
    const int j_hi = (P0 + QB - 1) / KVBLK + 1;
    const int NT = j_hi - 1;
    const int kbn = KVBLK;
    const int qlo = P0 + wid * QBLK, qm = qlo + r32 - 4 * hi;
    LAS char* V_lds = lds; LAS char* K_lds = lds + 2 * SHM_V;
    LAS float* ws = (LAS float*)(lds + OFF_WS) + wid * 64; LAS float* li_l = ws; LAS float* al_l = ws + 32;
    LAS float* cumS = (LAS float*)(lds + OFF_CUM);
    { const float* CUMG = B.CUM + (size_t)cur.bh * PP; const float cref = CUMG[P0]; const int n4 = (P0 + QB) >> 2;
      for (int i = tid; i < n4; i += 512) { const f32x4 c = *((const f32x4*)CUMG + i); *((LAS f32x4*)cumS + i) = (cref - c) * INVS; } }
    __syncthreads();
    float m_reg = -1e30f, l_reg = 0; f32x16 o[4] = {};
    const int sr = tid >> 4, sc = (tid & 15) * 8, vst0 = v_st(sr, sc), vst1 = v_st(32 + sr, sc), kws = KSWZ(sr, sc * 2);
    const int vb0 = (int)(uintptr_t)V_lds + v_rd_base(lane);
    const bf16* Kh = blk_k(B, cur); const bf16* Vh = blk_v(B, cur);
#define RESC(a) do { if (__any((a) < 1.f)) { if (hi == 0) al_l[r32] = (a); asm volatile("s_waitcnt lgkmcnt(0)" ::: "memory");              \
                     for (int d_ = 0; d_ < 4; ++d_) for (int r = 0; r < 16; ++r) o[d_][r] *= al_l[crow(r, hi)]; } } while (0)
#define KBASE(t) ((1 + (t)) * KVBLK)
#define CSP(t) (cumS + KBASE(t) + 4 * hi)
#define MASKT(P0_, P1_, t) do { const int kb_ = KBASE(t); if (kb_ + KVBLK - 1 > qlo) mask_causal(P0_, P1_, qm - kb_); if (kb_ == KVBLK) mask_pad(P0_, P1_, hi); } while (0)
#define SEAM_K0() do { VMWN(8); SWRITE_HK(0); SBAR(); } while (0)
    f32x16 pA0, pA1, pB0, pB1; float mnA, mnB, alA, alB; bf16x8 pa0, pa1, pa2, pa3;
    SWRITE_HV(0); SBAR();
    if (NT > 1) { SLOAD_H(Kh, Vh, KBASE(1)); }
    SBAR(); qkt<0>(pA0, pA1, K_lds, r32, hi, S.qr, CSP(0));
    MASKT(pA0, pA1, 0); partialSM(pA0, pA1, m_reg, mnA, alA);
    if (NT > 1) { VMW(); SWRITE_H(1); }
    __syncthreads();
#define HALF_STEP(PX0, PX1, mnX, alX, PY0, PY1, alY, t, KB, VB, SB) do {                                                      \
        SBAR(); qkt<KB>(PX0, PX1, K_lds, r32, hi, S.qr, CSP(t));                                             \
        finishSM(PY0, PY1, alY, l_reg, pa0, pa1, pa2, pa3); SBAR();                                                           \
        if ((t) + 1 < NT) { SLOAD_H(Kh, Vh, KBASE((t) + 1)); SBAR(); }                                               \
        pv_tile<VB>(o, vb0, pa0, pa1, pa2, pa3); MASKT(PX0, PX1, (t)); partialSM(PX0, PX1, m_reg, mnX, alX);                                        \
        __syncthreads();                                                                                                      \
        if ((t) + 1 < NT) { VMW(); SWRITE_H(SB); }                                                                          \
        RESC(alX); __syncthreads(); } while (0)
    for (int t = 1; t + 1 < NT; t += 2) {
        HALF_STEP(pB0, pB1, mnB, alB, pA0, pA1, alA, t, 1, 0, 0);
        HALF_STEP(pA0, pA1, mnA, alA, pB0, pB1, alB, t + 1, 0, 1, 1);
    }
    const bool even = (NT & 1) == 0;
    if (even) { SBAR(); qkt<1>(pB0, pB1, K_lds, r32, hi, S.qr, CSP(NT - 1)); SBAR(); }
    { const bf16* Kn = blk_k(B, nxt); const bf16* Vn = blk_v(B, nxt); SLOAD_H(Kn, Vn, kbn); } SBAR();
    { const bf16* Qn = blk_q(B, nxt);
#pragma unroll
    for (int d0 = 0; d0 < 8; ++d0) S.qr[d0] = load8(Qn + (size_t)(wid * QBLK + r32) * LDQ + d0 * 16 + hi * 8); }
    SBAR();
    finishSM(pA0, pA1, alA, l_reg, pa0, pa1, pa2, pa3); SBAR();
    pv_tile<0>(o, vb0, pa0, pa1, pa2, pa3);
    if (even) { MASKT(pB0, pB1, NT - 1); partialSM(pB0, pB1, m_reg, mnB, alB); __syncthreads(); RESC(alB);
        finishSM(pB0, pB1, alB, l_reg, pa0, pa1, pa2, pa3); SBAR(); pv_tile<1>(o, vb0, pa0, pa1, pa2, pa3); }
    SBAR(); SEAM_K0();
    if (hi == 0) li_l[r32] = l_reg; asm volatile("s_waitcnt lgkmcnt(0)" ::: "memory");
    float rli[16];
#pragma unroll
    for (int r = 0; r < 16; ++r) rli[r] = __builtin_amdgcn_rcpf(li_l[crow(r, hi)]);
    int r32e = r32, hie = hi; asm volatile("" : "+v"(r32e), "+v"(hie));
    const size_t m0 = (size_t)(cur.bh >> 3) * SEQ + cur.qb * 256 + wid * QBLK + 4 * hie;
    bf16* Ow = B.OA + m0 * LDO + (cur.bh & 7) * 128 + r32e; float* Sw = B.SSQ + m0 * 8 + (cur.bh & 7);
#pragma unroll
    for (int r = 0; r < 16; ++r) { const int orow = (r & 3) + 8 * (r >> 2); float sq = 0.f;
#pragma unroll
        for (int d0 = 0; d0 < 4; ++d0) { const float v = o[d0][r] * rli[r]; sq += v * v;
            const float vn = __shfl_xor(v, 1);
            if ((r32e & 1) == 0) *(unsigned*)(Ow + (size_t)orow * LDO + d0 * 32) = cvtpk(v, vn); }
        sq += __shfl_xor(sq, 1); sq += __shfl_xor(sq, 2); sq += __shfl_xor(sq, 4); sq += __shfl_xor(sq, 8); sq += __shfl_xor(sq, 16);
        if (r32e == 0) Sw[(size_t)orow * 8] = sq; }
    __syncthreads();
#undef RESC
#undef KBASE
#undef CSP
#undef MASKT
#undef SEAM_K0
#undef HALF_STEP
}
#undef ROW
#undef VMW
#undef VMWN
#undef SLOAD_H
#undef SWRITE_HK
#undef SWRITE_HV
#undef SWRITE_H
#undef KSWZ
#undef SBAR
}

__device__ __forceinline__ void fox_phase(Frame& F) {
    const int total = NB * NH * 8, stride = F.G; int L = F.vcu; if (L >= total) return;
    const fox::Bases B{(const bf16*)(F.ws + WS_U), (bf16*)(F.ws + WS_HN), (float*)(F.ws + WS_SSQ), (const float*)(F.ws + WS_CUM)};
    int pass = 0;
    fox::BlockRef cur{L >> 3, L & 7};
    fox::Seam S;
    fox::prime(B, cur, (LAS char*)F.lds, S);
    for (;;) {
        const bool more_pass = pass == 0, more_item = L + stride < total, last = !more_pass && !more_item;
        int Ln = L, passn = pass + 1;
        if (!more_pass) { passn = 0; Ln = more_item ? L + stride : L; }
        fox::BlockRef nxt{Ln >> 3, passn ? 15 - (Ln & 7) : (Ln & 7)};
        if (last) nxt = cur;
        fox::block(B, cur, nxt, (LAS char*)F.lds, S);
        if (last) break;
        cur = nxt; pass = passn; L = Ln;
    }
}


namespace ret {
typedef short s16x4 __attribute__((ext_vector_type(4)));
typedef short v4i16_t __attribute__((ext_vector_type(4)));
__device__ __forceinline__ s16x4 vtr(const LAS char* p) { return __builtin_bit_cast(s16x4, __builtin_amdgcn_ds_read_tr16_b64_v4i16((LAS v4i16_t*)p)); }
__device__ __forceinline__ int kswz(int row, int colB) { return row * 256 + (colB ^ ((row & 7) << 4)); }
__device__ __forceinline__ int vswz(int row, int colB) { return row * 256 + (colB ^ ((row & 7) << 5)); }
__device__ __forceinline__ int aswz(int row, int colB) { return row * 256 + (colB ^ ((((row & 3) | ((row >> 1) & 4))) << 5)); }
constexpr int A_KB = 32768, A_VB = 4096, A_OFF_V = 2 * A_KB;
__device__ __forceinline__ void states(Frame& F) {
    const int tid = F.tid, lane = F.lane, w = F.wave, g = lane >> 4, q = (lane & 15) >> 2, pp = lane & 3;
    const bf16* U = (const bf16*)(F.ws + WS_U); bf16* ST = (bf16*)(F.ws + WS_ST);
    LAS char* lds = (LAS char*)F.lds;
    for (int unit = F.vcu; unit < NB * NH * 8; unit += F.G) {
        const int bh = unit >> 3, es = unit & 7, b = bh >> 3, h = bh & 7;
        const bf16* Kg = U + 4 * USTR + ((size_t)b * PP) * 1024 + h * 128;
        const bf16* Vg = U + 5 * USTR + ((size_t)b * PP) * 1024 + h * 128 + es * 16;
        const float wdec = exp2f(128.0f * log2f(1.0f - exp2f(-5.0f - (float)h)));
        f32x4 S = (f32x4){0.f, 0.f, 0.f, 0.f};
        u32x4 kr[4], vr;
#define RA_LOAD(n) do { _Pragma("unroll") for (int i = 0; i < 4; ++i) { const int pc = tid + 512 * i, row = pc >> 4, c16 = pc & 15; kr[i] = *(const u32x4*)(Kg + (size_t)((n) * 128 + row) * 1024 + c16 * 8); } \
        if (tid < 256) { const int row = tid >> 1, c16 = tid & 1; vr = *(const u32x4*)(Vg + (size_t)((n) * 128 + row) * 1024 + c16 * 8); } } while (0)
#define RA_WRITE(bf) do { _Pragma("unroll") for (int i = 0; i < 4; ++i) { const int pc = tid + 512 * i, row = pc >> 4, c16 = pc & 15; *(LAS u32x4*)(lds + (bf) * A_KB + aswz(row, c16 * 16)) = kr[i]; } \
        if (tid < 256) { const int row = tid >> 1, c16 = tid & 1; *(LAS u32x4*)(lds + A_OFF_V + (bf) * A_VB + row * 32 + c16 * 16) = vr; } } while (0)
        RA_LOAD(0); RA_WRITE(0);
        __syncthreads();
        for (int n = 0; n < 32; ++n) {
            const int bf = n & 1;
            if (n + 1 < 32) RA_LOAD(n + 1);
            f32x4 acc = (f32x4){0.f, 0.f, 0.f, 0.f};
#pragma unroll
            for (int s = 0; s < 4; ++s) {
                const int r0 = 32 * s + 8 * g + q;
                const s16x4 a0 = vtr(lds + bf * A_KB + aswz(r0, (16 * w + 4 * pp) * 2)), a1 = vtr(lds + bf * A_KB + aswz(r0 + 4, (16 * w + 4 * pp) * 2));
                const s16x4 b0 = vtr(lds + A_OFF_V + bf * A_VB + r0 * 32 + pp * 8), b1 = vtr(lds + A_OFF_V + bf * A_VB + (r0 + 4) * 32 + pp * 8);
                acc = __builtin_amdgcn_mfma_f32_16x16x32_bf16((bf16x8){a0[0], a0[1], a0[2], a0[3], a1[0], a1[1], a1[2], a1[3]}, (bf16x8){b0[0], b0[1], b0[2], b0[3], b1[0], b1[1], b1[2], b1[3]}, acc, 0, 0, 0);
            }
            S = (S + acc) * wdec;
            { u32x2 o; o.x = cvt_pk_bf16(S[0], S[1]); o.y = cvt_pk_bf16(S[2], S[3]);
              *(u32x2*)(ST + (((size_t)bh * 32 + n) * 128 + es * 16 + (lane & 15)) * 128 + 16 * w + 4 * g) = o; }
            if (n + 1 < 32) { RA_WRITE(bf ^ 1); }
            __syncthreads();
        }
#undef RA_LOAD
#undef RA_WRITE
    }
}
constexpr int B_K = 0, B_V = 32768, B_S = 65536;
__device__ __forceinline__ void outputs(Frame& F) {
    const int tid = F.tid, lane = F.lane, w = F.wave, g = lane >> 4, il = lane & 15, q = il >> 2, pp = lane & 3;
    const bf16* U = (const bf16*)(F.ws + WS_U); const bf16* ST = (const bf16*)(F.ws + WS_ST); bf16* OA = (bf16*)(F.ws + WS_HN);
    LAS char* lds = (LAS char*)F.lds;
    u32x4 pk[4], pv[4], ps[4];
#define RB_LOAD(unit) do { const int bh_ = (unit) >> 5, n_ = ((unit) & 31) + 1, b_ = bh_ >> 3, h_ = bh_ & 7; \
        const bf16* Kg = U + 4 * USTR + ((size_t)(b_ * PP + n_ * 128)) * 1024 + h_ * 128; const bf16* Vg = U + 5 * USTR + ((size_t)(b_ * PP + n_ * 128)) * 1024 + h_ * 128; \
        const bf16* Sg = ST + ((size_t)bh_ * 32 + (n_ - 1)) * 16384; \
        _Pragma("unroll") for (int i = 0; i < 4; ++i) { const int pc = tid + 512 * i, row = pc >> 4, c16 = pc & 15; pk[i] = *(const u32x4*)(Kg + (size_t)row * 1024 + c16 * 8); pv[i] = *(const u32x4*)(Vg + (size_t)row * 1024 + c16 * 8); \
            ps[i] = *(const u32x4*)(Sg + (size_t)row * 128 + c16 * 8); } } while (0)
#define RB_WRITE() do { _Pragma("unroll") for (int i = 0; i < 4; ++i) { const int pc = tid + 512 * i, row = pc >> 4, c16 = pc & 15; *(LAS u32x4*)(lds + B_K + kswz(row, c16 * 16)) = pk[i]; \
            *(LAS u32x4*)(lds + B_V + vswz(row, c16 * 16)) = pv[i]; *(LAS u32x4*)(lds + B_S + kswz(row, c16 * 16)) = ps[i]; } } while (0)
    int unit = F.vcu; if (unit >= NB * NH * 32) return;
    RB_LOAD(unit); RB_WRITE();
    __syncthreads();
    for (;;) {
        const int nu = unit + F.G; const bool more = nu < NB * NH * 32;
        const int bh = unit >> 5, n = (unit & 31) + 1, b = bh >> 3, h = bh & 7;
        const size_t urow = (size_t)(b * PP + n * 128 + 16 * w + il);
        bf16x8 qx[4];
#pragma unroll
        for (int s = 0; s < 4; ++s) qx[s] = *(const bf16x8*)(U + 3 * USTR + urow * 1024 + h * 128 + 32 * s + 8 * g);
        if (more) RB_LOAD(nu);
        u32x2 P[8];
#pragma unroll
        for (int jb = 0; jb < 8; ++jb) {
            P[jb] = (u32x2){0u, 0u};
            if (jb <= w) {
                f32x4 d = (f32x4){0.f, 0.f, 0.f, 0.f};
#pragma unroll
                for (int s = 0; s < 4; ++s) { const bf16x8 a = *(const LAS bf16x8*)(lds + B_K + kswz(16 * jb + il, 64 * s + 16 * g)); d = __builtin_amdgcn_mfma_f32_16x16x32_bf16(a, qx[s], d, 0, 0, 0); }
                if (jb == w) {
#pragma unroll
                    for (int r = 0; r < 4; ++r) if (4 * g + r > il) d[r] = 0.f; }
                P[jb].x = cvt_pk_bf16(d[0], d[1]); P[jb].y = cvt_pk_bf16(d[2], d[3]);
            }
        }
        f32x4 o[8];
#pragma unroll
        for (int eb = 0; eb < 8; ++eb) { f32x4 acc = (f32x4){0.f, 0.f, 0.f, 0.f};
#pragma unroll
            for (int s = 0; s < 4; ++s) { const bf16x8 a = *(const LAS bf16x8*)(lds + B_S + kswz(16 * eb + il, 64 * s + 16 * g)); acc = __builtin_amdgcn_mfma_f32_16x16x32_bf16(a, qx[s], acc, 0, 0, 0); }
#pragma unroll
            for (int t = 0; t < 4; ++t) { if (2 * t <= w) {
                const int r0 = 32 * t + 4 * g + q;
                const s16x4 a0 = vtr(lds + B_V + vswz(r0, (16 * eb + 4 * pp) * 2)), a1 = vtr(lds + B_V + vswz(r0 + 16, (16 * eb + 4 * pp) * 2));
                const u32x4 bw = (u32x4){P[2 * t].x, P[2 * t].y, P[2 * t + 1].x, P[2 * t + 1].y};
                acc = __builtin_amdgcn_mfma_f32_16x16x32_bf16((bf16x8){a0[0], a0[1], a0[2], a0[3], a1[0], a1[1], a1[2], a1[3]}, __builtin_bit_cast(bf16x8, bw), acc, 0, 0, 0); } }
            o[eb] = acc; }
        float sm = 0.f;
#pragma unroll
        for (int eb = 0; eb < 8; ++eb) sm += (o[eb][0] + o[eb][1]) + (o[eb][2] + o[eb][3]);
        sm += __shfl_xor(sm, 16); sm += __shfl_xor(sm, 32);
        const float mu = sm * (1.0f / HD); float sv = 0.f;
#pragma unroll
        for (int eb = 0; eb < 8; ++eb) { o[eb] = o[eb] - mu; sv += (o[eb][0] * o[eb][0] + o[eb][1] * o[eb][1]) + (o[eb][2] * o[eb][2] + o[eb][3] * o[eb][3]); }
        sv += __shfl_xor(sv, 16); sv += __shfl_xor(sv, 32);
        const float rstd = 1.0f / sqrtf(sv * (1.0f / HD) + EPS);
        const size_t m = (size_t)b * SEQ + (n - 1) * 128 + 16 * w + il;
#pragma unroll
        for (int eb = 0; eb < 8; ++eb) { const int e0 = 16 * eb + 4 * g;
            const u32x2 gg = *(const u32x2*)(U + 6 * USTR + urow * 1024 + h * 128 + e0);
            u32x2 ov; ov.x = cvt_pk_bf16(o[eb][0] * rstd * bf_lo(gg.x), o[eb][1] * rstd * bf_hi(gg.x)); ov.y = cvt_pk_bf16(o[eb][2] * rstd * bf_lo(gg.y), o[eb][3] * rstd * bf_hi(gg.y));
            *(u32x2*)(OA + m * DM + 1024 + h * 128 + e0) = ov; }
        __syncthreads();
        if (!more) break;
        RB_WRITE();
        __syncthreads();
        unit = nu;
    }
#undef RB_LOAD
#undef RB_WRITE
}
}

struct POutProj {
    static constexpr bool PERM = false, HAS_MID = true;
    int nt; const char* Abase; unsigned ldb2; const char* Bt; const float* x; float* out; const float* SSQ;
    __device__ __forceinline__ void a_offs(const g8::Unit& u, const int (&R)[2], const int (&C)[2], unsigned (&o)[2][2]) const {
#pragma unroll
        for (int h = 0; h < 2; ++h)
#pragma unroll
            for (int i = 0; i < 2; ++i) o[h][i] = (unsigned)(((u.pm * 256 + h * 128 + R[i]) * DM + C[i]) * 2);
    }
    __device__ __forceinline__ const char* b_tile(const g8::Unit& u, int t) const { return Bt + (size_t)u.pn * 256 * ldb2 + (size_t)t * 128; }
    __device__ __forceinline__ void mid(f32x4 (&acc)[2][2][4][2], const g8::Unit& u, int wr, int wc, int fr, int fq) const {
#pragma unroll
        for (int ai = 0; ai < 2; ++ai)
#pragma unroll
            for (int m = 0; m < 4; ++m) { const int r = u.pm * 256 + ai * 128 + wr * 64 + m * 16 + fr;
                const f32x4 s0 = *(const f32x4*)(SSQ + (size_t)r * 8), s1 = *(const f32x4*)(SSQ + (size_t)r * 8 + 4);
                const float rs = 1.0f / sqrtf(((s0.x + s0.y) + (s0.z + s0.w) + (s1.x + s1.y) + (s1.z + s1.w)) * (1.0f / 1024.0f) + EPS);
#pragma unroll
                for (int bj = 0; bj < 2; ++bj)
#pragma unroll
                    for (int n = 0; n < 2; ++n) acc[ai][bj][m][n] = acc[ai][bj][m][n] * rs; }
    }
    __device__ __forceinline__ void epi(const f32x4 (&acc)[2][2][4][2], const g8::Unit& u, int wr, int wc, int fr, int fq) const {
        const int row0 = u.pm * 256 + wr * 64 + fr, col0 = u.pn * 256 + wc * 32 + 4 * fq;
#pragma unroll
        for (int ai = 0; ai < 2; ++ai)
#pragma unroll
            for (int m = 0; m < 4; ++m) { const size_t off = (size_t)(row0 + ai * 128 + m * 16) * DM + col0;
#pragma unroll
                for (int bj = 0; bj < 2; ++bj)
#pragma unroll
                    for (int n = 0; n < 2; ++n) *(f32x4*)(out + off + bj * 128 + n * 16) = *(const f32x4*)(x + off + bj * 128 + n * 16) + acc[ai][bj][m][n]; }
    }
};

__device__ __forceinline__ void p4_router(Frame& F) {
    const int gw = F.vcu * NWAVES + F.wave, NGW = F.G * NWAVES, lane = F.lane;
    const float* H1 = F.out; const float* g2 = F.in[8]; const float* WRT = (const float*)(F.ws + WS_WRT);
    const float* brg = F.in[10]; const float* bre = F.in[12];
    bf16* HN2 = (bf16*)(F.ws + WS_HN); int* TOK = (int*)(F.ws + WS_TOK); float* WLO = (float*)(F.ws + WS_WLO); float* WHI = (float*)(F.ws + WS_WHI);
    for (int row = gw; row < MTOK; row += NGW) {
        const float* xr = H1 + (size_t)row * DM;
        f32x4 v[8]; float ss = 0.f;
#pragma unroll
        for (int j = 0; j < 8; ++j) { v[j] = *((const f32x4*)xr + lane + 64 * j); ss += (v[j].x * v[j].x + v[j].y * v[j].y) + (v[j].z * v[j].z + v[j].w * v[j].w); }
        const float rs = 1.0f / sqrtf(wave_sum(ss) * (1.0f / DM) + EPS);
        float mylg = 0.f;
#pragma unroll 1
        for (int jj = 0; jj < 20; ++jj) { float s = 0.f;
#pragma unroll
            for (int j = 0; j < 8; ++j) { const f32x4 w = *((const f32x4*)(WRT + jj * DM) + lane + 64 * j); s += (v[j].x * w.x + v[j].y * w.y) + (v[j].z * w.z + v[j].w * w.w); }
            const float tot = wave_sum(s) * rs + (jj < 4 ? brg[jj] : bre[jj - 4]); mylg = (lane == jj) ? tot : mylg; }
        float lgt[20];
#pragma unroll
        for (int jj = 0; jj < 20; ++jj) lgt[jj] = __shfl(mylg, jj);
        bf16* orow = HN2 + (size_t)row * DM;
#pragma unroll
        for (int j = 0; j < 8; ++j) { const f32x4 g = *((const f32x4*)g2 + lane + 64 * j); const f32x4 y = v[j] * rs * g; u32x2 w; w.x = cvt_pk_bf16(y.x, y.y); w.y = cvt_pk_bf16(y.z, y.w); *((u32x2*)orow + lane + 64 * j) = w; }
        int gs = 0; float gm = lgt[0];
#pragma unroll
        for (int i = 1; i < 4; ++i) if (lgt[i] > gm) { gm = lgt[i]; gs = i; }
        float den = 0.f;
#pragma unroll
        for (int i = 0; i < 4; ++i) den += __expf(lgt[i] - gm);
        const float pg = 1.0f / den;
        float e4[4];
#pragma unroll
        for (int i = 0; i < 4; ++i) { float a = lgt[4 + i];
#pragma unroll
            for (int g = 1; g < 4; ++g) a = (gs == g) ? lgt[4 + 4 * g + i] : a;
            e4[i] = a; }
        int i1 = 0; float v1 = e4[0];
#pragma unroll
        for (int i = 1; i < 4; ++i) if (e4[i] > v1) { v1 = e4[i]; i1 = i; }
        int i2 = -1; float v2 = -__builtin_inff();
#pragma unroll
        for (int i = 0; i < 4; ++i) if (i != i1 && e4[i] > v2) { v2 = e4[i]; i2 = i; }
        const float ex = __expf(v2 - v1); const float w1 = pg / (1.f + ex), w2 = pg * ex / (1.f + ex);
        const int lo = i1 < i2 ? i1 : i2, hi = i1 < i2 ? i2 : i1; const float wlo = i1 < i2 ? w1 : w2, whi = i1 < i2 ? w2 : w1;
        const int pair = (lo == 0) ? (hi - 1) : (lo == 1) ? (hi + 1) : 5;
        const int cls = gs * 6 + pair;
        if (lane == 0) { const unsigned pos = atomicAdd(F.ctl + CW_CNT + 64 * cls, 1u);
            TOK[cls * CLS_CAP + pos] = row; WLO[cls * CLS_CAP + pos] = wlo; WHI[cls * CLS_CAP + pos] = whi; }
    }
}

__device__ __forceinline__ void cls_experts(int cls, int& elo, int& ehi) { const int g = cls / 6, pr = cls % 6; const int lo = pr < 3 ? 0 : (pr < 5 ? 1 : 2), hi = pr < 3 ? pr + 1 : (pr < 5 ? pr - 1 : 3); elo = 4 * g + lo; ehi = 4 * g + hi; }
__device__ __forceinline__ void moe_tables(Frame& F) {
    volatile LAS int* T = (volatile LAS int*)(F.lds + TBL_OFF);
    if (F.tid == 0) {
        int base = 0;
        for (int c = 0; c < NCLS; ++c) { int n = (int)__hip_atomic_load(F.ctl + CW_CNT + 64 * c, __ATOMIC_RELAXED, __HIP_MEMORY_SCOPE_AGENT); if (n > CLS_CAP) n = CLS_CAP; T[c] = n; T[32 + c] = base; const int nt = (n + 255) >> 8;
            for (int i = 0; i < nt; ++i) T[96 + base + i] = c; base += nt; }
        T[64] = base;
        int ne = 0;
        for (int e = 0; e < NEXP; ++e) { T[72 + e] = ne;
            for (int c = (e >> 2) * 6; c < (e >> 2) * 6 + 6; ++c) { int elo, ehi; cls_experts(c, elo, ehi); if (elo != e && ehi != e) continue; const int slot = (ehi == e) ? 1 : 0;
                const int nt = (T[c] + 255) >> 8; for (int i = 0; i < nt; ++i) { T[192 + ne] = (T[32 + c] + i) | (slot << 8) | (c << 16) | (i << 24); ++ne; } } }
        T[72 + NEXP] = ne; T[65] = ne;
    }
    __syncthreads();
}
struct SchedGU {
    const LAS int* T; int G, c;
    __device__ bool next(int i, g8::Unit& u) const {
        const int L = i * G + c; const int ne = __builtin_amdgcn_readfirstlane(T[65]); if (L >= ne * 8) return false;
        int e = 0;
#pragma unroll
        for (int k = 1; k < NEXP; ++k) { const int o = __builtin_amdgcn_readfirstlane(T[72 + k]); if (L >= o * 8) e = k; }
        const int e0 = __builtin_amdgcn_readfirstlane(T[72 + e]), e1 = __builtin_amdgcn_readfirstlane(T[72 + e + 1]); const int cnt = e1 - e0, loc = L - e0 * 8;
        const int ntile = loc / cnt, mt = loc - ntile * cnt; const int ent = __builtin_amdgcn_readfirstlane(T[192 + e0 + mt]);
        u.pm = ent & 0xff; u.pn = ntile; u.a0 = e; u.a1 = (ent >> 8) & 1; u.a2 = (ent >> 16) & 0xff; u.a3 = (ent >> 24) & 0xff; return true;
    }
};
struct SchedDown {
    const LAS int* T; int G, c;
    __device__ bool next(int i, g8::Unit& u) const {
        const int L = i * G + c; const int NT = __builtin_amdgcn_readfirstlane(T[64]); if (L >= NT * 8) return false;
        const int tl = L >> 3; const int cls = __builtin_amdgcn_readfirstlane(T[96 + tl]); const int tb = __builtin_amdgcn_readfirstlane(T[32 + cls]);
        int elo, ehi; cls_experts(cls, elo, ehi);
        u.pm = tl; u.pn = L & 7; u.a0 = elo; u.a1 = ehi; u.a2 = cls; u.a3 = tl - tb; return true;
    }
};

struct PGateUp {
    static constexpr bool PERM = true, HAS_MID = false;
    int nt; const char* Abase; unsigned ldb2; const char* WGU; const int* TOK; const float* WLO; const float* WHI; const LAS int* T; bf16* ACT;
    __device__ __forceinline__ void a_offs(const g8::Unit& u, const int (&R)[2], const int (&C)[2], unsigned (&o)[2][2]) const {
        const int cnt = T[u.a2];
#pragma unroll
        for (int h = 0; h < 2; ++h)
#pragma unroll
            for (int i = 0; i < 2; ++i) { int pos = u.a3 * 256 + h * 128 + R[i]; if (pos >= cnt) pos = 0; const int tok = TOK[u.a2 * CLS_CAP + pos]; o[h][i] = (unsigned)((tok * DM + C[i]) * 2); }
    }
    __device__ __forceinline__ const char* b_tile(const g8::Unit& u, int t) const { return WGU + ((size_t)u.a0 * 2048 + (size_t)u.pn * 256) * ldb2 + (size_t)t * 128; }
    __device__ __forceinline__ void mid(f32x4 (&)[2][2][4][2], const g8::Unit&, int, int, int, int) const {}
    __device__ __forceinline__ void epi(const f32x4 (&acc)[2][2][4][2], const g8::Unit& u, int wr, int wc, int fr, int fq) const {
        const int cnt = T[u.a2]; const float* WS = u.a1 ? WHI : WLO;
#pragma unroll
        for (int ai = 0; ai < 2; ++ai)
#pragma unroll
            for (int m = 0; m < 4; ++m) { const int rl = ai * 128 + wr * 64 + m * 16 + fr; const int pos = u.a3 * 256 + rl;
                const float w = (pos < cnt) ? WS[u.a2 * CLS_CAP + pos] : 0.f;
                const f32x4 g0 = acc[ai][0][m][0], g1 = acc[ai][0][m][1], u0 = acc[ai][1][m][0], u1 = acc[ai][1][m][1];
                f32x4 a0, a1;
#pragma unroll
                for (int e = 0; e < 4; ++e) { a0[e] = g0[e] / (1.f + __expf(-g0[e])) * u0[e] * w; a1[e] = g1[e] / (1.f + __expf(-g1[e])) * u1[e] * w; }
                u32x4 o; o.x = cvt_pk_bf16(a0[0], a0[1]); o.y = cvt_pk_bf16(a0[2], a0[3]); o.z = cvt_pk_bf16(a1[0], a1[1]); o.w = cvt_pk_bf16(a1[2], a1[3]);
                *(u32x4*)(ACT + ((size_t)u.pm * 256 + rl) * 2048 + u.a1 * 1024 + u.pn * 128 + wc * 32 + 8 * fq) = o; }
    }
};
struct PDown {
    static constexpr bool PERM = false, HAS_MID = false;
    int nt; const char* Abase; unsigned ldb2; const char* WD; const int* TOK; const LAS int* T; float* out;
    __device__ __forceinline__ void a_offs(const g8::Unit& u, const int (&R)[2], const int (&C)[2], unsigned (&o)[2][2]) const {
#pragma unroll
        for (int h = 0; h < 2; ++h)
#pragma unroll
            for (int i = 0; i < 2; ++i) o[h][i] = (unsigned)(((u.pm * 256 + h * 128 + R[i]) * 2048 + C[i]) * 2);
    }
    __device__ __forceinline__ const char* b_tile(const g8::Unit& u, int t) const { const int e = (t < 16) ? u.a0 : u.a1; return WD + ((size_t)e * 2048 + (size_t)u.pn * 256) * ldb2 + (size_t)(t & 15) * 128; }
    __device__ __forceinline__ void mid(f32x4 (&)[2][2][4][2], const g8::Unit&, int, int, int, int) const {}
    __device__ __forceinline__ void epi(const f32x4 (&acc)[2][2][4][2], const g8::Unit& u, int wr, int wc, int fr, int fq) const {
        const int cnt = T[u.a2]; const int col0 = u.pn * 256 + wc * 32 + 4 * fq;
#pragma unroll
        for (int ai = 0; ai < 2; ++ai)
#pragma unroll
            for (int m = 0; m < 4; ++m) { const int pos = u.a3 * 256 + ai * 128 + wr * 64 + m * 16 + fr;
                if (pos < cnt) { const int tok = TOK[u.a2 * CLS_CAP + pos]; float* rowp = out + (size_t)tok * DM + col0;
#pragma unroll
                    for (int bj = 0; bj < 2; ++bj)
#pragma unroll
                        for (int n = 0; n < 2; ++n) { f32x4* q = (f32x4*)(rowp + bj * 128 + n * 16); *q = *q + acc[ai][bj][m][n]; } } }
    }
};

__device__ __forceinline__ void p7_final(Frame& F) {
    const int gw = F.vcu * NWAVES + F.wave, NGW = F.G * NWAVES, lane = F.lane; const float* gf = F.in[16];
    f32x4 gv[8];
#pragma unroll
    for (int j = 0; j < 8; ++j) gv[j] = *((const f32x4*)gf + lane + 64 * j);
    for (int row = gw; row < MTOK; row += NGW) {
        float* xr = F.out + (size_t)row * DM; f32x4 v[8]; float ss = 0.f;
#pragma unroll
        for (int j = 0; j < 8; ++j) { v[j] = *((const f32x4*)xr + lane + 64 * j); ss += (v[j].x * v[j].x + v[j].y * v[j].y) + (v[j].z * v[j].z + v[j].w * v[j].w); }
        const float rs = 1.0f / sqrtf(wave_sum(ss) * (1.0f / DM) + EPS);
#pragma unroll
        for (int j = 0; j < 8; ++j) *((f32x4*)xr + lane + 64 * j) = v[j] * rs * gv[j];
    }
}

struct Args { const float* in[17]; float* out; unsigned char* ws; int ph_lo, ph_hi; };
__global__ void __launch_bounds__(NWAVES * 64, 2) fwd_kernel(Args args) {
    extern __shared__ __attribute__((aligned(16))) unsigned char lds[];
    Frame F;
    F.lds = (LAS unsigned char*)lds;
    F.MISC = (volatile LAS unsigned*)(F.lds + MISC_OFF);
    F.tid = threadIdx.x; F.lane = F.tid & 63; F.wave = __builtin_amdgcn_readfirstlane(F.tid >> 6);
    F.G = gridDim.x; { const int bx = blockIdx.x; F.vcu = (F.G % 8 == 0) ? (bx % 8) * (F.G / 8) + bx / 8 : bx; }
#pragma unroll
    for (int i = 0; i < 17; ++i) F.in[i] = args.in[i];
    F.out = args.out; F.ws = args.ws; F.ctl = (unsigned*)(args.ws + WS_CTL);
    for (int u = F.tid; u < (LDS_BYTES - RING_BYTES) / 4; u += NWAVES * 64) ((LAS unsigned*)(F.lds + RING_BYTES))[u] = 0u;
    __syncthreads();
    XcdBarrier bar = xcd_barrier_post(F.ctl + CW_BAR, F.MISC + 8);
    const int lo = args.ph_lo, hi = args.ph_hi;
#define IN(k) (lo <= (k) && (k) < hi)
#define GRID_BAR(k) do { if (IN(k) && IN((k) + 1)) xcd_barrier(bar); } while (0)
    bf16* U = (bf16*)(F.ws + WS_U);
    if (IN(0)) { p0_prologue(F); } GRID_BAR(0);
    if (IN(1)) {
        p1_cumsum(F); p1_meta_kv(F);
        PInProj p{DM / 64, (const char*)(F.ws + WS_HN), (unsigned)(DM * 2), (const char*)(F.ws + WS_WINT), U, (const f32x2*)(F.ws + WS_ROPE)};
        g8::StaticOrder S; S.init(MTOK, NIN, F.G, (int)blockIdx.x);
        g8::gemm_phase<PInProj, g8::StaticOrder, true>(F.lds, p, S);
    } GRID_BAR(1);
    if (IN(2)) {
#ifdef NAIVE_RET
        attn_simple<true>(F); __syncthreads(); fox_phase(F);
#else
        ret::states(F); __syncthreads(); fox_phase(F); xcd_barrier(bar); ret::outputs(F);
#endif
    } GRID_BAR(2);
    if (IN(3)) {
        POutProj p{DM / 64, (const char*)(F.ws + WS_HN), (unsigned)(DM * 2), (const char*)(F.ws + WS_WOUTT), F.in[0], F.out, (const float*)(F.ws + WS_SSQ)};
        g8::StaticOrder S; S.init(MTOK, DM, F.G, (int)blockIdx.x);
        g8::gemm_phase<POutProj, g8::StaticOrder, true>(F.lds, p, S);
    } GRID_BAR(3);
    if (IN(4)) { p4_router(F); } GRID_BAR(4);
    if (IN(5)) {
        moe_tables(F);
        PGateUp p{DM / 64, (const char*)(F.ws + WS_HN), (unsigned)(DM * 2), (const char*)(F.ws + WS_WGU), (const int*)(F.ws + WS_TOK), (const float*)(F.ws + WS_WLO), (const float*)(F.ws + WS_WHI),
                  (const LAS int*)(F.lds + TBL_OFF), U};
        SchedGU S{(const LAS int*)(F.lds + TBL_OFF), F.G, F.vcu};
        g8::gemm_phase<PGateUp, SchedGU, true>(F.lds, p, S);
    } GRID_BAR(5);
    if (IN(6)) {
        if (!IN(5)) moe_tables(F);
        PDown p{2048 / 64, (const char*)U, (unsigned)(DE * 2), (const char*)(F.ws + WS_WD), (const int*)(F.ws + WS_TOK), (const LAS int*)(F.lds + TBL_OFF), F.out};
        SchedDown S{(const LAS int*)(F.lds + TBL_OFF), F.G, F.vcu};
        g8::gemm_phase<PDown, SchedDown, true>(F.lds, p, S);
    } GRID_BAR(6);
    if (IN(7)) { p7_final(F); }
#undef IN
#undef GRID_BAR
}

extern "C" void kernel_launch(void* const* d_in, const int* in_sizes, int n_in, void* d_out, int out_size, void* d_ws, size_t ws_size, hipStream_t stream) {
    static int grid = 0;
    if (grid == 0) {
        if (n_in != 17 || out_size != MTOK * DM || ws_size < WS_END) { fprintf(stderr, "kernel_launch: unexpected shapes (n_in %d out %d ws %zu)\n", n_in, out_size, ws_size); grid = -1; return; }
        int dev = 0, cus = 0, per_cu = 0;
        if (hipGetDevice(&dev) != hipSuccess || hipDeviceGetAttribute(&cus, hipDeviceAttributeMultiprocessorCount, dev) != hipSuccess) { grid = -1; return; }
        if (hipFuncSetAttribute((const void*)fwd_kernel, hipFuncAttributeMaxDynamicSharedMemorySize, LDS_BYTES) != hipSuccess) { fprintf(stderr, "kernel_launch: hipFuncSetAttribute failed\n"); grid = -1; return; }
        if (hipOccupancyMaxActiveBlocksPerMultiprocessor(&per_cu, (const void*)fwd_kernel, NWAVES * 64, LDS_BYTES) != hipSuccess || per_cu < 1) fprintf(stderr, "kernel_launch: occupancy query says %d\n", per_cu);
        (void)hipGetLastError();
        grid = cus;
    }
    if (grid < 0) return;
    (void)hipMemsetAsync((char*)d_ws + WS_CTL, 0, CTL_ZERO_BYTES, stream);
    Args a{};
    for (int i = 0; i < 17; ++i) a.in[i] = (const float*)d_in[i];
    a.out = (float*)d_out; a.ws = (unsigned char*)d_ws; a.ph_lo = 0; a.ph_hi = 8;
    hipLaunchKernelGGL(fwd_kernel, dim3(grid), dim3(NWAVES * 64), LDS_BYTES, stream, a);
}
```

```cpp
#include <hip/hip_runtime.h>
#include <cstdio>
#include <cstdint>

#define LAS __attribute__((address_space(3)))
#define GAS __attribute__((address_space(1)))
typedef unsigned short bf16;
typedef short bf16x8 __attribute__((ext_vector_type(8)));
typedef float f32x4 __attribute__((ext_vector_type(4)));
typedef float f32x2 __attribute__((ext_vector_type(2)));
typedef unsigned u32x4 __attribute__((ext_vector_type(4)));
typedef unsigned u32x2 __attribute__((ext_vector_type(2)));

constexpr int NB = 4, SEQ = 4096, DM = 2048, PADN = 112, NMETA = 16, PP = SEQ + 128, HD = 128, NH = 8;
constexpr int MTOK = NB * SEQ;
constexpr int INC = 7176;
constexpr int NIN = 7168;
constexpr int NEXP = 16, DE = 1024, NCLS = 24, CLS_CAP = 16384;
constexpr float EPS = 1e-6f;
constexpr float SCALE = 0.08838834764831845f;

constexpr size_t MiB = 1u << 20;
constexpr size_t WS_CTL = 0, CTL_ZERO_BYTES = 1 * MiB;
constexpr size_t WS_LOGF = 1 * MiB;
constexpr size_t WS_CUM = WS_LOGF + 1 * MiB;
constexpr size_t WS_SSQ = WS_CUM + 1 * MiB;
constexpr size_t WS_ROPE = WS_SSQ + 1 * MiB;
constexpr size_t WS_WRT = WS_ROPE + 3 * MiB;
constexpr size_t WS_HNMETA = WS_WRT + 1 * MiB;
constexpr size_t WS_TOK = WS_HNMETA + 1 * MiB;
constexpr size_t WS_WLO = WS_TOK + 2 * MiB;
constexpr size_t WS_WHI = WS_WLO + 2 * MiB;
constexpr size_t WS_WINT = 16 * MiB;
constexpr size_t WS_WOUTT = 44 * MiB;
constexpr size_t WS_WGU = 52 * MiB;
constexpr size_t WS_WD = 180 * MiB;
constexpr size_t WS_HN = 244 * MiB;
constexpr size_t WS_U = 308 * MiB;
constexpr size_t USTR = (size_t)NB * PP * 1024;
constexpr size_t WS_ST = WS_U + 7 * 33 * MiB;
constexpr size_t WS_END = WS_ST + 32 * MiB;
static_assert(WS_WHI + 2 * MiB <= WS_WINT && USTR * 2 == 33 * MiB, "ws map");
constexpr int CW_BAR = 4096;
constexpr int CW_CNT = 16384;

constexpr int RING_BYTES = 131072;
constexpr int MISC_OFF = RING_BYTES + 320;
constexpr int TBL_OFF = RING_BYTES + 1024;
constexpr int LDS_BYTES = 147456;
constexpr int NWAVES = 8;

__device__ __forceinline__ unsigned cvt_pk_bf16(float lo, float hi) { unsigned r; asm volatile("v_cvt_pk_bf16_f32 %0, %1, %2" : "=v"(r) : "v"(lo), "v"(hi)); return r; }
__device__ __forceinline__ unsigned pk_fp8x4(float a, float b, float c, float d) {
    a = __builtin_amdgcn_fmed3f(a, -448.f, 448.f); b = __builtin_amdgcn_fmed3f(b, -448.f, 448.f); c = __builtin_amdgcn_fmed3f(c, -448.f, 448.f); d = __builtin_amdgcn_fmed3f(d, -448.f, 448.f);
    int w = 0; w = __builtin_amdgcn_cvt_pk_fp8_f32(a, b, w, false); w = __builtin_amdgcn_cvt_pk_fp8_f32(c, d, w, true); return (unsigned)w; }
constexpr float SA1 = 16.f, SW1 = 1024.f, SA2 = 32.f, SW2 = 512.f;
__device__ __forceinline__ float bf_lo(unsigned w) { return __uint_as_float(w << 16); }
__device__ __forceinline__ float bf_hi(unsigned w) { return __uint_as_float(w & 0xffff0000u); }
__device__ __forceinline__ float wave_sum(float v) {
#pragma unroll
    for (int o = 1; o < 64; o <<= 1) v += __shfl_xor(v, o);
    return v;
}
__device__ __forceinline__ float wave_max(float v) {
#pragma unroll
    for (int o = 1; o < 64; o <<= 1) v = fmaxf(v, __shfl_xor(v, o));
    return v;
}
#define LDS_WAIT() asm volatile("s_waitcnt lgkmcnt(0)" ::: "memory")
#define VM_WAIT() asm volatile("s_waitcnt vmcnt(0)" ::: "memory")

#define XB_TMO      128
#define XB_XCNT(j)  (256  + 64 * (j))
#define XB_XSUB(j)  (1280 + 64 * (j))
#define XB_XGEN(j)  (2304 + 64 * (j))
#define XB_TOP      3328
#define XB_TOPGEN   3392
#define XCD_BAR_WORDS 3456
#define XB_SPIN_CAP (1u << 21)
__device__ __forceinline__ unsigned xb_ld(unsigned* p)              { return __hip_atomic_load(p, __ATOMIC_RELAXED, __HIP_MEMORY_SCOPE_AGENT); }
__device__ __forceinline__ unsigned xb_add(unsigned* p, unsigned v) { return __hip_atomic_fetch_add(p, v, __ATOMIC_RELAXED, __HIP_MEMORY_SCOPE_AGENT); }
__device__ __forceinline__ unsigned xb_xcc_id() { return (unsigned)__builtin_amdgcn_s_getreg((3 << 11) | 20) & 0xFu; }
#define XB_SPIN(cond, bar) do { unsigned _sp = 0; while (cond) { __builtin_amdgcn_s_sleep(1); \
    if ((++_sp & 255u) == 0u) { if (xb_ld(&(bar)[XB_TMO])) break; if (_sp > XB_SPIN_CAP) { atomicAdd(&(bar)[XB_TMO], 1u); break; } } } } while (0)
struct XcdBarrier { unsigned* bar; unsigned x; volatile LAS unsigned* st; };
__device__ __forceinline__ XcdBarrier xcd_barrier_post(unsigned* bar, volatile LAS unsigned* st) {
    XcdBarrier b; b.bar = bar; b.x = xb_xcc_id(); b.st = st;
    if (threadIdx.x == 0) (void)xb_add(&bar[XB_XCNT(b.x)], 1u);
    return b;
}
__device__ __forceinline__ void xcd_barrier_complete(unsigned* bar, unsigned x, unsigned& nloc, unsigned& nx) {
    const unsigned G = gridDim.x * gridDim.y * gridDim.z;
    unsigned sum, cnt, mine, sp = 0u;
    for (;;) {
        sum = 0u; cnt = 0u; mine = 0u;
#pragma unroll
        for (unsigned j = 0; j < 16; ++j) { const unsigned c = xb_ld(&bar[XB_XCNT(j)]); sum += c; cnt += (c > 0u) ? 1u : 0u; mine = (j == x) ? c : mine; }
        if (sum == G) break;
        __builtin_amdgcn_s_sleep(1);
        if ((++sp & 255u) == 0u) { if (xb_ld(&bar[XB_TMO])) break; if (sp > XB_SPIN_CAP) { atomicAdd(&bar[XB_TMO], 1u); break; } }
    }
    nloc = mine > 0u ? mine : 1u; nx = cnt > 0u ? cnt : 1u;
}
__device__ __forceinline__ void xcd_barrier(const XcdBarrier& b) {
    asm volatile("s_waitcnt vmcnt(0)" ::: "memory");
    __syncthreads();
    if (threadIdx.x == 0) {
        unsigned* bar = b.bar;
        __builtin_amdgcn_s_waitcnt(0);
        unsigned nloc = b.st[0], nx = b.st[1];
        if (nloc == 0u) { xcd_barrier_complete(bar, b.x, nloc, nx); b.st[0] = nloc; b.st[1] = nx; }
        const unsigned old = xb_add(&bar[XB_XSUB(b.x)], 1u);
        const unsigned gen = old / nloc;
        if (old + 1u == (gen + 1u) * nloc) {
            __builtin_amdgcn_fence(__ATOMIC_RELEASE, "agent");
            asm volatile("s_waitcnt vmcnt(0)" ::: "memory");
            const unsigned og = xb_add(&bar[XB_TOP], 1u);
            const unsigned tg = og / nx;
            if (og + 1u == (tg + 1u) * nx) xb_add(&bar[XB_TOPGEN], 1u);
            else XB_SPIN(xb_ld(&bar[XB_TOPGEN]) == tg, bar);
            __builtin_amdgcn_fence(__ATOMIC_ACQUIRE, "agent");
            xb_add(&bar[XB_XGEN(b.x)], 1u);
            asm volatile("s_waitcnt vmcnt(0)" ::: "memory");
        } else {
            XB_SPIN(xb_ld(&bar[XB_XGEN(b.x)]) == gen, bar);
            __builtin_amdgcn_fence(__ATOMIC_ACQUIRE, "agent");
            asm volatile("s_waitcnt vmcnt(0)" ::: "memory");
        }
    }
    __syncthreads();
}

namespace g8 {
constexpr int BM = 256, BK = 64, HALF = 128, HTB = HALF * BK * 2, NXCD = 8, WGM = 8;
__device__ __forceinline__ int lds_byte(int r, int c) { const int st = (r >> 4) * 2 + (c >> 5), rr = r & 15, cc = c & 31, ob = rr * 64 + cc * 2; return st * 1024 + (ob ^ (((ob >> 9) & 1) << 5)); }
__device__ __forceinline__ void stage_rc(int b, int& R, int& C) { const int st = b / 1024, sb = b % 1024, swz = sb ^ (((sb >> 9) & 1) << 5); R = (st >> 1) * 16 + swz / 64; C = (st & 1) * 32 + (swz % 64) / 2; }
__device__ __forceinline__ int perm32(int rho) { const int n = rho >> 4, i = rho & 15; return 8 * (i >> 2) + 4 * n + (i & 3); }

struct Unit { int pm, pn, a0, a1, a2, a3; };
typedef int v8i_t __attribute__((ext_vector_type(8)));

struct StaticOrder {
    int nM, nN, nwg, G, c;
    __device__ void init(int M, int N, int G_, int c_) { nM = M / BM; nN = N / BM; nwg = nM * nN; G = G_; c = c_; }
    __device__ bool next(int i, Unit& u) const {
        const long L = (long)i * G + c; if (L >= nwg) return false;
        int wgid = (int)L; { const int q = nwg / NXCD, r = nwg % NXCD, xcd = wgid % NXCD, off = wgid / NXCD; wgid = (xcd < r ? xcd * (q + 1) : r * (q + 1) + (xcd - r) * q) + off; }
        const int nig = WGM * nN, gid = wgid / nig, fm = gid * WGM, gsz = (nM - fm) < WGM ? (nM - fm) : WGM;
        u.pm = fm + ((wgid % nig) % gsz); u.pn = (wgid % nig) / gsz; u.a0 = u.a1 = u.a2 = u.a3 = 0; return true;
    }
};

template <class P, class Sched, bool ALIGN_EPI>
__device__ __forceinline__ void gemm_phase(LAS unsigned char* lds, const P& p, const Sched& S) {
    const int tid = threadIdx.x, wid = __builtin_amdgcn_readfirstlane(tid >> 6), lane = tid & 63, wr = wid >> 2, wc = wid & 3, fr = lane & 15, fq = lane >> 4;
    const int nt = p.nt;
    unsigned voffB[2], voffA[2];
#pragma unroll
    for (int i = 0; i < 2; ++i) { int R, C; stage_rc(tid * 16 + i * 8192, R, C); const int Rb = P::PERM ? ((R & ~31) + perm32(R & 31)) : R;
        voffB[i] = (unsigned)Rb * p.ldb2 + (unsigned)C * 2u; voffA[i] = (unsigned)R * p.lda2 + (unsigned)C * 2u; }
    const size_t hstepB = (size_t)HALF * p.ldb2, hstepA = (size_t)HALF * p.lda2;
    const unsigned ldsw = (unsigned)wid * 1024u;
    const int aoff = lds_byte(wr * 64 + fr, fq * 8), boff = lds_byte(wc * 32 + fr, fq * 8);
#define PG8_SA(b, h) (((b) * 2 + (h)) * HTB)
#define PG8_SB(b, h) ((4 + (b) * 2 + (h)) * HTB)
#define PG8_STAGE(bufoff, gbase, v0, v1) do { \
        __builtin_amdgcn_global_load_lds((const unsigned*)((const char*)(gbase) + (v0)), (LAS unsigned*)(lds + (bufoff) + ldsw), 16, 0, 0); \
        __builtin_amdgcn_global_load_lds((const unsigned*)((const char*)(gbase) + (v1)), (LAS unsigned*)(lds + (bufoff) + ldsw + 8192), 16, 0, 0); } while (0)
#define PG8_LD32(p0_, p1_) ({ const u32x4 lo_ = *(const LAS u32x4*)(p0_), hi_ = *(const LAS u32x4*)(p1_); (v8i_t){(int)lo_.x, (int)lo_.y, (int)lo_.z, (int)lo_.w, (int)hi_.x, (int)hi_.y, (int)hi_.z, (int)hi_.w}; })
#define PG8_LDA(dst, b, h) do { _Pragma("unroll") for (int m = 0; m < 4; ++m) dst[m] = PG8_LD32(lds + PG8_SA(b, h) + aoff + m * 2048, lds + PG8_SA(b, h) + aoff + m * 2048 + 1024); } while (0)
#define PG8_LDB(dst, b, h) do { _Pragma("unroll") for (int n = 0; n < 2; ++n) dst[n] = PG8_LD32(lds + PG8_SB(b, h) + boff + n * 2048, lds + PG8_SB(b, h) + boff + n * 2048 + 1024); } while (0)
#define PG8_LOH(v) __builtin_bit_cast(bf16x8, __builtin_shufflevector(v, v, 0, 1, 2, 3))
#define PG8_HIH(v) __builtin_bit_cast(bf16x8, __builtin_shufflevector(v, v, 4, 5, 6, 7))
#define PG8_MMA(ai, bj, At, Bt) do { __builtin_amdgcn_s_setprio(1); _Pragma("unroll") for (int m = 0; m < 4; ++m) _Pragma("unroll") for (int n = 0; n < 2; ++n) { \
        if constexpr (P::FP8) { asm volatile("v_mfma_f32_16x16x128_f8f6f4 %0, %1, %2, %0" : "+v"(acc[ai][bj][m][n]) : "v"(Bt[n]), "v"(At[m])); } \
        else { acc[ai][bj][m][n] = __builtin_amdgcn_mfma_f32_16x16x32_bf16(PG8_LOH(Bt[n]), PG8_LOH(At[m]), acc[ai][bj][m][n], 0, 0, 0); \
               acc[ai][bj][m][n] = __builtin_amdgcn_mfma_f32_16x16x32_bf16(PG8_HIH(Bt[n]), PG8_HIH(At[m]), acc[ai][bj][m][n], 0, 0, 0); } } \
        __builtin_amdgcn_s_setprio(0); } while (0)
#define PG8_WAIT_V(n) asm volatile("s_waitcnt vmcnt(" #n ")" ::: "memory")
#define PG8_WAIT_L(n) asm volatile("s_waitcnt lgkmcnt(" #n ")" ::: "memory")
#define PG8_BAR __builtin_amdgcn_s_barrier()
#define PG8_SCHED __builtin_amdgcn_sched_barrier(0)
    Unit cur, nxt; int ui = 0;
    if (!S.next(0, cur)) return;
    f32x4 acc[2][2][4][2];
#pragma unroll
    for (int a = 0; a < 2; ++a)
#pragma unroll
        for (int b = 0; b < 2; ++b)
#pragma unroll
            for (int m = 0; m < 4; ++m)
#pragma unroll
                for (int n = 0; n < 2; ++n) acc[a][b][m][n] = (f32x4){0.f, 0.f, 0.f, 0.f};
    v8i_t At[4], B0[2], B1[2];
    unsigned oc[2][2], on[2][2];
    const char* cA = p.Abase; const char* nA = p.Abase;
    if constexpr (P::GATHER) { p.a_offs(cur, oc); } else { cA = p.Abase + (size_t)cur.pm * 2 * hstepA; }
#define PG8_STA(bufoff, base_, h_, O_) do { if constexpr (P::GATHER) { PG8_STAGE(bufoff, base_, O_[h_][0], O_[h_][1]); } else { PG8_STAGE(bufoff, (base_) + (h_) * hstepA, voffA[0], voffA[1]); } } while (0)
    {
        const char* b0 = p.b_tile(cur, 0); const char* b1 = p.b_tile(cur, 1);
        PG8_STAGE(PG8_SB(0, 0), b0, voffB[0], voffB[1]); PG8_STAGE(PG8_SB(0, 1), b0 + hstepB, voffB[0], voffB[1]);
        PG8_STA(PG8_SA(0, 0), cA, 0, oc); PG8_STA(PG8_SA(0, 1), cA, 1, oc);
        if (wr == 1) PG8_BAR;
        PG8_WAIT_V(2); PG8_BAR;
        PG8_STAGE(PG8_SB(1, 0), b1, voffB[0], voffB[1]); PG8_STA(PG8_SA(1, 0), cA + 128, 0, oc); PG8_STAGE(PG8_SB(1, 1), b1 + hstepB, voffB[0], voffB[1]);
        PG8_WAIT_V(6); PG8_BAR;
    }
    for (;;) {
        const bool has_next = S.next(ui + 1, nxt);
        if (!has_next) nxt = cur;
        if constexpr (P::GATHER) { p.a_offs(nxt, on); } else { nA = p.Abase + (size_t)nxt.pm * 2 * hstepA; }
#pragma unroll 1
        for (int t = 0; t < nt; t += 2) {
            const bool last = (t == nt - 2);
            if constexpr (P::HAS_MID) { if (t == (nt >> 1)) p.mid(acc, cur, wr, wc, fr, fq); }
            const char* a1 = cA + (size_t)(t + 1) * 128;
            const char* a2 = last ? nA : cA + (size_t)(t + 2) * 128; const char* a3 = a2 + 128;
            unsigned o2[2][2];
            if constexpr (P::GATHER) { o2[0][0] = last ? on[0][0] : oc[0][0]; o2[0][1] = last ? on[0][1] : oc[0][1]; o2[1][0] = last ? on[1][0] : oc[1][0]; o2[1][1] = last ? on[1][1] : oc[1][1]; }
            const char* b2 = last ? p.b_tile(nxt, 0) : p.b_tile(cur, t + 2); const char* b3 = last ? p.b_tile(nxt, 1) : p.b_tile(cur, t + 3);
            PG8_LDB(B0, 0, 0); PG8_LDB(B1, 0, 1); PG8_SCHED; PG8_LDA(At, 0, 0); PG8_STA(PG8_SA(1, 1), a1, 1, oc);
            PG8_WAIT_V(8); PG8_WAIT_L(0); PG8_BAR; PG8_MMA(0, 0, At, B0); PG8_MMA(0, 1, At, B1); PG8_BAR; PG8_SCHED;
            PG8_LDA(At, 0, 1); PG8_STAGE(PG8_SB(0, 0), b2, voffB[0], voffB[1]); PG8_STAGE(PG8_SB(0, 1), b2 + hstepB, voffB[0], voffB[1]); PG8_STA(PG8_SA(0, 0), a2, 0, o2);
            PG8_WAIT_V(8); PG8_WAIT_L(0); PG8_BAR; PG8_MMA(1, 0, At, B0); PG8_MMA(1, 1, At, B1); PG8_BAR; PG8_SCHED;
            PG8_LDB(B0, 1, 0); PG8_LDB(B1, 1, 1); PG8_SCHED; PG8_LDA(At, 1, 0); PG8_STA(PG8_SA(0, 1), a2, 1, o2);
            PG8_WAIT_V(8); PG8_WAIT_L(0); PG8_BAR; PG8_MMA(0, 0, At, B0); PG8_MMA(0, 1, At, B1); PG8_BAR; PG8_SCHED;
            PG8_LDA(At, 1, 1); PG8_STAGE(PG8_SB(1, 0), b3, voffB[0], voffB[1]); PG8_STAGE(PG8_SB(1, 1), b3 + hstepB, voffB[0], voffB[1]); PG8_STA(PG8_SA(1, 0), a3, 0, o2);
            PG8_WAIT_V(8); PG8_WAIT_L(0); PG8_BAR; PG8_MMA(1, 0, At, B0); PG8_MMA(1, 1, At, B1); PG8_BAR; PG8_SCHED;
        }
        if constexpr (ALIGN_EPI) { if (wr == 0) PG8_BAR; }
        if constexpr (P::FP8) { asm volatile("s_nop 15\n\ts_nop 15" ::: "memory"); }
        p.epi(acc, cur, wr, wc, fr, fq);
        if (!has_next) break;
#pragma unroll
        for (int a = 0; a < 2; ++a)
#pragma unroll
            for (int b = 0; b < 2; ++b)
#pragma unroll
                for (int m = 0; m < 4; ++m)
#pragma unroll
                    for (int n = 0; n < 2; ++n) acc[a][b][m][n] = (f32x4){0.f, 0.f, 0.f, 0.f};
        cur = nxt; cA = nA; ++ui;
        if constexpr (P::GATHER) { oc[0][0] = on[0][0]; oc[0][1] = on[0][1]; oc[1][0] = on[1][0]; oc[1][1] = on[1][1]; }
        if constexpr (ALIGN_EPI) { if (wr == 1) PG8_BAR; }
    }
    PG8_WAIT_V(0);
    if constexpr (!ALIGN_EPI) { if (wr == 0) PG8_BAR; }
    PG8_BAR;
#undef PG8_SA
#undef PG8_SB
#undef PG8_STAGE
#undef PG8_STA
#undef PG8_LDA
#undef PG8_LDB
#undef PG8_LD32
#undef PG8_LOH
#undef PG8_HIH
#undef PG8_MMA
#undef PG8_WAIT_V
#undef PG8_WAIT_L
#undef PG8_BAR
#undef PG8_SCHED
}
}

struct Frame {
    LAS unsigned char* lds;
    volatile LAS unsigned* MISC;
    unsigned* ctl;
    int tid, lane, wave, vcu, G;
    const float* in[17];
    float* out;
    unsigned char* ws;
};

__device__ __forceinline__ void p0_transpose_item(const float* W, int ldw, int K, bf16* WT, int k0, int scol0, int drow0, const float* kscale, LAS float* scr, int lane) {
#pragma unroll 8
    for (int i = 0; i < 32; ++i) { const int kk = 2 * i + (lane >> 5); float v = W[(size_t)(k0 + kk) * ldw + scol0 + (lane & 31)]; if (kscale) v *= kscale[k0 + kk]; scr[kk * 33 + (lane & 31)] = v; }
    LDS_WAIT(); asm volatile("" ::: "memory");
    const int c = lane & 7;
#pragma unroll
    for (int j = 0; j < 4; ++j) { const int n = (lane >> 3) + 8 * j; const LAS float* s = scr + (8 * c) * 33 + n;
        u32x4 o; o.x = cvt_pk_bf16(s[0 * 33], s[1 * 33]); o.y = cvt_pk_bf16(s[2 * 33], s[3 * 33]); o.z = cvt_pk_bf16(s[4 * 33], s[5 * 33]); o.w = cvt_pk_bf16(s[6 * 33], s[7 * 33]);
        *(u32x4*)(WT + (size_t)(drow0 + n) * K + k0 + 8 * c) = o; }
    LDS_WAIT(); asm volatile("" ::: "memory");
}

__device__ __forceinline__ void p0_transpose_item8(const float* W, int ldw, int K, unsigned char* WT, int k0, int scol0, int drow0, float sc, LAS float* scr, int lane) {
#pragma unroll 8
    for (int i = 0; i < 32; ++i) { const int kk = 2 * i + (lane >> 5); scr[kk * 33 + (lane & 31)] = W[(size_t)(k0 + kk) * ldw + scol0 + (lane & 31)] * sc; }
    LDS_WAIT(); asm volatile("" ::: "memory");
    const int c = lane & 7;
#pragma unroll
    for (int j = 0; j < 4; ++j) { const int n = (lane >> 3) + 8 * j; const LAS float* s = scr + (8 * c) * 33 + n;
        u32x2 o; o.x = pk_fp8x4(s[0 * 33], s[1 * 33], s[2 * 33], s[3 * 33]); o.y = pk_fp8x4(s[4 * 33], s[5 * 33], s[6 * 33], s[7 * 33]);
        *(u32x2*)(WT + (size_t)(drow0 + n) * K + k0 + 8 * c) = o; }
    LDS_WAIT(); asm volatile("" ::: "memory");
}
__device__ __forceinline__ float log_sigmoid(float x) { return fminf(x, 0.f) - log1pf(__expf(-fabsf(x))); }

__device__ __forceinline__ void p0_prologue(Frame& F) {
    const int gw = F.vcu * NWAVES + F.wave, NGW = F.G * NWAVES, lane = F.lane;
    const int gt = F.vcu * 512 + F.tid, NGT = F.G * 512;
    {
        LAS float* scr = (LAS float*)(F.lds + F.wave * 16384);
        const float* w_in = F.in[3]; const float* w_out = F.in[7]; const float* w_gate = F.in[13]; const float* w_up = F.in[14]; const float* w_down = F.in[15];
        bf16* WINT = (bf16*)(F.ws + WS_WINT); bf16* WOUTT = (bf16*)(F.ws + WS_WOUTT); unsigned char* WGU = (unsigned char*)(F.ws + WS_WGU); unsigned char* WD = (unsigned char*)(F.ws + WS_WD);
        constexpr int I_IN = 32 * 224, I_OUT = 32 * 64, I_G = 16 * 32 * 32, I_D = 16 * 16 * 64;
        constexpr int NITEMS = I_IN + I_OUT + 2 * I_G + I_D;
        for (int it = gw; it < NITEMS; it += NGW) {
            int r = it;
            if (r < I_IN) { const int kb = r / 224, nb = r % 224, n0 = nb * 32; p0_transpose_item(w_in, INC, DM, WINT, kb * 64, n0 + (n0 >= 3072 ? 8 : 0), n0, nullptr, scr, lane); continue; } r -= I_IN;
            if (r < I_OUT) { const int kb = r / 64, nb = r % 64; const float* ks = (kb < 16) ? F.in[5] : (F.in[6] - 1024); p0_transpose_item(w_out, DM, DM, WOUTT, kb * 64, nb * 32, nb * 32, ks, scr, lane); continue; } r -= I_OUT;
            if (r < 2 * I_G) { const int up = r >= I_G; if (up) r -= I_G; const int e = r / 1024, q = r % 1024, kb = q / 32, nb = q % 32, n0 = nb * 32;
                p0_transpose_item8((up ? w_up : w_gate) + (size_t)e * DM * DE, DE, DM, WGU + (size_t)e * 2048 * DM, kb * 64, n0, (n0 >> 7) * 256 + up * 128 + (n0 & 127), SW1, scr, lane); continue; } r -= 2 * I_G;
            { const int e = r / 1024, q = r % 1024, kb = q / 64, nb = q % 64; p0_transpose_item8(w_down + (size_t)e * DE * DM, DM, DE, WD + (size_t)e * DM * DE, kb * 64, nb * 32, nb * 32, SW2, scr, lane); }
        }
    }
    {
        float* WRT = (float*)(F.ws + WS_WRT); const float* g2 = F.in[8]; const float* wrg = F.in[9]; const float* wre = F.in[11];
        for (int i = gt; i < 20 * DM; i += NGT) { const int j = i / DM, k = i % DM; WRT[i] = g2[k] * (j < 4 ? wrg[k * 4 + j] : wre[k * 16 + (j - 4)]); }
        f32x2* ROPE = (f32x2*)(F.ws + WS_ROPE);
        for (int i = gt; i < 4112 * 64; i += NGT) { const int pos = i >> 6, k = i & 63;
            const float lin = (float)k * (1.0f / 63.0f); const float ang = 1.0f / exp2f(lin * 13.287712379549449f);
            const float ph = (float)pos * ang; const double rev = (double)ph * 0.15915494309189535; const float fr = (float)(rev - floor(rev));
            ROPE[i] = (f32x2){__builtin_amdgcn_cosf(fr), __builtin_amdgcn_sinf(fr)}; }
        bf16* U = (bf16*)(F.ws + WS_U);
        for (int i = gt; i < 4 * NB * PADN * 128; i += NGT) { const int c8 = i & 127, row = (i >> 7) % PADN, bb = ((i >> 7) / PADN) % NB, cl = (i >> 7) / (PADN * NB);
            const int cls = (cl == 0) ? 1 : (cl == 1) ? 2 : (cl == 2) ? 4 : 5;
            *(u32x4*)(U + cls * USTR + ((size_t)(bb * PP + row)) * 1024 + c8 * 8) = (u32x4){0u, 0u, 0u, 0u}; }
        float* LOGF = (float*)(F.ws + WS_LOGF);
        for (int i = gt; i < 32 * PADN; i += NGT) LOGF[(i / PADN) * PP + (i % PADN)] = 0.f;
    }
    __syncthreads();
    {
        LAS float* WF = (LAS float*)F.lds; const float* w_in = F.in[3]; const float* g1 = F.in[2];
        for (int i = F.tid; i < 8 * DM; i += 512) { const int k = i >> 3, h = i & 7; WF[h * DM + k] = g1[k] * w_in[(size_t)k * INC + 3072 + h]; }
        __syncthreads();
        f32x4 gv[8];
#pragma unroll
        for (int j = 0; j < 8; ++j) gv[j] = *((const f32x4*)g1 + lane + 64 * j);
        bf16* HN = (bf16*)(F.ws + WS_HN); bf16* HNMETA = (bf16*)(F.ws + WS_HNMETA); float* LOGF = (float*)(F.ws + WS_LOGF); const float* bfv = F.in[4];
        for (int row = gw; row < MTOK + NMETA; row += NGW) {
            const bool meta = row >= MTOK; const int mj = row - MTOK;
            const float* xr = meta ? (F.in[1] + (size_t)mj * DM) : (F.in[0] + (size_t)row * DM);
            f32x4 v[8]; float ss = 0.f;
#pragma unroll
            for (int j = 0; j < 8; ++j) { v[j] = *((const f32x4*)xr + lane + 64 * j); ss += (v[j].x * v[j].x + v[j].y * v[j].y) + (v[j].z * v[j].z + v[j].w * v[j].w); }
            const float rs = 1.0f / sqrtf(wave_sum(ss) * (1.0f / DM) + EPS);
            float fl[8];
#pragma unroll
            for (int h = 0; h < 8; ++h) { float s = 0.f;
#pragma unroll
                for (int j = 0; j < 8; ++j) { const f32x4 w = *((const LAS f32x4*)(WF + h * DM) + lane + 64 * j); s += (v[j].x * w.x + v[j].y * w.y) + (v[j].z * w.z + v[j].w * w.w); }
                fl[h] = wave_sum(s) * rs; }
            bf16* orow = meta ? (HNMETA + (size_t)mj * DM) : (HN + (size_t)row * DM);
#pragma unroll
            for (int j = 0; j < 8; ++j) { const f32x4 y = v[j] * rs * gv[j]; u32x2 w; w.x = cvt_pk_bf16(y.x, y.y); w.y = cvt_pk_bf16(y.z, y.w); *((u32x2*)orow + lane + 64 * j) = w; }
            if (lane < 8) { float f = fl[0];
#pragma unroll
                for (int h = 1; h < 8; ++h) f = (lane == h) ? fl[h] : f;
                const float lf = log_sigmoid(f + bfv[lane]);
                if (meta) { for (int bb = 0; bb < NB; ++bb) LOGF[(bb * NH + lane) * PP + PADN + mj] = lf; }
                else { const int bb = row >> 12, t = row & 4095; LOGF[(bb * NH + lane) * PP + 128 + t] = lf; } }
        }
    }
}

__device__ __forceinline__ void p1_cumsum(Frame& F) {
    const int gw = F.vcu * NWAVES + F.wave, NGW = F.G * NWAVES, lane = F.lane;
    const float* LOGF = (const float*)(F.ws + WS_LOGF); float* CUM = (float*)(F.ws + WS_CUM);
    for (int s = gw; s < NB * NH; s += NGW) {
        const float* src = LOGF + (size_t)s * PP + lane * 66; float* dst = CUM + (size_t)s * PP + lane * 66;
        float loc = 0.f; for (int i = 0; i < 66; ++i) loc += src[i];
        float inc = loc;
#pragma unroll
        for (int o = 1; o < 64; o <<= 1) { const float t = __shfl_up(inc, o); if (lane >= o) inc += t; }
        float run = inc - loc;
        for (int i = 0; i < 66; ++i) { run += src[i]; dst[i] = run; }
    }
}
__device__ __forceinline__ void p1_meta_kv(Frame& F) {
    const int lane = F.lane, w = F.wave;
    const bf16* HNMETA = (const bf16*)(F.ws + WS_HNMETA); const bf16* WINT = (const bf16*)(F.ws + WS_WINT); bf16* U = (bf16*)(F.ws + WS_U);
    const f32x2* ROPE = (const f32x2*)(F.ws + WS_ROPE);
    LAS float* red = (LAS float*)F.lds;
    for (int blk = blockIdx.x; blk < 256; blk += F.G) {
        const int kv0 = blk * 16, q = kv0 >> 10, col0 = kv0 & 1023;
        const int cls = (q == 0) ? 1 : (q == 1) ? 2 : (q == 2) ? 4 : 5;
        const int nrow0 = ((q == 0) ? 1024 : (q == 1) ? 2048 : (q == 2) ? 4096 : 5120) + col0;
        f32x4 acc = (f32x4){0.f, 0.f, 0.f, 0.f};
#pragma unroll
        for (int s = 0; s < 8; ++s) { const int k0 = w * 256 + s * 32 + 8 * (lane >> 4);
            const bf16x8 a = *(const bf16x8*)(HNMETA + (size_t)(lane & 15) * DM + k0);
            const bf16x8 b = *(const bf16x8*)(WINT + (size_t)(nrow0 + (lane & 15)) * DM + k0);
            acc = __builtin_amdgcn_mfma_f32_16x16x32_bf16(a, b, acc, 0, 0, 0); }
#pragma unroll
        for (int r = 0; r < 4; ++r) red[w * 256 + ((lane >> 4) * 4 + r) * 16 + (lane & 15)] = acc[r];
        __syncthreads();
        if (F.tid < 256) { const int row = F.tid >> 4, col = F.tid & 15;
            float v = 0.f, vp = 0.f;
#pragma unroll
            for (int ww = 0; ww < 8; ++ww) { v += red[ww * 256 + row * 16 + col]; vp += red[ww * 256 + row * 16 + (col ^ 1)]; }
            float o = v;
            if (q == 2) { const int d = (col0 + col) & 127; const f32x2 cs = ROPE[row * 64 + (d >> 1)];
                const int hh = (col0 + col) >> 7; const float lg2h = log2f(1.0f - exp2f(-5.0f - (float)hh));
                o = ((col & 1) ? (v * cs.x + vp * cs.y) : (v * cs.x - vp * cs.y)) * SCALE * exp2f(-(float)(PADN + row + 1) * lg2h); }
            const unsigned short ob = (unsigned short)(cvt_pk_bf16(o, 0.f) & 0xffffu);
            for (int bb = 0; bb < NB; ++bb) U[cls * USTR + ((size_t)(bb * PP + PADN + row)) * 1024 + col0 + col] = ob; }
        __syncthreads();
    }
}

struct PInProj {
    static constexpr bool PERM = true, HAS_MID = false, FP8 = false, GATHER = false;
    int nt; const char* Abase; unsigned lda2, ldb2; const char* Bt; bf16* U; const f32x2* ROPE;
    __device__ __forceinline__ void a_offs(const g8::Unit&, unsigned (&)[2][2]) const {}
    __device__ __forceinline__ const char* b_tile(const g8::Unit& u, int t) const { return Bt + (size_t)u.pn * 256 * ldb2 + (size_t)t * 128; }
    __device__ __forceinline__ void mid(f32x4 (&)[2][2][4][2], const g8::Unit&, int, int, int, int) const {}
    __device__ __forceinline__ void epi(const f32x4 (&acc)[2][2][4][2], const g8::Unit& u, int wr, int wc, int fr, int fq) const {
        const int cls = u.pn >> 2;
        bf16* base = U + (size_t)cls * USTR;
        const int ccol0 = (u.pn & 3) * 256 + wc * 32 + 8 * fq;
        const int bb = u.pm >> 4;
#pragma unroll
        for (int ai = 0; ai < 2; ++ai)
#pragma unroll
            for (int m = 0; m < 4; ++m) {
                const int t = ((u.pm & 15) << 8) + ai * 128 + wr * 64 + m * 16 + fr;
                bf16* rowp = base + ((size_t)(bb * PP + 128 + t)) * 1024 + ccol0;
                f32x4 c0 = (f32x4){1.f, 0.f, 1.f, 0.f}, c1 = c0;
                if (cls == 3 || cls == 4) { const f32x4* rp = (const f32x4*)(ROPE + (size_t)(t + 16) * 64 + wc * 16 + fq * 4); c0 = rp[0]; c1 = rp[1]; }
#pragma unroll
                for (int bj = 0; bj < 2; ++bj) {
                    f32x4 v0 = acc[ai][bj][m][0], v1 = acc[ai][bj][m][1];
                    if (cls == 3 || cls == 4) {
                        f32x4 r0, r1;
                        r0.x = v0.x * c0.x - v0.y * c0.y; r0.y = v0.y * c0.x + v0.x * c0.y; r0.z = v0.z * c0.z - v0.w * c0.w; r0.w = v0.w * c0.z + v0.z * c0.w;
                        r1.x = v1.x * c1.x - v1.y * c1.y; r1.y = v1.y * c1.x + v1.x * c1.y; r1.z = v1.z * c1.z - v1.w * c1.w; r1.w = v1.w * c1.z + v1.z * c1.w;
                        const int hh = (u.pn & 3) * 2 + bj; const float lg2h = log2f(1.0f - exp2f(-5.0f - (float)hh)); const float ip1 = (float)((t & 127) + 1);
                        const float sc = (cls == 4) ? SCALE * exp2f(-ip1 * lg2h) : exp2f(ip1 * lg2h); v0 = r0 * sc; v1 = r1 * sc;
                    } else if (cls == 6) {
#pragma unroll
                        for (int e = 0; e < 4; ++e) { v0[e] = v0[e] / (1.f + __expf(-v0[e])); v1[e] = v1[e] / (1.f + __expf(-v1[e])); }
                    }
                    u32x4 w; w.x = cvt_pk_bf16(v0[0], v0[1]); w.y = cvt_pk_bf16(v0[2], v0[3]); w.z = cvt_pk_bf16(v1[0], v1[1]); w.w = cvt_pk_bf16(v1[2], v1[3]);
                    *(u32x4*)(rowp + bj * 128) = w;
                }
            }
    }
};

template <bool RET>
__device__ __forceinline__ void attn_simple(Frame& F) {
    const int gw = F.vcu * NWAVES + F.wave, NGW = F.G * NWAVES, lane = F.lane;
    LAS float* wl = (LAS float*)(F.lds + F.wave * 1024);
    const bf16* U = (const bf16*)(F.ws + WS_U); const float* CUM = (const float*)(F.ws + WS_CUM);
    bf16* OA = (bf16*)(F.ws + WS_HN); float* SSQ = (float*)(F.ws + WS_SSQ);
    for (int row = gw; row < NB * NH * SEQ; row += NGW) {
        const int t = row & 4095, bh = row >> 12, b = bh >> 3, h = bh & 7, p = 128 + t, m = b * SEQ + t;
        const bf16* Qb = U + (RET ? 3 : 0) * USTR + ((size_t)(b * PP + p)) * 1024 + h * 128;
        const bf16* Kb = U + (RET ? 4 : 1) * USTR + ((size_t)b * PP) * 1024 + h * 128;
        const bf16* Vb = U + (RET ? 5 : 2) * USTR + ((size_t)b * PP) * 1024 + h * 128;
        { const unsigned qw = *(const unsigned*)(Qb + 2 * lane); wl[2 * lane] = bf_lo(qw); wl[2 * lane + 1] = bf_hi(qw); }
        LDS_WAIT(); asm volatile("" ::: "memory");
        float m_run = -1e30f, l_run = 0.f, o0 = 0.f, o1 = 0.f;
        const float ct = RET ? 0.f : CUM[(size_t)bh * PP + p];
        const float lg2 = RET ? log2f(1.0f - exp2f(-5.0f - (float)h)) : 0.f;
        for (int s0 = 64; s0 <= p; s0 += 64) {
            const int s = s0 + lane;
            const bf16* kr = Kb + (size_t)s * 1024;
            float sc = 0.f;
#pragma unroll
            for (int c = 0; c < 16; ++c) { const u32x4 kv = *(const u32x4*)(kr + 8 * c); const f32x4 qa = *(const LAS f32x4*)(wl + 8 * c), qb = *(const LAS f32x4*)(wl + 8 * c + 4);
                sc += bf_lo(kv.x) * qa.x + bf_hi(kv.x) * qa.y + bf_lo(kv.y) * qa.z + bf_hi(kv.y) * qa.w + bf_lo(kv.z) * qb.x + bf_hi(kv.z) * qb.y + bf_lo(kv.w) * qb.z + bf_hi(kv.w) * qb.w; }
            const bool valid = (s <= p) && (s >= PADN);
            float pw;
            if constexpr (RET) { pw = valid ? sc * exp2f((float)(((p >> 7) - (s >> 7)) * 128) * lg2) : 0.f; }
            else {
                const float lg = valid ? (sc * SCALE + (ct - CUM[(size_t)bh * PP + s])) : -__builtin_inff();
                const float mn = fmaxf(m_run, wave_max(lg)); const float alpha = __expf(m_run - mn);
                pw = valid ? __expf(lg - mn) : 0.f;
                l_run = l_run * alpha + wave_sum(pw); o0 *= alpha; o1 *= alpha; m_run = mn;
            }
            asm volatile("" ::: "memory");
            wl[128 + lane] = pw;
            LDS_WAIT(); asm volatile("" ::: "memory");
#pragma unroll 8
            for (int k = 0; k < 64; ++k) { const float pk = wl[128 + k]; const unsigned vw = *(const unsigned*)(Vb + (size_t)(s0 + k) * 1024 + 2 * lane); o0 += pk * bf_lo(vw); o1 += pk * bf_hi(vw); }
            LDS_WAIT(); asm volatile("" ::: "memory");
        }
        if constexpr (RET) {
            const float mu = wave_sum(o0 + o1) * (1.0f / HD); const float d0 = o0 - mu, d1 = o1 - mu;
            const float var = wave_sum(d0 * d0 + d1 * d1) * (1.0f / HD); const float r = 1.0f / sqrtf(var + EPS);
            const unsigned gw2 = *(const unsigned*)(U + 6 * USTR + ((size_t)(b * PP + p)) * 1024 + h * 128 + 2 * lane);
            *(unsigned*)(OA + (size_t)m * DM + 1024 + h * 128 + 2 * lane) = cvt_pk_bf16(d0 * r * bf_lo(gw2), d1 * r * bf_hi(gw2));
        } else {
            const float il = 1.0f / l_run; o0 *= il; o1 *= il;
            *(unsigned*)(OA + (size_t)m * DM + h * 128 + 2 * lane) = cvt_pk_bf16(o0, o1);
            const float sq = wave_sum(o0 * o0 + o1 * o1); if (lane == 0) SSQ[(size_t)m * 8 + h] = sq;
        }
        asm volatile("" ::: "memory");
    }
}


namespace fox {
constexpr int NW = 8, QBLK = 32, KVBLK = 64, QB = 256, D = 128, LDQ = 1024, LDO = 2048;
constexpr int SHM_V = KVBLK * D * 2, SHM_K = KVBLK * D * 2;
constexpr int OFF_WS = 2 * SHM_V + 2 * SHM_K, OFF_CUM = OFF_WS + 2048, LDS_NEED = OFF_CUM + PP * 4;
static_assert(LDS_NEED <= RING_BYTES, "fox lds");
constexpr float THR = 8.f;
constexpr float INVS = 11.313708498984761f;
typedef float f32x16 __attribute__((ext_vector_type(16)));
typedef short s16x4 __attribute__((ext_vector_type(4)));
#define KSWZ(row, colB) ((row) * 256 + ((colB) ^ (((row) & 7) << 4)))
#define SBAR() __builtin_amdgcn_sched_barrier(0)
__device__ __forceinline__ int v_st(int k, int c) { const int kk = (k & ~0xC) | ((k & 4) << 1) | ((k & 8) >> 1); return ((kk >> 3) * 4 + (c >> 5)) * 512 + ((kk & 7) * 32 + (c & 31)) * 2; }
__device__ __forceinline__ int v_rd_base(int lane) { return ((lane & 3) << 3) | (((lane >> 2) & 3) << 6) | (((lane >> 4) & 1) << 5) | (((lane >> 5) & 1) << 8); }
constexpr int v_rd_off(int d0, int ks, int half) { return d0 * 512 + ks * 4096 + half * 2048; }
__device__ __forceinline__ int crow(int r, int hi) { return (r & 3) + 8 * (r >> 2) + 4 * hi; }
__device__ __forceinline__ unsigned cvtpk(float lo, float hi) { unsigned r; asm volatile("v_cvt_pk_bf16_f32 %0, %1, %2" : "=v"(r) : "v"(lo), "v"(hi)); return r; }
__device__ __forceinline__ bf16x8 load8(const bf16* p) { return *reinterpret_cast<const bf16x8*>(p); }
__device__ __forceinline__ void mask_causal(f32x16& p0, f32x16& p1, int dq) {
    const float NEG = -__builtin_inff();
#pragma unroll
    for (int r = 0; r < 16; ++r) { const int c = (r & 3) + 8 * (r >> 2); if (dq - c < 0) p0[r] = NEG; if (dq - c - 32 < 0) p1[r] = NEG; }
}
__device__ __forceinline__ void mask_pad(f32x16& p0, f32x16& p1, int hi) {
    const float NEG = -__builtin_inff();
#pragma unroll
    for (int r = 0; r < 16; ++r) { const int c = (r & 3) + 8 * (r >> 2); p0[r] = NEG; if (c + 4 * hi < 16) p1[r] = NEG; }
}
__device__ __forceinline__ void partialSM(f32x16& p0, f32x16& p1, float& m_reg, float& mn, float& alpha) {
    float pmax = p0[0]; for (int r = 1; r < 16; ++r) pmax = fmaxf(pmax, p0[r]); for (int r = 0; r < 16; ++r) pmax = fmaxf(pmax, p1[r]);
    { auto rr = __builtin_amdgcn_permlane32_swap(__float_as_uint(pmax), __float_as_uint(pmax), false, false);
      pmax = fmaxf(__uint_as_float(rr[0]), __uint_as_float(rr[1])); }
    constexpr float C2 = 1.4426950408889634f * SCALE;
    if (__builtin_expect(__all((pmax - m_reg) * SCALE <= THR), 1)) { mn = m_reg; alpha = 1.f; }
    else { mn = fmaxf(m_reg, pmax); alpha = __builtin_amdgcn_exp2f((m_reg - mn) * C2); m_reg = mn; }
    const float mnL = -mn * C2;
    for (int r = 0; r < 16; ++r) p0[r] = fmaf(p0[r], C2, mnL); for (int r = 0; r < 16; ++r) p1[r] = fmaf(p1[r], C2, mnL);
    for (int r = 0; r < 16; ++r) p0[r] = __builtin_amdgcn_exp2f(p0[r]);
}
__device__ __forceinline__ void finishSM(f32x16& p0, f32x16& p1, float alpha, float& l_reg, bf16x8& pa0, bf16x8& pa1, bf16x8& pa2, bf16x8& pa3) {
    for (int r = 0; r < 16; ++r) p1[r] = __builtin_amdgcn_exp2f(p1[r]);
    float ps = 0; for (int r = 0; r < 16; ++r) ps += p0[r]; for (int r = 0; r < 16; ++r) ps += p1[r];
    { auto rr = __builtin_amdgcn_permlane32_swap(__float_as_uint(ps), __float_as_uint(ps), false, false);
      ps = __uint_as_float(rr[0]) + __uint_as_float(rr[1]); }
    l_reg = l_reg * alpha + ps;
#define PK4(P, B_, OUT) do { unsigned a0 = cvtpk(P[B_+0], P[B_+1]), a1 = cvtpk(P[B_+2], P[B_+3]);                          \
        unsigned b0 = cvtpk(P[B_+4], P[B_+5]), b1 = cvtpk(P[B_+6], P[B_+7]);                                             \
        auto r0 = __builtin_amdgcn_permlane32_swap(a0, b0, false, false); auto r1 = __builtin_amdgcn_permlane32_swap(a1, b1, false, false); \
        u32x4 w = {r0[0], r1[0], r0[1], r1[1]}; OUT = *reinterpret_cast<bf16x8*>(&w); } while (0)
    PK4(p0, 0, pa0); PK4(p0, 8, pa1); PK4(p1, 0, pa2); PK4(p1, 8, pa3);
#undef PK4
}
template <int KB>
__device__ __forceinline__ void qkt(f32x16& p0, f32x16& p1, const LAS char* K_lds, int r32, int hi, const bf16x8* qr, const LAS float* cs) {
#pragma unroll
    for (int g = 0; g < 4; ++g) { const f32x4 a = *(const LAS f32x4*)(cs + 8 * g), b = *(const LAS f32x4*)(cs + 32 + 8 * g);
        p0[4 * g] = a[0]; p0[4 * g + 1] = a[1]; p0[4 * g + 2] = a[2]; p0[4 * g + 3] = a[3]; p1[4 * g] = b[0]; p1[4 * g + 1] = b[1]; p1[4 * g + 2] = b[2]; p1[4 * g + 3] = b[3]; }
    const LAS char* kb[4];
#pragma unroll
    for (int dd = 0; dd < 4; ++dd) kb[dd] = K_lds + KB * SHM_K + KSWZ(r32, (dd * 16 + hi * 8) * 2);
#pragma unroll
    for (int d0 = 0; d0 < 8; ++d0) { const LAS char* a = kb[d0 & 3] + (d0 >> 2) * 128;
        bf16x8 b0 = *reinterpret_cast<const LAS bf16x8*>(a);
        bf16x8 b1 = *reinterpret_cast<const LAS bf16x8*>(a + 32 * 256);
        p0 = __builtin_amdgcn_mfma_f32_32x32x16_bf16(b0, qr[d0], p0, 0, 0, 0);
        p1 = __builtin_amdgcn_mfma_f32_32x32x16_bf16(b1, qr[d0], p1, 0, 0, 0); }
}
template <int VB>
__device__ __forceinline__ void pv_tile(f32x16* o, int vb0, bf16x8 pa0, bf16x8 pa1, bf16x8 pa2, bf16x8 pa3) {
#define TRRD(dst, off) asm volatile("ds_read_b64_tr_b16 %0, %1 offset:%2" : "=&v"(dst) : "v"(vb0), "i"(off) : "memory")
#define PV_D0(d0) do { s16x4 l0, l1, l2, l3, h0, h1, h2, h3; constexpr int b_ = VB * SHM_V + v_rd_off(d0, 0, 0); \
        TRRD(l0, b_); TRRD(h0, b_ + 2048); TRRD(l1, b_ + 4096); TRRD(h1, b_ + 6144); TRRD(l2, b_ + 8192); TRRD(h2, b_ + 10240); TRRD(l3, b_ + 12288); TRRD(h3, b_ + 14336); \
        asm volatile("s_waitcnt lgkmcnt(0)" ::: "memory"); SBAR();   \
        o[d0] = __builtin_amdgcn_mfma_f32_32x32x16_bf16(pa0, (bf16x8){l0[0], l0[1], l0[2], l0[3], h0[0], h0[1], h0[2], h0[3]}, o[d0], 0, 0, 0);   \
        o[d0] = __builtin_amdgcn_mfma_f32_32x32x16_bf16(pa1, (bf16x8){l1[0], l1[1], l1[2], l1[3], h1[0], h1[1], h1[2], h1[3]}, o[d0], 0, 0, 0);   \
        o[d0] = __builtin_amdgcn_mfma_f32_32x32x16_bf16(pa2, (bf16x8){l2[0], l2[1], l2[2], l2[3], h2[0], h2[1], h2[2], h2[3]}, o[d0], 0, 0, 0);   \
        o[d0] = __builtin_amdgcn_mfma_f32_32x32x16_bf16(pa3, (bf16x8){l3[0], l3[1], l3[2], l3[3], h3[0], h3[1], h3[2], h3[3]}, o[d0], 0, 0, 0); } while (0)
    PV_D0(0); PV_D0(1); PV_D0(2); PV_D0(3);
#undef PV_D0
#undef TRRD
}
struct BlockRef { int bh, qb; };
struct Bases { const bf16* U; bf16* OA; float* SSQ; const float* CUM; };
__device__ __forceinline__ int blk_p0(const BlockRef& r) { return 128 + r.qb * 256; }
__device__ __forceinline__ const bf16* blk_q(const Bases& B, const BlockRef& r) { return B.U + ((size_t)((r.bh >> 3) * PP + blk_p0(r))) * 1024 + (r.bh & 7) * 128; }
__device__ __forceinline__ const bf16* blk_k(const Bases& B, const BlockRef& r) { return B.U + 1 * USTR + ((size_t)(r.bh >> 3) * PP) * 1024 + (r.bh & 7) * 128; }
__device__ __forceinline__ const bf16* blk_v(const Bases& B, const BlockRef& r) { return B.U + 2 * USTR + ((size_t)(r.bh >> 3) * PP) * 1024 + (r.bh & 7) * 128; }
struct Seam { bf16x8 qr[8]; bf16x8 st_v0, st_v1, st_k0, st_k1; };
#define ROW(p, k0, rr) ((p) + (size_t)((k0) + (rr)) * LDQ + sc)
#define VMW() asm volatile("s_waitcnt vmcnt(0)" ::: "memory")
#define VMWN(n) asm volatile("s_waitcnt vmcnt(%0)" :: "i"(n) : "memory")
#define SLOAD_H(Kp, Vp, k0) do { S.st_v0 = load8(ROW(Vp, k0, sr)); S.st_v1 = load8(ROW(Vp, k0, 32 + sr));              \
                         S.st_k0 = load8(ROW(Kp, k0, sr)); S.st_k1 = load8(ROW(Kp, k0, 32 + sr)); } while (0)
#define SWRITE_HK(bf) do { *(LAS bf16x8*)(K_lds + (bf) * SHM_K + kws) = S.st_k0; *(LAS bf16x8*)(K_lds + (bf) * SHM_K + kws + 32 * 256) = S.st_k1; } while (0)
#define SWRITE_HV(bf) do { *(LAS bf16x8*)(V_lds + (bf) * SHM_V + vst0) = S.st_v0; *(LAS bf16x8*)(V_lds + (bf) * SHM_V + vst1) = S.st_v1; } while (0)
#define SWRITE_H(bf) do { SWRITE_HV(bf); SWRITE_HK(bf); } while (0)
__device__ __forceinline__ void prime(const Bases& B, const BlockRef& cur, LAS char* lds, Seam& S) {
    const int tid = threadIdx.x, wid = __builtin_amdgcn_readfirstlane(tid >> 6), lane = tid & 63, r32 = lane & 31, hi = lane >> 5;
    const int sr = tid >> 4, sc = (tid & 15) * 8, kws = KSWZ(sr, sc * 2); LAS char* K_lds = lds + 2 * SHM_V;
    const int kb0 = KVBLK;
#pragma unroll
    for (int d0 = 0; d0 < 8; ++d0) S.qr[d0] = load8(blk_q(B, cur) + (size_t)(wid * QBLK + r32) * LDQ + d0 * 16 + hi * 8);
    { const bf16* Kp = blk_k(B, cur); const bf16* Vp = blk_v(B, cur); SLOAD_H(Kp, Vp, kb0); } VMW(); SWRITE_HK(0);
    __syncthreads();
}
__device__ __forceinline__ void block(const Bases& B, const BlockRef& cur, const BlockRef& nxt, LAS char* lds, Seam& S) {
    const int tid = threadIdx.x, wid = __builtin_amdgcn_readfirstlane(tid >> 6), lane = tid & 63, r32 = lane & 31, hi = lane >> 5;
    const int P0 = blk_p0(cur);
    const int j_hi = (P0 + QB - 1) / KVBLK + 1;
    const int NT = j_hi - 1;
    const int kbn = KVBLK;
    const int qlo = P0 + wid * QBLK, qm = qlo + r32 - 4 * hi;
    LAS char* V_lds = lds; LAS char* K_lds = lds + 2 * SHM_V;
    LAS float* ws = (LAS float*)(lds + OFF_WS) + wid * 64; LAS float* li_l = ws; LAS float* al_l = ws + 32;
    LAS float* cumS = (LAS float*)(lds + OFF_CUM);
    { const float* CUMG = B.CUM + (size_t)cur.bh * PP; const float cref = CUMG[P0]; const int n4 = (P0 + QB) >> 2;
      for (int i = tid; i < n4; i += 512) { const f32x4 c = *((const f32x4*)CUMG + i); *((LAS f32x4*)cumS + i) = (cref - c) * INVS; } }
    __syncthreads();
    float m_reg = -1e30f, l_reg = 0; f32x16 o[4] = {};
    const int sr = tid >> 4, sc = (tid & 15) * 8, vst0 = v_st(sr, sc), vst1 = v_st(32 + sr, sc), kws = KSWZ(sr, sc * 2);
    const int vb0 = (int)(uintptr_t)V_lds + v_rd_base(lane);
    const bf16* Kh = blk_k(B, cur); const bf16* Vh = blk_v(B, cur);
#define RESC(a) do { if (__any((a) < 1.f)) { if (hi == 0) al_l[r32] = (a); asm volatile("s_waitcnt lgkmcnt(0)" ::: "memory");              \
                     for (int d_ = 0; d_ < 4; ++d_) for (int r = 0; r < 16; ++r) o[d_][r] *= al_l[crow(r, hi)]; } } while (0)
#define KBASE(t) ((1 + (t)) * KVBLK)
#define CSP(t) (cumS + KBASE(t) + 4 * hi)
#define MASKT(P0_, P1_, t) do { const int kb_ = KBASE(t); if (kb_ + KVBLK - 1 > qlo) mask_causal(P0_, P1_, qm - kb_); if (kb_ == KVBLK) mask_pad(P0_, P1_, hi); } while (0)
#define SEAM_K0() do { VMWN(8); SWRITE_HK(0); SBAR(); } while (0)
    f32x16 pA0, pA1, pB0, pB1; float mnA, mnB, alA, alB; bf16x8 pa0, pa1, pa2, pa3;
    SWRITE_HV(0); SBAR();
    if (NT > 1) { SLOAD_H(Kh, Vh, KBASE(1)); }
    SBAR(); qkt<0>(pA0, pA1, K_lds, r32, hi, S.qr, CSP(0));
    MASKT(pA0, pA1, 0); partialSM(pA0, pA1, m_reg, mnA, alA);
    if (NT > 1) { VMW(); SWRITE_H(1); }
    __syncthreads();
#define HALF_STEP(PX0, PX1, mnX, alX, PY0, PY1, alY, t, KB, VB, SB) do {                                                      \
        SBAR(); qkt<KB>(PX0, PX1, K_lds, r32, hi, S.qr, CSP(t));                                             \
        finishSM(PY0, PY1, alY, l_reg, pa0, pa1, pa2, pa3); SBAR();                                                           \
        if ((t) + 1 < NT) { SLOAD_H(Kh, Vh, KBASE((t) + 1)); SBAR(); }                                               \
        pv_tile<VB>(o, vb0, pa0, pa1, pa2, pa3); MASKT(PX0, PX1, (t)); partialSM(PX0, PX1, m_reg, mnX, alX);                                        \
        __syncthreads();                                                                                                      \
        if ((t) + 1 < NT) { VMW(); SWRITE_H(SB); }                                                                          \
        RESC(alX); __syncthreads(); } while (0)
    for (int t = 1; t + 1 < NT; t += 2) {
        HALF_STEP(pB0, pB1, mnB, alB, pA0, pA1, alA, t, 1, 0, 0);
        HALF_STEP(pA0, pA1, mnA, alA, pB0, pB1, alB, t + 1, 0, 1, 1);
    }
    const bool even = (NT & 1) == 0;
    if (even) { SBAR(); qkt<1>(pB0, pB1, K_lds, r32, hi, S.qr, CSP(NT - 1)); SBAR(); }
    { const bf16* Kn = blk_k(B, nxt); const bf16* Vn = blk_v(B, nxt); SLOAD_H(Kn, Vn, kbn); } SBAR();
    { const bf16* Qn = blk_q(B, nxt);
#pragma unroll
    for (int d0 = 0; d0 < 8; ++d0) S.qr[d0] = load8(Qn + (size_t)(wid * QBLK + r32) * LDQ + d0 * 16 + hi * 8); }
    SBAR();
    finishSM(pA0, pA1, alA, l_reg, pa0, pa1, pa2, pa3); SBAR();
    pv_tile<0>(o, vb0, pa0, pa1, pa2, pa3);
    if (even) { MASKT(pB0, pB1, NT - 1); partialSM(pB0, pB1, m_reg, mnB, alB); __syncthreads(); RESC(alB);
        finishSM(pB0, pB1, alB, l_reg, pa0, pa1, pa2, pa3); SBAR(); pv_tile<1>(o, vb0, pa0, pa1, pa2, pa3); }
    SBAR(); SEAM_K0();
    if (hi == 0) li_l[r32] = l_reg; asm volatile("s_waitcnt lgkmcnt(0)" ::: "memory");
    float rli[16];
#pragma unroll
    for (int r = 0; r < 16; ++r) rli[r] = __builtin_amdgcn_rcpf(li_l[crow(r, hi)]);
    int r32e = r32, hie = hi; asm volatile("" : "+v"(r32e), "+v"(hie));
    const size_t m0 = (size_t)(cur.bh >> 3) * SEQ + cur.qb * 256 + wid * QBLK + 4 * hie;
    bf16* Ow = B.OA + m0 * LDO + (cur.bh & 7) * 128 + r32e; float* Sw = B.SSQ + m0 * 8 + (cur.bh & 7);
#pragma unroll
    for (int r = 0; r < 16; ++r) { const int orow = (r & 3) + 8 * (r >> 2); float sq = 0.f;
#pragma unroll
        for (int d0 = 0; d0 < 4; ++d0) { const float v = o[d0][r] * rli[r]; sq += v * v;
            const float vn = __shfl_xor(v, 1);
            if ((r32e & 1) == 0) *(unsigned*)(Ow + (size_t)orow * LDO + d0 * 32) = cvtpk(v, vn); }
        sq += __shfl_xor(sq, 1); sq += __shfl_xor(sq, 2); sq += __shfl_xor(sq, 4); sq += __shfl_xor(sq, 8); sq += __shfl_xor(sq, 16);
        if (r32e == 0) Sw[(size_t)orow * 8] = sq; }
    __syncthreads();
#undef RESC
#undef KBASE
#undef CSP
#undef MASKT
#undef SEAM_K0
#undef HALF_STEP
}
#undef ROW
#undef VMW
#undef VMWN
#undef SLOAD_H
#undef SWRITE_HK
#undef SWRITE_HV
#undef SWRITE_H
#undef KSWZ
#undef SBAR
}

__device__ __forceinline__ void fox_phase(Frame& F) {
    const int total = NB * NH * 8, stride = F.G; int L = F.vcu; if (L >= total) return;
    const fox::Bases B{(const bf16*)(F.ws + WS_U), (bf16*)(F.ws + WS_HN), (float*)(F.ws + WS_SSQ), (const float*)(F.ws + WS_CUM)};
    int pass = 0;
    fox::BlockRef cur{L >> 3, L & 7};
    fox::Seam S;
    fox::prime(B, cur, (LAS char*)F.lds, S);
    for (;;) {
        const bool more_pass = pass == 0, more_item = L + stride < total, last = !more_pass && !more_item;
        int Ln = L, passn = pass + 1;
        if (!more_pass) { passn = 0; Ln = more_item ? L + stride : L; }
        fox::BlockRef nxt{Ln >> 3, passn ? 15 - (Ln & 7) : (Ln & 7)};
        if (last) nxt = cur;
        fox::block(B, cur, nxt, (LAS char*)F.lds, S);
        if (last) break;
        cur = nxt; pass = passn; L = Ln;
    }
}


namespace ret {
typedef short s16x4 __attribute__((ext_vector_type(4)));
typedef short v4i16_t __attribute__((ext_vector_type(4)));
__device__ __forceinline__ s16x4 vtr(const LAS char* p) { return __builtin_bit_cast(s16x4, __builtin_amdgcn_ds_read_tr16_b64_v4i16((LAS v4i16_t*)p)); }
__device__ __forceinline__ int kswz(int row, int colB) { return row * 256 + (colB ^ ((row & 7) << 4)); }
__device__ __forceinline__ int vswz(int row, int colB) { return row * 256 + (colB ^ ((row & 7) << 5)); }
__device__ __forceinline__ int aswz(int row, int colB) { return row * 256 + (colB ^ ((((row & 3) | ((row >> 1) & 4))) << 5)); }
constexpr int A_KB = 32768, A_VB = 4096, A_OFF_V = 2 * A_KB;
__device__ __forceinline__ void states(Frame& F) {
    const int tid = F.tid, lane = F.lane, w = F.wave, g = lane >> 4, q = (lane & 15) >> 2, pp = lane & 3;
    const bf16* U = (const bf16*)(F.ws + WS_U); bf16* ST = (bf16*)(F.ws + WS_ST);
    LAS char* lds = (LAS char*)F.lds;
    for (int unit = F.vcu; unit < NB * NH * 8; unit += F.G) {
        const int bh = unit >> 3, es = unit & 7, b = bh >> 3, h = bh & 7;
        const bf16* Kg = U + 4 * USTR + ((size_t)b * PP) * 1024 + h * 128;
        const bf16* Vg = U + 5 * USTR + ((size_t)b * PP) * 1024 + h * 128 + es * 16;
        const float wdec = exp2f(128.0f * log2f(1.0f - exp2f(-5.0f - (float)h)));
        f32x4 S = (f32x4){0.f, 0.f, 0.f, 0.f};
        u32x4 kr[4], vr;
#define RA_LOAD(n) do { _Pragma("unroll") for (int i = 0; i < 4; ++i) { const int pc = tid + 512 * i, row = pc >> 4, c16 = pc & 15; kr[i] = *(const u32x4*)(Kg + (size_t)((n) * 128 + row) * 1024 + c16 * 8); } \
        if (tid < 256) { const int row = tid >> 1, c16 = tid & 1; vr = *(const u32x4*)(Vg + (size_t)((n) * 128 + row) * 1024 + c16 * 8); } } while (0)
#define RA_WRITE(bf) do { _Pragma("unroll") for (int i = 0; i < 4; ++i) { const int pc = tid + 512 * i, row = pc >> 4, c16 = pc & 15; *(LAS u32x4*)(lds + (bf) * A_KB + aswz(row, c16 * 16)) = kr[i]; } \
        if (tid < 256) { const int row = tid >> 1, c16 = tid & 1; *(LAS u32x4*)(lds + A_OFF_V + (bf) * A_VB + row * 32 + c16 * 16) = vr; } } while (0)
        RA_LOAD(0); RA_WRITE(0);
        __syncthreads();
        for (int n = 0; n < 32; ++n) {
            const int bf = n & 1;
            if (n + 1 < 32) RA_LOAD(n + 1);
            f32x4 acc = (f32x4){0.f, 0.f, 0.f, 0.f};
#pragma unroll
            for (int s = 0; s < 4; ++s) {
                const int r0 = 32 * s + 8 * g + q;
                const s16x4 a0 = vtr(lds + bf * A_KB + aswz(r0, (16 * w + 4 * pp) * 2)), a1 = vtr(lds + bf * A_KB + aswz(r0 + 4, (16 * w + 4 * pp) * 2));
                const s16x4 b0 = vtr(lds + A_OFF_V + bf * A_VB + r0 * 32 + pp * 8), b1 = vtr(lds + A_OFF_V + bf * A_VB + (r0 + 4) * 32 + pp * 8);
                acc = __builtin_amdgcn_mfma_f32_16x16x32_bf16((bf16x8){a0[0], a0[1], a0[2], a0[3], a1[0], a1[1], a1[2], a1[3]}, (bf16x8){b0[0], b0[1], b0[2], b0[3], b1[0], b1[1], b1[2], b1[3]}, acc, 0, 0, 0);
            }
            S = (S + acc) * wdec;
            { u32x2 o; o.x = cvt_pk_bf16(S[0], S[1]); o.y = cvt_pk_bf16(S[2], S[3]);
              *(u32x2*)(ST + (((size_t)bh * 32 + n) * 128 + es * 16 + (lane & 15)) * 128 + 16 * w + 4 * g) = o; }
            if (n + 1 < 32) { RA_WRITE(bf ^ 1); }
            __syncthreads();
        }
#undef RA_LOAD
#undef RA_WRITE
    }
}
constexpr int B_K = 0, B_V = 32768, B_S = 65536;
__device__ __forceinline__ void outputs(Frame& F) {
    const int tid = F.tid, lane = F.lane, w = F.wave, g = lane >> 4, il = lane & 15, q = il >> 2, pp = lane & 3;
    const bf16* U = (const bf16*)(F.ws + WS_U); const bf16* ST = (const bf16*)(F.ws + WS_ST); bf16* OA = (bf16*)(F.ws + WS_HN);
    LAS char* lds = (LAS char*)F.lds;
    u32x4 pk[4], pv[4], ps[4];
#define RB_LOAD(unit) do { const int bh_ = (unit) >> 5, n_ = ((unit) & 31) + 1, b_ = bh_ >> 3, h_ = bh_ & 7; \
        const bf16* Kg = U + 4 * USTR + ((size_t)(b_ * PP + n_ * 128)) * 1024 + h_ * 128; const bf16* Vg = U + 5 * USTR + ((size_t)(b_ * PP + n_ * 128)) * 1024 + h_ * 128; \
        const bf16* Sg = ST + ((size_t)bh_ * 32 + (n_ - 1)) * 16384; \
        _Pragma("unroll") for (int i = 0; i < 4; ++i) { const int pc = tid + 512 * i, row = pc >> 4, c16 = pc & 15; pk[i] = *(const u32x4*)(Kg + (size_t)row * 1024 + c16 * 8); pv[i] = *(const u32x4*)(Vg + (size_t)row * 1024 + c16 * 8); \
            ps[i] = *(const u32x4*)(Sg + (size_t)row * 128 + c16 * 8); } } while (0)
#define RB_WRITE() do { _Pragma("unroll") for (int i = 0; i < 4; ++i) { const int pc = tid + 512 * i, row = pc >> 4, c16 = pc & 15; *(LAS u32x4*)(lds + B_K + kswz(row, c16 * 16)) = pk[i]; \
            *(LAS u32x4*)(lds + B_V + vswz(row, c16 * 16)) = pv[i]; *(LAS u32x4*)(lds + B_S + kswz(row, c16 * 16)) = ps[i]; } } while (0)
    int unit = F.vcu; if (unit >= NB * NH * 32) return;
    RB_LOAD(unit); RB_WRITE();
    __syncthreads();
    for (;;) {
        const int nu = unit + F.G; const bool more = nu < NB * NH * 32;
        const int bh = unit >> 5, n = (unit & 31) + 1, b = bh >> 3, h = bh & 7;
        const size_t urow = (size_t)(b * PP + n * 128 + 16 * w + il);
        bf16x8 qx[4];
#pragma unroll
        for (int s = 0; s < 4; ++s) qx[s] = *(const bf16x8*)(U + 3 * USTR + urow * 1024 + h * 128 + 32 * s + 8 * g);
        if (more) RB_LOAD(nu);
        u32x2 P[8];
#pragma unroll
        for (int jb = 0; jb < 8; ++jb) {
            P[jb] = (u32x2){0u, 0u};
            if (jb <= w) {
                f32x4 d = (f32x4){0.f, 0.f, 0.f, 0.f};
#pragma unroll
                for (int s = 0; s < 4; ++s) { const bf16x8 a = *(const LAS bf16x8*)(lds + B_K + kswz(16 * jb + il, 64 * s + 16 * g)); d = __builtin_amdgcn_mfma_f32_16x16x32_bf16(a, qx[s], d, 0, 0, 0); }
                if (jb == w) {
#pragma unroll
                    for (int r = 0; r < 4; ++r) if (4 * g + r > il) d[r] = 0.f; }
                P[jb].x = cvt_pk_bf16(d[0], d[1]); P[jb].y = cvt_pk_bf16(d[2], d[3]);
            }
        }
        f32x4 o[8];
#pragma unroll
        for (int eb = 0; eb < 8; ++eb) { f32x4 acc = (f32x4){0.f, 0.f, 0.f, 0.f};
#pragma unroll
            for (int s = 0; s < 4; ++s) { const bf16x8 a = *(const LAS bf16x8*)(lds + B_S + kswz(16 * eb + il, 64 * s + 16 * g)); acc = __builtin_amdgcn_mfma_f32_16x16x32_bf16(a, qx[s], acc, 0, 0, 0); }
#pragma unroll
            for (int t = 0; t < 4; ++t) { if (2 * t <= w) {
                const int r0 = 32 * t + 4 * g + q;
                const s16x4 a0 = vtr(lds + B_V + vswz(r0, (16 * eb + 4 * pp) * 2)), a1 = vtr(lds + B_V + vswz(r0 + 16, (16 * eb + 4 * pp) * 2));
                const u32x4 bw = (u32x4){P[2 * t].x, P[2 * t].y, P[2 * t + 1].x, P[2 * t + 1].y};
                acc = __builtin_amdgcn_mfma_f32_16x16x32_bf16((bf16x8){a0[0], a0[1], a0[2], a0[3], a1[0], a1[1], a1[2], a1[3]}, __builtin_bit_cast(bf16x8, bw), acc, 0, 0, 0); } }
            o[eb] = acc; }
        float sm = 0.f;
#pragma unroll
        for (int eb = 0; eb < 8; ++eb) sm += (o[eb][0] + o[eb][1]) + (o[eb][2] + o[eb][3]);
        sm += __shfl_xor(sm, 16); sm += __shfl_xor(sm, 32);
        const float mu = sm * (1.0f / HD); float sv = 0.f;
#pragma unroll
        for (int eb = 0; eb < 8; ++eb) { o[eb] = o[eb] - mu; sv += (o[eb][0] * o[eb][0] + o[eb][1] * o[eb][1]) + (o[eb][2] * o[eb][2] + o[eb][3] * o[eb][3]); }
        sv += __shfl_xor(sv, 16); sv += __shfl_xor(sv, 32);
        const float rstd = 1.0f / sqrtf(sv * (1.0f / HD) + EPS);
        const size_t m = (size_t)b * SEQ + (n - 1) * 128 + 16 * w + il;
#pragma unroll
        for (int eb = 0; eb < 8; ++eb) { const int e0 = 16 * eb + 4 * g;
            const u32x2 gg = *(const u32x2*)(U + 6 * USTR + urow * 1024 + h * 128 + e0);
            u32x2 ov; ov.x = cvt_pk_bf16(o[eb][0] * rstd * bf_lo(gg.x), o[eb][1] * rstd * bf_hi(gg.x)); ov.y = cvt_pk_bf16(o[eb][2] * rstd * bf_lo(gg.y), o[eb][3] * rstd * bf_hi(gg.y));
            *(u32x2*)(OA + m * DM + 1024 + h * 128 + e0) = ov; }
        __syncthreads();
        if (!more) break;
        RB_WRITE();
        __syncthreads();
        unit = nu;
    }
#undef RB_LOAD
#undef RB_WRITE
}
}

struct POutProj {
    static constexpr bool PERM = false, HAS_MID = true, FP8 = false, GATHER = false;
    int nt; const char* Abase; unsigned lda2, ldb2; const char* Bt; const float* x; float* out; const float* SSQ;
    __device__ __forceinline__ void a_offs(const g8::Unit&, unsigned (&)[2][2]) const {}
    __device__ __forceinline__ const char* b_tile(const g8::Unit& u, int t) const { return Bt + (size_t)u.pn * 256 * ldb2 + (size_t)t * 128; }
    __device__ __forceinline__ void mid(f32x4 (&acc)[2][2][4][2], const g8::Unit& u, int wr, int wc, int fr, int fq) const {
#pragma unroll
        for (int ai = 0; ai < 2; ++ai)
#pragma unroll
            for (int m = 0; m < 4; ++m) { const int r = u.pm * 256 + ai * 128 + wr * 64 + m * 16 + fr;
                const f32x4 s0 = *(const f32x4*)(SSQ + (size_t)r * 8), s1 = *(const f32x4*)(SSQ + (size_t)r * 8 + 4);
                const float rs = 1.0f / sqrtf(((s0.x + s0.y) + (s0.z + s0.w) + (s1.x + s1.y) + (s1.z + s1.w)) * (1.0f / 1024.0f) + EPS);
#pragma unroll
                for (int bj = 0; bj < 2; ++bj)
#pragma unroll
                    for (int n = 0; n < 2; ++n) acc[ai][bj][m][n] = acc[ai][bj][m][n] * rs; }
    }
    __device__ __forceinline__ void epi(const f32x4 (&acc)[2][2][4][2], const g8::Unit& u, int wr, int wc, int fr, int fq) const {
        const int row0 = u.pm * 256 + wr * 64 + fr, col0 = u.pn * 256 + wc * 32 + 4 * fq;
#pragma unroll
        for (int ai = 0; ai < 2; ++ai)
#pragma unroll
            for (int m = 0; m < 4; ++m) { const size_t off = (size_t)(row0 + ai * 128 + m * 16) * DM + col0;
#pragma unroll
                for (int bj = 0; bj < 2; ++bj)
#pragma unroll
                    for (int n = 0; n < 2; ++n) *(f32x4*)(out + off + bj * 128 + n * 16) = *(const f32x4*)(x + off + bj * 128 + n * 16) + acc[ai][bj][m][n]; }
    }
};

__device__ __forceinline__ void p4_router(Frame& F) {
    const int gw = F.vcu * NWAVES + F.wave, NGW = F.G * NWAVES, lane = F.lane;
    const float* H1 = F.out; const float* g2 = F.in[8]; const float* WRT = (const float*)(F.ws + WS_WRT);
    const float* brg = F.in[10]; const float* bre = F.in[12];
    unsigned char* HN2 = (unsigned char*)(F.ws + WS_HN); int* TOK = (int*)(F.ws + WS_TOK); float* WLO = (float*)(F.ws + WS_WLO); float* WHI = (float*)(F.ws + WS_WHI);
    for (int row = gw; row < MTOK; row += NGW) {
        const float* xr = H1 + (size_t)row * DM;
        f32x4 v[8]; float ss = 0.f;
#pragma unroll
        for (int j = 0; j < 8; ++j) { v[j] = *((const f32x4*)xr + lane + 64 * j); ss += (v[j].x * v[j].x + v[j].y * v[j].y) + (v[j].z * v[j].z + v[j].w * v[j].w); }
        const float rs = 1.0f / sqrtf(wave_sum(ss) * (1.0f / DM) + EPS);
        float mylg = 0.f;
#pragma unroll 1
        for (int jj = 0; jj < 20; ++jj) { float s = 0.f;
#pragma unroll
            for (int j = 0; j < 8; ++j) { const f32x4 w = *((const f32x4*)(WRT + jj * DM) + lane + 64 * j); s += (v[j].x * w.x + v[j].y * w.y) + (v[j].z * w.z + v[j].w * w.w); }
            const float tot = wave_sum(s) * rs + (jj < 4 ? brg[jj] : bre[jj - 4]); mylg = (lane == jj) ? tot : mylg; }
        float lgt[20];
#pragma unroll
        for (int jj = 0; jj < 20; ++jj) lgt[jj] = __shfl(mylg, jj);
        unsigned char* orow = HN2 + (size_t)row * DM;
#pragma unroll
        for (int j = 0; j < 8; ++j) { const f32x4 g = *((const f32x4*)g2 + lane + 64 * j); const f32x4 y = v[j] * (rs * SA1) * g; *((unsigned*)orow + lane + 64 * j) = pk_fp8x4(y.x, y.y, y.z, y.w); }
        int gs = 0; float gm = lgt[0];
#pragma unroll
        for (int i = 1; i < 4; ++i) if (lgt[i] > gm) { gm = lgt[i]; gs = i; }
        float den = 0.f;
#pragma unroll
        for (int i = 0; i < 4; ++i) den += __expf(lgt[i] - gm);
        const float pg = 1.0f / den;
        float e4[4];
#pragma unroll
        for (int i = 0; i < 4; ++i) { float a = lgt[4 + i];
#pragma unroll
            for (int g = 1; g < 4; ++g) a = (gs == g) ? lgt[4 + 4 * g + i] : a;
            e4[i] = a; }
        int i1 = 0; float v1 = e4[0];
#pragma unroll
        for (int i = 1; i < 4; ++i) if (e4[i] > v1) { v1 = e4[i]; i1 = i; }
        int i2 = -1; float v2 = -__builtin_inff();
#pragma unroll
        for (int i = 0; i < 4; ++i) if (i != i1 && e4[i] > v2) { v2 = e4[i]; i2 = i; }
        const float ex = __expf(v2 - v1); const float w1 = pg / (1.f + ex), w2 = pg * ex / (1.f + ex);
        const int lo = i1 < i2 ? i1 : i2, hi = i1 < i2 ? i2 : i1; const float wlo = i1 < i2 ? w1 : w2, whi = i1 < i2 ? w2 : w1;
        const int pair = (lo == 0) ? (hi - 1) : (lo == 1) ? (hi + 1) : 5;
        const int cls = gs * 6 + pair;
        if (lane == 0) { const unsigned pos = atomicAdd(F.ctl + CW_CNT + 64 * cls, 1u);
            TOK[cls * CLS_CAP + pos] = row; WLO[cls * CLS_CAP + pos] = wlo; WHI[cls * CLS_CAP + pos] = whi; }
    }
}

__device__ __forceinline__ void cls_experts(int cls, int& elo, int& ehi) { const int g = cls / 6, pr = cls % 6; const int lo = pr < 3 ? 0 : (pr < 5 ? 1 : 2), hi = pr < 3 ? pr + 1 : (pr < 5 ? pr - 1 : 3); elo = 4 * g + lo; ehi = 4 * g + hi; }
__device__ __forceinline__ void moe_tables(Frame& F) {
    volatile LAS int* T = (volatile LAS int*)(F.lds + TBL_OFF);
    if (F.tid == 0) {
        int base = 0;
        for (int c = 0; c < NCLS; ++c) { int n = (int)__hip_atomic_load(F.ctl + CW_CNT + 64 * c, __ATOMIC_RELAXED, __HIP_MEMORY_SCOPE_AGENT); if (n > CLS_CAP) n = CLS_CAP; T[c] = n; T[32 + c] = base; const int nt = (n + 255) >> 8;
            for (int i = 0; i < nt; ++i) T[96 + base + i] = c; base += nt; }
        T[64] = base;
        int ne = 0;
        for (int e = 0; e < NEXP; ++e) { T[72 + e] = ne;
            for (int c = (e >> 2) * 6; c < (e >> 2) * 6 + 6; ++c) { int elo, ehi; cls_experts(c, elo, ehi); if (elo != e && ehi != e) continue; const int slot = (ehi == e) ? 1 : 0;
                const int nt = (T[c] + 255) >> 8; for (int i = 0; i < nt; ++i) { T[192 + ne] = (T[32 + c] + i) | (slot << 8) | (c << 16) | (i << 24); ++ne; } } }
        T[72 + NEXP] = ne; T[65] = ne;
    }
    __syncthreads();
}
struct SchedGU {
    const LAS int* T; int G, c;
    __device__ bool next(int i, g8::Unit& u) const {
        const int L = i * G + c; const int ne = __builtin_amdgcn_readfirstlane(T[65]); if (L >= ne * 8) return false;
        int e = 0;
#pragma unroll
        for (int k = 1; k < NEXP; ++k) { const int o = __builtin_amdgcn_readfirstlane(T[72 + k]); if (L >= o * 8) e = k; }
        const int e0 = __builtin_amdgcn_readfirstlane(T[72 + e]), e1 = __builtin_amdgcn_readfirstlane(T[72 + e + 1]); const int cnt = e1 - e0, loc = L - e0 * 8;
        const int ntile = loc / cnt, mt = loc - ntile * cnt; const int ent = __builtin_amdgcn_readfirstlane(T[192 + e0 + mt]);
        u.pm = ent & 0xff; u.pn = ntile; u.a0 = e; u.a1 = (ent >> 8) & 1; u.a2 = (ent >> 16) & 0xff; u.a3 = (ent >> 24) & 0xff; return true;
    }
};
struct SchedDown {
    const LAS int* T; int G, c;
    __device__ bool next(int i, g8::Unit& u) const {
        const int L = i * G + c; const int NT = __builtin_amdgcn_readfirstlane(T[64]); if (L >= NT * 8) return false;
        const int tl = L >> 3; const int cls = __builtin_amdgcn_readfirstlane(T[96 + tl]); const int tb = __builtin_amdgcn_readfirstlane(T[32 + cls]);
        int elo, ehi; cls_experts(cls, elo, ehi);
        u.pm = tl; u.pn = L & 7; u.a0 = elo; u.a1 = ehi; u.a2 = cls; u.a3 = tl - tb; return true;
    }
};

struct PGateUp {
    static constexpr bool PERM = true, HAS_MID = false, FP8 = true, GATHER = true;
    int nt; const char* Abase; unsigned lda2, ldb2; const char* WGU; const int* TOK; const float* WLO; const float* WHI; const LAS int* T; unsigned char* ACT;
    __device__ __forceinline__ void a_offs(const g8::Unit& u, unsigned (&o)[2][2]) const {
        const int cnt = T[u.a2];
#pragma unroll
        for (int i = 0; i < 2; ++i) { int R, C; g8::stage_rc((int)threadIdx.x * 16 + i * 8192, R, C);
#pragma unroll
            for (int h = 0; h < 2; ++h) { int pos = u.a3 * 256 + h * 128 + R; if (pos >= cnt) pos = 0; const int tok = TOK[u.a2 * CLS_CAP + pos]; o[h][i] = (unsigned)(tok * DM + C * 2); } }
    }
    __device__ __forceinline__ const char* b_tile(const g8::Unit& u, int t) const { return WGU + ((size_t)u.a0 * 2048 + (size_t)u.pn * 256) * ldb2 + (size_t)t * 128; }
    __device__ __forceinline__ void mid(f32x4 (&)[2][2][4][2], const g8::Unit&, int, int, int, int) const {}
    __device__ __forceinline__ void epi(const f32x4 (&acc)[2][2][4][2], const g8::Unit& u, int wr, int wc, int fr, int fq) const {
        const int cnt = T[u.a2]; const float* WS = u.a1 ? WHI : WLO; constexpr float INV = 1.0f / (SA1 * SW1);
#pragma unroll
        for (int ai = 0; ai < 2; ++ai)
#pragma unroll
            for (int m = 0; m < 4; ++m) { const int rl = ai * 128 + wr * 64 + m * 16 + fr; const int pos = u.a3 * 256 + rl;
                const float w = ((pos < cnt) ? WS[u.a2 * CLS_CAP + pos] : 0.f) * SA2;
                const f32x4 g0 = acc[ai][0][m][0] * INV, g1 = acc[ai][0][m][1] * INV, u0 = acc[ai][1][m][0] * INV, u1 = acc[ai][1][m][1] * INV;
                f32x4 a0, a1;
#pragma unroll
                for (int e = 0; e < 4; ++e) { a0[e] = g0[e] / (1.f + __expf(-g0[e])) * u0[e] * w; a1[e] = g1[e] / (1.f + __expf(-g1[e])) * u1[e] * w; }
                u32x2 o; o.x = pk_fp8x4(a0[0], a0[1], a0[2], a0[3]); o.y = pk_fp8x4(a1[0], a1[1], a1[2], a1[3]);
                *(u32x2*)(ACT + ((size_t)u.pm * 256 + rl) * 2048 + u.a1 * 1024 + u.pn * 128 + wc * 32 + 8 * fq) = o; }
    }
};
struct PDown {
    static constexpr bool PERM = false, HAS_MID = false, FP8 = true, GATHER = false;
    int nt; const char* Abase; unsigned lda2, ldb2; const char* WD; const int* TOK; const LAS int* T; float* out;
    __device__ __forceinline__ void a_offs(const g8::Unit&, unsigned (&)[2][2]) const {}
    __device__ __forceinline__ const char* b_tile(const g8::Unit& u, int t) const { const int e = (t < 8) ? u.a0 : u.a1; return WD + ((size_t)e * 2048 + (size_t)u.pn * 256) * ldb2 + (size_t)(t & 7) * 128; }
    __device__ __forceinline__ void mid(f32x4 (&)[2][2][4][2], const g8::Unit&, int, int, int, int) const {}
    __device__ __forceinline__ void epi(const f32x4 (&acc)[2][2][4][2], const g8::Unit& u, int wr, int wc, int fr, int fq) const {
        const int cnt = T[u.a2]; const int col0 = u.pn * 256 + wc * 32 + 4 * fq; constexpr float INV = 1.0f / (SA2 * SW2);
#pragma unroll
        for (int ai = 0; ai < 2; ++ai)
#pragma unroll
            for (int m = 0; m < 4; ++m) { const int pos = u.a3 * 256 + ai * 128 + wr * 64 + m * 16 + fr;
                if (pos < cnt) { const int tok = TOK[u.a2 * CLS_CAP + pos]; float* rowp = out + (size_t)tok * DM + col0;
#pragma unroll
                    for (int bj = 0; bj < 2; ++bj)
#pragma unroll
                        for (int n = 0; n < 2; ++n) { f32x4* q = (f32x4*)(rowp + bj * 128 + n * 16); *q = *q + acc[ai][bj][m][n] * INV; } } }
    }
};

__device__ __forceinline__ void p7_final(Frame& F) {
    const int gw = F.vcu * NWAVES + F.wave, NGW = F.G * NWAVES, lane = F.lane; const float* gf = F.in[16];
    f32x4 gv[8];
#pragma unroll
    for (int j = 0; j < 8; ++j) gv[j] = *((const f32x4*)gf + lane + 64 * j);
    for (int row = gw; row < MTOK; row += NGW) {
        float* xr = F.out + (size_t)row * DM; f32x4 v[8]; float ss = 0.f;
#pragma unroll
        for (int j = 0; j < 8; ++j) { v[j] = *((const f32x4*)xr + lane + 64 * j); ss += (v[j].x * v[j].x + v[j].y * v[j].y) + (v[j].z * v[j].z + v[j].w * v[j].w); }
        const float rs = 1.0f / sqrtf(wave_sum(ss) * (1.0f / DM) + EPS);
#pragma unroll
        for (int j = 0; j < 8; ++j) *((f32x4*)xr + lane + 64 * j) = v[j] * rs * gv[j];
    }
}

struct Args { const float* in[17]; float* out; unsigned char* ws; int ph_lo, ph_hi; };
__global__ void __launch_bounds__(NWAVES * 64, 2) fwd_kernel(Args args) {
    extern __shared__ __attribute__((aligned(16))) unsigned char lds[];
    Frame F;
    F.lds = (LAS unsigned char*)lds;
    F.MISC = (volatile LAS unsigned*)(F.lds + MISC_OFF);
    F.tid = threadIdx.x; F.lane = F.tid & 63; F.wave = __builtin_amdgcn_readfirstlane(F.tid >> 6);
    F.G = gridDim.x; { const int bx = blockIdx.x; F.vcu = (F.G % 8 == 0) ? (bx % 8) * (F.G / 8) + bx / 8 : bx; }
#pragma unroll
    for (int i = 0; i < 17; ++i) F.in[i] = args.in[i];
    F.out = args.out; F.ws = args.ws; F.ctl = (unsigned*)(args.ws + WS_CTL);
    for (int u = F.tid; u < (LDS_BYTES - RING_BYTES) / 4; u += NWAVES * 64) ((LAS unsigned*)(F.lds + RING_BYTES))[u] = 0u;
    __syncthreads();
    XcdBarrier bar = xcd_barrier_post(F.ctl + CW_BAR, F.MISC + 8);
    const int lo = args.ph_lo, hi = args.ph_hi;
#define IN(k) (lo <= (k) && (k) < hi)
#define GRID_BAR(k) do { if (IN(k) && IN((k) + 1)) xcd_barrier(bar); } while (0)
    bf16* U = (bf16*)(F.ws + WS_U);
    if (IN(0)) { p0_prologue(F); } GRID_BAR(0);
    if (IN(1)) {
        p1_cumsum(F); p1_meta_kv(F);
        PInProj p{DM / 64, (const char*)(F.ws + WS_HN), (unsigned)(DM * 2), (unsigned)(DM * 2), (const char*)(F.ws + WS_WINT), U, (const f32x2*)(F.ws + WS_ROPE)};
        g8::StaticOrder S; S.init(MTOK, NIN, F.G, (int)blockIdx.x);
        g8::gemm_phase<PInProj, g8::StaticOrder, true>(F.lds, p, S);
    } GRID_BAR(1);
    if (IN(2)) {
#ifdef NAIVE_RET
        attn_simple<true>(F); __syncthreads(); fox_phase(F);
#else
        ret::states(F); __syncthreads(); fox_phase(F); xcd_barrier(bar); ret::outputs(F);
#endif
    } GRID_BAR(2);
    if (IN(3)) {
        POutProj p{DM / 64, (const char*)(F.ws + WS_HN), (unsigned)(DM * 2), (unsigned)(DM * 2), (const char*)(F.ws + WS_WOUTT), F.in[0], F.out, (const float*)(F.ws + WS_SSQ)};
        g8::StaticOrder S; S.init(MTOK, DM, F.G, (int)blockIdx.x);
        g8::gemm_phase<POutProj, g8::StaticOrder, true>(F.lds, p, S);
    } GRID_BAR(3);
    if (IN(4)) { p4_router(F); } GRID_BAR(4);
    if (IN(5)) {
        moe_tables(F);
        PGateUp p{DM / 128, (const char*)(F.ws + WS_HN), (unsigned)DM, (unsigned)DM, (const char*)(F.ws + WS_WGU), (const int*)(F.ws + WS_TOK), (const float*)(F.ws + WS_WLO), (const float*)(F.ws + WS_WHI),
                  (const LAS int*)(F.lds + TBL_OFF), (unsigned char*)U};
        SchedGU S{(const LAS int*)(F.lds + TBL_OFF), F.G, F.vcu};
        g8::gemm_phase<PGateUp, SchedGU, true>(F.lds, p, S);
    } GRID_BAR(5);
    if (IN(6)) {
        if (!IN(5)) moe_tables(F);
        PDown p{2048 / 128, (const char*)U, 2048u, (unsigned)DE, (const char*)(F.ws + WS_WD), (const int*)(F.ws + WS_TOK), (const LAS int*)(F.lds + TBL_OFF), F.out};
        SchedDown S{(const LAS int*)(F.lds + TBL_OFF), F.G, F.vcu};
        g8::gemm_phase<PDown, SchedDown, true>(F.lds, p, S);
    } GRID_BAR(6);
    if (IN(7)) { p7_final(F); }
#undef IN
#undef GRID_BAR
}

extern "C" void kernel_launch(void* const* d_in, const int* in_sizes, int n_in, void* d_out, int out_size, void* d_ws, size_t ws_size, hipStream_t stream) {
    static int grid = 0;
    if (grid == 0) {
        if (n_in != 17 || out_size != MTOK * DM || ws_size < WS_END) { fprintf(stderr, "kernel_launch: unexpected shapes (n_in %d out %d ws %zu)\n", n_in, out_size, ws_size); grid = -1; return; }
        int dev = 0, cus = 0, per_cu = 0;
        if (hipGetDevice(&dev) != hipSuccess || hipDeviceGetAttribute(&cus, hipDeviceAttributeMultiprocessorCount, dev) != hipSuccess) { grid = -1; return; }
        if (hipFuncSetAttribute((const void*)fwd_kernel, hipFuncAttributeMaxDynamicSharedMemorySize, LDS_BYTES) != hipSuccess) { fprintf(stderr, "kernel_launch: hipFuncSetAttribute failed\n"); grid = -1; return; }
        if (hipOccupancyMaxActiveBlocksPerMultiprocessor(&per_cu, (const void*)fwd_kernel, NWAVES * 64, LDS_BYTES) != hipSuccess || per_cu < 1) fprintf(stderr, "kernel_launch: occupancy query says %d\n", per_cu);
        (void)hipGetLastError();
        grid = cus;
    }
    if (grid < 0) return;
    (void)hipMemsetAsync((char*)d_ws + WS_CTL, 0, CTL_ZERO_BYTES, stream);
    Args a{};
    for (int i = 0; i < 17; ++i) a.in[i] = (const float*)d_in[i];
    a.out = (float*)d_out; a.ws = (unsigned char*)d_ws; a.ph_lo = 0; a.ph_hi = 8;
    hipLaunchKernelGGL(fwd_kernel, dim3(grid), dim3(NWAVES * 64), LDS_BYTES, stream, a);
}
```

```cpp
#include <hip/hip_runtime.h>
#include <cstdio>
#include <cstdint>

#define LAS __attribute__((address_space(3)))
#define GAS __attribute__((address_space(1)))
typedef unsigned short bf16;
typedef short bf16x8 __attribute__((ext_vector_type(8)));
typedef float f32x4 __attribute__((ext_vector_type(4)));
typedef float f32x2 __attribute__((ext_vector_type(2)));
typedef unsigned u32x4 __attribute__((ext_vector_type(4)));
typedef unsigned u32x2 __attribute__((ext_vector_type(2)));

constexpr int NB = 4, SEQ = 4096, DM = 2048, PADN = 112, NMETA = 16, PP = SEQ + 128, HD = 128, NH = 8;
constexpr int MTOK = NB * SEQ;
constexpr int INC = 7176;
constexpr int NIN = 7168;
constexpr int NEXP = 16, DE = 1024, NCLS = 24, CLS_CAP = 16384;
constexpr float EPS = 1e-6f;
constexpr float SCALE = 0.08838834764831845f;

constexpr size_t MiB = 1u << 20;
constexpr size_t WS_CTL = 0, CTL_ZERO_BYTES = 1 * MiB;
constexpr size_t WS_LOGF = 1 * MiB;
constexpr size_t WS_CUM = WS_LOGF + 1 * MiB;
constexpr size_t WS_SSQ = WS_CUM + 1 * MiB;
constexpr size_t WS_ROPE = WS_SSQ + 1 * MiB;
constexpr size_t WS_WRT = WS_ROPE + 3 * MiB;
constexpr size_t WS_HNMETA = WS_WRT + 1 * MiB;
constexpr size_t WS_TOK = WS_HNMETA + 1 * MiB;
constexpr size_t WS_WLO = WS_TOK + 2 * MiB;
constexpr size_t WS_WHI = WS_WLO + 2 * MiB;
constexpr size_t WS_WINT = 16 * MiB;
constexpr size_t WS_WOUTT = 44 * MiB;
constexpr size_t WS_WGU = 52 * MiB;
constexpr size_t WS_WD = 180 * MiB;
constexpr size_t WS_HN = 244 * MiB;
constexpr size_t WS_U = 308 * MiB;
constexpr size_t USTR = (size_t)NB * PP * 1024;
constexpr size_t WS_ST = WS_U + 7 * 33 * MiB;
constexpr size_t WS_RSS = WS_ST + 32 * MiB;
constexpr size_t WS_END = WS_RSS + 2 * MiB;
static_assert(WS_WHI + 2 * MiB <= WS_WINT && USTR * 2 == 33 * MiB, "ws map");
constexpr int CW_BAR = 4096;
constexpr int CW_CNT = 16384;

constexpr int RING_BYTES = 131072;
constexpr int MISC_OFF = RING_BYTES + 320;
constexpr int TBL_OFF = RING_BYTES + 1024;
constexpr int LDS_BYTES = 147456;
constexpr int NWAVES = 8;
#ifndef REPP_V
#define REPP_V (-1)
#endif
constexpr int REPP = REPP_V;

__device__ __forceinline__ unsigned cvt_pk_bf16(float lo, float hi) { unsigned r; asm volatile("v_cvt_pk_bf16_f32 %0, %1, %2" : "=v"(r) : "v"(lo), "v"(hi)); return r; }
__device__ __forceinline__ unsigned pk_fp8x4(float a, float b, float c, float d) {
    a = __builtin_amdgcn_fmed3f(a, -448.f, 448.f); b = __builtin_amdgcn_fmed3f(b, -448.f, 448.f); c = __builtin_amdgcn_fmed3f(c, -448.f, 448.f); d = __builtin_amdgcn_fmed3f(d, -448.f, 448.f);
    int w = 0; w = __builtin_amdgcn_cvt_pk_fp8_f32(a, b, w, false); w = __builtin_amdgcn_cvt_pk_fp8_f32(c, d, w, true); return (unsigned)w; }
constexpr float SA1 = 16.f, SW1 = 1024.f, SA2 = 32.f, SW2 = 512.f;
__device__ __forceinline__ float bf_lo(unsigned w) { return __uint_as_float(w << 16); }
__device__ __forceinline__ float bf_hi(unsigned w) { return __uint_as_float(w & 0xffff0000u); }
__device__ __forceinline__ float wave_sum(float v) {
#pragma unroll
    for (int o = 1; o < 64; o <<= 1) v += __shfl_xor(v, o);
    return v;
}
__device__ __forceinline__ float wave_max(float v) {
#pragma unroll
    for (int o = 1; o < 64; o <<= 1) v = fmaxf(v, __shfl_xor(v, o));
    return v;
}
#define LDS_WAIT() asm volatile("s_waitcnt lgkmcnt(0)" ::: "memory")
#define VM_WAIT() asm volatile("s_waitcnt vmcnt(0)" ::: "memory")

#define XB_TMO      128
#define XB_XCNT(j)  (256  + 64 * (j))
#define XB_XSUB(j)  (1280 + 64 * (j))
#define XB_XGEN(j)  (2304 + 64 * (j))
#define XB_TOP      3328
#define XB_TOPGEN   3392
#define XCD_BAR_WORDS 3456
#define XB_SPIN_CAP (1u << 21)
__device__ __forceinline__ unsigned xb_ld(unsigned* p)              { return __hip_atomic_load(p, __ATOMIC_RELAXED, __HIP_MEMORY_SCOPE_AGENT); }
__device__ __forceinline__ unsigned xb_add(unsigned* p, unsigned v) { return __hip_atomic_fetch_add(p, v, __ATOMIC_RELAXED, __HIP_MEMORY_SCOPE_AGENT); }
__device__ __forceinline__ unsigned xb_xcc_id() { return (unsigned)__builtin_amdgcn_s_getreg((3 << 11) | 20) & 0xFu; }
#define XB_SPIN(cond, bar) do { unsigned _sp = 0; while (cond) { __builtin_amdgcn_s_sleep(1); \
    if ((++_sp & 255u) == 0u) { if (xb_ld(&(bar)[XB_TMO])) break; if (_sp > XB_SPIN_CAP) { atomicAdd(&(bar)[XB_TMO], 1u); break; } } } } while (0)
struct XcdBarrier { unsigned* bar; unsigned x; volatile LAS unsigned* st; };
__device__ __forceinline__ XcdBarrier xcd_barrier_post(unsigned* bar, volatile LAS unsigned* st) {
    XcdBarrier b; b.bar = bar; b.x = xb_xcc_id(); b.st = st;
    if (threadIdx.x == 0) (void)xb_add(&bar[XB_XCNT(b.x)], 1u);
    return b;
}
__device__ __forceinline__ void xcd_barrier_complete(unsigned* bar, unsigned x, unsigned& nloc, unsigned& nx) {
    const unsigned G = gridDim.x * gridDim.y * gridDim.z;
    unsigned sum, cnt, mine, sp = 0u;
    for (;;) {
        sum = 0u; cnt = 0u; mine = 0u;
#pragma unroll
        for (unsigned j = 0; j < 16; ++j) { const unsigned c = xb_ld(&bar[XB_XCNT(j)]); sum += c; cnt += (c > 0u) ? 1u : 0u; mine = (j == x) ? c : mine; }
        if (sum == G) break;
        __builtin_amdgcn_s_sleep(1);
        if ((++sp & 255u) == 0u) { if (xb_ld(&bar[XB_TMO])) break; if (sp > XB_SPIN_CAP) { atomicAdd(&bar[XB_TMO], 1u); break; } }
    }
    nloc = mine > 0u ? mine : 1u; nx = cnt > 0u ? cnt : 1u;
}
__device__ __forceinline__ void xcd_barrier(const XcdBarrier& b) {
    asm volatile("s_waitcnt vmcnt(0)" ::: "memory");
    __syncthreads();
    if (threadIdx.x == 0) {
        unsigned* bar = b.bar;
        __builtin_amdgcn_s_waitcnt(0);
        unsigned nloc = b.st[0], nx = b.st[1];
        if (nloc == 0u) { xcd_barrier_complete(bar, b.x, nloc, nx); b.st[0] = nloc; b.st[1] = nx; }
        const unsigned old = xb_add(&bar[XB_XSUB(b.x)], 1u);
        const unsigned gen = old / nloc;
        if (old + 1u == (gen + 1u) * nloc) {
            __builtin_amdgcn_fence(__ATOMIC_RELEASE, "agent");
            asm volatile("s_waitcnt vmcnt(0)" ::: "memory");
            const unsigned og = xb_add(&bar[XB_TOP], 1u);
            const unsigned tg = og / nx;
            if (og + 1u == (tg + 1u) * nx) xb_add(&bar[XB_TOPGEN], 1u);
            else XB_SPIN(xb_ld(&bar[XB_TOPGEN]) == tg, bar);
            __builtin_amdgcn_fence(__ATOMIC_ACQUIRE, "agent");
            xb_add(&bar[XB_XGEN(b.x)], 1u);
            asm volatile("s_waitcnt vmcnt(0)" ::: "memory");
        } else {
            XB_SPIN(xb_ld(&bar[XB_XGEN(b.x)]) == gen, bar);
            __builtin_amdgcn_fence(__ATOMIC_ACQUIRE, "agent");
            asm volatile("s_waitcnt vmcnt(0)" ::: "memory");
        }
    }
    __syncthreads();
}

namespace g8 {
constexpr int BM = 256, BK = 64, HALF = 128, HTB = HALF * BK * 2, NXCD = 8, WGM = 8;
__device__ __forceinline__ int lds_byte(int r, int c) { const int st = (r >> 4) * 2 + (c >> 5), rr = r & 15, cc = c & 31, ob = rr * 64 + cc * 2; return st * 1024 + (ob ^ (((ob >> 9) & 1) << 5)); }
__device__ __forceinline__ void stage_rc(int b, int& R, int& C) { const int st = b / 1024, sb = b % 1024, swz = sb ^ (((sb >> 9) & 1) << 5); R = (st >> 1) * 16 + swz / 64; C = (st & 1) * 32 + (swz % 64) / 2; }
__device__ __forceinline__ int perm32(int rho) { const int n = rho >> 4, i = rho & 15; return 8 * (i >> 2) + 4 * n + (i & 3); }

struct Unit { int pm, pn, a0, a1, a2, a3; };
typedef int v8i_t __attribute__((ext_vector_type(8)));

struct StaticOrder {
    int nM, nN, nwg, G, c;
    __device__ void init(int M, int N, int G_, int c_) { nM = M / BM; nN = N / BM; nwg = nM * nN; G = G_; c = c_; }
    __device__ bool next(int i, Unit& u) const {
        const long L = (long)i * G + c; if (L >= nwg) return false;
        int wgid = (int)L; { const int q = nwg / NXCD, r = nwg % NXCD, xcd = wgid % NXCD, off = wgid / NXCD; wgid = (xcd < r ? xcd * (q + 1) : r * (q + 1) + (xcd - r) * q) + off; }
        const int nig = WGM * nN, gid = wgid / nig, fm = gid * WGM, gsz = (nM - fm) < WGM ? (nM - fm) : WGM;
        u.pm = fm + ((wgid % nig) % gsz); u.pn = (wgid % nig) / gsz; u.a0 = u.a1 = u.a2 = u.a3 = 0; return true;
    }
};

template <class P, class Sched, bool ALIGN_EPI>
__device__ __forceinline__ void gemm_phase(LAS unsigned char* lds, const P& p, const Sched& S) {
    const int tid = threadIdx.x, wid = __builtin_amdgcn_readfirstlane(tid >> 6), lane = tid & 63, wr = wid >> 2, wc = wid & 3, fr = lane & 15, fq = lane >> 4;
    const int nt = p.nt;
    unsigned voffB[2], voffA[2];
#pragma unroll
    for (int i = 0; i < 2; ++i) { int R, C; stage_rc(tid * 16 + i * 8192, R, C); const int Rb = P::PERM ? ((R & ~31) + perm32(R & 31)) : R;
        voffB[i] = (unsigned)Rb * p.ldb2 + (unsigned)C * 2u; voffA[i] = (unsigned)R * p.lda2 + (unsigned)C * 2u; }
    const size_t hstepB = (size_t)HALF * p.ldb2, hstepA = (size_t)HALF * p.lda2;
    const unsigned ldsw = (unsigned)wid * 1024u;
    const int aoff = lds_byte(wr * 64 + fr, fq * 8), boff = lds_byte(wc * 32 + fr, fq * 8);
#define PG8_SA(b, h) (((b) * 2 + (h)) * HTB)
#define PG8_SB(b, h) ((4 + (b) * 2 + (h)) * HTB)
#define PG8_STAGE(bufoff, gbase, v0, v1) do { \
        __builtin_amdgcn_global_load_lds((const unsigned*)((const char*)(gbase) + (v0)), (LAS unsigned*)(lds + (bufoff) + ldsw), 16, 0, 0); \
        __builtin_amdgcn_global_load_lds((const unsigned*)((const char*)(gbase) + (v1)), (LAS unsigned*)(lds + (bufoff) + ldsw + 8192), 16, 0, 0); } while (0)
#define PG8_LD32(p0_, p1_) ({ const u32x4 lo_ = *(const LAS u32x4*)(p0_), hi_ = *(const LAS u32x4*)(p1_); (v8i_t){(int)lo_.x, (int)lo_.y, (int)lo_.z, (int)lo_.w, (int)hi_.x, (int)hi_.y, (int)hi_.z, (int)hi_.w}; })
#define PG8_LDA(dst, b, h) do { _Pragma("unroll") for (int m = 0; m < 4; ++m) dst[m] = PG8_LD32(lds + PG8_SA(b, h) + aoff + m * 2048, lds + PG8_SA(b, h) + aoff + m * 2048 + 1024); } while (0)
#define PG8_LDB(dst, b, h) do { _Pragma("unroll") for (int n = 0; n < 2; ++n) dst[n] = PG8_LD32(lds + PG8_SB(b, h) + boff + n * 2048, lds + PG8_SB(b, h) + boff + n * 2048 + 1024); } while (0)
#define PG8_LOH(v) __builtin_bit_cast(bf16x8, __builtin_shufflevector(v, v, 0, 1, 2, 3))
#define PG8_HIH(v) __builtin_bit_cast(bf16x8, __builtin_shufflevector(v, v, 4, 5, 6, 7))
#define PG8_MMA(ai, bj, At, Bt) do { __builtin_amdgcn_s_setprio(1); _Pragma("unroll") for (int m = 0; m < 4; ++m) _Pragma("unroll") for (int n = 0; n < 2; ++n) { \
        if constexpr (P::FP8) { asm volatile("v_mfma_f32_16x16x128_f8f6f4 %0, %1, %2, %0" : "+v"(acc[ai][bj][m][n]) : "v"(Bt[n]), "v"(At[m])); } \
        else { acc[ai][bj][m][n] = __builtin_amdgcn_mfma_f32_16x16x32_bf16(PG8_LOH(Bt[n]), PG8_LOH(At[m]), acc[ai][bj][m][n], 0, 0, 0); \
               acc[ai][bj][m][n] = __builtin_amdgcn_mfma_f32_16x16x32_bf16(PG8_HIH(Bt[n]), PG8_HIH(At[m]), acc[ai][bj][m][n], 0, 0, 0); } } \
        __builtin_amdgcn_s_setprio(0); } while (0)
#define PG8_WAIT_V(n) asm volatile("s_waitcnt vmcnt(" #n ")" ::: "memory")
#define PG8_WAIT_L(n) asm volatile("s_waitcnt lgkmcnt(" #n ")" ::: "memory")
#define PG8_BAR __builtin_amdgcn_s_barrier()
#define PG8_SCHED __builtin_amdgcn_sched_barrier(0)
    Unit cur, nxt; int ui = 0;
    if (!S.next(0, cur)) return;
    f32x4 acc[2][2][4][2];
#pragma unroll
    for (int a = 0; a < 2; ++a)
#pragma unroll
        for (int b = 0; b < 2; ++b)
#pragma unroll
            for (int m = 0; m < 4; ++m)
#pragma unroll
                for (int n = 0; n < 2; ++n) acc[a][b][m][n] = (f32x4){0.f, 0.f, 0.f, 0.f};
    v8i_t At[4], B0[2], B1[2];
    unsigned oc[2][2];
    constexpr int ONOFF = RING_BYTES + 4096;
    const char* cA = p.Abase; const char* nA = p.Abase;
    if constexpr (P::GATHER) { p.a_offs(cur, oc); } else { cA = p.Abase + (size_t)cur.pm * 2 * hstepA; }
#define PG8_STA(bufoff, base_, h_, O_) do { if constexpr (P::GATHER) { PG8_STAGE(bufoff, base_, O_[h_][0], O_[h_][1]); } else { PG8_STAGE(bufoff, (base_) + (h_) * hstepA, voffA[0], voffA[1]); } } while (0)
    {
        const char* b0 = p.b_tile(cur, 0); const char* b1 = p.b_tile(cur, 1);
        PG8_STAGE(PG8_SB(0, 0), b0, voffB[0], voffB[1]); PG8_STAGE(PG8_SB(0, 1), b0 + hstepB, voffB[0], voffB[1]);
        PG8_STA(PG8_SA(0, 0), cA, 0, oc); PG8_STA(PG8_SA(0, 1), cA, 1, oc);
        if (wr == 1) PG8_BAR;
        PG8_WAIT_V(2); PG8_BAR;
        PG8_STAGE(PG8_SB(1, 0), b1, voffB[0], voffB[1]); PG8_STA(PG8_SA(1, 0), cA + 128, 0, oc); PG8_STAGE(PG8_SB(1, 1), b1 + hstepB, voffB[0], voffB[1]);
        PG8_WAIT_V(6); PG8_BAR;
    }
    for (;;) {
        const bool has_next = S.next(ui + 1, nxt);
        if (!has_next) nxt = cur;
        if constexpr (P::GATHER) { unsigned on[2][2]; p.a_offs(nxt, on); *(LAS u32x4*)(lds + ONOFF + tid * 16) = (u32x4){on[0][0], on[0][1], on[1][0], on[1][1]}; } else { nA = p.Abase + (size_t)nxt.pm * 2 * hstepA; }
#pragma unroll 1
        for (int t = 0; t < nt; t += 2) {
            const bool last = (t == nt - 2);
            if constexpr (P::HAS_MID) { if (t == (nt >> 1)) p.mid(acc, cur, wr, wc, fr, fq); }
            const char* a1 = cA + (size_t)(t + 1) * 128;
            const char* a2 = last ? nA : cA + (size_t)(t + 2) * 128; const char* a3 = a2 + 128;
            unsigned o2[2][2];
            if constexpr (P::GATHER) { const u32x4 onv = *(const LAS u32x4*)(lds + ONOFF + tid * 16);
                o2[0][0] = last ? onv.x : oc[0][0]; o2[0][1] = last ? onv.y : oc[0][1]; o2[1][0] = last ? onv.z : oc[1][0]; o2[1][1] = last ? onv.w : oc[1][1]; }
            const char* b2 = last ? p.b_tile(nxt, 0) : p.b_tile(cur, t + 2); const char* b3 = last ? p.b_tile(nxt, 1) : p.b_tile(cur, t + 3);
            PG8_LDB(B0, 0, 0); PG8_LDB(B1, 0, 1); PG8_SCHED; PG8_LDA(At, 0, 0); PG8_STA(PG8_SA(1, 1), a1, 1, oc);
            PG8_WAIT_V(8); PG8_WAIT_L(0); PG8_BAR; PG8_MMA(0, 0, At, B0); PG8_MMA(0, 1, At, B1); PG8_BAR; PG8_SCHED;
            PG8_LDA(At, 0, 1); PG8_STAGE(PG8_SB(0, 0), b2, voffB[0], voffB[1]); PG8_STAGE(PG8_SB(0, 1), b2 + hstepB, voffB[0], voffB[1]); PG8_STA(PG8_SA(0, 0), a2, 0, o2);
            PG8_WAIT_V(8); PG8_WAIT_L(0); PG8_BAR; PG8_MMA(1, 0, At, B0); PG8_MMA(1, 1, At, B1); PG8_BAR; PG8_SCHED;
            PG8_LDB(B0, 1, 0); PG8_LDB(B1, 1, 1); PG8_SCHED; PG8_LDA(At, 1, 0); PG8_STA(PG8_SA(0, 1), a2, 1, o2);
            PG8_WAIT_V(8); PG8_WAIT_L(0); PG8_BAR; PG8_MMA(0, 0, At, B0); PG8_MMA(0, 1, At, B1); PG8_BAR; PG8_SCHED;
            PG8_LDA(At, 1, 1); PG8_STAGE(PG8_SB(1, 0), b3, voffB[0], voffB[1]); PG8_STAGE(PG8_SB(1, 1), b3 + hstepB, voffB[0], voffB[1]); PG8_STA(PG8_SA(1, 0), a3, 0, o2);
            PG8_WAIT_V(8); PG8_WAIT_L(0); PG8_BAR; PG8_MMA(1, 0, At, B0); PG8_MMA(1, 1, At, B1); PG8_BAR; PG8_SCHED;
        }
        if constexpr (ALIGN_EPI) { if (wr == 0) PG8_BAR; }
        if constexpr (P::FP8) { asm volatile("s_nop 15\n\ts_nop 15" ::: "memory"); }
        p.epi(acc, cur, wr, wc, fr, fq);
        if (!has_next) break;
#pragma unroll
        for (int a = 0; a < 2; ++a)
#pragma unroll
            for (int b = 0; b < 2; ++b)
#pragma unroll
                for (int m = 0; m < 4; ++m)
#pragma unroll
                    for (int n = 0; n < 2; ++n) acc[a][b][m][n] = (f32x4){0.f, 0.f, 0.f, 0.f};
        cur = nxt; cA = nA; ++ui;
        if constexpr (P::GATHER) { const u32x4 onv = *(const LAS u32x4*)(lds + ONOFF + tid * 16); oc[0][0] = onv.x; oc[0][1] = onv.y; oc[1][0] = onv.z; oc[1][1] = onv.w; }
        if constexpr (ALIGN_EPI) { if (wr == 1) PG8_BAR; }
    }
    PG8_WAIT_V(0);
    if constexpr (!ALIGN_EPI) { if (wr == 0) PG8_BAR; }
    PG8_BAR;
#undef PG8_SA
#undef PG8_SB
#undef PG8_STAGE
#undef PG8_STA
#undef PG8_LDA
#undef PG8_LDB
#undef PG8_LD32
#undef PG8_LOH
#undef PG8_HIH
#undef PG8_MMA
#undef PG8_WAIT_V
#undef PG8_WAIT_L
#undef PG8_BAR
#undef PG8_SCHED
}
}

struct Args { const float* in[17]; float* out; unsigned char* ws; int ph_lo, ph_hi; };
struct Frame {
    const Args* A;
    LAS unsigned char* lds;
    volatile LAS unsigned* MISC;
    int wave, vcu, G;
};

__device__ __forceinline__ void p0_transpose_item(const float* W, int ldw, int K, bf16* WT, int k0, int scol0, int drow0, const float* kscale, LAS float* scr, int lane) {
    float vv[32];
#pragma unroll
    for (int i = 0; i < 32; ++i) { const int kk = 2 * i + (lane >> 5); vv[i] = W[(size_t)(k0 + kk) * ldw + scol0 + (lane & 31)]; }
#pragma unroll
    for (int i = 0; i < 32; ++i) { const int kk = 2 * i + (lane >> 5); float v = vv[i]; if (kscale) v *= kscale[k0 + kk]; scr[kk * 33 + (lane & 31)] = v; }
    LDS_WAIT(); asm volatile("" ::: "memory");
    const int c = lane & 7;
#pragma unroll
    for (int j = 0; j < 4; ++j) { const int n = (lane >> 3) + 8 * j; const LAS float* s = scr + (8 * c) * 33 + n;
        u32x4 o; o.x = cvt_pk_bf16(s[0 * 33], s[1 * 33]); o.y = cvt_pk_bf16(s[2 * 33], s[3 * 33]); o.z = cvt_pk_bf16(s[4 * 33], s[5 * 33]); o.w = cvt_pk_bf16(s[6 * 33], s[7 * 33]);
        *(u32x4*)(WT + (size_t)(drow0 + n) * K + k0 + 8 * c) = o; }
    LDS_WAIT(); asm volatile("" ::: "memory");
}

__device__ __forceinline__ void p0_transpose_item8(const float* W, int ldw, int K, unsigned char* WT, int k0, int scol0, int drow0, float sc, LAS float* scr, int lane) {
    float vv[32];
#pragma unroll
    for (int i = 0; i < 32; ++i) { const int kk = 2 * i + (lane >> 5); vv[i] = W[(size_t)(k0 + kk) * ldw + scol0 + (lane & 31)]; }
#pragma unroll
    for (int i = 0; i < 32; ++i) { const int kk = 2 * i + (lane >> 5); scr[kk * 33 + (lane & 31)] = vv[i] * sc; }
    LDS_WAIT(); asm volatile("" ::: "memory");
    const int c = lane & 7;
#pragma unroll
    for (int j = 0; j < 4; ++j) { const int n = (lane >> 3) + 8 * j; const LAS float* s = scr + (8 * c) * 33 + n;
        u32x2 o; o.x = pk_fp8x4(s[0 * 33], s[1 * 33], s[2 * 33], s[3 * 33]); o.y = pk_fp8x4(s[4 * 33], s[5 * 33], s[6 * 33], s[7 * 33]);
        *(u32x2*)(WT + (size_t)(drow0 + n) * K + k0 + 8 * c) = o; }
    LDS_WAIT(); asm volatile("" ::: "memory");
}
__device__ __forceinline__ float log_sigmoid(float x) { return fminf(x, 0.f) - log1pf(__expf(-fabsf(x))); }

__device__ __forceinline__ void p0_prologue(Frame& F) {
    const int gw = F.vcu * NWAVES + F.wave, NGW = F.G * NWAVES, lane = ((int)(threadIdx.x & 63));
    const int gt = F.vcu * 512 + ((int)threadIdx.x), NGT = F.G * 512;
    {
        LAS float* scr = (LAS float*)(F.lds + F.wave * 16384);
        const float* w_in = F.A->in[3]; const float* w_out = F.A->in[7]; const float* w_gate = F.A->in[13]; const float* w_up = F.A->in[14]; const float* w_down = F.A->in[15];
        bf16* WINT = (bf16*)(F.A->ws + WS_WINT); bf16* WOUTT = (bf16*)(F.A->ws + WS_WOUTT); unsigned char* WGU = (unsigned char*)(F.A->ws + WS_WGU); unsigned char* WD = (unsigned char*)(F.A->ws + WS_WD);
        constexpr int I_IN = 32 * 224, I_OUT = 32 * 64, I_G = 16 * 32 * 32, I_D = 16 * 16 * 64;
        constexpr int NITEMS = I_IN + I_OUT + 2 * I_G + I_D;
        for (int it = gw; it < NITEMS; it += NGW) {
            int r = it;
            if (r < I_IN) { const int kb = r / 224, nb = r % 224, n0 = nb * 32; p0_transpose_item(w_in, INC, DM, WINT, kb * 64, n0 + (n0 >= 3072 ? 8 : 0), n0, nullptr, scr, lane); continue; } r -= I_IN;
            if (r < I_OUT) { const int kb = r / 64, nb = r % 64; const float* ks = (kb < 16) ? F.A->in[5] : (F.A->in[6] - 1024); p0_transpose_item(w_out, DM, DM, WOUTT, kb * 64, nb * 32, nb * 32, ks, scr, lane); continue; } r -= I_OUT;
            if (r < 2 * I_G) { const int up = r >= I_G; if (up) r -= I_G; const int e = r / 1024, q = r % 1024, kb = q / 32, nb = q % 32, n0 = nb * 32;
                p0_transpose_item8((up ? w_up : w_gate) + (size_t)e * DM * DE, DE, DM, WGU + (size_t)e * 2048 * DM, kb * 64, n0, (n0 >> 7) * 256 + up * 128 + (n0 & 127), SW1, scr, lane); continue; } r -= 2 * I_G;
            { const int e = r / 1024, q = r % 1024, kb = q / 64, nb = q % 64; p0_transpose_item8(w_down + (size_t)e * DE * DM, DM, DE, WD + (size_t)e * DM * DE, kb * 64, nb * 32, nb * 32, SW2, scr, lane); }
        }
    }
    {
        float* WRT = (float*)(F.A->ws + WS_WRT); const float* g2 = F.A->in[8]; const float* wrg = F.A->in[9]; const float* wre = F.A->in[11];
        for (int i = gt; i < 32 * DM; i += NGT) { const int j = i / DM, k = i % DM; WRT[i] = (j < 20) ? g2[k] * (j < 4 ? wrg[k * 4 + j] : wre[k * 16 + (j - 4)]) : 0.f; }
        f32x2* ROPE = (f32x2*)(F.A->ws + WS_ROPE);
        for (int i = gt; i < 4112 * 64; i += NGT) { const int pos = i >> 6, k = i & 63;
            const float lin = (float)k * (1.0f / 63.0f); const float ang = 1.0f / exp2f(lin * 13.287712379549449f);
            const float ph = (float)pos * ang; const double rev = (double)ph * 0.15915494309189535; const float fr = (float)(rev - floor(rev));
            ROPE[i] = (f32x2){__builtin_amdgcn_cosf(fr), __builtin_amdgcn_sinf(fr)}; }
        bf16* U = (bf16*)(F.A->ws + WS_U);
        for (int i = gt; i < 4 * NB * PADN * 128; i += NGT) { const int c8 = i & 127, row = (i >> 7) % PADN, bb = ((i >> 7) / PADN) % NB, cl = (i >> 7) / (PADN * NB);
            const int cls = (cl == 0) ? 1 : (cl == 1) ? 2 : (cl == 2) ? 4 : 5;
            *(u32x4*)(U + cls * USTR + ((size_t)(bb * PP + row)) * 1024 + c8 * 8) = (u32x4){0u, 0u, 0u, 0u}; }
        float* LOGF = (float*)(F.A->ws + WS_LOGF);
        for (int i = gt; i < 32 * PADN; i += NGT) LOGF[(i / PADN) * PP + (i % PADN)] = 0.f;
    }
    __syncthreads();
    {
        LAS float* WF = (LAS float*)F.lds; const float* w_in = F.A->in[3]; const float* g1 = F.A->in[2];
        for (int i = ((int)threadIdx.x); i < 8 * DM; i += 512) { const int k = i >> 3, h = i & 7; WF[h * DM + k] = g1[k] * w_in[(size_t)k * INC + 3072 + h]; }
        __syncthreads();
        f32x4 gv[8];
#pragma unroll
        for (int j = 0; j < 8; ++j) gv[j] = *((const f32x4*)g1 + lane + 64 * j);
        bf16* HN = (bf16*)(F.A->ws + WS_HN); bf16* HNMETA = (bf16*)(F.A->ws + WS_HNMETA); float* LOGF = (float*)(F.A->ws + WS_LOGF); const float* bfv = F.A->in[4];
        for (int row = gw; row < MTOK + NMETA; row += NGW) {
            const bool meta = row >= MTOK; const int mj = row - MTOK;
            const float* xr = meta ? (F.A->in[1] + (size_t)mj * DM) : (F.A->in[0] + (size_t)row * DM);
            f32x4 v[8]; float ss = 0.f;
#pragma unroll
            for (int j = 0; j < 8; ++j) { v[j] = *((const f32x4*)xr + lane + 64 * j); ss += (v[j].x * v[j].x + v[j].y * v[j].y) + (v[j].z * v[j].z + v[j].w * v[j].w); }
            const float rs = 1.0f / sqrtf(wave_sum(ss) * (1.0f / DM) + EPS);
            float fl[8];
#pragma unroll
            for (int h = 0; h < 8; ++h) { float s = 0.f;
#pragma unroll
                for (int j = 0; j < 8; ++j) { const f32x4 w = *((const LAS f32x4*)(WF + h * DM) + lane + 64 * j); s += (v[j].x * w.x + v[j].y * w.y) + (v[j].z * w.z + v[j].w * w.w); }
                fl[h] = wave_sum(s) * rs; }
            bf16* orow = meta ? (HNMETA + (size_t)mj * DM) : (HN + (size_t)row * DM);
#pragma unroll
            for (int j = 0; j < 8; ++j) { const f32x4 y = v[j] * rs * gv[j]; u32x2 w; w.x = cvt_pk_bf16(y.x, y.y); w.y = cvt_pk_bf16(y.z, y.w); *((u32x2*)orow + lane + 64 * j) = w; }
            if (lane < 8) { float f = fl[0];
#pragma unroll
                for (int h = 1; h < 8; ++h) f = (lane == h) ? fl[h] : f;
                const float lf = log_sigmoid(f + bfv[lane]);
                if (meta) { for (int bb = 0; bb < NB; ++bb) LOGF[(bb * NH + lane) * PP + PADN + mj] = lf; }
                else { const int bb = row >> 12, t = row & 4095; LOGF[(bb * NH + lane) * PP + 128 + t] = lf; } }
        }
    }
}

__device__ __forceinline__ void p1_cumsum(Frame& F) {
    const int gw = F.vcu * NWAVES + F.wave, NGW = F.G * NWAVES, lane = ((int)(threadIdx.x & 63));
    const float* LOGF = (const float*)(F.A->ws + WS_LOGF); float* CUM = (float*)(F.A->ws + WS_CUM);
    for (int s = gw; s < NB * NH; s += NGW) {
        const float* src = LOGF + (size_t)s * PP + lane * 66; float* dst = CUM + (size_t)s * PP + lane * 66;
        float loc = 0.f; for (int i = 0; i < 66; ++i) loc += src[i];
        float inc = loc;
#pragma unroll
        for (int o = 1; o < 64; o <<= 1) { const float t = __shfl_up(inc, o); if (lane >= o) inc += t; }
        float run = inc - loc;
        for (int i = 0; i < 66; ++i) { run += src[i]; dst[i] = run; }
    }
}
__device__ __forceinline__ void p1_meta_kv(Frame& F) {
    const int lane = ((int)(threadIdx.x & 63)), w = F.wave;
    const bf16* HNMETA = (const bf16*)(F.A->ws + WS_HNMETA); const bf16* WINT = (const bf16*)(F.A->ws + WS_WINT); bf16* U = (bf16*)(F.A->ws + WS_U);
    const f32x2* ROPE = (const f32x2*)(F.A->ws + WS_ROPE);
    LAS float* red = (LAS float*)F.lds;
    for (int blk = blockIdx.x; blk < 256; blk += F.G) {
        const int kv0 = blk * 16, q = kv0 >> 10, col0 = kv0 & 1023;
        const int cls = (q == 0) ? 1 : (q == 1) ? 2 : (q == 2) ? 4 : 5;
        const int nrow0 = ((q == 0) ? 1024 : (q == 1) ? 2048 : (q == 2) ? 4096 : 5120) + col0;
        f32x4 acc = (f32x4){0.f, 0.f, 0.f, 0.f};
#pragma unroll
        for (int s = 0; s < 8; ++s) { const int k0 = w * 256 + s * 32 + 8 * (lane >> 4);
            const bf16x8 a = *(const bf16x8*)(HNMETA + (size_t)(lane & 15) * DM + k0);
            const bf16x8 b = *(const bf16x8*)(WINT + (size_t)(nrow0 + (lane & 15)) * DM + k0);
            acc = __builtin_amdgcn_mfma_f32_16x16x32_bf16(a, b, acc, 0, 0, 0); }
#pragma unroll
        for (int r = 0; r < 4; ++r) red[w * 256 + ((lane >> 4) * 4 + r) * 16 + (lane & 15)] = acc[r];
        __syncthreads();
        if (((int)threadIdx.x) < 256) { const int row = ((int)threadIdx.x) >> 4, col = ((int)threadIdx.x) & 15;
            float v = 0.f, vp = 0.f;
#pragma unroll
            for (int ww = 0; ww < 8; ++ww) { v += red[ww * 256 + row * 16 + col]; vp += red[ww * 256 + row * 16 + (col ^ 1)]; }
            float o = v;
            if (q == 2) { const int d = (col0 + col) & 127; const f32x2 cs = ROPE[row * 64 + (d >> 1)];
                const int hh = (col0 + col) >> 7; const float lg2h = log2f(1.0f - exp2f(-5.0f - (float)hh));
                o = ((col & 1) ? (v * cs.x + vp * cs.y) : (v * cs.x - vp * cs.y)) * SCALE * exp2f(-(float)(PADN + row + 1) * lg2h); }
            const unsigned short ob = (unsigned short)(cvt_pk_bf16(o, 0.f) & 0xffffu);
            for (int bb = 0; bb < NB; ++bb) U[cls * USTR + ((size_t)(bb * PP + PADN + row)) * 1024 + col0 + col] = ob; }
        __syncthreads();
    }
}

struct PInProj {
    static constexpr bool PERM = true, HAS_MID = false, FP8 = false, GATHER = false;
    int nt; const char* Abase; unsigned lda2, ldb2; const char* Bt; bf16* U; const f32x2* ROPE;
    __device__ __forceinline__ void a_offs(const g8::Unit&, unsigned (&)[2][2]) const {}
    __device__ __forceinline__ const char* b_tile(const g8::Unit& u, int t) const { return Bt + (size_t)u.pn * 256 * ldb2 + (size_t)t * 128; }
    __device__ __forceinline__ void mid(f32x4 (&)[2][2][4][2], const g8::Unit&, int, int, int, int) const {}
    __device__ __forceinline__ void epi(const f32x4 (&acc)[2][2][4][2], const g8::Unit& u, int wr, int wc, int fr, int fq) const {
        const int cls = u.pn >> 2;
        bf16* base = U + (size_t)cls * USTR;
        const int ccol0 = (u.pn & 3) * 256 + wc * 32 + 8 * fq;
        const int bb = u.pm >> 4;
#pragma unroll
        for (int ai = 0; ai < 2; ++ai)
#pragma unroll
            for (int m = 0; m < 4; ++m) {
                const int t = ((u.pm & 15) << 8) + ai * 128 + wr * 64 + m * 16 + fr;
                bf16* rowp = base + ((size_t)(bb * PP + 128 + t)) * 1024 + ccol0;
                f32x4 c0 = (f32x4){1.f, 0.f, 1.f, 0.f}, c1 = c0;
                if (cls == 3 || cls == 4) { const f32x4* rp = (const f32x4*)(ROPE + (size_t)(t + 16) * 64 + wc * 16 + fq * 4); c0 = rp[0]; c1 = rp[1]; }
#pragma unroll
                for (int bj = 0; bj < 2; ++bj) {
                    f32x4 v0 = acc[ai][bj][m][0], v1 = acc[ai][bj][m][1];
                    if (cls == 3 || cls == 4) {
                        f32x4 r0, r1;
                        r0.x = v0.x * c0.x - v0.y * c0.y; r0.y = v0.y * c0.x + v0.x * c0.y; r0.z = v0.z * c0.z - v0.w * c0.w; r0.w = v0.w * c0.z + v0.z * c0.w;
                        r1.x = v1.x * c1.x - v1.y * c1.y; r1.y = v1.y * c1.x + v1.x * c1.y; r1.z = v1.z * c1.z - v1.w * c1.w; r1.w = v1.w * c1.z + v1.z * c1.w;
                        const int hh = (u.pn & 3) * 2 + bj; const float lg2h = log2f(1.0f - exp2f(-5.0f - (float)hh)); const float ip1 = (float)((t & 127) + 1);
                        const float sc = (cls == 4) ? SCALE * exp2f(-ip1 * lg2h) : exp2f(ip1 * lg2h); v0 = r0 * sc; v1 = r1 * sc;
                    } else if (cls == 6) {
#pragma unroll
                        for (int e = 0; e < 4; ++e) { v0[e] = v0[e] / (1.f + __expf(-v0[e])); v1[e] = v1[e] / (1.f + __expf(-v1[e])); }
                    }
                    u32x4 w; w.x = cvt_pk_bf16(v0[0], v0[1]); w.y = cvt_pk_bf16(v0[2], v0[3]); w.z = cvt_pk_bf16(v1[0], v1[1]); w.w = cvt_pk_bf16(v1[2], v1[3]);
                    *(u32x4*)(rowp + bj * 128) = w;
                }
            }
    }
};

template <bool RET>
__device__ __forceinline__ void attn_simple(Frame& F) {
    const int gw = F.vcu * NWAVES + F.wave, NGW = F.G * NWAVES, lane = ((int)(threadIdx.x & 63));
    LAS float* wl = (LAS float*)(F.lds + F.wave * 1024);
    const bf16* U = (const bf16*)(F.A->ws + WS_U); const float* CUM = (const float*)(F.A->ws + WS_CUM);
    bf16* OA = (bf16*)(F.A->ws + WS_HN); float* SSQ = (float*)(F.A->ws + WS_SSQ);
    for (int row = gw; row < NB * NH * SEQ; row += NGW) {
        const int t = row & 4095, bh = row >> 12, b = bh >> 3, h = bh & 7, p = 128 + t, m = b * SEQ + t;
        const bf16* Qb = U + (RET ? 3 : 0) * USTR + ((size_t)(b * PP + p)) * 1024 + h * 128;
        const bf16* Kb = U + (RET ? 4 : 1) * USTR + ((size_t)b * PP) * 1024 + h * 128;
        const bf16* Vb = U + (RET ? 5 : 2) * USTR + ((size_t)b * PP) * 1024 + h * 128;
        { const unsigned qw = *(const unsigned*)(Qb + 2 * lane); wl[2 * lane] = bf_lo(qw); wl[2 * lane + 1] = bf_hi(qw); }
        LDS_WAIT(); asm volatile("" ::: "memory");
        float m_run = -1e30f, l_run = 0.f, o0 = 0.f, o1 = 0.f;
        const float ct = RET ? 0.f : CUM[(size_t)bh * PP + p];
        const float lg2 = RET ? log2f(1.0f - exp2f(-5.0f - (float)h)) : 0.f;
        for (int s0 = 64; s0 <= p; s0 += 64) {
            const int s = s0 + lane;
            const bf16* kr = Kb + (size_t)s * 1024;
            float sc = 0.f;
#pragma unroll
            for (int c = 0; c < 16; ++c) { const u32x4 kv = *(const u32x4*)(kr + 8 * c); const f32x4 qa = *(const LAS f32x4*)(wl + 8 * c), qb = *(const LAS f32x4*)(wl + 8 * c + 4);
                sc += bf_lo(kv.x) * qa.x + bf_hi(kv.x) * qa.y + bf_lo(kv.y) * qa.z + bf_hi(kv.y) * qa.w + bf_lo(kv.z) * qb.x + bf_hi(kv.z) * qb.y + bf_lo(kv.w) * qb.z + bf_hi(kv.w) * qb.w; }
            const bool valid = (s <= p) && (s >= PADN);
            float pw;
            if constexpr (RET) { pw = valid ? sc * exp2f((float)(((p >> 7) - (s >> 7)) * 128) * lg2) : 0.f; }
            else {
                const float lg = valid ? (sc * SCALE + (ct - CUM[(size_t)bh * PP + s])) : -__builtin_inff();
                const float mn = fmaxf(m_run, wave_max(lg)); const float alpha = __expf(m_run - mn);
                pw = valid ? __expf(lg - mn) : 0.f;
                l_run = l_run * alpha + wave_sum(pw); o0 *= alpha; o1 *= alpha; m_run = mn;
            }
            asm volatile("" ::: "memory");
            wl[128 + lane] = pw;
            LDS_WAIT(); asm volatile("" ::: "memory");
#pragma unroll 8
            for (int k = 0; k < 64; ++k) { const float pk = wl[128 + k]; const unsigned vw = *(const unsigned*)(Vb + (size_t)(s0 + k) * 1024 + 2 * lane); o0 += pk * bf_lo(vw); o1 += pk * bf_hi(vw); }
            LDS_WAIT(); asm volatile("" ::: "memory");
        }
        if constexpr (RET) {
            const float mu = wave_sum(o0 + o1) * (1.0f / HD); const float d0 = o0 - mu, d1 = o1 - mu;
            const float var = wave_sum(d0 * d0 + d1 * d1) * (1.0f / HD); const float r = 1.0f / sqrtf(var + EPS);
            const unsigned gw2 = *(const unsigned*)(U + 6 * USTR + ((size_t)(b * PP + p)) * 1024 + h * 128 + 2 * lane);
            *(unsigned*)(OA + (size_t)m * DM + 1024 + h * 128 + 2 * lane) = cvt_pk_bf16(d0 * r * bf_lo(gw2), d1 * r * bf_hi(gw2));
        } else {
            const float il = 1.0f / l_run; o0 *= il; o1 *= il;
            *(unsigned*)(OA + (size_t)m * DM + h * 128 + 2 * lane) = cvt_pk_bf16(o0, o1);
            const float sq = wave_sum(o0 * o0 + o1 * o1); if (lane == 0) SSQ[(size_t)m * 8 + h] = sq;
        }
        asm volatile("" ::: "memory");
    }
}


namespace fox {
constexpr int NW = 8, QBLK = 32, KVBLK = 64, QB = 256, D = 128, LDQ = 1024, LDO = 2048;
constexpr int SHM_V = KVBLK * D * 2, SHM_K = KVBLK * D * 2;
constexpr int OFF_WS = 2 * SHM_V + 2 * SHM_K, OFF_CUM = OFF_WS + 2048, LDS_NEED = OFF_CUM + PP * 4;
static_assert(LDS_NEED <= RING_BYTES, "fox lds");
constexpr float THR = 8.f;
constexpr float INVS = 11.313708498984761f;
typedef float f32x16 __attribute__((ext_vector_type(16)));
typedef short s16x4 __attribute__((ext_vector_type(4)));
#define KSWZ(row, colB) ((row) * 256 + ((colB) ^ (((row) & 7) << 4)))
#define SBAR() __builtin_amdgcn_sched_barrier(0)
__device__ __forceinline__ int v_st(int k, int c) { const int kk = (k & ~0xC) | ((k & 4) << 1) | ((k & 8) >> 1); return ((kk >> 3) * 4 + (c >> 5)) * 512 + ((kk & 7) * 32 + (c & 31)) * 2; }
__device__ __forceinline__ int v_rd_base(int lane) { return ((lane & 3) << 3) | (((lane >> 2) & 3) << 6) | (((lane >> 4) & 1) << 5) | (((lane >> 5) & 1) << 8); }
constexpr int v_rd_off(int d0, int ks, int half) { return d0 * 512 + ks * 4096 + half * 2048; }
__device__ __forceinline__ int crow(int r, int hi) { return (r & 3) + 8 * (r >> 2) + 4 * hi; }
__device__ __forceinline__ unsigned cvtpk(float lo, float hi) { unsigned r; asm volatile("v_cvt_pk_bf16_f32 %0, %1, %2" : "=v"(r) : "v"(lo), "v"(hi)); return r; }
__device__ __forceinline__ bf16x8 load8(const bf16* p) { return *reinterpret_cast<const bf16x8*>(p); }
__device__ __forceinline__ void mask_causal(f32x16& p0, f32x16& p1, int dq) {
    const float NEG = -__builtin_inff();
#pragma unroll
    for (int r = 0; r < 16; ++r) { const int c = (r & 3) + 8 * (r >> 2); if (dq - c < 0) p0[r] = NEG; if (dq - c - 32 < 0) p1[r] = NEG; }
}
__device__ __forceinline__ void mask_pad(f32x16& p0, f32x16& p1, int hi) {
    const float NEG = -__builtin_inff();
#pragma unroll
    for (int r = 0; r < 16; ++r) { const int c = (r & 3) + 8 * (r >> 2); p0[r] = NEG; if (c + 4 * hi < 16) p1[r] = NEG; }
}
__device__ __forceinline__ void partialSM(f32x16& p0, f32x16& p1, float& m_reg, float& mn, float& alpha) {
    float pmax = p0[0]; for (int r = 1; r < 16; ++r) pmax = fmaxf(pmax, p0[r]); for (int r = 0; r < 16; ++r) pmax = fmaxf(pmax, p1[r]);
    { auto rr = __builtin_amdgcn_permlane32_swap(__float_as_uint(pmax), __float_as_uint(pmax), false, false);
      pmax = fmaxf(__uint_as_float(rr[0]), __uint_as_float(rr[1])); }
    constexpr float C2 = 1.4426950408889634f * SCALE;
    if (__builtin_expect(__all((pmax - m_reg) * SCALE <= THR), 1)) { mn = m_reg; alpha = 1.f; }
    else { mn = fmaxf(m_reg, pmax); alpha = __builtin_amdgcn_exp2f((m_reg - mn) * C2); m_reg = mn; }
    const float mnL = -mn * C2;
    for (int r = 0; r < 16; ++r) p0[r] = fmaf(p0[r], C2, mnL); for (int r = 0; r < 16; ++r) p1[r] = fmaf(p1[r], C2, mnL);
    for (int r = 0; r < 16; ++r) p0[r] = __builtin_amdgcn_exp2f(p0[r]);
}
__device__ __forceinline__ void finishSM(f32x16& p0, f32x16& p1, float alpha, float& l_reg, bf16x8& pa0, bf16x8& pa1, bf16x8& pa2, bf16x8& pa3) {
    for (int r = 0; r < 16; ++r) p1[r] = __builtin_amdgcn_exp2f(p1[r]);
    float ps = 0; for (int r = 0; r < 16; ++r) ps += p0[r]; for (int r = 0; r < 16; ++r) ps += p1[r];
    { auto rr = __builtin_amdgcn_permlane32_swap(__float_as_uint(ps), __float_as_uint(ps), false, false);
      ps = __uint_as_float(rr[0]) + __uint_as_float(rr[1]); }
    l_reg = l_reg * alpha + ps;
#define PK4(P, B_, OUT) do { unsigned a0 = cvtpk(P[B_+0], P[B_+1]), a1 = cvtpk(P[B_+2], P[B_+3]);                          \
        unsigned b0 = cvtpk(P[B_+4], P[B_+5]), b1 = cvtpk(P[B_+6], P[B_+7]);                                             \
        auto r0 = __builtin_amdgcn_permlane32_swap(a0, b0, false, false); auto r1 = __builtin_amdgcn_permlane32_swap(a1, b1, false, false); \
        u32x4 w = {r0[0], r1[0], r0[1], r1[1]}; OUT = *reinterpret_cast<bf16x8*>(&w); } while (0)
    PK4(p0, 0, pa0); PK4(p0, 8, pa1); PK4(p1, 0, pa2); PK4(p1, 8, pa3);
#undef PK4
}
template <int KB>
__device__ __forceinline__ void qkt(f32x16& p0, f32x16& p1, const LAS char* K_lds, int r32, int hi, const bf16x8* qr, const LAS float* cs) {
#pragma unroll
    for (int g = 0; g < 4; ++g) { const f32x4 a = *(const LAS f32x4*)(cs + 8 * g), b = *(const LAS f32x4*)(cs + 32 + 8 * g);
        p0[4 * g] = a[0]; p0[4 * g + 1] = a[1]; p0[4 * g + 2] = a[2]; p0[4 * g + 3] = a[3]; p1[4 * g] = b[0]; p1[4 * g + 1] = b[1]; p1[4 * g + 2] = b[2]; p1[4 * g + 3] = b[3]; }
    const LAS char* kb[4];
#pragma unroll
    for (int dd = 0; dd < 4; ++dd) kb[dd] = K_lds + KB * SHM_K + KSWZ(r32, (dd * 16 + hi * 8) * 2);
#pragma unroll
    for (int d0 = 0; d0 < 8; ++d0) { const LAS char* a = kb[d0 & 3] + (d0 >> 2) * 128;
        bf16x8 b0 = *reinterpret_cast<const LAS bf16x8*>(a);
        bf16x8 b1 = *reinterpret_cast<const LAS bf16x8*>(a + 32 * 256);
        p0 = __builtin_amdgcn_mfma_f32_32x32x16_bf16(b0, qr[d0], p0, 0, 0, 0);
        p1 = __builtin_amdgcn_mfma_f32_32x32x16_bf16(b1, qr[d0], p1, 0, 0, 0); }
}
template <int VB>
__device__ __forceinline__ void pv_tile(f32x16* o, int vb0, bf16x8 pa0, bf16x8 pa1, bf16x8 pa2, bf16x8 pa3) {
#define TRRD(dst, off) asm volatile("ds_read_b64_tr_b16 %0, %1 offset:%2" : "=&v"(dst) : "v"(vb0), "i"(off) : "memory")
#define PV_D0(d0) do { s16x4 l0, l1, l2, l3, h0, h1, h2, h3; constexpr int b_ = VB * SHM_V + v_rd_off(d0, 0, 0); \
        TRRD(l0, b_); TRRD(h0, b_ + 2048); TRRD(l1, b_ + 4096); TRRD(h1, b_ + 6144); TRRD(l2, b_ + 8192); TRRD(h2, b_ + 10240); TRRD(l3, b_ + 12288); TRRD(h3, b_ + 14336); \
        asm volatile("s_waitcnt lgkmcnt(0)" ::: "memory"); SBAR();   \
        o[d0] = __builtin_amdgcn_mfma_f32_32x32x16_bf16(pa0, (bf16x8){l0[0], l0[1], l0[2], l0[3], h0[0], h0[1], h0[2], h0[3]}, o[d0], 0, 0, 0);   \
        o[d0] = __builtin_amdgcn_mfma_f32_32x32x16_bf16(pa1, (bf16x8){l1[0], l1[1], l1[2], l1[3], h1[0], h1[1], h1[2], h1[3]}, o[d0], 0, 0, 0);   \
        o[d0] = __builtin_amdgcn_mfma_f32_32x32x16_bf16(pa2, (bf16x8){l2[0], l2[1], l2[2], l2[3], h2[0], h2[1], h2[2], h2[3]}, o[d0], 0, 0, 0);   \
        o[d0] = __builtin_amdgcn_mfma_f32_32x32x16_bf16(pa3, (bf16x8){l3[0], l3[1], l3[2], l3[3], h3[0], h3[1], h3[2], h3[3]}, o[d0], 0, 0, 0); } while (0)
    PV_D0(0); PV_D0(1); PV_D0(2); PV_D0(3);
#undef PV_D0
#undef TRRD
}
struct BlockRef { int bh, qb; };
struct Bases { const bf16* U; bf16* OA; float* SSQ; const float* CUM; };
__device__ __forceinline__ int blk_p0(const BlockRef& r) { return 128 + r.qb * 256; }
__device__ __forceinline__ const bf16* blk_q(const Bases& B, const BlockRef& r) { return B.U + ((size_t)((r.bh >> 3) * PP + blk_p0(r))) * 1024 + (r.bh & 7) * 128; }
__device__ __forceinline__ const bf16* blk_k(const Bases& B, const BlockRef& r) { return B.U + 1 * USTR + ((size_t)(r.bh >> 3) * PP) * 1024 + (r.bh & 7) * 128; }
__device__ __forceinline__ const bf16* blk_v(const Bases& B, const BlockRef& r) { return B.U + 2 * USTR + ((size_t)(r.bh >> 3) * PP) * 1024 + (r.bh & 7) * 128; }
struct Seam { bf16x8 qr[8]; bf16x8 st_v0, st_v1, st_k0, st_k1; };
#define ROW(p, k0, rr) ((p) + (size_t)((k0) + (rr)) * LDQ + sc)
#define VMW() asm volatile("s_waitcnt vmcnt(0)" ::: "memory")
#define VMWN(n) asm volatile("s_waitcnt vmcnt(%0)" :: "i"(n) : "memory")
#define SLOAD_H(Kp, Vp, k0) do { S.st_v0 = load8(ROW(Vp, k0, sr)); S.st_v1 = load8(ROW(Vp, k0, 32 + sr));              \
                         S.st_k0 = load8(ROW(Kp, k0, sr)); S.st_k1 = load8(ROW(Kp, k0, 32 + sr)); } while (0)
#define SWRITE_HK(bf) do { *(LAS bf16x8*)(K_lds + (bf) * SHM_K + kws) = S.st_k0; *(LAS bf16x8*)(K_lds + (bf) * SHM_K + kws + 32 * 256) = S.st_k1; } while (0)
#define SWRITE_HV(bf) do { *(LAS bf16x8*)(V_lds + (bf) * SHM_V + vst0) = S.st_v0; *(LAS bf16x8*)(V_lds + (bf) * SHM_V + vst1) = S.st_v1; } while (0)
#define SWRITE_H(bf) do { SWRITE_HV(bf); SWRITE_HK(bf); } while (0)
__device__ __forceinline__ void prime(const Bases& B, const BlockRef& cur, LAS char* lds, Seam& S) {
    const int tid = threadIdx.x, wid = __builtin_amdgcn_readfirstlane(tid >> 6), lane = tid & 63, r32 = lane & 31, hi = lane >> 5;
    const int sr = tid >> 4, sc = (tid & 15) * 8, kws = KSWZ(sr, sc * 2); LAS char* K_lds = lds + 2 * SHM_V;
    const int kb0 = KVBLK;
#pragma unroll
    for (int d0 = 0; d0 < 8; ++d0) S.qr[d0] = load8(blk_q(B, cur) + (size_t)(wid * QBLK + r32) * LDQ + d0 * 16 + hi * 8);
    { const bf16* Kp = blk_k(B, cur); const bf16* Vp = blk_v(B, cur); SLOAD_H(Kp, Vp, kb0); } VMW(); SWRITE_HK(0);
    __syncthreads();
}
__device__ __forceinline__ void block(const Bases& B, const BlockRef& cur, const BlockRef& nxt, LAS char* lds, Seam& S) {
    const int tid = threadIdx.x, wid = __builtin_amdgcn_readfirstlane(tid >> 6), lane = tid & 63, r32 = lane & 31, hi = lane >> 5;
    const int P0 = blk_p0(cur);
    const int j_hi = (P0 + QB - 1) / KVBLK + 1;
    const int NT = j_hi - 1;
    const int kbn = KVBLK;
    const int qlo = P0 + wid * QBLK, qm = qlo + r32 - 4 * hi;
    LAS char* V_lds = lds; LAS char* K_lds = lds + 2 * SHM_V;
    LAS float* ws = (LAS float*)(lds + OFF_WS) + wid * 64; LAS float* li_l = ws; LAS float* al_l = ws + 32;
    LAS float* cumS = (LAS float*)(lds + OFF_CUM);
    { const float* CUMG = B.CUM + (size_t)cur.bh * PP; const float cref = CUMG[P0]; const int n4 = (P0 + QB) >> 2;
      for (int i = tid; i < n4; i += 512) { const f32x4 c = *((const f32x4*)CUMG + i); *((LAS f32x4*)cumS + i) = (cref - c) * INVS; } }
    __syncthreads();
    float m_reg = -1e30f, l_reg = 0; f32x16 o[4] = {};
    const int sr = tid >> 4, sc = (tid & 15) * 8, vst0 = v_st(sr, sc), vst1 = v_st(32 + sr, sc), kws = KSWZ(sr, sc * 2);
    const int vb0 = (int)(uintptr_t)V_lds + v_rd_base(lane);
    const bf16* Kh = blk_k(B, cur); const bf16* Vh = blk_v(B, cur);
#define RESC(a) do { if (__any((a) < 1.f)) { if (hi == 0) al_l[r32] = (a); asm volatile("s_waitcnt lgkmcnt(0)" ::: "memory");              \
                     for (int d_ = 0; d_ < 4; ++d_) for (int r = 0; r < 16; ++r) o[d_][r] *= al_l[crow(r, hi)]; } } while (0)
#define KBASE(t) ((1 + (t)) * KVBLK)
#define CSP(t) (cumS + KBASE(t) + 4 * hi)
#define MASKT(P0_, P1_, t) do { const int kb_ = KBASE(t); if (kb_ + KVBLK - 1 > qlo) mask_causal(P0_, P1_, qm - kb_); if (kb_ == KVBLK) mask_pad(P0_, P1_, hi); } while (0)
#define SEAM_K0() do { VMWN(8); SWRITE_HK(0); SBAR(); } while (0)
    f32x16 pA0, pA1, pB0, pB1; float mnA, mnB, alA, alB; bf16x8 pa0, pa1, pa2, pa3;
    SWRITE_HV(0); SBAR();
    if (NT > 1) { SLOAD_H(Kh, Vh, KBASE(1)); }
    SBAR(); qkt<0>(pA0, pA1, K_lds, r32, hi, S.qr, CSP(0));
    MASKT(pA0, pA1, 0); partialSM(pA0, pA1, m_reg, mnA, alA);
    if (NT > 1) { VMW(); SWRITE_H(1); }
    __syncthreads();
#define HALF_STEP(PX0, PX1, mnX, alX, PY0, PY1, alY, t, KB, VB, SB) do {                                                      \
        SBAR(); qkt<KB>(PX0, PX1, K_lds, r32, hi, S.qr, CSP(t));                                             \
        finishSM(PY0, PY1, alY, l_reg, pa0, pa1, pa2, pa3); SBAR();                                                           \
        if ((t) + 1 < NT) { SLOAD_H(Kh, Vh, KBASE((t) + 1)); SBAR(); }                                               \
        pv_tile<VB>(o, vb0, pa0, pa1, pa2, pa3); MASKT(PX0, PX1, (t)); partialSM(PX0, PX1, m_reg, mnX, alX);                                        \
        __syncthreads();                                                                                                      \
        if ((t) + 1 < NT) { VMW(); SWRITE_H(SB); }                                                                          \
        RESC(alX); __syncthreads(); } while (0)
    for (int t = 1; t + 1 < NT; t += 2) {
        HALF_STEP(pB0, pB1, mnB, alB, pA0, pA1, alA, t, 1, 0, 0);
        HALF_STEP(pA0, pA1, mnA, alA, pB0, pB1, alB, t + 1, 0, 1, 1);
    }
    const bool even = (NT & 1) == 0;
    if (even) { SBAR(); qkt<1>(pB0, pB1, K_lds, r32, hi, S.qr, CSP(NT - 1)); SBAR(); }
    { const bf16* Kn = blk_k(B, nxt); const bf16* Vn = blk_v(B, nxt); SLOAD_H(Kn, Vn, kbn); } SBAR();
    { const bf16* Qn = blk_q(B, nxt);
#pragma unroll
    for (int d0 = 0; d0 < 8; ++d0) S.qr[d0] = load8(Qn + (size_t)(wid * QBLK + r32) * LDQ + d0 * 16 + hi * 8); }
    SBAR();
    finishSM(pA0, pA1, alA, l_reg, pa0, pa1, pa2, pa3); SBAR();
    pv_tile<0>(o, vb0, pa0, pa1, pa2, pa3);
    if (even) { MASKT(pB0, pB1, NT - 1); partialSM(pB0, pB1, m_reg, mnB, alB); __syncthreads(); RESC(alB);
        finishSM(pB0, pB1, alB, l_reg, pa0, pa1, pa2, pa3); SBAR(); pv_tile<1>(o, vb0, pa0, pa1, pa2, pa3); }
    SBAR(); SEAM_K0();
    if (hi == 0) li_l[r32] = l_reg; asm volatile("s_waitcnt lgkmcnt(0)" ::: "memory");
    float rli[16];
#pragma unroll
    for (int r = 0; r < 16; ++r) rli[r] = __builtin_amdgcn_rcpf(li_l[crow(r, hi)]);
    int r32e = r32, hie = hi; asm volatile("" : "+v"(r32e), "+v"(hie));
    const size_t m0 = (size_t)(cur.bh >> 3) * SEQ + cur.qb * 256 + wid * QBLK + 4 * hie;
    bf16* Ow = B.OA + m0 * LDO + (cur.bh & 7) * 128 + r32e; float* Sw = B.SSQ + m0 * 8 + (cur.bh & 7);
#pragma unroll
    for (int r = 0; r < 16; ++r) { const int orow = (r & 3) + 8 * (r >> 2); float sq = 0.f;
#pragma unroll
        for (int d0 = 0; d0 < 4; ++d0) { const float v = o[d0][r] * rli[r]; sq += v * v;
            const float vn = __shfl_xor(v, 1);
            if ((r32e & 1) == 0) *(unsigned*)(Ow + (size_t)orow * LDO + d0 * 32) = cvtpk(v, vn); }
        sq += __shfl_xor(sq, 1); sq += __shfl_xor(sq, 2); sq += __shfl_xor(sq, 4); sq += __shfl_xor(sq, 8); sq += __shfl_xor(sq, 16);
        if (r32e == 0) Sw[(size_t)orow * 8] = sq; }
    __syncthreads();
#undef RESC
#undef KBASE
#undef CSP
#undef MASKT
#undef SEAM_K0
#undef HALF_STEP
}
#undef ROW
#undef VMW
#undef VMWN
#undef SLOAD_H
#undef SWRITE_HK
#undef SWRITE_HV
#undef SWRITE_H
#undef KSWZ
#undef SBAR
}

__device__ __forceinline__ void fox_phase(Frame& F) {
    const int total = NB * NH * 8, stride = F.G; int L = F.vcu; if (L >= total) return;
    const fox::Bases B{(const bf16*)(F.A->ws + WS_U), (bf16*)(F.A->ws + WS_HN), (float*)(F.A->ws + WS_SSQ), (const float*)(F.A->ws + WS_CUM)};
    int pass = 0;
    fox::BlockRef cur{L >> 3, L & 7};
    fox::Seam S;
    fox::prime(B, cur, (LAS char*)F.lds, S);
    for (;;) {
        const bool more_pass = pass == 0, more_item = L + stride < total, last = !more_pass && !more_item;
        int Ln = L, passn = pass + 1;
        if (!more_pass) { passn = 0; Ln = more_item ? L + stride : L; }
        fox::BlockRef nxt{Ln >> 3, passn ? 15 - (Ln & 7) : (Ln & 7)};
        if (last) nxt = cur;
        fox::block(B, cur, nxt, (LAS char*)F.lds, S);
        if (last) break;
        cur = nxt; pass = passn; L = Ln;
    }
}


namespace ret {
typedef short s16x4 __attribute__((ext_vector_type(4)));
typedef short v4i16_t __attribute__((ext_vector_type(4)));
__device__ __forceinline__ s16x4 vtr(const LAS char* p) { return __builtin_bit_cast(s16x4, __builtin_amdgcn_ds_read_tr16_b64_v4i16((LAS v4i16_t*)p)); }
__device__ __forceinline__ int kswz(int row, int colB) { return row * 256 + (colB ^ ((row & 7) << 4)); }
__device__ __forceinline__ int vswz(int row, int colB) { return row * 256 + (colB ^ ((row & 7) << 5)); }
__device__ __forceinline__ int aswz(int row, int colB) { return row * 256 + (colB ^ ((((row & 3) | ((row >> 1) & 4))) << 5)); }
constexpr int A_KB = 32768, A_VB = 4096, A_OFF_V = 2 * A_KB;
__device__ __forceinline__ void states(Frame& F) {
    const int tid = ((int)threadIdx.x), lane = ((int)(threadIdx.x & 63)), w = F.wave, g = lane >> 4, q = (lane & 15) >> 2, pp = lane & 3;
    const bf16* U = (const bf16*)(F.A->ws + WS_U); bf16* ST = (bf16*)(F.A->ws + WS_ST);
    LAS char* lds = (LAS char*)F.lds;
    for (int unit = F.vcu; unit < NB * NH * 8; unit += F.G) {
        const int bh = unit >> 3, es = unit & 7, b = bh >> 3, h = bh & 7;
        const bf16* Kg = U + 4 * USTR + ((size_t)b * PP) * 1024 + h * 128;
        const bf16* Vg = U + 5 * USTR + ((size_t)b * PP) * 1024 + h * 128 + es * 16;
        const float wdec = exp2f(128.0f * log2f(1.0f - exp2f(-5.0f - (float)h)));
        f32x4 S = (f32x4){0.f, 0.f, 0.f, 0.f};
        u32x4 kr[4], vr;
#define RA_LOAD(n) do { _Pragma("unroll") for (int i = 0; i < 4; ++i) { const int pc = tid + 512 * i, row = pc >> 4, c16 = pc & 15; kr[i] = *(const u32x4*)(Kg + (size_t)((n) * 128 + row) * 1024 + c16 * 8); } \
        if (tid < 256) { const int row = tid >> 1, c16 = tid & 1; vr = *(const u32x4*)(Vg + (size_t)((n) * 128 + row) * 1024 + c16 * 8); } } while (0)
#define RA_WRITE(bf) do { _Pragma("unroll") for (int i = 0; i < 4; ++i) { const int pc = tid + 512 * i, row = pc >> 4, c16 = pc & 15; *(LAS u32x4*)(lds + (bf) * A_KB + aswz(row, c16 * 16)) = kr[i]; } \
        if (tid < 256) { const int row = tid >> 1, c16 = tid & 1; *(LAS u32x4*)(lds + A_OFF_V + (bf) * A_VB + row * 32 + c16 * 16) = vr; } } while (0)
        RA_LOAD(0); RA_WRITE(0);
        __syncthreads();
        for (int n = 0; n < 32; ++n) {
            const int bf = n & 1;
            if (n + 1 < 32) RA_LOAD(n + 1);
            f32x4 acc = (f32x4){0.f, 0.f, 0.f, 0.f};
#pragma unroll
            for (int s = 0; s < 4; ++s) {
                const int r0 = 32 * s + 8 * g + q;
                const s16x4 a0 = vtr(lds + bf * A_KB + aswz(r0, (16 * w + 4 * pp) * 2)), a1 = vtr(lds + bf * A_KB + aswz(r0 + 4, (16 * w + 4 * pp) * 2));
                const s16x4 b0 = vtr(lds + A_OFF_V + bf * A_VB + r0 * 32 + pp * 8), b1 = vtr(lds + A_OFF_V + bf * A_VB + (r0 + 4) * 32 + pp * 8);
                acc = __builtin_amdgcn_mfma_f32_16x16x32_bf16((bf16x8){a0[0], a0[1], a0[2], a0[3], a1[0], a1[1], a1[2], a1[3]}, (bf16x8){b0[0], b0[1], b0[2], b0[3], b1[0], b1[1], b1[2], b1[3]}, acc, 0, 0, 0);
            }
            S = (S + acc) * wdec;
            { u32x2 o; o.x = cvt_pk_bf16(S[0], S[1]); o.y = cvt_pk_bf16(S[2], S[3]);
              *(u32x2*)(ST + (((size_t)bh * 32 + n) * 128 + es * 16 + (lane & 15)) * 128 + 16 * w + 4 * g) = o; }
            if (n + 1 < 32) { RA_WRITE(bf ^ 1); }
            __syncthreads();
        }
#undef RA_LOAD
#undef RA_WRITE
    }
}
constexpr int B_K = 0, B_V = 32768, B_S = 65536;
__device__ __forceinline__ void outputs(Frame& F) {
    const int tid = ((int)threadIdx.x), lane = ((int)(threadIdx.x & 63)), w = F.wave, g = lane >> 4, il = lane & 15, q = il >> 2, pp = lane & 3;
    const bf16* U = (const bf16*)(F.A->ws + WS_U); const bf16* ST = (const bf16*)(F.A->ws + WS_ST); bf16* OA = (bf16*)(F.A->ws + WS_HN);
    LAS char* lds = (LAS char*)F.lds;
    u32x4 pk[4], pv[4], ps[4];
#define RB_LOAD(unit) do { const int bh_ = (unit) >> 5, n_ = ((unit) & 31) + 1, b_ = bh_ >> 3, h_ = bh_ & 7; \
        const bf16* Kg = U + 4 * USTR + ((size_t)(b_ * PP + n_ * 128)) * 1024 + h_ * 128; const bf16* Vg = U + 5 * USTR + ((size_t)(b_ * PP + n_ * 128)) * 1024 + h_ * 128; \
        const bf16* Sg = ST + ((size_t)bh_ * 32 + (n_ - 1)) * 16384; \
        _Pragma("unroll") for (int i = 0; i < 4; ++i) { const int pc = tid + 512 * i, row = pc >> 4, c16 = pc & 15; pk[i] = *(const u32x4*)(Kg + (size_t)row * 1024 + c16 * 8); pv[i] = *(const u32x4*)(Vg + (size_t)row * 1024 + c16 * 8); \
            ps[i] = *(const u32x4*)(Sg + (size_t)row * 128 + c16 * 8); } } while (0)
#define RB_WRITE() do { _Pragma("unroll") for (int i = 0; i < 4; ++i) { const int pc = tid + 512 * i, row = pc >> 4, c16 = pc & 15; *(LAS u32x4*)(lds + B_K + kswz(row, c16 * 16)) = pk[i]; \
            *(LAS u32x4*)(lds + B_V + vswz(row, c16 * 16)) = pv[i]; *(LAS u32x4*)(lds + B_S + kswz(row, c16 * 16)) = ps[i]; } } while (0)
    int unit = F.vcu; if (unit >= NB * NH * 32) return;
    RB_LOAD(unit); RB_WRITE();
    __syncthreads();
    for (;;) {
        const int nu = unit + F.G; const bool more = nu < NB * NH * 32;
        const int bh = unit >> 5, n = (unit & 31) + 1, b = bh >> 3, h = bh & 7;
        const size_t urow = (size_t)(b * PP + n * 128 + 16 * w + il);
        bf16x8 qx[4];
#pragma unroll
        for (int s = 0; s < 4; ++s) qx[s] = *(const bf16x8*)(U + 3 * USTR + urow * 1024 + h * 128 + 32 * s + 8 * g);
        if (more) RB_LOAD(nu);
        u32x2 P[8];
#pragma unroll
        for (int jb = 0; jb < 8; ++jb) {
            P[jb] = (u32x2){0u, 0u};
            if (jb <= w) {
                f32x4 d = (f32x4){0.f, 0.f, 0.f, 0.f};
#pragma unroll
                for (int s = 0; s < 4; ++s) { const bf16x8 a = *(const LAS bf16x8*)(lds + B_K + kswz(16 * jb + il, 64 * s + 16 * g)); d = __builtin_amdgcn_mfma_f32_16x16x32_bf16(a, qx[s], d, 0, 0, 0); }
                if (jb == w) {
#pragma unroll
                    for (int r = 0; r < 4; ++r) if (4 * g + r > il) d[r] = 0.f; }
                P[jb].x = cvt_pk_bf16(d[0], d[1]); P[jb].y = cvt_pk_bf16(d[2], d[3]);
            }
        }
        f32x4 o[8];
#pragma unroll
        for (int eb = 0; eb < 8; ++eb) { f32x4 acc = (f32x4){0.f, 0.f, 0.f, 0.f};
#pragma unroll
            for (int s = 0; s < 4; ++s) { const bf16x8 a = *(const LAS bf16x8*)(lds + B_S + kswz(16 * eb + il, 64 * s + 16 * g)); acc = __builtin_amdgcn_mfma_f32_16x16x32_bf16(a, qx[s], acc, 0, 0, 0); }
#pragma unroll
            for (int t = 0; t < 4; ++t) { if (2 * t <= w) {
                const int r0 = 32 * t + 4 * g + q;
                const s16x4 a0 = vtr(lds + B_V + vswz(r0, (16 * eb + 4 * pp) * 2)), a1 = vtr(lds + B_V + vswz(r0 + 16, (16 * eb + 4 * pp) * 2));
                const u32x4 bw = (u32x4){P[2 * t].x, P[2 * t].y, P[2 * t + 1].x, P[2 * t + 1].y};
                acc = __builtin_amdgcn_mfma_f32_16x16x32_bf16((bf16x8){a0[0], a0[1], a0[2], a0[3], a1[0], a1[1], a1[2], a1[3]}, __builtin_bit_cast(bf16x8, bw), acc, 0, 0, 0); } }
            o[eb] = acc; }
        float sm = 0.f;
#pragma unroll
        for (int eb = 0; eb < 8; ++eb) sm += (o[eb][0] + o[eb][1]) + (o[eb][2] + o[eb][3]);
        sm += __shfl_xor(sm, 16); sm += __shfl_xor(sm, 32);
        const float mu = sm * (1.0f / HD); float sv = 0.f;
#pragma unroll
        for (int eb = 0; eb < 8; ++eb) { o[eb] = o[eb] - mu; sv += (o[eb][0] * o[eb][0] + o[eb][1] * o[eb][1]) + (o[eb][2] * o[eb][2] + o[eb][3] * o[eb][3]); }
        sv += __shfl_xor(sv, 16); sv += __shfl_xor(sv, 32);
        const float rstd = 1.0f / sqrtf(sv * (1.0f / HD) + EPS);
        const size_t m = (size_t)b * SEQ + (n - 1) * 128 + 16 * w + il;
#pragma unroll
        for (int eb = 0; eb < 8; ++eb) { const int e0 = 16 * eb + 4 * g;
            const u32x2 gg = *(const u32x2*)(U + 6 * USTR + urow * 1024 + h * 128 + e0);
            u32x2 ov; ov.x = cvt_pk_bf16(o[eb][0] * rstd * bf_lo(gg.x), o[eb][1] * rstd * bf_hi(gg.x)); ov.y = cvt_pk_bf16(o[eb][2] * rstd * bf_lo(gg.y), o[eb][3] * rstd * bf_hi(gg.y));
            *(u32x2*)(OA + m * DM + 1024 + h * 128 + e0) = ov; }
        __syncthreads();
        if (!more) break;
        RB_WRITE();
        __syncthreads();
        unit = nu;
    }
#undef RB_LOAD
#undef RB_WRITE
}
}

struct POutProj {
    static constexpr bool PERM = false, HAS_MID = true, FP8 = false, GATHER = false;
    int nt; const char* Abase; unsigned lda2, ldb2; const char* Bt; const float* x; float* out; const float* SSQ;
    __device__ __forceinline__ void a_offs(const g8::Unit&, unsigned (&)[2][2]) const {}
    __device__ __forceinline__ const char* b_tile(const g8::Unit& u, int t) const { return Bt + (size_t)u.pn * 256 * ldb2 + (size_t)t * 128; }
    __device__ __forceinline__ void mid(f32x4 (&acc)[2][2][4][2], const g8::Unit& u, int wr, int wc, int fr, int fq) const {
#pragma unroll
        for (int ai = 0; ai < 2; ++ai)
#pragma unroll
            for (int m = 0; m < 4; ++m) { const int r = u.pm * 256 + ai * 128 + wr * 64 + m * 16 + fr;
                const f32x4 s0 = *(const f32x4*)(SSQ + (size_t)r * 8), s1 = *(const f32x4*)(SSQ + (size_t)r * 8 + 4);
                const float rs = 1.0f / sqrtf(((s0.x + s0.y) + (s0.z + s0.w) + (s1.x + s1.y) + (s1.z + s1.w)) * (1.0f / 1024.0f) + EPS);
#pragma unroll
                for (int bj = 0; bj < 2; ++bj)
#pragma unroll
                    for (int n = 0; n < 2; ++n) acc[ai][bj][m][n] = acc[ai][bj][m][n] * rs; }
    }
    __device__ __forceinline__ void epi(const f32x4 (&acc)[2][2][4][2], const g8::Unit& u, int wr, int wc, int fr, int fq) const {
        const int row0 = u.pm * 256 + wr * 64 + fr, col0 = u.pn * 256 + wc * 32 + 4 * fq;
#pragma unroll
        for (int ai = 0; ai < 2; ++ai)
#pragma unroll
            for (int m = 0; m < 4; ++m) { const size_t off = (size_t)(row0 + ai * 128 + m * 16) * DM + col0;
#pragma unroll
                for (int bj = 0; bj < 2; ++bj)
#pragma unroll
                    for (int n = 0; n < 2; ++n) *(f32x4*)(out + off + bj * 128 + n * 16) = *(const f32x4*)(x + off + bj * 128 + n * 16) + acc[ai][bj][m][n]; }
    }
};

__device__ __forceinline__ void p4_router(Frame& F) {
    const int lane = ((int)(threadIdx.x & 63)), w = F.wave, blk = w & 3, kh = w >> 2, row = lane & 15, kq = lane >> 4;
    const float* H1 = F.A->out; const float* g2 = F.A->in[8]; const float* WRT = (const float*)(F.A->ws + WS_WRT);
    const float* brg = F.A->in[10]; const float* bre = F.A->in[12];
    unsigned char* HN2 = (unsigned char*)(F.A->ws + WS_HN); int* TOK = (int*)(F.A->ws + WS_TOK); float* WLO = (float*)(F.A->ws + WS_WLO); float* WHI = (float*)(F.A->ws + WS_WHI); float* RSS = (float*)(F.A->ws + WS_RSS);
    LAS float* part = (LAS float*)F.lds;
    LAS float* pss = part + 2 * 64 * 32;
    for (int rb = F.vcu; rb < MTOK / 64; rb += F.G) {
        const int m0 = rb * 64 + blk * 16;
        const float* xp = H1 + (size_t)(m0 + row) * DM + kh * 1024 + 4 * kq;
        const float* w0p = WRT + (size_t)row * DM + kh * 1024 + 4 * kq; const float* w1p = w0p + 16 * DM; const float* gp = g2 + kh * 1024 + 4 * kq;
        unsigned* op = (unsigned*)(HN2 + (size_t)(m0 + row) * DM + kh * 1024 + 4 * kq);
        f32x4 acc0 = (f32x4){0.f, 0.f, 0.f, 0.f}, acc1 = acc0; float ss = 0.f;
#pragma unroll 4
        for (int s = 0; s < 64; ++s) {
            const f32x4 xa = *(const f32x4*)(xp + 16 * s), b0 = *(const f32x4*)(w0p + 16 * s), b1 = *(const f32x4*)(w1p + 16 * s), gg = *(const f32x4*)(gp + 16 * s);
#pragma unroll
            for (int j = 0; j < 4; ++j) { acc0 = __builtin_amdgcn_mfma_f32_16x16x4f32(xa[j], b0[j], acc0, 0, 0, 0); acc1 = __builtin_amdgcn_mfma_f32_16x16x4f32(xa[j], b1[j], acc1, 0, 0, 0); }
            ss += (xa.x * xa.x + xa.y * xa.y) + (xa.z * xa.z + xa.w * xa.w);
            const f32x4 y = xa * gg * SA1; op[4 * s] = pk_fp8x4(y.x, y.y, y.z, y.w);
        }
        ss += __shfl_xor(ss, 16); ss += __shfl_xor(ss, 32);
#pragma unroll
        for (int r = 0; r < 4; ++r) { part[(kh * 64 + blk * 16 + 4 * kq + r) * 32 + row] = acc0[r]; part[(kh * 64 + blk * 16 + 4 * kq + r) * 32 + 16 + row] = acc1[r]; }
        if (kq == 0) pss[kh * 64 + blk * 16 + row] = ss;
        __syncthreads();
        if (((int)threadIdx.x) < 64) {
            const int r = ((int)threadIdx.x), m = rb * 64 + r;
            const float rs = 1.0f / sqrtf((pss[r] + pss[64 + r]) * (1.0f / DM) + EPS);
            float lgt[20];
#pragma unroll
            for (int j = 0; j < 20; ++j) lgt[j] = (part[r * 32 + j] + part[(64 + r) * 32 + j]) * rs + (j < 4 ? brg[j] : bre[j - 4]);
            int gs = 0; float gm = lgt[0];
#pragma unroll
            for (int i = 1; i < 4; ++i) if (lgt[i] > gm) { gm = lgt[i]; gs = i; }
            float den = 0.f;
#pragma unroll
            for (int i = 0; i < 4; ++i) den += __expf(lgt[i] - gm);
            const float pg = 1.0f / den;
            float e4[4];
#pragma unroll
            for (int i = 0; i < 4; ++i) { float a = lgt[4 + i];
#pragma unroll
                for (int g = 1; g < 4; ++g) a = (gs == g) ? lgt[4 + 4 * g + i] : a;
                e4[i] = a; }
            int i1 = 0; float v1 = e4[0];
#pragma unroll
            for (int i = 1; i < 4; ++i) if (e4[i] > v1) { v1 = e4[i]; i1 = i; }
            int i2 = -1; float v2 = -__builtin_inff();
#pragma unroll
            for (int i = 0; i < 4; ++i) if (i != i1 && e4[i] > v2) { v2 = e4[i]; i2 = i; }
            const float ex = __expf(v2 - v1); const float w1 = pg / (1.f + ex), w2 = pg * ex / (1.f + ex);
            const int lo = i1 < i2 ? i1 : i2, hi = i1 < i2 ? i2 : i1; const float wlo = i1 < i2 ? w1 : w2, whi = i1 < i2 ? w2 : w1;
            const int pair = (lo == 0) ? (hi - 1) : (lo == 1) ? (hi + 1) : 5;
            const int cls = gs * 6 + pair;
            const unsigned pos = __hip_atomic_fetch_add(((unsigned*)F.A->ws) + CW_CNT + 64 * cls, 1u, __ATOMIC_RELAXED, __HIP_MEMORY_SCOPE_AGENT);
            TOK[cls * CLS_CAP + pos] = m; WLO[cls * CLS_CAP + pos] = wlo; WHI[cls * CLS_CAP + pos] = whi; RSS[cls * CLS_CAP + pos] = rs;
        }
        __syncthreads();
    }
}

__device__ __forceinline__ void cls_experts(int cls, int& elo, int& ehi) { const int g = cls / 6, pr = cls % 6; const int lo = pr < 3 ? 0 : (pr < 5 ? 1 : 2), hi = pr < 3 ? pr + 1 : (pr < 5 ? pr - 1 : 3); elo = 4 * g + lo; ehi = 4 * g + hi; }
__device__ __forceinline__ void moe_tables(Frame& F) {
    volatile LAS int* T = (volatile LAS int*)(F.lds + TBL_OFF);
    if (((int)threadIdx.x) == 0) {
        int base = 0;
        for (int c = 0; c < NCLS; ++c) { int n = (int)__hip_atomic_load(((unsigned*)F.A->ws) + CW_CNT + 64 * c, __ATOMIC_RELAXED, __HIP_MEMORY_SCOPE_AGENT); if (n > CLS_CAP) n = CLS_CAP; T[c] = n; T[32 + c] = base; const int nt = (n + 255) >> 8;
            for (int i = 0; i < nt; ++i) T[96 + base + i] = c; base += nt; }
        T[64] = base;
        int ne = 0;
        for (int e = 0; e < NEXP; ++e) { T[72 + e] = ne;
            for (int c = (e >> 2) * 6; c < (e >> 2) * 6 + 6; ++c) { int elo, ehi; cls_experts(c, elo, ehi); if (elo != e && ehi != e) continue; const int slot = (ehi == e) ? 1 : 0;
                const int nt = (T[c] + 255) >> 8; for (int i = 0; i < nt; ++i) { T[192 + ne] = (T[32 + c] + i) | (slot << 8) | (c << 16) | (i << 24); ++ne; } } }
        T[72 + NEXP] = ne; T[65] = ne;
    }
    __syncthreads();
}
struct SchedGU {
    const LAS int* T; int G, c;
    __device__ bool next(int i, g8::Unit& u) const {
        const int L = i * G + c; const int ne = __builtin_amdgcn_readfirstlane(T[65]); if (L >= ne * 8) return false;
        int e = 0;
#pragma unroll
        for (int k = 1; k < NEXP; ++k) { const int o = __builtin_amdgcn_readfirstlane(T[72 + k]); if (L >= o * 8) e = k; }
        const int e0 = __builtin_amdgcn_readfirstlane(T[72 + e]), e1 = __builtin_amdgcn_readfirstlane(T[72 + e + 1]); const int cnt = e1 - e0, loc = L - e0 * 8;
        const int ntile = loc / cnt, mt = loc - ntile * cnt; const int ent = __builtin_amdgcn_readfirstlane(T[192 + e0 + mt]);
        u.pm = ent & 0xff; u.pn = ntile; u.a0 = e; u.a1 = (ent >> 8) & 1; u.a2 = (ent >> 16) & 0xff; u.a3 = (ent >> 24) & 0xff; return true;
    }
};
struct SchedDown {
    const LAS int* T; int G, c;
    __device__ bool next(int i, g8::Unit& u) const {
        const int L = i * G + c; const int NT = __builtin_amdgcn_readfirstlane(T[64]); if (L >= NT * 8) return false;
        const int tl = L >> 3; const int cls = __builtin_amdgcn_readfirstlane(T[96 + tl]); const int tb = __builtin_amdgcn_readfirstlane(T[32 + cls]);
        int elo, ehi; cls_experts(cls, elo, ehi);
        u.pm = tl; u.pn = L & 7; u.a0 = elo; u.a1 = ehi; u.a2 = cls; u.a3 = tl - tb; return true;
    }
};

struct PGateUp {
    static constexpr bool PERM = true, HAS_MID = false, FP8 = true, GATHER = true;
    int nt; const char* Abase; unsigned lda2, ldb2; const char* WGU; const int* TOK; const float* WLO; const float* WHI; const float* RSS; const LAS int* T; unsigned char* ACT;
    __device__ __forceinline__ void a_offs(const g8::Unit& u, unsigned (&o)[2][2]) const {
        const int cnt = T[u.a2];
#pragma unroll
        for (int i = 0; i < 2; ++i) { int R, C; g8::stage_rc((int)threadIdx.x * 16 + i * 8192, R, C);
#pragma unroll
            for (int h = 0; h < 2; ++h) { int pos = u.a3 * 256 + h * 128 + R; if (pos >= cnt) pos = 0; const int tok = TOK[u.a2 * CLS_CAP + pos]; o[h][i] = (unsigned)(tok * DM + C * 2); } }
    }
    __device__ __forceinline__ const char* b_tile(const g8::Unit& u, int t) const { return WGU + ((size_t)u.a0 * 2048 + (size_t)u.pn * 256) * ldb2 + (size_t)t * 128; }
    __device__ __forceinline__ void mid(f32x4 (&)[2][2][4][2], const g8::Unit&, int, int, int, int) const {}
    __device__ __forceinline__ void epi(const f32x4 (&acc)[2][2][4][2], const g8::Unit& u, int wr, int wc, int fr, int fq) const {
        const int cnt = T[u.a2]; const float* WS = u.a1 ? WHI : WLO; constexpr float INV = 1.0f / (SA1 * SW1);
#pragma unroll
        for (int ai = 0; ai < 2; ++ai)
#pragma unroll
            for (int m = 0; m < 4; ++m) { const int rl = ai * 128 + wr * 64 + m * 16 + fr; const int pos = u.a3 * 256 + rl;
                const float w = ((pos < cnt) ? WS[u.a2 * CLS_CAP + pos] : 0.f) * SA2; const float rsi = ((pos < cnt) ? RSS[u.a2 * CLS_CAP + pos] : 0.f) * INV;
                const f32x4 g0 = acc[ai][0][m][0] * rsi, g1 = acc[ai][0][m][1] * rsi, u0 = acc[ai][1][m][0] * rsi, u1 = acc[ai][1][m][1] * rsi;
                f32x4 a0, a1;
#pragma unroll
                for (int e = 0; e < 4; ++e) { a0[e] = g0[e] / (1.f + __expf(-g0[e])) * u0[e] * w; a1[e] = g1[e] / (1.f + __expf(-g1[e])) * u1[e] * w; }
                u32x2 o; o.x = pk_fp8x4(a0[0], a0[1], a0[2], a0[3]); o.y = pk_fp8x4(a1[0], a1[1], a1[2], a1[3]);
                *(u32x2*)(ACT + ((size_t)u.pm * 256 + rl) * 2048 + u.a1 * 1024 + u.pn * 128 + wc * 32 + 8 * fq) = o; }
    }
};
struct PDown {
    static constexpr bool PERM = false, HAS_MID = false, FP8 = true, GATHER = false;
    int nt; const char* Abase; unsigned lda2, ldb2; const char* WD; const int* TOK; const LAS int* T; float* out;
    __device__ __forceinline__ void a_offs(const g8::Unit&, unsigned (&)[2][2]) const {}
    __device__ __forceinline__ const char* b_tile(const g8::Unit& u, int t) const { const int e = (t < 8) ? u.a0 : u.a1; return WD + ((size_t)e * 2048 + (size_t)u.pn * 256) * ldb2 + (size_t)(t & 7) * 128; }
    __device__ __forceinline__ void mid(f32x4 (&)[2][2][4][2], const g8::Unit&, int, int, int, int) const {}
    __device__ __forceinline__ void epi(const f32x4 (&acc)[2][2][4][2], const g8::Unit& u, int wr, int wc, int fr, int fq) const {
        const int cnt = T[u.a2]; const int col0 = u.pn * 256 + wc * 32 + 4 * fq; constexpr float INV = 1.0f / (SA2 * SW2);
#pragma unroll
        for (int ai = 0; ai < 2; ++ai)
#pragma unroll
            for (int m = 0; m < 4; ++m) { const int pos = u.a3 * 256 + ai * 128 + wr * 64 + m * 16 + fr;
                if (pos < cnt) { const int tok = TOK[u.a2 * CLS_CAP + pos]; float* rowp = out + (size_t)tok * DM + col0;
#pragma unroll
                    for (int bj = 0; bj < 2; ++bj)
#pragma unroll
                        for (int n = 0; n < 2; ++n) { f32x4* q = (f32x4*)(rowp + bj * 128 + n * 16); *q = *q + acc[ai][bj][m][n] * INV; } } }
    }
};

__device__ __forceinline__ void p7_final(Frame& F) {
    const int gw = F.vcu * NWAVES + F.wave, NGW = F.G * NWAVES, lane = ((int)(threadIdx.x & 63)); const float* gf = F.A->in[16];
    f32x4 gv[8];
#pragma unroll
    for (int j = 0; j < 8; ++j) gv[j] = *((const f32x4*)gf + lane + 64 * j);
    for (int row = gw; row < MTOK; row += NGW) {
        float* xr = F.A->out + (size_t)row * DM; f32x4 v[8]; float ss = 0.f;
#pragma unroll
        for (int j = 0; j < 8; ++j) { v[j] = *((const f32x4*)xr + lane + 64 * j); ss += (v[j].x * v[j].x + v[j].y * v[j].y) + (v[j].z * v[j].z + v[j].w * v[j].w); }
        const float rs = 1.0f / sqrtf(wave_sum(ss) * (1.0f / DM) + EPS);
#pragma unroll
        for (int j = 0; j < 8; ++j) *((f32x4*)xr + lane + 64 * j) = v[j] * rs * gv[j];
    }
}

__global__ void __launch_bounds__(NWAVES * 64, 2) fwd_kernel(Args args) {
    extern __shared__ __attribute__((aligned(16))) unsigned char lds[];
    Frame F;
    F.lds = (LAS unsigned char*)lds;
    F.MISC = (volatile LAS unsigned*)(F.lds + MISC_OFF);
    F.wave = __builtin_amdgcn_readfirstlane((int)threadIdx.x >> 6);
    F.G = gridDim.x; { const int bx = blockIdx.x; F.vcu = (F.G % 8 == 0) ? (bx % 8) * (F.G / 8) + bx / 8 : bx; }
    F.A = &args;
    { int t0 = (int)threadIdx.x; asm volatile("" : "+v"(t0));
      for (int u = t0; u < (LDS_BYTES - RING_BYTES) / 4; u += NWAVES * 64) ((LAS unsigned*)(F.lds + RING_BYTES))[u] = 0u; }
    __syncthreads();
    (void)xcd_barrier_post((unsigned*)args.ws + CW_BAR, F.MISC + 8);
#define MKBAR() XcdBarrier bar; bar.bar = (unsigned*)args.ws + CW_BAR; bar.x = xb_xcc_id(); bar.st = (volatile LAS unsigned*)(F.lds + MISC_OFF) + 8
    const int lo = args.ph_lo, hi = args.ph_hi;
#define IN(k) (lo <= (k) && (k) < hi)
#define GRID_BAR(k) do { if (IN(k) && IN((k) + 1)) { MKBAR(); xcd_barrier(bar); } } while (0)
    bf16* U = (bf16*)(F.A->ws + WS_U);
#define PHASE(k, ...) do { if (IN(k)) { __VA_ARGS__ if constexpr (REPP == (k)) { { MKBAR(); xcd_barrier(bar); } __VA_ARGS__ } } GRID_BAR(k); } while (0)
    PHASE(0, p0_prologue(F););
    PHASE(1,
        p1_cumsum(F); p1_meta_kv(F);
        { PInProj p{DM / 64, (const char*)(F.A->ws + WS_HN), (unsigned)(DM * 2), (unsigned)(DM * 2), (const char*)(F.A->ws + WS_WINT), U, (const f32x2*)(F.A->ws + WS_ROPE)};
        g8::StaticOrder S; S.init(MTOK, NIN, F.G, (int)blockIdx.x);
        g8::gemm_phase<PInProj, g8::StaticOrder, true>(F.lds, p, S); });
    PHASE(2, ret::states(F); __syncthreads();
        if constexpr (REPP == 21) { ret::states(F); __syncthreads(); }
        fox_phase(F);
        if constexpr (REPP == 20) { __syncthreads(); fox_phase(F); }
        { MKBAR(); xcd_barrier(bar); } ret::outputs(F);
        if constexpr (REPP == 22) { __syncthreads(); ret::outputs(F); });
    PHASE(3,
        { POutProj p{DM / 64, (const char*)(F.A->ws + WS_HN), (unsigned)(DM * 2), (unsigned)(DM * 2), (const char*)(F.A->ws + WS_WOUTT), F.A->in[0], F.A->out, (const float*)(F.A->ws + WS_SSQ)};
        g8::StaticOrder S; S.init(MTOK, DM, F.G, (int)blockIdx.x);
        g8::gemm_phase<POutProj, g8::StaticOrder, true>(F.lds, p, S); });
    PHASE(4, p4_router(F););
    PHASE(5,
        moe_tables(F);
        { PGateUp p{DM / 128, (const char*)(F.A->ws + WS_HN), (unsigned)DM, (unsigned)DM, (const char*)(F.A->ws + WS_WGU), (const int*)(F.A->ws + WS_TOK), (const float*)(F.A->ws + WS_WLO), (const float*)(F.A->ws + WS_WHI), (const float*)(F.A->ws + WS_RSS),
                  (const LAS int*)(F.lds + TBL_OFF), (unsigned char*)U};
        SchedGU S{(const LAS int*)(F.lds + TBL_OFF), F.G, F.vcu};
        g8::gemm_phase<PGateUp, SchedGU, true>(F.lds, p, S); });
    PHASE(6,
        if (!IN(5)) moe_tables(F);
        { PDown p{2048 / 128, (const char*)U, 2048u, (unsigned)DE, (const char*)(F.A->ws + WS_WD), (const int*)(F.A->ws + WS_TOK), (const LAS int*)(F.lds + TBL_OFF), F.A->out};
        SchedDown S{(const LAS int*)(F.lds + TBL_OFF), F.G, F.vcu};
        g8::gemm_phase<PDown, SchedDown, true>(F.lds, p, S); });
    PHASE(7, p7_final(F););
#undef PHASE
#undef IN
#undef GRID_BAR
}

extern "C" void kernel_launch(void* const* d_in, const int* in_sizes, int n_in, void* d_out, int out_size, void* d_ws, size_t ws_size, hipStream_t stream) {
    static int grid = 0;
    if (grid == 0) {
        if (n_in != 17 || out_size != MTOK * DM || ws_size < WS_END) { fprintf(stderr, "kernel_launch: unexpected shapes (n_in %d out %d ws %zu)\n", n_in, out_size, ws_size); grid = -1; return; }
        int dev = 0, cus = 0, per_cu = 0;
        if (hipGetDevice(&dev) != hipSuccess || hipDeviceGetAttribute(&cus, hipDeviceAttributeMultiprocessorCount, dev) != hipSuccess) { grid = -1; return; }
        if (hipFuncSetAttribute((const void*)fwd_kernel, hipFuncAttributeMaxDynamicSharedMemorySize, LDS_BYTES) != hipSuccess) { fprintf(stderr, "kernel_launch: hipFuncSetAttribute failed\n"); grid = -1; return; }
        if (hipOccupancyMaxActiveBlocksPerMultiprocessor(&per_cu, (const void*)fwd_kernel, NWAVES * 64, LDS_BYTES) != hipSuccess || per_cu < 1) fprintf(stderr, "kernel_launch: occupancy query says %d\n", per_cu);
        (void)hipGetLastError();
        grid = cus;
    }
    if (grid < 0) return;
    (void)hipMemsetAsync((char*)d_ws + WS_CTL, 0, CTL_ZERO_BYTES, stream);
    Args a{};
    for (int i = 0; i < 17; ++i) a.in[i] = (const float*)d_in[i];
    a.out = (float*)d_out; a.ws = (unsigned char*)d_ws; a.ph_lo = 0; a.ph_hi = 8;
    hipLaunchKernelGGL(fwd_kernel, dim3(grid), dim3(NWAVES * 64), LDS_BYTES, stream, a);
}
```

```cpp
#include <hip/hip_runtime.h>
#include <cstdio>
#include <cstdint>

#define LAS __attribute__((address_space(3)))
#define GAS __attribute__((address_space(1)))
typedef unsigned short bf16;
typedef short bf16x8 __attribute__((ext_vector_type(8)));
typedef float f32x4 __attribute__((ext_vector_type(4)));
typedef float f32x2 __attribute__((ext_vector_type(2)));
typedef unsigned u32x4 __attribute__((ext_vector_type(4)));
typedef unsigned u32x2 __attribute__((ext_vector_type(2)));

constexpr int NB = 4, SEQ = 4096, DM = 2048, PADN = 112, NMETA = 16, PP = SEQ + 128, HD = 128, NH = 8;
constexpr int MTOK = NB * SEQ;
constexpr int INC = 7176;
constexpr int NIN = 7168;
constexpr int NEXP = 16, DE = 1024, NCLS = 24, CLS_CAP = 16384;
constexpr float EPS = 1e-6f;
constexpr float SCALE = 0.08838834764831845f;

constexpr size_t MiB = 1u << 20;
constexpr size_t WS_CTL = 0, CTL_ZERO_BYTES = 1 * MiB;
constexpr size_t WS_LOGF = 1 * MiB;
constexpr size_t WS_CUM = WS_LOGF + 1 * MiB;
constexpr size_t WS_SSQ = WS_CUM + 1 * MiB;
constexpr size_t WS_ROPE = WS_SSQ + 1 * MiB;
constexpr size_t WS_WRT = WS_ROPE + 3 * MiB;
constexpr size_t WS_HNMETA = WS_WRT + 1 * MiB;
constexpr size_t WS_TOK = WS_HNMETA + 1 * MiB;
constexpr size_t WS_WLO = WS_TOK + 2 * MiB;
constexpr size_t WS_WHI = WS_WLO + 2 * MiB;
constexpr size_t WS_WINT = 16 * MiB;
constexpr size_t WS_WOUTT = 44 * MiB;
constexpr size_t WS_WGU = 52 * MiB;
constexpr size_t WS_WD = 180 * MiB;
constexpr size_t WS_HN = 244 * MiB;
constexpr size_t WS_U = 308 * MiB;
constexpr size_t WS_Y = WS_U + 64 * MiB;
constexpr size_t USTR = (size_t)NB * PP * 1024;
constexpr size_t WS_ST = WS_U + 7 * 33 * MiB;
constexpr size_t WS_RSS = WS_ST + 32 * MiB;
constexpr size_t WS_END = WS_RSS + 2 * MiB;
static_assert(WS_WHI + 2 * MiB <= WS_WINT && USTR * 2 == 33 * MiB, "ws map");
constexpr int CW_BAR = 4096;
constexpr int CW_CNT = 16384;

constexpr int RING_BYTES = 131072;
constexpr int MISC_OFF = RING_BYTES + 320;
constexpr int TBL_OFF = RING_BYTES + 1024;
constexpr int LDS_BYTES = 147456;
constexpr int NWAVES = 8;
#ifndef REPP_V
#define REPP_V (-1)
#endif
constexpr int REPP = REPP_V;

__device__ __forceinline__ unsigned cvt_pk_bf16(float lo, float hi) { unsigned r; asm volatile("v_cvt_pk_bf16_f32 %0, %1, %2" : "=v"(r) : "v"(lo), "v"(hi)); return r; }
__device__ __forceinline__ unsigned pk_fp8x4(float a, float b, float c, float d) {
    a = __builtin_amdgcn_fmed3f(a, -448.f, 448.f); b = __builtin_amdgcn_fmed3f(b, -448.f, 448.f); c = __builtin_amdgcn_fmed3f(c, -448.f, 448.f); d = __builtin_amdgcn_fmed3f(d, -448.f, 448.f);
    int w = 0; w = __builtin_amdgcn_cvt_pk_fp8_f32(a, b, w, false); w = __builtin_amdgcn_cvt_pk_fp8_f32(c, d, w, true); return (unsigned)w; }
constexpr float SA1 = 16.f, SW1 = 1024.f, SA2 = 32.f, SW2 = 512.f;
__device__ __forceinline__ float bf_lo(unsigned w) { return __uint_as_float(w << 16); }
__device__ __forceinline__ float bf_hi(unsigned w) { return __uint_as_float(w & 0xffff0000u); }
__device__ __forceinline__ float wave_sum(float v) {
#pragma unroll
    for (int o = 1; o < 64; o <<= 1) v += __shfl_xor(v, o);
    return v;
}
__device__ __forceinline__ float wave_max(float v) {
#pragma unroll
    for (int o = 1; o < 64; o <<= 1) v = fmaxf(v, __shfl_xor(v, o));
    return v;
}
#define LDS_WAIT() asm volatile("s_waitcnt lgkmcnt(0)" ::: "memory")
#define VM_WAIT() asm volatile("s_waitcnt vmcnt(0)" ::: "memory")

#define XB_TMO      128
#define XB_XCNT(j)  (256  + 64 * (j))
#define XB_XSUB(j)  (1280 + 64 * (j))
#define XB_XGEN(j)  (2304 + 64 * (j))
#define XB_TOP      3328
#define XB_TOPGEN   3392
#define XCD_BAR_WORDS 3456
#define XB_SPIN_CAP (1u << 21)
__device__ __forceinline__ unsigned xb_ld(unsigned* p)              { return __hip_atomic_load(p, __ATOMIC_RELAXED, __HIP_MEMORY_SCOPE_AGENT); }
__device__ __forceinline__ unsigned xb_add(unsigned* p, unsigned v) { return __hip_atomic_fetch_add(p, v, __ATOMIC_RELAXED, __HIP_MEMORY_SCOPE_AGENT); }
__device__ __forceinline__ unsigned xb_xcc_id() { return (unsigned)__builtin_amdgcn_s_getreg((3 << 11) | 20) & 0xFu; }
#define XB_SPIN(cond, bar) do { unsigned _sp = 0; while (cond) { __builtin_amdgcn_s_sleep(1); \
    if ((++_sp & 255u) == 0u) { if (xb_ld(&(bar)[XB_TMO])) break; if (_sp > XB_SPIN_CAP) { atomicAdd(&(bar)[XB_TMO], 1u); break; } } } } while (0)
struct XcdBarrier { unsigned* bar; unsigned x; volatile LAS unsigned* st; };
__device__ __forceinline__ XcdBarrier xcd_barrier_post(unsigned* bar, volatile LAS unsigned* st) {
    XcdBarrier b; b.bar = bar; b.x = xb_xcc_id(); b.st = st;
    if (threadIdx.x == 0) (void)xb_add(&bar[XB_XCNT(b.x)], 1u);
    return b;
}
__device__ __forceinline__ void xcd_barrier_complete(unsigned* bar, unsigned x, unsigned& nloc, unsigned& nx) {
    const unsigned G = gridDim.x * gridDim.y * gridDim.z;
    unsigned sum, cnt, mine, sp = 0u;
    for (;;) {
        sum = 0u; cnt = 0u; mine = 0u;
#pragma unroll
        for (unsigned j = 0; j < 16; ++j) { const unsigned c = xb_ld(&bar[XB_XCNT(j)]); sum += c; cnt += (c > 0u) ? 1u : 0u; mine = (j == x) ? c : mine; }
        if (sum == G) break;
        __builtin_amdgcn_s_sleep(1);
        if ((++sp & 255u) == 0u) { if (xb_ld(&bar[XB_TMO])) break; if (sp > XB_SPIN_CAP) { atomicAdd(&bar[XB_TMO], 1u); break; } }
    }
    nloc = mine > 0u ? mine : 1u; nx = cnt > 0u ? cnt : 1u;
}
__device__ __forceinline__ void xcd_barrier(const XcdBarrier& b) {
    asm volatile("s_waitcnt vmcnt(0)" ::: "memory");
    __syncthreads();
    if (threadIdx.x == 0) {
        unsigned* bar = b.bar;
        __builtin_amdgcn_s_waitcnt(0);
        unsigned nloc = b.st[0], nx = b.st[1];
        if (nloc == 0u) { xcd_barrier_complete(bar, b.x, nloc, nx); b.st[0] = nloc; b.st[1] = nx; }
        const unsigned old = xb_add(&bar[XB_XSUB(b.x)], 1u);
        const unsigned gen = old / nloc;
        if (old + 1u == (gen + 1u) * nloc) {
            __builtin_amdgcn_fence(__ATOMIC_RELEASE, "agent");
            asm volatile("s_waitcnt vmcnt(0)" ::: "memory");
            const unsigned og = xb_add(&bar[XB_TOP], 1u);
            const unsigned tg = og / nx;
            if (og + 1u == (tg + 1u) * nx) xb_add(&bar[XB_TOPGEN], 1u);
            else XB_SPIN(xb_ld(&bar[XB_TOPGEN]) == tg, bar);
            __builtin_amdgcn_fence(__ATOMIC_ACQUIRE, "agent");
            xb_add(&bar[XB_XGEN(b.x)], 1u);
            asm volatile("s_waitcnt vmcnt(0)" ::: "memory");
        } else {
            XB_SPIN(xb_ld(&bar[XB_XGEN(b.x)]) == gen, bar);
            __builtin_amdgcn_fence(__ATOMIC_ACQUIRE, "agent");
            asm volatile("s_waitcnt vmcnt(0)" ::: "memory");
        }
    }
    __syncthreads();
}

namespace g8 {
constexpr int BM = 256, BK = 64, HALF = 128, HTB = HALF * BK * 2, NXCD = 8, WGM = 8;
__device__ __forceinline__ int lds_byte(int r, int c) { const int st = (r >> 4) * 2 + (c >> 5), rr = r & 15, cc = c & 31, ob = rr * 64 + cc * 2; return st * 1024 + (ob ^ (((ob >> 9) & 1) << 5)); }
__device__ __forceinline__ void stage_rc(int b, int& R, int& C) { const int st = b / 1024, sb = b % 1024, swz = sb ^ (((sb >> 9) & 1) << 5); R = (st >> 1) * 16 + swz / 64; C = (st & 1) * 32 + (swz % 64) / 2; }
__device__ __forceinline__ int perm32(int rho) { const int n = rho >> 4, i = rho & 15; return 8 * (i >> 2) + 4 * n + (i & 3); }

struct Unit { int pm, pn, a0, a1, a2, a3; };
typedef int v8i_t __attribute__((ext_vector_type(8)));

struct StaticOrder {
    int nM, nN, nwg, G, c;
    __device__ void init(int M, int N, int G_, int c_) { nM = M / BM; nN = N / BM; nwg = nM * nN; G = G_; c = c_; }
    __device__ bool next(int i, Unit& u) const {
        const long L = (long)i * G + c; if (L >= nwg) return false;
        int wgid = (int)L; { const int q = nwg / NXCD, r = nwg % NXCD, xcd = wgid % NXCD, off = wgid / NXCD; wgid = (xcd < r ? xcd * (q + 1) : r * (q + 1) + (xcd - r) * q) + off; }
        const int nig = WGM * nN, gid = wgid / nig, fm = gid * WGM, gsz = (nM - fm) < WGM ? (nM - fm) : WGM;
        u.pm = fm + ((wgid % nig) % gsz); u.pn = (wgid % nig) / gsz; u.a0 = u.a1 = u.a2 = u.a3 = 0; return true;
    }
};

template <class P, class Sched, bool ALIGN_EPI>
__device__ __forceinline__ void gemm_phase(LAS unsigned char* lds, const P& p, const Sched& S) {
    const int tid = threadIdx.x, wid = __builtin_amdgcn_readfirstlane(tid >> 6), lane = tid & 63, wr = wid >> 2, wc = wid & 3, fr = lane & 15, fq = lane >> 4;
    const int nt = p.nt;
    unsigned voffB[2], voffA[2];
#pragma unroll
    for (int i = 0; i < 2; ++i) { int R, C; stage_rc(tid * 16 + i * 8192, R, C); const int Rb = P::PERM ? ((R & ~31) + perm32(R & 31)) : R;
        voffB[i] = (unsigned)Rb * p.ldb2 + (unsigned)C * 2u; voffA[i] = (unsigned)R * p.lda2 + (unsigned)C * 2u; }
    const size_t hstepB = (size_t)HALF * p.ldb2, hstepA = (size_t)HALF * p.lda2;
    const unsigned ldsw = (unsigned)wid * 1024u;
    const int aoff = lds_byte(wr * 64 + fr, fq * 8), boff = lds_byte(wc * 32 + fr, fq * 8);
#define PG8_SA(b, h) (((b) * 2 + (h)) * HTB)
#define PG8_SB(b, h) ((4 + (b) * 2 + (h)) * HTB)
#define PG8_STAGE(bufoff, gbase, v0, v1) do { \
        __builtin_amdgcn_global_load_lds((const unsigned*)((const char*)(gbase) + (v0)), (LAS unsigned*)(lds + (bufoff) + ldsw), 16, 0, 0); \
        __builtin_amdgcn_global_load_lds((const unsigned*)((const char*)(gbase) + (v1)), (LAS unsigned*)(lds + (bufoff) + ldsw + 8192), 16, 0, 0); } while (0)
#define PG8_LD32(p0_, p1_) ({ const u32x4 lo_ = *(const LAS u32x4*)(p0_), hi_ = *(const LAS u32x4*)(p1_); (v8i_t){(int)lo_.x, (int)lo_.y, (int)lo_.z, (int)lo_.w, (int)hi_.x, (int)hi_.y, (int)hi_.z, (int)hi_.w}; })
#define PG8_LDA(dst, b, h) do { _Pragma("unroll") for (int m = 0; m < 4; ++m) dst[m] = PG8_LD32(lds + PG8_SA(b, h) + aoff + m * 2048, lds + PG8_SA(b, h) + aoff + m * 2048 + 1024); } while (0)
#define PG8_LDB(dst, b, h) do { _Pragma("unroll") for (int n = 0; n < 2; ++n) dst[n] = PG8_LD32(lds + PG8_SB(b, h) + boff + n * 2048, lds + PG8_SB(b, h) + boff + n * 2048 + 1024); } while (0)
#define PG8_LOH(v) __builtin_bit_cast(bf16x8, __builtin_shufflevector(v, v, 0, 1, 2, 3))
#define PG8_HIH(v) __builtin_bit_cast(bf16x8, __builtin_shufflevector(v, v, 4, 5, 6, 7))
#define PG8_MMA(ai, bj, At, Bt) do { __builtin_amdgcn_s_setprio(1); _Pragma("unroll") for (int m = 0; m < 4; ++m) _Pragma("unroll") for (int n = 0; n < 2; ++n) { \
        if constexpr (P::FP8) { asm volatile("v_mfma_f32_16x16x128_f8f6f4 %0, %1, %2, %0" : "+v"(acc[ai][bj][m][n]) : "v"(Bt[n]), "v"(At[m])); } \
        else { acc[ai][bj][m][n] = __builtin_amdgcn_mfma_f32_16x16x32_bf16(PG8_LOH(Bt[n]), PG8_LOH(At[m]), acc[ai][bj][m][n], 0, 0, 0); \
               acc[ai][bj][m][n] = __builtin_amdgcn_mfma_f32_16x16x32_bf16(PG8_HIH(Bt[n]), PG8_HIH(At[m]), acc[ai][bj][m][n], 0, 0, 0); } } \
        __builtin_amdgcn_s_setprio(0); } while (0)
#define PG8_WAIT_V(n) asm volatile("s_waitcnt vmcnt(" #n ")" ::: "memory")
#define PG8_WAIT_L(n) asm volatile("s_waitcnt lgkmcnt(" #n ")" ::: "memory")
#define PG8_BAR __builtin_amdgcn_s_barrier()
#define PG8_SCHED __builtin_amdgcn_sched_barrier(0)
    Unit cur, nxt; int ui = 0;
    if (!S.next(0, cur)) return;
    f32x4 acc[2][2][4][2];
#pragma unroll
    for (int a = 0; a < 2; ++a)
#pragma unroll
        for (int b = 0; b < 2; ++b)
#pragma unroll
            for (int m = 0; m < 4; ++m)
#pragma unroll
                for (int n = 0; n < 2; ++n) acc[a][b][m][n] = (f32x4){0.f, 0.f, 0.f, 0.f};
    v8i_t At[4], B0[2], B1[2];
    unsigned oc[2][2];
    constexpr int ONOFF = RING_BYTES + 4096;
    const char* cA = p.Abase; const char* nA = p.Abase;
    if constexpr (P::GATHER) { p.a_offs(cur, oc); } else { cA = p.Abase + (size_t)cur.pm * 2 * hstepA; }
#define PG8_STA(bufoff, base_, h_, O_) do { if constexpr (P::GATHER) { PG8_STAGE(bufoff, base_, O_[h_][0], O_[h_][1]); } else { PG8_STAGE(bufoff, (base_) + (h_) * hstepA, voffA[0], voffA[1]); } } while (0)
    {
        const char* b0 = p.b_tile(cur, 0); const char* b1 = p.b_tile(cur, 1);
        PG8_STAGE(PG8_SB(0, 0), b0, voffB[0], voffB[1]); PG8_STAGE(PG8_SB(0, 1), b0 + hstepB, voffB[0], voffB[1]);
        PG8_STA(PG8_SA(0, 0), cA, 0, oc); PG8_STA(PG8_SA(0, 1), cA, 1, oc);
        if (wr == 1) PG8_BAR;
        PG8_WAIT_V(2); PG8_BAR;
        PG8_STAGE(PG8_SB(1, 0), b1, voffB[0], voffB[1]); PG8_STA(PG8_SA(1, 0), cA + 128, 0, oc); PG8_STAGE(PG8_SB(1, 1), b1 + hstepB, voffB[0], voffB[1]);
        PG8_WAIT_V(6); PG8_BAR;
    }
    for (;;) {
        const bool has_next = S.next(ui + 1, nxt);
        if (!has_next) nxt = cur;
        if constexpr (P::GATHER) { unsigned on[2][2]; p.a_offs(nxt, on); *(LAS u32x4*)(lds + ONOFF + tid * 16) = (u32x4){on[0][0], on[0][1], on[1][0], on[1][1]}; } else { nA = p.Abase + (size_t)nxt.pm * 2 * hstepA; }
#pragma unroll 1
        for (int t = 0; t < nt; t += 2) {
            const bool last = (t == nt - 2);
            if constexpr (P::HAS_MID) { if (t == (nt >> 1)) p.mid(acc, cur, wr, wc, fr, fq); }
            const char* a1 = cA + (size_t)(t + 1) * 128;
            const char* a2 = last ? nA : cA + (size_t)(t + 2) * 128; const char* a3 = a2 + 128;
            unsigned o2[2][2];
            if constexpr (P::GATHER) { const u32x4 onv = *(const LAS u32x4*)(lds + ONOFF + tid * 16);
                o2[0][0] = last ? onv.x : oc[0][0]; o2[0][1] = last ? onv.y : oc[0][1]; o2[1][0] = last ? onv.z : oc[1][0]; o2[1][1] = last ? onv.w : oc[1][1]; }
            const char* b2 = last ? p.b_tile(nxt, 0) : p.b_tile(cur, t + 2); const char* b3 = last ? p.b_tile(nxt, 1) : p.b_tile(cur, t + 3);
            PG8_LDB(B0, 0, 0); PG8_LDB(B1, 0, 1); PG8_SCHED; PG8_LDA(At, 0, 0); PG8_STA(PG8_SA(1, 1), a1, 1, oc);
            PG8_WAIT_V(8); PG8_WAIT_L(0); PG8_BAR; PG8_MMA(0, 0, At, B0); PG8_MMA(0, 1, At, B1); PG8_BAR; PG8_SCHED;
            PG8_LDA(At, 0, 1); PG8_STAGE(PG8_SB(0, 0), b2, voffB[0], voffB[1]); PG8_STAGE(PG8_SB(0, 1), b2 + hstepB, voffB[0], voffB[1]); PG8_STA(PG8_SA(0, 0), a2, 0, o2);
            PG8_WAIT_V(8); PG8_WAIT_L(0); PG8_BAR; PG8_MMA(1, 0, At, B0); PG8_MMA(1, 1, At, B1); PG8_BAR; PG8_SCHED;
            PG8_LDB(B0, 1, 0); PG8_LDB(B1, 1, 1); PG8_SCHED; PG8_LDA(At, 1, 0); PG8_STA(PG8_SA(0, 1), a2, 1, o2);
            PG8_WAIT_V(8); PG8_WAIT_L(0); PG8_BAR; PG8_MMA(0, 0, At, B0); PG8_MMA(0, 1, At, B1); PG8_BAR; PG8_SCHED;
            PG8_LDA(At, 1, 1); PG8_STAGE(PG8_SB(1, 0), b3, voffB[0], voffB[1]); PG8_STAGE(PG8_SB(1, 1), b3 + hstepB, voffB[0], voffB[1]); PG8_STA(PG8_SA(1, 0), a3, 0, o2);
            PG8_WAIT_V(8); PG8_WAIT_L(0); PG8_BAR; PG8_MMA(1, 0, At, B0); PG8_MMA(1, 1, At, B1); PG8_BAR; PG8_SCHED;
        }
        if constexpr (ALIGN_EPI) { if (wr == 0) PG8_BAR; }
        if constexpr (P::FP8) { asm volatile("s_nop 15\n\ts_nop 15" ::: "memory"); }
        p.epi(acc, cur, wr, wc, fr, fq);
        if (!has_next) break;
#pragma unroll
        for (int a = 0; a < 2; ++a)
#pragma unroll
            for (int b = 0; b < 2; ++b)
#pragma unroll
                for (int m = 0; m < 4; ++m)
#pragma unroll
                    for (int n = 0; n < 2; ++n) acc[a][b][m][n] = (f32x4){0.f, 0.f, 0.f, 0.f};
        cur = nxt; cA = nA; ++ui;
        if constexpr (P::GATHER) { const u32x4 onv = *(const LAS u32x4*)(lds + ONOFF + tid * 16); oc[0][0] = onv.x; oc[0][1] = onv.y; oc[1][0] = onv.z; oc[1][1] = onv.w; }
        if constexpr (ALIGN_EPI) { if (wr == 1) PG8_BAR; }
    }
    PG8_WAIT_V(0);
    if constexpr (!ALIGN_EPI) { if (wr == 0) PG8_BAR; }
    PG8_BAR;
#undef PG8_SA
#undef PG8_SB
#undef PG8_STAGE
#undef PG8_STA
#undef PG8_LDA
#undef PG8_LDB
#undef PG8_LD32
#undef PG8_LOH
#undef PG8_HIH
#undef PG8_MMA
#undef PG8_WAIT_V
#undef PG8_WAIT_L
#undef PG8_BAR
#undef PG8_SCHED
}
}

struct Args { const float* in[17]; float* out; unsigned char* ws; int ph_lo, ph_hi; };
struct Frame {
    const Args* A;
    LAS unsigned char* lds;
    volatile LAS unsigned* MISC;
    int wave, vcu, G;
};

struct TItem { const float* W; void* WT; const float* kscale; int ldw, K, k0, scol0, drow0; float sc; int fp8; };
__device__ __forceinline__ void titem_load(const TItem& t, f32x4 (&vv)[8], int lane) {
#pragma unroll
    for (int i = 0; i < 8; ++i) { const int kk = 8 * i + (lane >> 3); vv[i] = *(const f32x4*)(t.W + (size_t)(t.k0 + kk) * t.ldw + t.scol0 + 4 * (lane & 7)); }
}
__device__ __forceinline__ void titem_store(const TItem& t, const f32x4 (&vv)[8], LAS float* scr, int lane) {
#pragma unroll
    for (int i = 0; i < 8; ++i) { const int kk = 8 * i + (lane >> 3); float sc = t.sc; if (t.kscale) sc *= t.kscale[t.k0 + kk]; LAS float* d = scr + kk * 33 + 4 * (lane & 7);
        d[0] = vv[i].x * sc; d[1] = vv[i].y * sc; d[2] = vv[i].z * sc; d[3] = vv[i].w * sc; }
    LDS_WAIT(); asm volatile("" ::: "memory");
    const int c = lane & 7;
#pragma unroll
    for (int j = 0; j < 4; ++j) { const int n = (lane >> 3) + 8 * j; const LAS float* s = scr + (8 * c) * 33 + n;
        if (t.fp8) { u32x2 o; o.x = pk_fp8x4(s[0 * 33], s[1 * 33], s[2 * 33], s[3 * 33]); o.y = pk_fp8x4(s[4 * 33], s[5 * 33], s[6 * 33], s[7 * 33]);
            *(u32x2*)((unsigned char*)t.WT + (size_t)(t.drow0 + n) * t.K + t.k0 + 8 * c) = o; }
        else { u32x4 o; o.x = cvt_pk_bf16(s[0 * 33], s[1 * 33]); o.y = cvt_pk_bf16(s[2 * 33], s[3 * 33]); o.z = cvt_pk_bf16(s[4 * 33], s[5 * 33]); o.w = cvt_pk_bf16(s[6 * 33], s[7 * 33]);
            *(u32x4*)((bf16*)t.WT + (size_t)(t.drow0 + n) * t.K + t.k0 + 8 * c) = o; } }
    LDS_WAIT(); asm volatile("" ::: "memory");
}
__device__ __forceinline__ float log_sigmoid(float x) { return fminf(x, 0.f) - log1pf(__expf(-fabsf(x))); }

__device__ __forceinline__ void p0_prologue(Frame& F) {
    const int gw = F.vcu * NWAVES + F.wave, NGW = F.G * NWAVES, lane = ((int)(threadIdx.x & 63));
    const int gt = F.vcu * 512 + ((int)threadIdx.x), NGT = F.G * 512;
    {
        LAS float* scr = (LAS float*)(F.lds + F.wave * 16384);
        const float* w_in = F.A->in[3]; const float* w_out = F.A->in[7]; const float* w_gate = F.A->in[13]; const float* w_up = F.A->in[14]; const float* w_down = F.A->in[15];
        bf16* WINT = (bf16*)(F.A->ws + WS_WINT); bf16* WOUTT = (bf16*)(F.A->ws + WS_WOUTT); unsigned char* WGU = (unsigned char*)(F.A->ws + WS_WGU); unsigned char* WD = (unsigned char*)(F.A->ws + WS_WD);
        constexpr int I_IN = 32 * 224, I_OUT = 32 * 64, I_G = 16 * 32 * 32, I_D = 16 * 16 * 64;
        constexpr int NITEMS = I_IN + I_OUT + 2 * I_G + I_D;
        auto decode = [&](int it) -> TItem {
            TItem t; t.kscale = nullptr; t.sc = 1.f; t.fp8 = 0; int r = it;
            if (r < I_IN) { const int kb = r / 224, nb = r % 224, n0 = nb * 32; t.W = w_in; t.ldw = INC; t.K = DM; t.WT = WINT; t.k0 = kb * 64; t.scol0 = n0 + (n0 >= 3072 ? 8 : 0); t.drow0 = n0; return t; } r -= I_IN;
            if (r < I_OUT) { const int kb = r / 64, nb = r % 64; t.W = w_out; t.ldw = DM; t.K = DM; t.WT = WOUTT; t.k0 = kb * 64; t.scol0 = nb * 32; t.drow0 = nb * 32; t.kscale = (kb < 16) ? F.A->in[5] : (F.A->in[6] - 1024); return t; } r -= I_OUT;
            if (r < 2 * I_G) { const int up = r >= I_G; if (up) r -= I_G; const int e = r / 1024, q = r % 1024, kb = q / 32, nb = q % 32, n0 = nb * 32;
                t.W = (up ? w_up : w_gate) + (size_t)e * DM * DE; t.ldw = DE; t.K = DM; t.WT = WGU + (size_t)e * 2048 * DM; t.k0 = kb * 64; t.scol0 = n0; t.drow0 = (n0 >> 7) * 256 + up * 128 + (n0 & 127); t.sc = SW1; t.fp8 = 1; return t; } r -= 2 * I_G;
            { const int e = r / 1024, q = r % 1024, kb = q / 64, nb = q % 64; t.W = w_down + (size_t)e * DE * DM; t.ldw = DM; t.K = DE; t.WT = WD + (size_t)e * DM * DE; t.k0 = kb * 64; t.scol0 = nb * 32; t.drow0 = nb * 32; t.sc = SW2; t.fp8 = 1; return t; }
        };
        f32x4 va[8], vb[8];
        int it = gw;
        if (it < NITEMS) {
            TItem ta = decode(it); titem_load(ta, va, lane);
            for (;;) {
                const int itb = it + NGW; TItem tb = ta; const bool hb = itb < NITEMS;
                if (hb) { tb = decode(itb); titem_load(tb, vb, lane); }
                titem_store(ta, va, scr, lane);
                if (!hb) break;
                const int ita = itb + NGW; const bool ha = ita < NITEMS;
                if (ha) { ta = decode(ita); titem_load(ta, va, lane); }
                titem_store(tb, vb, scr, lane);
                if (!ha) break;
                it = ita;
            }
        }
    }
    {
        float* WRT = (float*)(F.A->ws + WS_WRT); const float* g2 = F.A->in[8]; const float* wrg = F.A->in[9]; const float* wre = F.A->in[11];
        for (int i = gt; i < 32 * DM; i += NGT) { const int j = i / DM, k = i % DM; WRT[i] = (j < 20) ? g2[k] * (j < 4 ? wrg[k * 4 + j] : wre[k * 16 + (j - 4)]) : 0.f; }
        f32x2* ROPE = (f32x2*)(F.A->ws + WS_ROPE);
        for (int i = gt; i < 4112 * 64; i += NGT) { const int pos = i >> 6, k = i & 63;
            const float lin = (float)k * (1.0f / 63.0f); const float ang = 1.0f / exp2f(lin * 13.287712379549449f);
            const float ph = (float)pos * ang; const double rev = (double)ph * 0.15915494309189535; const float fr = (float)(rev - floor(rev));
            ROPE[i] = (f32x2){__builtin_amdgcn_cosf(fr), __builtin_amdgcn_sinf(fr)}; }
        bf16* U = (bf16*)(F.A->ws + WS_U);
        for (int i = gt; i < 4 * NB * PADN * 128; i += NGT) { const int c8 = i & 127, row = (i >> 7) % PADN, bb = ((i >> 7) / PADN) % NB, cl = (i >> 7) / (PADN * NB);
            const int cls = (cl == 0) ? 1 : (cl == 1) ? 2 : (cl == 2) ? 4 : 5;
            *(u32x4*)(U + cls * USTR + ((size_t)(bb * PP + row)) * 1024 + c8 * 8) = (u32x4){0u, 0u, 0u, 0u}; }
        float* LOGF = (float*)(F.A->ws + WS_LOGF);
        for (int i = gt; i < 32 * PADN; i += NGT) LOGF[(i / PADN) * PP + (i % PADN)] = 0.f;
    }
    __syncthreads();
    {
        LAS float* WF = (LAS float*)F.lds; const float* w_in = F.A->in[3]; const float* g1 = F.A->in[2];
        for (int i = ((int)threadIdx.x); i < 8 * DM; i += 512) { const int k = i >> 3, h = i & 7; WF[h * DM + k] = g1[k] * w_in[(size_t)k * INC + 3072 + h]; }
        __syncthreads();
        f32x4 gv[8];
#pragma unroll
        for (int j = 0; j < 8; ++j) gv[j] = *((const f32x4*)g1 + lane + 64 * j);
        bf16* HN = (bf16*)(F.A->ws + WS_HN); bf16* HNMETA = (bf16*)(F.A->ws + WS_HNMETA); float* LOGF = (float*)(F.A->ws + WS_LOGF); const float* bfv = F.A->in[4];
        for (int row = gw; row < MTOK + NMETA; row += NGW) {
            const bool meta = row >= MTOK; const int mj = row - MTOK;
            const float* xr = meta ? (F.A->in[1] + (size_t)mj * DM) : (F.A->in[0] + (size_t)row * DM);
            f32x4 v[8]; float ss = 0.f;
#pragma unroll
            for (int j = 0; j < 8; ++j) { v[j] = *((const f32x4*)xr + lane + 64 * j); ss += (v[j].x * v[j].x + v[j].y * v[j].y) + (v[j].z * v[j].z + v[j].w * v[j].w); }
            const float rs = 1.0f / sqrtf(wave_sum(ss) * (1.0f / DM) + EPS);
            float fl[8];
#pragma unroll
            for (int h = 0; h < 8; ++h) { float s = 0.f;
#pragma unroll
                for (int j = 0; j < 8; ++j) { const f32x4 w = *((const LAS f32x4*)(WF + h * DM) + lane + 64 * j); s += (v[j].x * w.x + v[j].y * w.y) + (v[j].z * w.z + v[j].w * w.w); }
                fl[h] = wave_sum(s) * rs; }
            bf16* orow = meta ? (HNMETA + (size_t)mj * DM) : (HN + (size_t)row * DM);
#pragma unroll
            for (int j = 0; j < 8; ++j) { const f32x4 y = v[j] * rs * gv[j]; u32x2 w; w.x = cvt_pk_bf16(y.x, y.y); w.y = cvt_pk_bf16(y.z, y.w); *((u32x2*)orow + lane + 64 * j) = w; }
            if (lane < 8) { float f = fl[0];
#pragma unroll
                for (int h = 1; h < 8; ++h) f = (lane == h) ? fl[h] : f;
                const float lf = log_sigmoid(f + bfv[lane]);
                if (meta) { for (int bb = 0; bb < NB; ++bb) LOGF[(bb * NH + lane) * PP + PADN + mj] = lf; }
                else { const int bb = row >> 12, t = row & 4095; LOGF[(bb * NH + lane) * PP + 128 + t] = lf; } }
        }
    }
}

__device__ __forceinline__ void p1_cumsum(Frame& F) {
    const int gw = F.vcu * NWAVES + F.wave, NGW = F.G * NWAVES, lane = ((int)(threadIdx.x & 63));
    const float* LOGF = (const float*)(F.A->ws + WS_LOGF); float* CUM = (float*)(F.A->ws + WS_CUM);
    for (int s = gw; s < NB * NH; s += NGW) {
        const float* src = LOGF + (size_t)s * PP + lane * 66; float* dst = CUM + (size_t)s * PP + lane * 66;
        float loc = 0.f; for (int i = 0; i < 66; ++i) loc += src[i];
        float inc = loc;
#pragma unroll
        for (int o = 1; o < 64; o <<= 1) { const float t = __shfl_up(inc, o); if (lane >= o) inc += t; }
        float run = inc - loc;
        for (int i = 0; i < 66; ++i) { run += src[i]; dst[i] = run; }
    }
}
__device__ __forceinline__ void p1_meta_kv(Frame& F) {
    const int lane = ((int)(threadIdx.x & 63)), w = F.wave;
    const bf16* HNMETA = (const bf16*)(F.A->ws + WS_HNMETA); const bf16* WINT = (const bf16*)(F.A->ws + WS_WINT); bf16* U = (bf16*)(F.A->ws + WS_U);
    const f32x2* ROPE = (const f32x2*)(F.A->ws + WS_ROPE);
    LAS float* red = (LAS float*)F.lds;
    for (int blk = blockIdx.x; blk < 256; blk += F.G) {
        const int kv0 = blk * 16, q = kv0 >> 10, col0 = kv0 & 1023;
        const int cls = (q == 0) ? 1 : (q == 1) ? 2 : (q == 2) ? 4 : 5;
        const int nrow0 = ((q == 0) ? 1024 : (q == 1) ? 2048 : (q == 2) ? 4096 : 5120) + col0;
        f32x4 acc = (f32x4){0.f, 0.f, 0.f, 0.f};
#pragma unroll
        for (int s = 0; s < 8; ++s) { const int k0 = w * 256 + s * 32 + 8 * (lane >> 4);
            const bf16x8 a = *(const bf16x8*)(HNMETA + (size_t)(lane & 15) * DM + k0);
            const bf16x8 b = *(const bf16x8*)(WINT + (size_t)(nrow0 + (lane & 15)) * DM + k0);
            acc = __builtin_amdgcn_mfma_f32_16x16x32_bf16(a, b, acc, 0, 0, 0); }
#pragma unroll
        for (int r = 0; r < 4; ++r) red[w * 256 + ((lane >> 4) * 4 + r) * 16 + (lane & 15)] = acc[r];
        __syncthreads();
        if (((int)threadIdx.x) < 256) { const int row = ((int)threadIdx.x) >> 4, col = ((int)threadIdx.x) & 15;
            float v = 0.f, vp = 0.f;
#pragma unroll
            for (int ww = 0; ww < 8; ++ww) { v += red[ww * 256 + row * 16 + col]; vp += red[ww * 256 + row * 16 + (col ^ 1)]; }
            float o = v;
            if (q == 2) { const int d = (col0 + col) & 127; const f32x2 cs = ROPE[row * 64 + (d >> 1)];
                const int hh = (col0 + col) >> 7; const float lg2h = log2f(1.0f - exp2f(-5.0f - (float)hh));
                o = ((col & 1) ? (v * cs.x + vp * cs.y) : (v * cs.x - vp * cs.y)) * SCALE * exp2f(-(float)(PADN + row + 1) * lg2h); }
            const unsigned short ob = (unsigned short)(cvt_pk_bf16(o, 0.f) & 0xffffu);
            for (int bb = 0; bb < NB; ++bb) U[cls * USTR + ((size_t)(bb * PP + PADN + row)) * 1024 + col0 + col] = ob; }
        __syncthreads();
    }
}

struct PInProj {
    static constexpr bool PERM = true, HAS_MID = false, FP8 = false, GATHER = false;
    int nt; const char* Abase; unsigned lda2, ldb2; const char* Bt; bf16* U; const f32x2* ROPE;
    __device__ __forceinline__ void a_offs(const g8::Unit&, unsigned (&)[2][2]) const {}
    __device__ __forceinline__ const char* b_tile(const g8::Unit& u, int t) const { return Bt + (size_t)u.pn * 256 * ldb2 + (size_t)t * 128; }
    __device__ __forceinline__ void mid(f32x4 (&)[2][2][4][2], const g8::Unit&, int, int, int, int) const {}
    __device__ __forceinline__ void epi(const f32x4 (&acc)[2][2][4][2], const g8::Unit& u, int wr, int wc, int fr, int fq) const {
        const int cls = u.pn >> 2;
        bf16* base = U + (size_t)cls * USTR;
        const int ccol0 = (u.pn & 3) * 256 + wc * 32 + 8 * fq;
        const int bb = u.pm >> 4;
#pragma unroll
        for (int ai = 0; ai < 2; ++ai)
#pragma unroll
            for (int m = 0; m < 4; ++m) {
                const int t = ((u.pm & 15) << 8) + ai * 128 + wr * 64 + m * 16 + fr;
                bf16* rowp = base + ((size_t)(bb * PP + 128 + t)) * 1024 + ccol0;
                f32x4 c0 = (f32x4){1.f, 0.f, 1.f, 0.f}, c1 = c0;
                if (cls == 3 || cls == 4) { const f32x4* rp = (const f32x4*)(ROPE + (size_t)(t + 16) * 64 + wc * 16 + fq * 4); c0 = rp[0]; c1 = rp[1]; }
#pragma unroll
                for (int bj = 0; bj < 2; ++bj) {
                    f32x4 v0 = acc[ai][bj][m][0], v1 = acc[ai][bj][m][1];
                    if (cls == 3 || cls == 4) {
                        f32x4 r0, r1;
                        r0.x = v0.x * c0.x - v0.y * c0.y; r0.y = v0.y * c0.x + v0.x * c0.y; r0.z = v0.z * c0.z - v0.w * c0.w; r0.w = v0.w * c0.z + v0.z * c0.w;
                        r1.x = v1.x * c1.x - v1.y * c1.y; r1.y = v1.y * c1.x + v1.x * c1.y; r1.z = v1.z * c1.z - v1.w * c1.w; r1.w = v1.w * c1.z + v1.z * c1.w;
                        const int hh = (u.pn & 3) * 2 + bj; const float lg2h = log2f(1.0f - exp2f(-5.0f - (float)hh)); const float ip1 = (float)((t & 127) + 1);
                        const float sc = (cls == 4) ? SCALE * exp2f(-ip1 * lg2h) : exp2f(ip1 * lg2h); v0 = r0 * sc; v1 = r1 * sc;
                    } else if (cls == 6) {
#pragma unroll
                        for (int e = 0; e < 4; ++e) { v0[e] = v0[e] / (1.f + __expf(-v0[e])); v1[e] = v1[e] / (1.f + __expf(-v1[e])); }
                    }
                    u32x4 w; w.x = cvt_pk_bf16(v0[0], v0[1]); w.y = cvt_pk_bf16(v0[2], v0[3]); w.z = cvt_pk_bf16(v1[0], v1[1]); w.w = cvt_pk_bf16(v1[2], v1[3]);
                    *(u32x4*)(rowp + bj * 128) = w;
                }
            }
    }
};

template <bool RET>
__device__ __forceinline__ void attn_simple(Frame& F) {
    const int gw = F.vcu * NWAVES + F.wave, NGW = F.G * NWAVES, lane = ((int)(threadIdx.x & 63));
    LAS float* wl = (LAS float*)(F.lds + F.wave * 1024);
    const bf16* U = (const bf16*)(F.A->ws + WS_U); const float* CUM = (const float*)(F.A->ws + WS_CUM);
    bf16* OA = (bf16*)(F.A->ws + WS_HN); float* SSQ = (float*)(F.A->ws + WS_SSQ);
    for (int row = gw; row < NB * NH * SEQ; row += NGW) {
        const int t = row & 4095, bh = row >> 12, b = bh >> 3, h = bh & 7, p = 128 + t, m = b * SEQ + t;
        const bf16* Qb = U + (RET ? 3 : 0) * USTR + ((size_t)(b * PP + p)) * 1024 + h * 128;
        const bf16* Kb = U + (RET ? 4 : 1) * USTR + ((size_t)b * PP) * 1024 + h * 128;
        const bf16* Vb = U + (RET ? 5 : 2) * USTR + ((size_t)b * PP) * 1024 + h * 128;
        { const unsigned qw = *(const unsigned*)(Qb + 2 * lane); wl[2 * lane] = bf_lo(qw); wl[2 * lane + 1] = bf_hi(qw); }
        LDS_WAIT(); asm volatile("" ::: "memory");
        float m_run = -1e30f, l_run = 0.f, o0 = 0.f, o1 = 0.f;
        const float ct = RET ? 0.f : CUM[(size_t)bh * PP + p];
        const float lg2 = RET ? log2f(1.0f - exp2f(-5.0f - (float)h)) : 0.f;
        for (int s0 = 64; s0 <= p; s0 += 64) {
            const int s = s0 + lane;
            const bf16* kr = Kb + (size_t)s * 1024;
            float sc = 0.f;
#pragma unroll
            for (int c = 0; c < 16; ++c) { const u32x4 kv = *(const u32x4*)(kr + 8 * c); const f32x4 qa = *(const LAS f32x4*)(wl + 8 * c), qb = *(const LAS f32x4*)(wl + 8 * c + 4);
                sc += bf_lo(kv.x) * qa.x + bf_hi(kv.x) * qa.y + bf_lo(kv.y) * qa.z + bf_hi(kv.y) * qa.w + bf_lo(kv.z) * qb.x + bf_hi(kv.z) * qb.y + bf_lo(kv.w) * qb.z + bf_hi(kv.w) * qb.w; }
            const bool valid = (s <= p) && (s >= PADN);
            float pw;
            if constexpr (RET) { pw = valid ? sc * exp2f((float)(((p >> 7) - (s >> 7)) * 128) * lg2) : 0.f; }
            else {
                const float lg = valid ? (sc * SCALE + (ct - CUM[(size_t)bh * PP + s])) : -__builtin_inff();
                const float mn = fmaxf(m_run, wave_max(lg)); const float alpha = __expf(m_run - mn);
                pw = valid ? __expf(lg - mn) : 0.f;
                l_run = l_run * alpha + wave_sum(pw); o0 *= alpha; o1 *= alpha; m_run = mn;
            }
            asm volatile("" ::: "memory");
            wl[128 + lane] = pw;
            LDS_WAIT(); asm volatile("" ::: "memory");
#pragma unroll 8
            for (int k = 0; k < 64; ++k) { const float pk = wl[128 + k]; const unsigned vw = *(const unsigned*)(Vb + (size_t)(s0 + k) * 1024 + 2 * lane); o0 += pk * bf_lo(vw); o1 += pk * bf_hi(vw); }
            LDS_WAIT(); asm volatile("" ::: "memory");
        }
        if constexpr (RET) {
            const float mu = wave_sum(o0 + o1) * (1.0f / HD); const float d0 = o0 - mu, d1 = o1 - mu;
            const float var = wave_sum(d0 * d0 + d1 * d1) * (1.0f / HD); const float r = 1.0f / sqrtf(var + EPS);
            const unsigned gw2 = *(const unsigned*)(U + 6 * USTR + ((size_t)(b * PP + p)) * 1024 + h * 128 + 2 * lane);
            *(unsigned*)(OA + (size_t)m * DM + 1024 + h * 128 + 2 * lane) = cvt_pk_bf16(d0 * r * bf_lo(gw2), d1 * r * bf_hi(gw2));
        } else {
            const float il = 1.0f / l_run; o0 *= il; o1 *= il;
            *(unsigned*)(OA + (size_t)m * DM + h * 128 + 2 * lane) = cvt_pk_bf16(o0, o1);
            const float sq = wave_sum(o0 * o0 + o1 * o1); if (lane == 0) SSQ[(size_t)m * 8 + h] = sq;
        }
        asm volatile("" ::: "memory");
    }
}


namespace fox {
constexpr int NW = 8, QBLK = 32, KVBLK = 64, QB = 256, D = 128, LDQ = 1024, LDO = 2048;
constexpr int SHM_V = KVBLK * D * 2, SHM_K = KVBLK * D * 2;
constexpr int OFF_WS = 2 * SHM_V + 2 * SHM_K, OFF_CUM = OFF_WS + 2048, LDS_NEED = OFF_CUM + PP * 4;
static_assert(LDS_NEED <= RING_BYTES, "fox lds");
constexpr float THR = 8.f;
constexpr float INVS = 11.313708498984761f;
typedef float f32x16 __attribute__((ext_vector_type(16)));
typedef short s16x4 __attribute__((ext_vector_type(4)));
#define KSWZ(row, colB) ((row) * 256 + ((colB) ^ (((row) & 7) << 4)))
#define SBAR() __builtin_amdgcn_sched_barrier(0)
__device__ __forceinline__ int v_st(int k, int c) { const int kk = (k & ~0xC) | ((k & 4) << 1) | ((k & 8) >> 1); return ((kk >> 3) * 4 + (c >> 5)) * 512 + ((kk & 7) * 32 + (c & 31)) * 2; }
__device__ __forceinline__ int v_rd_base(int lane) { return ((lane & 3) << 3) | (((lane >> 2) & 3) << 6) | (((lane >> 4) & 1) << 5) | (((lane >> 5) & 1) << 8); }
constexpr int v_rd_off(int d0, int ks, int half) { return d0 * 512 + ks * 4096 + half * 2048; }
__device__ __forceinline__ int crow(int r, int hi) { return (r & 3) + 8 * (r >> 2) + 4 * hi; }
__device__ __forceinline__ unsigned cvtpk(float lo, float hi) { unsigned r; asm volatile("v_cvt_pk_bf16_f32 %0, %1, %2" : "=v"(r) : "v"(lo), "v"(hi)); return r; }
__device__ __forceinline__ bf16x8 load8(const bf16* p) { return *reinterpret_cast<const bf16x8*>(p); }
__device__ __forceinline__ void mask_causal(f32x16& p0, f32x16& p1, int dq) {
    const float NEG = -__builtin_inff();
#pragma unroll
    for (int r = 0; r < 16; ++r) { const int c = (r & 3) + 8 * (r >> 2); if (dq - c < 0) p0[r] = NEG; if (dq - c - 32 < 0) p1[r] = NEG; }
}
__device__ __forceinline__ void mask_pad(f32x16& p0, f32x16& p1, int hi) {
    const float NEG = -__builtin_inff();
#pragma unroll
    for (int r = 0; r < 16; ++r) { const int c = (r & 3) + 8 * (r >> 2); p0[r] = NEG; if (c + 4 * hi < 16) p1[r] = NEG; }
}
__device__ __forceinline__ void partialSM(f32x16& p0, f32x16& p1, float& m_reg, float& mn, float& alpha) {
    float pmax = p0[0]; for (int r = 1; r < 16; ++r) pmax = fmaxf(pmax, p0[r]); for (int r = 0; r < 16; ++r) pmax = fmaxf(pmax, p1[r]);
    { auto rr = __builtin_amdgcn_permlane32_swap(__float_as_uint(pmax), __float_as_uint(pmax), false, false);
      pmax = fmaxf(__uint_as_float(rr[0]), __uint_as_float(rr[1])); }
    constexpr float C2 = 1.4426950408889634f * SCALE;
    if (__builtin_expect(__all((pmax - m_reg) * SCALE <= THR), 1)) { mn = m_reg; alpha = 1.f; }
    else { mn = fmaxf(m_reg, pmax); alpha = __builtin_amdgcn_exp2f((m_reg - mn) * C2); m_reg = mn; }
    const float mnL = -mn * C2;
    for (int r = 0; r < 16; ++r) p0[r] = fmaf(p0[r], C2, mnL); for (int r = 0; r < 16; ++r) p1[r] = fmaf(p1[r], C2, mnL);
    for (int r = 0; r < 16; ++r) p0[r] = __builtin_amdgcn_exp2f(p0[r]);
}
__device__ __forceinline__ void finishSM(f32x16& p0, f32x16& p1, float alpha, float& l_reg, bf16x8& pa0, bf16x8& pa1, bf16x8& pa2, bf16x8& pa3) {
    for (int r = 0; r < 16; ++r) p1[r] = __builtin_amdgcn_exp2f(p1[r]);
    float ps = 0; for (int r = 0; r < 16; ++r) ps += p0[r]; for (int r = 0; r < 16; ++r) ps += p1[r];
    { auto rr = __builtin_amdgcn_permlane32_swap(__float_as_uint(ps), __float_as_uint(ps), false, false);
      ps = __uint_as_float(rr[0]) + __uint_as_float(rr[1]); }
    l_reg = l_reg * alpha + ps;
#define PK4(P, B_, OUT) do { unsigned a0 = cvtpk(P[B_+0], P[B_+1]), a1 = cvtpk(P[B_+2], P[B_+3]);                          \
        unsigned b0 = cvtpk(P[B_+4], P[B_+5]), b1 = cvtpk(P[B_+6], P[B_+7]);                                             \
        auto r0 = __builtin_amdgcn_permlane32_swap(a0, b0, false, false); auto r1 = __builtin_amdgcn_permlane32_swap(a1, b1, false, false); \
        u32x4 w = {r0[0], r1[0], r0[1], r1[1]}; OUT = *reinterpret_cast<bf16x8*>(&w); } while (0)
    PK4(p0, 0, pa0); PK4(p0, 8, pa1); PK4(p1, 0, pa2); PK4(p1, 8, pa3);
#undef PK4
}
template <int KB>
__device__ __forceinline__ void qkt(f32x16& p0, f32x16& p1, const LAS char* K_lds, int r32, int hi, const bf16x8* qr, const LAS float* cs) {
#pragma unroll
    for (int g = 0; g < 4; ++g) { const f32x4 a = *(const LAS f32x4*)(cs + 8 * g), b = *(const LAS f32x4*)(cs + 32 + 8 * g);
        p0[4 * g] = a[0]; p0[4 * g + 1] = a[1]; p0[4 * g + 2] = a[2]; p0[4 * g + 3] = a[3]; p1[4 * g] = b[0]; p1[4 * g + 1] = b[1]; p1[4 * g + 2] = b[2]; p1[4 * g + 3] = b[3]; }
    const LAS char* kb[4];
#pragma unroll
    for (int dd = 0; dd < 4; ++dd) kb[dd] = K_lds + KB * SHM_K + KSWZ(r32, (dd * 16 + hi * 8) * 2);
#pragma unroll
    for (int d0 = 0; d0 < 8; ++d0) { const LAS char* a = kb[d0 & 3] + (d0 >> 2) * 128;
        bf16x8 b0 = *reinterpret_cast<const LAS bf16x8*>(a);
        bf16x8 b1 = *reinterpret_cast<const LAS bf16x8*>(a + 32 * 256);
        p0 = __builtin_amdgcn_mfma_f32_32x32x16_bf16(b0, qr[d0], p0, 0, 0, 0);
        p1 = __builtin_amdgcn_mfma_f32_32x32x16_bf16(b1, qr[d0], p1, 0, 0, 0); }
}
template <int VB>
__device__ __forceinline__ void pv_tile(f32x16* o, int vb0, bf16x8 pa0, bf16x8 pa1, bf16x8 pa2, bf16x8 pa3) {
#define TRRD(dst, off) asm volatile("ds_read_b64_tr_b16 %0, %1 offset:%2" : "=&v"(dst) : "v"(vb0), "i"(off) : "memory")
#define PV_D0(d0) do { s16x4 l0, l1, l2, l3, h0, h1, h2, h3; constexpr int b_ = VB * SHM_V + v_rd_off(d0, 0, 0); \
        TRRD(l0, b_); TRRD(h0, b_ + 2048); TRRD(l1, b_ + 4096); TRRD(h1, b_ + 6144); TRRD(l2, b_ + 8192); TRRD(h2, b_ + 10240); TRRD(l3, b_ + 12288); TRRD(h3, b_ + 14336); \
        asm volatile("s_waitcnt lgkmcnt(0)" ::: "memory"); SBAR();   \
        o[d0] = __builtin_amdgcn_mfma_f32_32x32x16_bf16(pa0, (bf16x8){l0[0], l0[1], l0[2], l0[3], h0[0], h0[1], h0[2], h0[3]}, o[d0], 0, 0, 0);   \
        o[d0] = __builtin_amdgcn_mfma_f32_32x32x16_bf16(pa1, (bf16x8){l1[0], l1[1], l1[2], l1[3], h1[0], h1[1], h1[2], h1[3]}, o[d0], 0, 0, 0);   \
        o[d0] = __builtin_amdgcn_mfma_f32_32x32x16_bf16(pa2, (bf16x8){l2[0], l2[1], l2[2], l2[3], h2[0], h2[1], h2[2], h2[3]}, o[d0], 0, 0, 0);   \
        o[d0] = __builtin_amdgcn_mfma_f32_32x32x16_bf16(pa3, (bf16x8){l3[0], l3[1], l3[2], l3[3], h3[0], h3[1], h3[2], h3[3]}, o[d0], 0, 0, 0); } while (0)
    PV_D0(0); PV_D0(1); PV_D0(2); PV_D0(3);
#undef PV_D0
#undef TRRD
}
struct BlockRef { int bh, qb; };
struct Bases { const bf16* U; bf16* OA; float* SSQ; const float* CUM; };
__device__ __forceinline__ int blk_p0(const BlockRef& r) { return 128 + r.qb * 256; }
__device__ __forceinline__ const bf16* blk_q(const Bases& B, const BlockRef& r) { return B.U + ((size_t)((r.bh >> 3) * PP + blk_p0(r))) * 1024 + (r.bh & 7) * 128; }
__device__ __forceinline__ const bf16* blk_k(const Bases& B, const BlockRef& r) { return B.U + 1 * USTR + ((size_t)(r.bh >> 3) * PP) * 1024 + (r.bh & 7) * 128; }
__device__ __forceinline__ const bf16* blk_v(const Bases& B, const BlockRef& r) { return B.U + 2 * USTR + ((size_t)(r.bh >> 3) * PP) * 1024 + (r.bh & 7) * 128; }
struct Seam { bf16x8 qr[8]; bf16x8 st_v0, st_v1, st_k0, st_k1; };
#define ROW(p, k0, rr) ((p) + (size_t)((k0) + (rr)) * LDQ + sc)
#define VMW() asm volatile("s_waitcnt vmcnt(0)" ::: "memory")
#define VMWN(n) asm volatile("s_waitcnt vmcnt(%0)" :: "i"(n) : "memory")
#define SLOAD_H(Kp, Vp, k0) do { S.st_v0 = load8(ROW(Vp, k0, sr)); S.st_v1 = load8(ROW(Vp, k0, 32 + sr));              \
                         S.st_k0 = load8(ROW(Kp, k0, sr)); S.st_k1 = load8(ROW(Kp, k0, 32 + sr)); } while (0)
#define SWRITE_HK(bf) do { *(LAS bf16x8*)(K_lds + (bf) * SHM_K + kws) = S.st_k0; *(LAS bf16x8*)(K_lds + (bf) * SHM_K + kws + 32 * 256) = S.st_k1; } while (0)
#define SWRITE_HV(bf) do { *(LAS bf16x8*)(V_lds + (bf) * SHM_V + vst0) = S.st_v0; *(LAS bf16x8*)(V_lds + (bf) * SHM_V + vst1) = S.st_v1; } while (0)
#define SWRITE_H(bf) do { SWRITE_HV(bf); SWRITE_HK(bf); } while (0)
__device__ __forceinline__ void prime(const Bases& B, const BlockRef& cur, LAS char* lds, Seam& S) {
    const int tid = threadIdx.x, wid = __builtin_amdgcn_readfirstlane(tid >> 6), lane = tid & 63, r32 = lane & 31, hi = lane >> 5;
    const int sr = tid >> 4, sc = (tid & 15) * 8, kws = KSWZ(sr, sc * 2); LAS char* K_lds = lds + 2 * SHM_V;
    const int kb0 = KVBLK;
#pragma unroll
    for (int d0 = 0; d0 < 8; ++d0) S.qr[d0] = load8(blk_q(B, cur) + (size_t)(wid * QBLK + r32) * LDQ + d0 * 16 + hi * 8);
    { const bf16* Kp = blk_k(B, cur); const bf16* Vp = blk_v(B, cur); SLOAD_H(Kp, Vp, kb0); } VMW(); SWRITE_HK(0);
    __syncthreads();
}
__device__ __forceinline__ void block(const Bases& B, const BlockRef& cur, const BlockRef& nxt, LAS char* lds, Seam& S) {
    const int tid = threadIdx.x, wid = __builtin_amdgcn_readfirstlane(tid >> 6), lane = tid & 63, r32 = lane & 31, hi = lane >> 5;
    const int P0 = blk_p0(cur);
    const int j_hi = (P0 + QB - 1) / KVBLK + 1;
    const int NT = j_hi - 1;
    const int kbn = KVBLK;
    const int qlo = P0 + wid * QBLK, qm = qlo + r32 - 4 * hi;
    LAS char* V_lds = lds; LAS char* K_lds = lds + 2 * SHM_V;
    LAS float* ws = (LAS float*)(lds + OFF_WS) + wid * 64; LAS float* li_l = ws; LAS float* al_l = ws + 32;
    LAS float* cumS = (LAS float*)(lds + OFF_CUM);
    { const float* CUMG = B.CUM + (size_t)cur.bh * PP; const float cref = CUMG[P0]; const int n4 = (P0 + QB) >> 2;
      for (int i = tid; i < n4; i += 512) { const f32x4 c = *((const f32x4*)CUMG + i); *((LAS f32x4*)cumS + i) = (cref - c) * INVS; } }
    __syncthreads();
    float m_reg = -1e30f, l_reg = 0; f32x16 o[4] = {};
    const int sr = tid >> 4, sc = (tid & 15) * 8, vst0 = v_st(sr, sc), vst1 = v_st(32 + sr, sc), kws = KSWZ(sr, sc * 2);
    const int vb0 = (int)(uintptr_t)V_lds + v_rd_base(lane);
    const bf16* Kh = blk_k(B, cur); const bf16* Vh = blk_v(B, cur);
#define RESC(a) do { if (__any((a) < 1.f)) { if (hi == 0) al_l[r32] = (a); asm volatile("s_waitcnt lgkmcnt(0)" ::: "memory");              \
                     for (int d_ = 0; d_ < 4; ++d_) for (int r = 0; r < 16; ++r) o[d_][r] *= al_l[crow(r, hi)]; } } while (0)
#define KBASE(t) ((1 + (t)) * KVBLK)
#define CSP(t) (cumS + KBASE(t) + 4 * hi)
#define MASKT(P0_, P1_, t) do { const int kb_ = KBASE(t); if (kb_ + KVBLK - 1 > qlo) mask_causal(P0_, P1_, qm - kb_); if (kb_ == KVBLK) mask_pad(P0_, P1_, hi); } while (0)
#define SEAM_K0() do { VMWN(8); SWRITE_HK(0); SBAR(); } while (0)
    f32x16 pA0, pA1, pB0, pB1; float mnA, mnB, alA, alB; bf16x8 pa0, pa1, pa2, pa3;
    SWRITE_HV(0); SBAR();
    if (NT > 1) { SLOAD_H(Kh, Vh, KBASE(1)); }
    SBAR(); qkt<0>(pA0, pA1, K_lds, r32, hi, S.qr, CSP(0));
    MASKT(pA0, pA1, 0); partialSM(pA0, pA1, m_reg, mnA, alA);
    if (NT > 1) { VMW(); SWRITE_H(1); }
    __syncthreads();
#define HALF_STEP(PX0, PX1, mnX, alX, PY0, PY1, alY, t, KB, VB, SB) do {                                                      \
        SBAR(); qkt<KB>(PX0, PX1, K_lds, r32, hi, S.qr, CSP(t));                                             \
        finishSM(PY0, PY1, alY, l_reg, pa0, pa1, pa2, pa3); SBAR();                                                           \
        if ((t) + 1 < NT) { SLOAD_H(Kh, Vh, KBASE((t) + 1)); SBAR(); }                                               \
        pv_tile<VB>(o, vb0, pa0, pa1, pa2, pa3); MASKT(PX0, PX1, (t)); partialSM(PX0, PX1, m_reg, mnX, alX);                                        \
        __syncthreads();                                                                                                      \
        if ((t) + 1 < NT) { VMW(); SWRITE_H(SB); }                                                                          \
        RESC(alX); __syncthreads(); } while (0)
    for (int t = 1; t + 1 < NT; t += 2) {
        HALF_STEP(pB0, pB1, mnB, alB, pA0, pA1, alA, t, 1, 0, 0);
        HALF_STEP(pA0, pA1, mnA, alA, pB0, pB1, alB, t + 1, 0, 1, 1);
    }
    const bool even = (NT & 1) == 0;
    if (even) { SBAR(); qkt<1>(pB0, pB1, K_lds, r32, hi, S.qr, CSP(NT - 1)); SBAR(); }
    { const bf16* Kn = blk_k(B, nxt); const bf16* Vn = blk_v(B, nxt); SLOAD_H(Kn, Vn, kbn); } SBAR();
    { const bf16* Qn = blk_q(B, nxt);
#pragma unroll
    for (int d0 = 0; d0 < 8; ++d0) S.qr[d0] = load8(Qn + (size_t)(wid * QBLK + r32) * LDQ + d0 * 16 + hi * 8); }
    SBAR();
    finishSM(pA0, pA1, alA, l_reg, pa0, pa1, pa2, pa3); SBAR();
    pv_tile<0>(o, vb0, pa0, pa1, pa2, pa3);
    if (even) { MASKT(pB0, pB1, NT - 1); partialSM(pB0, pB1, m_reg, mnB, alB); __syncthreads(); RESC(alB);
        finishSM(pB0, pB1, alB, l_reg, pa0, pa1, pa2, pa3); SBAR(); pv_tile<1>(o, vb0, pa0, pa1, pa2, pa3); }
    SBAR(); SEAM_K0();
    if (hi == 0) li_l[r32] = l_reg; asm volatile("s_waitcnt lgkmcnt(0)" ::: "memory");
    float rli[16];
#pragma unroll
    for (int r = 0; r < 16; ++r) rli[r] = __builtin_amdgcn_rcpf(li_l[crow(r, hi)]);
    int r32e = r32, hie = hi; asm volatile("" : "+v"(r32e), "+v"(hie));
    const size_t m0 = (size_t)(cur.bh >> 3) * SEQ + cur.qb * 256 + wid * QBLK + 4 * hie;
    bf16* Ow = B.OA + m0 * LDO + (cur.bh & 7) * 128 + r32e; float* Sw = B.SSQ + m0 * 8 + (cur.bh & 7);
#pragma unroll
    for (int r = 0; r < 16; ++r) { const int orow = (r & 3) + 8 * (r >> 2); float sq = 0.f;
#pragma unroll
        for (int d0 = 0; d0 < 4; ++d0) { const float v = o[d0][r] * rli[r]; sq += v * v;
            const float vn = __shfl_xor(v, 1);
            if ((r32e & 1) == 0) *(unsigned*)(Ow + (size_t)orow * LDO + d0 * 32) = cvtpk(v, vn); }
        sq += __shfl_xor(sq, 1); sq += __shfl_xor(sq, 2); sq += __shfl_xor(sq, 4); sq += __shfl_xor(sq, 8); sq += __shfl_xor(sq, 16);
        if (r32e == 0) Sw[(size_t)orow * 8] = sq; }
    __syncthreads();
#undef RESC
#undef KBASE
#undef CSP
#undef MASKT
#undef SEAM_K0
#undef HALF_STEP
}
#undef ROW
#undef VMW
#undef VMWN
#undef SLOAD_H
#undef SWRITE_HK
#undef SWRITE_HV
#undef SWRITE_H
#undef KSWZ
#undef SBAR
}

__device__ __forceinline__ void fox_phase(Frame& F) {
    const int total = NB * NH * 8, stride = F.G; int L = F.vcu; if (L >= total) return;
    const fox::Bases B{(const bf16*)(F.A->ws + WS_U), (bf16*)(F.A->ws + WS_HN), (float*)(F.A->ws + WS_SSQ), (const float*)(F.A->ws + WS_CUM)};
    int pass = 0;
    fox::BlockRef cur{L >> 3, L & 7};
    fox::Seam S;
    fox::prime(B, cur, (LAS char*)F.lds, S);
    for (;;) {
        const bool more_pass = pass == 0, more_item = L + stride < total, last = !more_pass && !more_item;
        int Ln = L, passn = pass + 1;
        if (!more_pass) { passn = 0; Ln = more_item ? L + stride : L; }
        fox::BlockRef nxt{Ln >> 3, passn ? 15 - (Ln & 7) : (Ln & 7)};
        if (last) nxt = cur;
        fox::block(B, cur, nxt, (LAS char*)F.lds, S);
        if (last) break;
        cur = nxt; pass = passn; L = Ln;
    }
}


namespace ret {
typedef short s16x4 __attribute__((ext_vector_type(4)));
typedef short v4i16_t __attribute__((ext_vector_type(4)));
__device__ __forceinline__ s16x4 vtr(const LAS char* p) { return __builtin_bit_cast(s16x4, __builtin_amdgcn_ds_read_tr16_b64_v4i16((LAS v4i16_t*)p)); }
__device__ __forceinline__ int kswz(int row, int colB) { return row * 256 + (colB ^ ((row & 7) << 4)); }
__device__ __forceinline__ int vswz(int row, int colB) { return row * 256 + (colB ^ ((row & 7) << 5)); }
__device__ __forceinline__ int aswz(int row, int colB) { return row * 256 + (colB ^ ((((row & 3) | ((row >> 1) & 4))) << 5)); }
constexpr int A_KB = 32768, A_VB = 4096, A_OFF_V = 2 * A_KB;
__device__ __forceinline__ void states(Frame& F) {
    const int tid = ((int)threadIdx.x), lane = ((int)(threadIdx.x & 63)), w = F.wave, g = lane >> 4, q = (lane & 15) >> 2, pp = lane & 3;
    const bf16* U = (const bf16*)(F.A->ws + WS_U); bf16* ST = (bf16*)(F.A->ws + WS_ST);
    LAS char* lds = (LAS char*)F.lds;
    for (int unit = F.vcu; unit < NB * NH * 8; unit += F.G) {
        const int bh = unit >> 3, es = unit & 7, b = bh >> 3, h = bh & 7;
        const bf16* Kg = U + 4 * USTR + ((size_t)b * PP) * 1024 + h * 128;
        const bf16* Vg = U + 5 * USTR + ((size_t)b * PP) * 1024 + h * 128 + es * 16;
        const float wdec = exp2f(128.0f * log2f(1.0f - exp2f(-5.0f - (float)h)));
        f32x4 S = (f32x4){0.f, 0.f, 0.f, 0.f};
        u32x4 krA[4], vrA, krB[4], vrB;
#define RA_LOAD(kr, vr, n) do { _Pragma("unroll") for (int i = 0; i < 4; ++i) { const int pc = tid + 512 * i, row = pc >> 4, c16 = pc & 15; kr[i] = *(const u32x4*)(Kg + (size_t)((n) * 128 + row) * 1024 + c16 * 8); } \
        if (tid < 256) { const int row = tid >> 1, c16 = tid & 1; vr = *(const u32x4*)(Vg + (size_t)((n) * 128 + row) * 1024 + c16 * 8); } } while (0)
#define RA_WRITE(kr, vr, bf) do { _Pragma("unroll") for (int i = 0; i < 4; ++i) { const int pc = tid + 512 * i, row = pc >> 4, c16 = pc & 15; *(LAS u32x4*)(lds + (bf) * A_KB + aswz(row, c16 * 16)) = kr[i]; } \
        if (tid < 256) { const int row = tid >> 1, c16 = tid & 1; *(LAS u32x4*)(lds + A_OFF_V + (bf) * A_VB + row * 32 + c16 * 16) = vr; } } while (0)
#define RA_STEP(n, bf) do { f32x4 acc = (f32x4){0.f, 0.f, 0.f, 0.f}; \
            _Pragma("unroll") for (int s = 0; s < 4; ++s) { const int r0 = 32 * s + 8 * g + q; \
                const s16x4 a0 = vtr(lds + (bf) * A_KB + aswz(r0, (16 * w + 4 * pp) * 2)), a1 = vtr(lds + (bf) * A_KB + aswz(r0 + 4, (16 * w + 4 * pp) * 2)); \
                const s16x4 b0 = vtr(lds + A_OFF_V + (bf) * A_VB + r0 * 32 + pp * 8), b1 = vtr(lds + A_OFF_V + (bf) * A_VB + (r0 + 4) * 32 + pp * 8); \
                acc = __builtin_amdgcn_mfma_f32_16x16x32_bf16((bf16x8){a0[0], a0[1], a0[2], a0[3], a1[0], a1[1], a1[2], a1[3]}, (bf16x8){b0[0], b0[1], b0[2], b0[3], b1[0], b1[1], b1[2], b1[3]}, acc, 0, 0, 0); } \
            S = (S + acc) * wdec; \
            { u32x2 o; o.x = cvt_pk_bf16(S[0], S[1]); o.y = cvt_pk_bf16(S[2], S[3]); \
              *(u32x2*)(ST + (((size_t)bh * 32 + (n)) * 128 + es * 16 + (lane & 15)) * 128 + 16 * w + 4 * g) = o; } } while (0)
        RA_LOAD(krA, vrA, 0); RA_WRITE(krA, vrA, 0); RA_LOAD(krA, vrA, 1);
        __syncthreads();
#define RA_BAR() asm volatile("s_waitcnt lgkmcnt(0)\n\ts_barrier" ::: "memory")
        for (int n = 0; n < 32; n += 2) {
            if (n + 2 < 32) RA_LOAD(krB, vrB, n + 2);
            RA_STEP(n, 0);
            RA_WRITE(krA, vrA, 1);
            RA_BAR();
            if (n + 3 < 32) RA_LOAD(krA, vrA, n + 3);
            RA_STEP(n + 1, 1);
            if (n + 2 < 32) RA_WRITE(krB, vrB, 0);
            RA_BAR();
        }
        __syncthreads();
#undef RA_BAR
#undef RA_STEP
#undef RA_LOAD
#undef RA_WRITE
    }
}
constexpr int B_K = 0, B_V = 32768, B_S = 65536;
__device__ __forceinline__ void outputs(Frame& F) {
    const int tid = ((int)threadIdx.x), lane = ((int)(threadIdx.x & 63)), w = F.wave, g = lane >> 4, il = lane & 15, q = il >> 2, pp = lane & 3;
    const bf16* U = (const bf16*)(F.A->ws + WS_U); const bf16* ST = (const bf16*)(F.A->ws + WS_ST); bf16* OA = (bf16*)(F.A->ws + WS_HN);
    LAS char* lds = (LAS char*)F.lds;
    u32x4 pk[4], pv[4], ps[4];
#define RB_LOAD(unit) do { const int bh_ = (unit) >> 5, n_ = ((unit) & 31) + 1, b_ = bh_ >> 3, h_ = bh_ & 7; \
        const bf16* Kg = U + 4 * USTR + ((size_t)(b_ * PP + n_ * 128)) * 1024 + h_ * 128; const bf16* Vg = U + 5 * USTR + ((size_t)(b_ * PP + n_ * 128)) * 1024 + h_ * 128; \
        const bf16* Sg = ST + ((size_t)bh_ * 32 + (n_ - 1)) * 16384; \
        _Pragma("unroll") for (int i = 0; i < 4; ++i) { const int pc = tid + 512 * i, row = pc >> 4, c16 = pc & 15; pk[i] = *(const u32x4*)(Kg + (size_t)row * 1024 + c16 * 8); pv[i] = *(const u32x4*)(Vg + (size_t)row * 1024 + c16 * 8); \
            ps[i] = *(const u32x4*)(Sg + (size_t)row * 128 + c16 * 8); } } while (0)
#define RB_WRITE() do { _Pragma("unroll") for (int i = 0; i < 4; ++i) { const int pc = tid + 512 * i, row = pc >> 4, c16 = pc & 15; *(LAS u32x4*)(lds + B_K + kswz(row, c16 * 16)) = pk[i]; \
            *(LAS u32x4*)(lds + B_V + vswz(row, c16 * 16)) = pv[i]; *(LAS u32x4*)(lds + B_S + kswz(row, c16 * 16)) = ps[i]; } } while (0)
    int unit = F.vcu; if (unit >= NB * NH * 32) return;
    RB_LOAD(unit); RB_WRITE();
    __syncthreads();
    for (;;) {
        const int nu = unit + F.G; const bool more = nu < NB * NH * 32;
        const int bh = unit >> 5, n = (unit & 31) + 1, b = bh >> 3, h = bh & 7;
        const size_t urow = (size_t)(b * PP + n * 128 + 16 * w + il);
        bf16x8 qx[4];
#pragma unroll
        for (int s = 0; s < 4; ++s) qx[s] = *(const bf16x8*)(U + 3 * USTR + urow * 1024 + h * 128 + 32 * s + 8 * g);
        if (more) RB_LOAD(nu);
        u32x2 P[8];
#pragma unroll
        for (int jb = 0; jb < 8; ++jb) {
            P[jb] = (u32x2){0u, 0u};
            if (jb <= w) {
                f32x4 d = (f32x4){0.f, 0.f, 0.f, 0.f};
#pragma unroll
                for (int s = 0; s < 4; ++s) { const bf16x8 a = *(const LAS bf16x8*)(lds + B_K + kswz(16 * jb + il, 64 * s + 16 * g)); d = __builtin_amdgcn_mfma_f32_16x16x32_bf16(a, qx[s], d, 0, 0, 0); }
                if (jb == w) {
#pragma unroll
                    for (int r = 0; r < 4; ++r) if (4 * g + r > il) d[r] = 0.f; }
                P[jb].x = cvt_pk_bf16(d[0], d[1]); P[jb].y = cvt_pk_bf16(d[2], d[3]);
            }
        }
        f32x4 o[8];
#pragma unroll
        for (int eb = 0; eb < 8; ++eb) { f32x4 acc = (f32x4){0.f, 0.f, 0.f, 0.f};
#pragma unroll
            for (int s = 0; s < 4; ++s) { const bf16x8 a = *(const LAS bf16x8*)(lds + B_S + kswz(16 * eb + il, 64 * s + 16 * g)); acc = __builtin_amdgcn_mfma_f32_16x16x32_bf16(a, qx[s], acc, 0, 0, 0); }
#pragma unroll
            for (int t = 0; t < 4; ++t) { if (2 * t <= w) {
                const int r0 = 32 * t + 4 * g + q;
                const s16x4 a0 = vtr(lds + B_V + vswz(r0, (16 * eb + 4 * pp) * 2)), a1 = vtr(lds + B_V + vswz(r0 + 16, (16 * eb + 4 * pp) * 2));
                const u32x4 bw = (u32x4){P[2 * t].x, P[2 * t].y, P[2 * t + 1].x, P[2 * t + 1].y};
                acc = __builtin_amdgcn_mfma_f32_16x16x32_bf16((bf16x8){a0[0], a0[1], a0[2], a0[3], a1[0], a1[1], a1[2], a1[3]}, __builtin_bit_cast(bf16x8, bw), acc, 0, 0, 0); } }
            o[eb] = acc; }
        float sm = 0.f;
#pragma unroll
        for (int eb = 0; eb < 8; ++eb) sm += (o[eb][0] + o[eb][1]) + (o[eb][2] + o[eb][3]);
        sm += __shfl_xor(sm, 16); sm += __shfl_xor(sm, 32);
        const float mu = sm * (1.0f / HD); float sv = 0.f;
#pragma unroll
        for (int eb = 0; eb < 8; ++eb) { o[eb] = o[eb] - mu; sv += (o[eb][0] * o[eb][0] + o[eb][1] * o[eb][1]) + (o[eb][2] * o[eb][2] + o[eb][3] * o[eb][3]); }
        sv += __shfl_xor(sv, 16); sv += __shfl_xor(sv, 32);
        const float rstd = 1.0f / sqrtf(sv * (1.0f / HD) + EPS);
        const size_t m = (size_t)b * SEQ + (n - 1) * 128 + 16 * w + il;
#pragma unroll
        for (int eb = 0; eb < 8; ++eb) { const int e0 = 16 * eb + 4 * g;
            const u32x2 gg = *(const u32x2*)(U + 6 * USTR + urow * 1024 + h * 128 + e0);
            u32x2 ov; ov.x = cvt_pk_bf16(o[eb][0] * rstd * bf_lo(gg.x), o[eb][1] * rstd * bf_hi(gg.x)); ov.y = cvt_pk_bf16(o[eb][2] * rstd * bf_lo(gg.y), o[eb][3] * rstd * bf_hi(gg.y));
            *(u32x2*)(OA + m * DM + 1024 + h * 128 + e0) = ov; }
        __syncthreads();
        if (!more) break;
        RB_WRITE();
        __syncthreads();
        unit = nu;
    }
#undef RB_LOAD
#undef RB_WRITE
}
}

struct POutProj {
    static constexpr bool PERM = false, HAS_MID = true, FP8 = false, GATHER = false;
    int nt; const char* Abase; unsigned lda2, ldb2; const char* Bt; const float* x; float* out; const float* SSQ;
    __device__ __forceinline__ void a_offs(const g8::Unit&, unsigned (&)[2][2]) const {}
    __device__ __forceinline__ const char* b_tile(const g8::Unit& u, int t) const { return Bt + (size_t)u.pn * 256 * ldb2 + (size_t)t * 128; }
    __device__ __forceinline__ void mid(f32x4 (&acc)[2][2][4][2], const g8::Unit& u, int wr, int wc, int fr, int fq) const {
#pragma unroll
        for (int ai = 0; ai < 2; ++ai)
#pragma unroll
            for (int m = 0; m < 4; ++m) { const int r = u.pm * 256 + ai * 128 + wr * 64 + m * 16 + fr;
                const f32x4 s0 = *(const f32x4*)(SSQ + (size_t)r * 8), s1 = *(const f32x4*)(SSQ + (size_t)r * 8 + 4);
                const float rs = 1.0f / sqrtf(((s0.x + s0.y) + (s0.z + s0.w) + (s1.x + s1.y) + (s1.z + s1.w)) * (1.0f / 1024.0f) + EPS);
#pragma unroll
                for (int bj = 0; bj < 2; ++bj)
#pragma unroll
                    for (int n = 0; n < 2; ++n) acc[ai][bj][m][n] = acc[ai][bj][m][n] * rs; }
    }
    __device__ __forceinline__ void epi(const f32x4 (&acc)[2][2][4][2], const g8::Unit& u, int wr, int wc, int fr, int fq) const {
        const int row0 = u.pm * 256 + wr * 64 + fr, col0 = u.pn * 256 + wc * 32 + 4 * fq;
#pragma unroll
        for (int ai = 0; ai < 2; ++ai)
#pragma unroll
            for (int m = 0; m < 4; ++m) { const size_t off = (size_t)(row0 + ai * 128 + m * 16) * DM + col0;
#pragma unroll
                for (int bj = 0; bj < 2; ++bj)
#pragma unroll
                    for (int n = 0; n < 2; ++n) *(f32x4*)(out + off + bj * 128 + n * 16) = *(const f32x4*)(x + off + bj * 128 + n * 16) + acc[ai][bj][m][n]; }
    }
};

__device__ __forceinline__ void p4_router(Frame& F) {
    const int lane = ((int)(threadIdx.x & 63)), w = F.wave, blk = w & 3, kh = w >> 2, row = lane & 15, kq = lane >> 4;
    const float* H1 = F.A->out; const float* g2 = F.A->in[8]; const float* WRT = (const float*)(F.A->ws + WS_WRT);
    const float* brg = F.A->in[10]; const float* bre = F.A->in[12];
    unsigned char* HN2 = (unsigned char*)(F.A->ws + WS_HN); int* TOK = (int*)(F.A->ws + WS_TOK); float* WLO = (float*)(F.A->ws + WS_WLO); float* WHI = (float*)(F.A->ws + WS_WHI); float* RSS = (float*)(F.A->ws + WS_RSS);
    LAS float* part = (LAS float*)F.lds;
    LAS float* pss = part + 2 * 64 * 32;
    for (int rb = F.vcu; rb < MTOK / 64; rb += F.G) {
        const int m0 = rb * 64 + blk * 16;
        const float* xp = H1 + (size_t)(m0 + row) * DM + kh * 1024 + 4 * kq;
        const float* w0p = WRT + (size_t)row * DM + kh * 1024 + 4 * kq; const float* w1p = w0p + 16 * DM; const float* gp = g2 + kh * 1024 + 4 * kq;
        unsigned* op = (unsigned*)(HN2 + (size_t)(m0 + row) * DM + kh * 1024 + 4 * kq);
        f32x4 acc0 = (f32x4){0.f, 0.f, 0.f, 0.f}, acc1 = acc0; float ss = 0.f;
#pragma unroll 4
        for (int s = 0; s < 64; ++s) {
            const f32x4 xa = *(const f32x4*)(xp + 16 * s), b0 = *(const f32x4*)(w0p + 16 * s), b1 = *(const f32x4*)(w1p + 16 * s), gg = *(const f32x4*)(gp + 16 * s);
#pragma unroll
            for (int j = 0; j < 4; ++j) { acc0 = __builtin_amdgcn_mfma_f32_16x16x4f32(xa[j], b0[j], acc0, 0, 0, 0); acc1 = __builtin_amdgcn_mfma_f32_16x16x4f32(xa[j], b1[j], acc1, 0, 0, 0); }
            ss += (xa.x * xa.x + xa.y * xa.y) + (xa.z * xa.z + xa.w * xa.w);
            const f32x4 y = xa * gg * SA1; op[4 * s] = pk_fp8x4(y.x, y.y, y.z, y.w);
        }
        ss += __shfl_xor(ss, 16); ss += __shfl_xor(ss, 32);
#pragma unroll
        for (int r = 0; r < 4; ++r) { part[(kh * 64 + blk * 16 + 4 * kq + r) * 32 + row] = acc0[r]; part[(kh * 64 + blk * 16 + 4 * kq + r) * 32 + 16 + row] = acc1[r]; }
        if (kq == 0) pss[kh * 64 + blk * 16 + row] = ss;
        __syncthreads();
        if (((int)threadIdx.x) < 64) {
            const int r = ((int)threadIdx.x), m = rb * 64 + r;
            const float rs = 1.0f / sqrtf((pss[r] + pss[64 + r]) * (1.0f / DM) + EPS);
            float lgt[20];
#pragma unroll
            for (int j = 0; j < 20; ++j) lgt[j] = (part[r * 32 + j] + part[(64 + r) * 32 + j]) * rs + (j < 4 ? brg[j] : bre[j - 4]);
            int gs = 0; float gm = lgt[0];
#pragma unroll
            for (int i = 1; i < 4; ++i) if (lgt[i] > gm) { gm = lgt[i]; gs = i; }
            float den = 0.f;
#pragma unroll
            for (int i = 0; i < 4; ++i) den += __expf(lgt[i] - gm);
            const float pg = 1.0f / den;
            float e4[4];
#pragma unroll
            for (int i = 0; i < 4; ++i) { float a = lgt[4 + i];
#pragma unroll
                for (int g = 1; g < 4; ++g) a = (gs == g) ? lgt[4 + 4 * g + i] : a;
                e4[i] = a; }
            int i1 = 0; float v1 = e4[0];
#pragma unroll
            for (int i = 1; i < 4; ++i) if (e4[i] > v1) { v1 = e4[i]; i1 = i; }
            int i2 = -1; float v2 = -__builtin_inff();
#pragma unroll
            for (int i = 0; i < 4; ++i) if (i != i1 && e4[i] > v2) { v2 = e4[i]; i2 = i; }
            const float ex = __expf(v2 - v1); const float w1 = pg / (1.f + ex), w2 = pg * ex / (1.f + ex);
            const int lo = i1 < i2 ? i1 : i2, hi = i1 < i2 ? i2 : i1; const float wlo = i1 < i2 ? w1 : w2, whi = i1 < i2 ? w2 : w1;
            const int pair = (lo == 0) ? (hi - 1) : (lo == 1) ? (hi + 1) : 5;
            const int cls = gs * 6 + pair;
            const unsigned pos = __hip_atomic_fetch_add(((unsigned*)F.A->ws) + CW_CNT + 64 * cls, 1u, __ATOMIC_RELAXED, __HIP_MEMORY_SCOPE_AGENT);
            TOK[cls * CLS_CAP + pos] = m; WLO[cls * CLS_CAP + pos] = wlo; WHI[cls * CLS_CAP + pos] = whi; RSS[cls * CLS_CAP + pos] = rs;
        }
        __syncthreads();
    }
}

__device__ __forceinline__ void cls_experts(int cls, int& elo, int& ehi) { const int g = cls / 6, pr = cls % 6; const int lo = pr < 3 ? 0 : (pr < 5 ? 1 : 2), hi = pr < 3 ? pr + 1 : (pr < 5 ? pr - 1 : 3); elo = 4 * g + lo; ehi = 4 * g + hi; }
__device__ __forceinline__ void moe_tables(Frame& F) {
    volatile LAS int* T = (volatile LAS int*)(F.lds + TBL_OFF);
    if (((int)threadIdx.x) == 0) {
        int base = 0;
        for (int c = 0; c < NCLS; ++c) { int n = (int)__hip_atomic_load(((unsigned*)F.A->ws) + CW_CNT + 64 * c, __ATOMIC_RELAXED, __HIP_MEMORY_SCOPE_AGENT); if (n > CLS_CAP) n = CLS_CAP; T[c] = n; T[32 + c] = base; const int nt = (n + 255) >> 8;
            for (int i = 0; i < nt; ++i) T[96 + base + i] = c; base += nt; }
        T[64] = base;
        int ne = 0;
        for (int e = 0; e < NEXP; ++e) { T[72 + e] = ne;
            for (int c = (e >> 2) * 6; c < (e >> 2) * 6 + 6; ++c) { int elo, ehi; cls_experts(c, elo, ehi); if (elo != e && ehi != e) continue; const int slot = (ehi == e) ? 1 : 0;
                const int nt = (T[c] + 255) >> 8; for (int i = 0; i < nt; ++i) { T[192 + ne] = (T[32 + c] + i) | (slot << 8) | (c << 16) | (i << 24); ++ne; } } }
        T[72 + NEXP] = ne; T[65] = ne;
    }
    __syncthreads();
}
struct SchedGU {
    const LAS int* T; int G, c;
    __device__ bool next(int i, g8::Unit& u) const {
        const int L = i * G + c; const int ne = __builtin_amdgcn_readfirstlane(T[65]); if (L >= ne * 8) return false;
        int e = 0;
#pragma unroll
        for (int k = 1; k < NEXP; ++k) { const int o = __builtin_amdgcn_readfirstlane(T[72 + k]); if (L >= o * 8) e = k; }
        const int e0 = __builtin_amdgcn_readfirstlane(T[72 + e]), e1 = __builtin_amdgcn_readfirstlane(T[72 + e + 1]); const int cnt = e1 - e0, loc = L - e0 * 8;
        const int ntile = loc / cnt, mt = loc - ntile * cnt; const int ent = __builtin_amdgcn_readfirstlane(T[192 + e0 + mt]);
        u.pm = ent & 0xff; u.pn = ntile; u.a0 = e; u.a1 = (ent >> 8) & 1; u.a2 = (ent >> 16) & 0xff; u.a3 = (ent >> 24) & 0xff; return true;
    }
};
struct SchedDown {
    const LAS int* T; int G, c;
    __device__ bool next(int i, g8::Unit& u) const {
        const int L = i * G + c; const int NT = __builtin_amdgcn_readfirstlane(T[64]); if (L >= NT * 8) return false;
        const int tl = L >> 3; const int cls = __builtin_amdgcn_readfirstlane(T[96 + tl]); const int tb = __builtin_amdgcn_readfirstlane(T[32 + cls]);
        int elo, ehi; cls_experts(cls, elo, ehi);
        u.pm = tl; u.pn = L & 7; u.a0 = elo; u.a1 = ehi; u.a2 = cls; u.a3 = tl - tb; return true;
    }
};

struct PGateUp {
    static constexpr bool PERM = true, HAS_MID = false, FP8 = true, GATHER = true;
    int nt; const char* Abase; unsigned lda2, ldb2; const char* WGU; const int* TOK; const float* WLO; const float* WHI; const float* RSS; const LAS int* T; unsigned char* ACT;
    __device__ __forceinline__ void a_offs(const g8::Unit& u, unsigned (&o)[2][2]) const {
        const int cnt = T[u.a2];
#pragma unroll
        for (int i = 0; i < 2; ++i) { int R, C; g8::stage_rc((int)threadIdx.x * 16 + i * 8192, R, C);
#pragma unroll
            for (int h = 0; h < 2; ++h) { int pos = u.a3 * 256 + h * 128 + R; if (pos >= cnt) pos = 0; const int tok = TOK[u.a2 * CLS_CAP + pos]; o[h][i] = (unsigned)(tok * DM + C * 2); } }
    }
    __device__ __forceinline__ const char* b_tile(const g8::Unit& u, int t) const { return WGU + ((size_t)u.a0 * 2048 + (size_t)u.pn * 256) * ldb2 + (size_t)t * 128; }
    __device__ __forceinline__ void mid(f32x4 (&)[2][2][4][2], const g8::Unit&, int, int, int, int) const {}
    __device__ __forceinline__ void epi(const f32x4 (&acc)[2][2][4][2], const g8::Unit& u, int wr, int wc, int fr, int fq) const {
        const int cnt = T[u.a2]; const float* WS = u.a1 ? WHI : WLO; constexpr float INV = 1.0f / (SA1 * SW1);
#pragma unroll
        for (int ai = 0; ai < 2; ++ai)
#pragma unroll
            for (int m = 0; m < 4; ++m) { const int rl = ai * 128 + wr * 64 + m * 16 + fr; const int pos = u.a3 * 256 + rl;
                const float w = ((pos < cnt) ? WS[u.a2 * CLS_CAP + pos] : 0.f) * SA2; const float rsi = ((pos < cnt) ? RSS[u.a2 * CLS_CAP + pos] : 0.f) * INV;
                const f32x4 g0 = acc[ai][0][m][0] * rsi, g1 = acc[ai][0][m][1] * rsi, u0 = acc[ai][1][m][0] * rsi, u1 = acc[ai][1][m][1] * rsi;
                f32x4 a0, a1;
#pragma unroll
                for (int e = 0; e < 4; ++e) { a0[e] = g0[e] / (1.f + __expf(-g0[e])) * u0[e] * w; a1[e] = g1[e] / (1.f + __expf(-g1[e])) * u1[e] * w; }
                u32x2 o; o.x = pk_fp8x4(a0[0], a0[1], a0[2], a0[3]); o.y = pk_fp8x4(a1[0], a1[1], a1[2], a1[3]);
                *(u32x2*)(ACT + ((size_t)u.pm * 256 + rl) * 2048 + u.a1 * 1024 + u.pn * 128 + wc * 32 + 8 * fq) = o; }
    }
};
struct PDown {
    static constexpr bool PERM = true, HAS_MID = false, FP8 = true, GATHER = false;
    int nt; const char* Abase; unsigned lda2, ldb2; const char* WD; const int* TOK; const LAS int* T; bf16* Y;
    __device__ __forceinline__ void a_offs(const g8::Unit&, unsigned (&)[2][2]) const {}
    __device__ __forceinline__ const char* b_tile(const g8::Unit& u, int t) const { const int e = (t < 8) ? u.a0 : u.a1; return WD + ((size_t)e * 2048 + (size_t)u.pn * 256) * ldb2 + (size_t)(t & 7) * 128; }
    __device__ __forceinline__ void mid(f32x4 (&)[2][2][4][2], const g8::Unit&, int, int, int, int) const {}
    __device__ __forceinline__ void epi(const f32x4 (&acc)[2][2][4][2], const g8::Unit& u, int wr, int wc, int fr, int fq) const {
        const int cnt = T[u.a2]; const int col0 = u.pn * 256 + wc * 32 + 8 * fq; constexpr float INV = 1.0f / (SA2 * SW2);
#pragma unroll
        for (int ai = 0; ai < 2; ++ai)
#pragma unroll
            for (int m = 0; m < 4; ++m) { const int pos = u.a3 * 256 + ai * 128 + wr * 64 + m * 16 + fr;
                if (pos < cnt) { const int tok = TOK[u.a2 * CLS_CAP + pos]; bf16* rowp = Y + (size_t)tok * DM + col0;
#pragma unroll
                    for (int bj = 0; bj < 2; ++bj) { const f32x4 v0 = acc[ai][bj][m][0] * INV, v1 = acc[ai][bj][m][1] * INV;
                        u32x4 w; w.x = cvt_pk_bf16(v0[0], v0[1]); w.y = cvt_pk_bf16(v0[2], v0[3]); w.z = cvt_pk_bf16(v1[0], v1[1]); w.w = cvt_pk_bf16(v1[2], v1[3]);
                        *(u32x4*)(rowp + bj * 128) = w; } } }
    }
};

__device__ __forceinline__ void p7_final(Frame& F) {
    const int gw = F.vcu * NWAVES + F.wave, NGW = F.G * NWAVES, lane = ((int)(threadIdx.x & 63)); const float* gf = F.A->in[16];
    const bf16* Y = (const bf16*)(F.A->ws + WS_Y);
    f32x4 gv[8];
#pragma unroll
    for (int j = 0; j < 8; ++j) gv[j] = *((const f32x4*)gf + lane + 64 * j);
    for (int row = gw; row < MTOK; row += NGW) {
        float* xr = F.A->out + (size_t)row * DM; const u32x2* yr = (const u32x2*)(Y + (size_t)row * DM); f32x4 v[8]; float ss = 0.f;
#pragma unroll
        for (int j = 0; j < 8; ++j) { v[j] = *((const f32x4*)xr + lane + 64 * j); const u32x2 y = yr[lane + 64 * j];
            v[j].x += bf_lo(y.x); v[j].y += bf_hi(y.x); v[j].z += bf_lo(y.y); v[j].w += bf_hi(y.y);
            ss += (v[j].x * v[j].x + v[j].y * v[j].y) + (v[j].z * v[j].z + v[j].w * v[j].w); }
        const float rs = 1.0f / sqrtf(wave_sum(ss) * (1.0f / DM) + EPS);
#pragma unroll
        for (int j = 0; j < 8; ++j) *((f32x4*)xr + lane + 64 * j) = v[j] * rs * gv[j];
    }
}

__global__ void __launch_bounds__(NWAVES * 64, 2) fwd_kernel(Args args) {
    extern __shared__ __attribute__((aligned(16))) unsigned char lds[];
    Frame F;
    F.lds = (LAS unsigned char*)lds;
    F.MISC = (volatile LAS unsigned*)(F.lds + MISC_OFF);
    F.wave = __builtin_amdgcn_readfirstlane((int)threadIdx.x >> 6);
    F.G = gridDim.x; { const int bx = blockIdx.x; F.vcu = (F.G % 8 == 0) ? (bx % 8) * (F.G / 8) + bx / 8 : bx; }
    F.A = &args;
    { int t0 = (int)threadIdx.x; asm volatile("" : "+v"(t0));
      for (int u = t0; u < (LDS_BYTES - RING_BYTES) / 4; u += NWAVES * 64) ((LAS unsigned*)(F.lds + RING_BYTES))[u] = 0u; }
    __syncthreads();
    (void)xcd_barrier_post((unsigned*)args.ws + CW_BAR, F.MISC + 8);
#define MKBAR() XcdBarrier bar; bar.bar = (unsigned*)args.ws + CW_BAR; bar.x = xb_xcc_id(); bar.st = (volatile LAS unsigned*)(F.lds + MISC_OFF) + 8
    const int lo = args.ph_lo, hi = args.ph_hi;
#define IN(k) (lo <= (k) && (k) < hi)
#define GRID_BAR(k) do { if (IN(k) && IN((k) + 1)) { MKBAR(); xcd_barrier(bar); } } while (0)
    bf16* U = (bf16*)(F.A->ws + WS_U);
#define PHASE(k, ...) do { if (IN(k)) { __VA_ARGS__ if constexpr (REPP == (k)) { { MKBAR(); xcd_barrier(bar); } __VA_ARGS__ } } GRID_BAR(k); } while (0)
    PHASE(0, p0_prologue(F););
    PHASE(1,
        p1_cumsum(F); p1_meta_kv(F);
        { PInProj p{DM / 64, (const char*)(F.A->ws + WS_HN), (unsigned)(DM * 2), (unsigned)(DM * 2), (const char*)(F.A->ws + WS_WINT), U, (const f32x2*)(F.A->ws + WS_ROPE)};
        g8::StaticOrder S; S.init(MTOK, NIN, F.G, (int)blockIdx.x);
        g8::gemm_phase<PInProj, g8::StaticOrder, true>(F.lds, p, S); });
    PHASE(2, ret::states(F); __syncthreads();
        if constexpr (REPP == 21) { ret::states(F); __syncthreads(); }
        fox_phase(F);
        if constexpr (REPP == 20) { __syncthreads(); fox_phase(F); }
        { MKBAR(); xcd_barrier(bar); } ret::outputs(F);
        if constexpr (REPP == 22) { __syncthreads(); ret::outputs(F); });
    PHASE(3,
        { POutProj p{DM / 64, (const char*)(F.A->ws + WS_HN), (unsigned)(DM * 2), (unsigned)(DM * 2), (const char*)(F.A->ws + WS_WOUTT), F.A->in[0], F.A->out, (const float*)(F.A->ws + WS_SSQ)};
        g8::StaticOrder S; S.init(MTOK, DM, F.G, (int)blockIdx.x);
        g8::gemm_phase<POutProj, g8::StaticOrder, true>(F.lds, p, S); });
    PHASE(4, p4_router(F););
    PHASE(5,
        moe_tables(F);
        { PGateUp p{DM / 128, (const char*)(F.A->ws + WS_HN), (unsigned)DM, (unsigned)DM, (const char*)(F.A->ws + WS_WGU), (const int*)(F.A->ws + WS_TOK), (const float*)(F.A->ws + WS_WLO), (const float*)(F.A->ws + WS_WHI), (const float*)(F.A->ws + WS_RSS),
                  (const LAS int*)(F.lds + TBL_OFF), (unsigned char*)U};
        SchedGU S{(const LAS int*)(F.lds + TBL_OFF), F.G, F.vcu};
        g8::gemm_phase<PGateUp, SchedGU, true>(F.lds, p, S); });
    PHASE(6,
        if (!IN(5)) moe_tables(F);
        { PDown p{2048 / 128, (const char*)U, 2048u, (unsigned)DE, (const char*)(F.A->ws + WS_WD), (const int*)(F.A->ws + WS_TOK), (const LAS int*)(F.lds + TBL_OFF), (bf16*)(F.A->ws + WS_Y)};
        SchedDown S{(const LAS int*)(F.lds + TBL_OFF), F.G, F.vcu};
        g8::gemm_phase<PDown, SchedDown, true>(F.lds, p, S); });
    PHASE(7, p7_final(F););
#undef PHASE
#undef IN
#undef GRID_BAR
}

extern "C" void kernel_launch(void* const* d_in, const int* in_sizes, int n_in, void* d_out, int out_size, void* d_ws, size_t ws_size, hipStream_t stream) {
    static int grid = 0;
    if (grid == 0) {
        if (n_in != 17 || out_size != MTOK * DM || ws_size < WS_END) { fprintf(stderr, "kernel_launch: unexpected shapes (n_in %d out %d ws %zu)\n", n_in, out_size, ws_size); grid = -1; return; }
        int dev = 0, cus = 0, per_cu = 0;
        if (hipGetDevice(&dev) != hipSuccess || hipDeviceGetAttribute(&cus, hipDeviceAttributeMultiprocessorCount, dev) != hipSuccess) { grid = -1; return; }
        if (hipFuncSetAttribute((const void*)fwd_kernel, hipFuncAttributeMaxDynamicSharedMemorySize, LDS_BYTES) != hipSuccess) { fprintf(stderr, "kernel_launch: hipFuncSetAttribute failed\n"); grid = -1; return; }
        if (hipOccupancyMaxActiveBlocksPerMultiprocessor(&per_cu, (const void*)fwd_kernel, NWAVES * 64, LDS_BYTES) != hipSuccess || per_cu < 1) fprintf(stderr, "kernel_launch: occupancy query says %d\n", per_cu);
        (void)hipGetLastError();
        grid = cus;
    }
    if (grid < 0) return;
    (void)hipMemsetAsync((char*)d_ws + WS_CTL, 0, CTL_ZERO_BYTES, stream);
    Args a{};
    for (int i = 0; i < 17; ++i) a.in[i] = (const float*)d_in[i];
    a.out = (float*)d_out; a.ws = (unsigned char*)d_ws; a.ph_lo = 0; a.ph_hi = 8;
    hipLaunchKernelGGL(fwd_kernel, dim3(grid), dim3(NWAVES * 64), LDS_BYTES, stream, a);
}
```

```cpp
#include <hip/hip_runtime.h>
#include <cstdio>
#include <cstdint>

#define LAS __attribute__((address_space(3)))
#define GAS __attribute__((address_space(1)))
typedef unsigned short bf16;
typedef short bf16x8 __attribute__((ext_vector_type(8)));
typedef float f32x4 __attribute__((ext_vector_type(4)));
typedef float f32x2 __attribute__((ext_vector_type(2)));
typedef unsigned u32x4 __attribute__((ext_vector_type(4)));
typedef unsigned u32x2 __attribute__((ext_vector_type(2)));

constexpr int NB = 4, SEQ = 4096, DM = 2048, PADN = 112, NMETA = 16, PP = SEQ + 128, HD = 128, NH = 8;
constexpr int MTOK = NB * SEQ;
constexpr int INC = 7176;
constexpr int NIN = 7168;
constexpr int NEXP = 16, DE = 1024, NCLS = 24, CLS_CAP = 16384;
constexpr float EPS = 1e-6f;
constexpr float SCALE = 0.08838834764831845f;

constexpr size_t MiB = 1u << 20;
constexpr size_t WS_CTL = 0, CTL_ZERO_BYTES = 1 * MiB;
constexpr size_t WS_LOGF = 1 * MiB;
constexpr size_t WS_CUM = WS_LOGF + 1 * MiB;
constexpr size_t WS_SSQ = WS_CUM + 1 * MiB;
constexpr size_t WS_ROPE = WS_SSQ + 1 * MiB;
constexpr size_t WS_WRT = WS_ROPE + 3 * MiB;
constexpr size_t WS_HNMETA = WS_WRT + 1 * MiB;
constexpr size_t WS_TOK = WS_HNMETA + 1 * MiB;
constexpr size_t WS_WLO = WS_TOK + 2 * MiB;
constexpr size_t WS_WHI = WS_WLO + 2 * MiB;
constexpr size_t WS_WINT = 16 * MiB;
constexpr size_t WS_WOUTT = 44 * MiB;
constexpr size_t WS_WGU = 52 * MiB;
constexpr size_t WS_WD = 180 * MiB;
constexpr size_t WS_HN = 244 * MiB;
constexpr size_t WS_U = 308 * MiB;
constexpr size_t WS_Y = WS_U + 64 * MiB;
constexpr size_t USTR = (size_t)NB * PP * 1024;
constexpr size_t WS_ST = WS_U + 7 * 33 * MiB;
constexpr size_t WS_RSS = WS_ST + 32 * MiB;
constexpr size_t WS_END = WS_RSS + 2 * MiB;
static_assert(WS_WHI + 2 * MiB <= WS_WINT && USTR * 2 == 33 * MiB, "ws map");
constexpr int CW_BAR = 4096;
constexpr int CW_CNT = 16384;
constexpr int CW_NRM = 20480;
constexpr int CW_MNRM = 20480 + 256;
constexpr int CW_QHEAD = 24576;

constexpr int RING_BYTES = 131072;
constexpr int MISC_OFF = RING_BYTES + 320;
constexpr int TBL_OFF = RING_BYTES + 1024;
constexpr int LDS_BYTES = 147456;
constexpr int NWAVES = 8;
#ifndef REPP_V
#define REPP_V (-1)
#endif
constexpr int REPP = REPP_V;

__device__ __forceinline__ unsigned cvt_pk_bf16(float lo, float hi) { unsigned r; asm volatile("v_cvt_pk_bf16_f32 %0, %1, %2" : "=v"(r) : "v"(lo), "v"(hi)); return r; }
__device__ __forceinline__ unsigned pk_fp8x4(float a, float b, float c, float d) {
    a = __builtin_amdgcn_fmed3f(a, -448.f, 448.f); b = __builtin_amdgcn_fmed3f(b, -448.f, 448.f); c = __builtin_amdgcn_fmed3f(c, -448.f, 448.f); d = __builtin_amdgcn_fmed3f(d, -448.f, 448.f);
    int w = 0; w = __builtin_amdgcn_cvt_pk_fp8_f32(a, b, w, false); w = __builtin_amdgcn_cvt_pk_fp8_f32(c, d, w, true); return (unsigned)w; }
constexpr float SA1 = 16.f, SW1 = 1024.f, SA2 = 32.f, SW2 = 512.f;
__device__ __forceinline__ float bf_lo(unsigned w) { return __uint_as_float(w << 16); }
__device__ __forceinline__ float bf_hi(unsigned w) { return __uint_as_float(w & 0xffff0000u); }
__device__ __forceinline__ float wave_sum(float v) {
#pragma unroll
    for (int o = 1; o < 64; o <<= 1) v += __shfl_xor(v, o);
    return v;
}
__device__ __forceinline__ float wave_max(float v) {
#pragma unroll
    for (int o = 1; o < 64; o <<= 1) v = fmaxf(v, __shfl_xor(v, o));
    return v;
}
#define LDS_WAIT() asm volatile("s_waitcnt lgkmcnt(0)" ::: "memory")
#define VM_WAIT() asm volatile("s_waitcnt vmcnt(0)" ::: "memory")

#define XB_TMO      128
#define XB_XCNT(j)  (256  + 64 * (j))
#define XB_XSUB(j)  (1280 + 64 * (j))
#define XB_XGEN(j)  (2304 + 64 * (j))
#define XB_TOP      3328
#define XB_TOPGEN   3392
#define XCD_BAR_WORDS 3456
#define XB_SPIN_CAP (1u << 21)
__device__ __forceinline__ unsigned xb_ld(unsigned* p)              { return __hip_atomic_load(p, __ATOMIC_RELAXED, __HIP_MEMORY_SCOPE_AGENT); }
__device__ __forceinline__ unsigned xb_add(unsigned* p, unsigned v) { return __hip_atomic_fetch_add(p, v, __ATOMIC_RELAXED, __HIP_MEMORY_SCOPE_AGENT); }
__device__ __forceinline__ unsigned xb_xcc_id() { return (unsigned)__builtin_amdgcn_s_getreg((3 << 11) | 20) & 0xFu; }
#define XB_SPIN(cond, bar) do { unsigned _sp = 0; while (cond) { __builtin_amdgcn_s_sleep(1); \
    if ((++_sp & 255u) == 0u) { if (xb_ld(&(bar)[XB_TMO])) break; if (_sp > XB_SPIN_CAP) { atomicAdd(&(bar)[XB_TMO], 1u); break; } } } } while (0)
struct XcdBarrier { unsigned* bar; unsigned x; volatile LAS unsigned* st; };
__device__ __forceinline__ XcdBarrier xcd_barrier_post(unsigned* bar, volatile LAS unsigned* st) {
    XcdBarrier b; b.bar = bar; b.x = xb_xcc_id(); b.st = st;
    if (threadIdx.x == 0) (void)xb_add(&bar[XB_XCNT(b.x)], 1u);
    return b;
}
__device__ __forceinline__ void xcd_barrier_complete(unsigned* bar, unsigned x, unsigned& nloc, unsigned& nx) {
    const unsigned G = gridDim.x * gridDim.y * gridDim.z;
    unsigned sum, cnt, mine, sp = 0u;
    for (;;) {
        sum = 0u; cnt = 0u; mine = 0u;
#pragma unroll
        for (unsigned j = 0; j < 16; ++j) { const unsigned c = xb_ld(&bar[XB_XCNT(j)]); sum += c; cnt += (c > 0u) ? 1u : 0u; mine = (j == x) ? c : mine; }
        if (sum == G) break;
        __builtin_amdgcn_s_sleep(1);
        if ((++sp & 255u) == 0u) { if (xb_ld(&bar[XB_TMO])) break; if (sp > XB_SPIN_CAP) { atomicAdd(&bar[XB_TMO], 1u); break; } }
    }
    nloc = mine > 0u ? mine : 1u; nx = cnt > 0u ? cnt : 1u;
}
__device__ __forceinline__ void xcd_barrier(const XcdBarrier& b) {
    asm volatile("s_waitcnt vmcnt(0)" ::: "memory");
    __syncthreads();
    if (threadIdx.x == 0) {
        unsigned* bar = b.bar;
        __builtin_amdgcn_s_waitcnt(0);
        unsigned nloc = b.st[0], nx = b.st[1];
        if (nloc == 0u) { xcd_barrier_complete(bar, b.x, nloc, nx); b.st[0] = nloc; b.st[1] = nx; }
        const unsigned old = xb_add(&bar[XB_XSUB(b.x)], 1u);
        const unsigned gen = old / nloc;
        if (old + 1u == (gen + 1u) * nloc) {
            __builtin_amdgcn_fence(__ATOMIC_RELEASE, "agent");
            asm volatile("s_waitcnt vmcnt(0)" ::: "memory");
            const unsigned og = xb_add(&bar[XB_TOP], 1u);
            const unsigned tg = og / nx;
            if (og + 1u == (tg + 1u) * nx) xb_add(&bar[XB_TOPGEN], 1u);
            else XB_SPIN(xb_ld(&bar[XB_TOPGEN]) == tg, bar);
            __builtin_amdgcn_fence(__ATOMIC_ACQUIRE, "agent");
            xb_add(&bar[XB_XGEN(b.x)], 1u);
            asm volatile("s_waitcnt vmcnt(0)" ::: "memory");
        } else {
            XB_SPIN(xb_ld(&bar[XB_XGEN(b.x)]) == gen, bar);
            __builtin_amdgcn_fence(__ATOMIC_ACQUIRE, "agent");
            asm volatile("s_waitcnt vmcnt(0)" ::: "memory");
        }
    }
    __syncthreads();
}

namespace g8 {
constexpr int BM = 256, BK = 64, HALF = 128, HTB = HALF * BK * 2, NXCD = 8, WGM = 8;
__device__ __forceinline__ int lds_byte(int r, int c) { const int st = (r >> 4) * 2 + (c >> 5), rr = r & 15, cc = c & 31, ob = rr * 64 + cc * 2; return st * 1024 + (ob ^ (((ob >> 9) & 1) << 5)); }
__device__ __forceinline__ void stage_rc(int b, int& R, int& C) { const int st = b / 1024, sb = b % 1024, swz = sb ^ (((sb >> 9) & 1) << 5); R = (st >> 1) * 16 + swz / 64; C = (st & 1) * 32 + (swz % 64) / 2; }
__device__ __forceinline__ int perm32(int rho) { const int n = rho >> 4, i = rho & 15; return 8 * (i >> 2) + 4 * n + (i & 3); }

struct Unit { int pm, pn, a0, a1, a2, a3; };
typedef int v8i_t __attribute__((ext_vector_type(8)));

struct StaticOrder {
    int nM, nN, nwg, G, c;
    __device__ void init(int M, int N, int G_, int c_) { nM = M / BM; nN = N / BM; nwg = nM * nN; G = G_; c = c_; }
    __device__ bool next(int i, Unit& u) const {
        const long L = (long)i * G + c; if (L >= nwg) return false;
        int wgid = (int)L; { const int q = nwg / NXCD, r = nwg % NXCD, xcd = wgid % NXCD, off = wgid / NXCD; wgid = (xcd < r ? xcd * (q + 1) : r * (q + 1) + (xcd - r) * q) + off; }
        const int nig = WGM * nN, gid = wgid / nig, fm = gid * WGM, gsz = (nM - fm) < WGM ? (nM - fm) : WGM;
        u.pm = fm + ((wgid % nig) % gsz); u.pn = (wgid % nig) / gsz; u.a0 = u.a1 = u.a2 = u.a3 = 0; return true;
    }
};

template <class P, class Sched, bool ALIGN_EPI>
__device__ __forceinline__ void gemm_phase(LAS unsigned char* lds, const P& p, const Sched& S) {
    const int tid = threadIdx.x, wid = __builtin_amdgcn_readfirstlane(tid >> 6), lane = tid & 63, wr = wid >> 2, wc = wid & 3, fr = lane & 15, fq = lane >> 4;
    const int nt = p.nt;
    unsigned voffB[2], voffA[2];
#pragma unroll
    for (int i = 0; i < 2; ++i) { int R, C; stage_rc(tid * 16 + i * 8192, R, C); const int Rb = P::PERM ? ((R & ~31) + perm32(R & 31)) : R;
        voffB[i] = (unsigned)Rb * p.ldb2 + (unsigned)C * 2u; voffA[i] = (unsigned)R * p.lda2 + (unsigned)C * 2u; }
    const size_t hstepB = (size_t)HALF * p.ldb2, hstepA = (size_t)HALF * p.lda2;
    const unsigned ldsw = (unsigned)wid * 1024u;
    const int aoff = lds_byte(wr * 64 + fr, fq * 8), boff = lds_byte(wc * 32 + fr, fq * 8);
#define PG8_SA(b, h) (((b) * 2 + (h)) * HTB)
#define PG8_SB(b, h) ((4 + (b) * 2 + (h)) * HTB)
#define PG8_STAGE(bufoff, gbase, v0, v1) do { \
        __builtin_amdgcn_global_load_lds((const unsigned*)((const char*)(gbase) + (v0)), (LAS unsigned*)(lds + (bufoff) + ldsw), 16, 0, 0); \
        __builtin_amdgcn_global_load_lds((const unsigned*)((const char*)(gbase) + (v1)), (LAS unsigned*)(lds + (bufoff) + ldsw + 8192), 16, 0, 0); } while (0)
#define PG8_LD32(p0_, p1_) ({ const u32x4 lo_ = *(const LAS u32x4*)(p0_), hi_ = *(const LAS u32x4*)(p1_); (v8i_t){(int)lo_.x, (int)lo_.y, (int)lo_.z, (int)lo_.w, (int)hi_.x, (int)hi_.y, (int)hi_.z, (int)hi_.w}; })
#define PG8_LDA(dst, b, h) do { _Pragma("unroll") for (int m = 0; m < 4; ++m) dst[m] = PG8_LD32(lds + PG8_SA(b, h) + aoff + m * 2048, lds + PG8_SA(b, h) + aoff + m * 2048 + 1024); } while (0)
#define PG8_LDB(dst, b, h) do { _Pragma("unroll") for (int n = 0; n < 2; ++n) dst[n] = PG8_LD32(lds + PG8_SB(b, h) + boff + n * 2048, lds + PG8_SB(b, h) + boff + n * 2048 + 1024); } while (0)
#define PG8_LOH(v) __builtin_bit_cast(bf16x8, __builtin_shufflevector(v, v, 0, 1, 2, 3))
#define PG8_HIH(v) __builtin_bit_cast(bf16x8, __builtin_shufflevector(v, v, 4, 5, 6, 7))
#define PG8_MMA(ai, bj, At, Bt) do { __builtin_amdgcn_s_setprio(1); _Pragma("unroll") for (int m = 0; m < 4; ++m) _Pragma("unroll") for (int n = 0; n < 2; ++n) { \
        if constexpr (P::FP8) { asm volatile("v_mfma_f32_16x16x128_f8f6f4 %0, %1, %2, %0" : "+v"(acc[ai][bj][m][n]) : "v"(Bt[n]), "v"(At[m])); } \
        else { acc[ai][bj][m][n] = __builtin_amdgcn_mfma_f32_16x16x32_bf16(PG8_LOH(Bt[n]), PG8_LOH(At[m]), acc[ai][bj][m][n], 0, 0, 0); \
               acc[ai][bj][m][n] = __builtin_amdgcn_mfma_f32_16x16x32_bf16(PG8_HIH(Bt[n]), PG8_HIH(At[m]), acc[ai][bj][m][n], 0, 0, 0); } } \
        __builtin_amdgcn_s_setprio(0); } while (0)
#define PG8_WAIT_V(n) asm volatile("s_waitcnt vmcnt(" #n ")" ::: "memory")
#define PG8_WAIT_L(n) asm volatile("s_waitcnt lgkmcnt(" #n ")" ::: "memory")
#define PG8_BAR __builtin_amdgcn_s_barrier()
#define PG8_SCHED __builtin_amdgcn_sched_barrier(0)
    Unit cur, nxt; int ui = 0;
    if (!S.next(0, cur)) return;
    f32x4 acc[2][2][4][2];
#pragma unroll
    for (int a = 0; a < 2; ++a)
#pragma unroll
        for (int b = 0; b < 2; ++b)
#pragma unroll
            for (int m = 0; m < 4; ++m)
#pragma unroll
                for (int n = 0; n < 2; ++n) acc[a][b][m][n] = (f32x4){0.f, 0.f, 0.f, 0.f};
    v8i_t At[4], B0[2], B1[2];
    unsigned oc[2][2];
    constexpr int ONOFF = RING_BYTES + 4096;
    const char* cA = p.Abase; const char* nA = p.Abase;
    if constexpr (P::GATHER) { p.a_offs(cur, oc); } else { cA = p.Abase + (size_t)cur.pm * 2 * hstepA; }
#define PG8_STA(bufoff, base_, h_, O_) do { if constexpr (P::GATHER) { PG8_STAGE(bufoff, base_, O_[h_][0], O_[h_][1]); } else { PG8_STAGE(bufoff, (base_) + (h_) * hstepA, voffA[0], voffA[1]); } } while (0)
    {
        const char* b0 = p.b_tile(cur, 0); const char* b1 = p.b_tile(cur, 1);
        PG8_STAGE(PG8_SB(0, 0), b0, voffB[0], voffB[1]); PG8_STAGE(PG8_SB(0, 1), b0 + hstepB, voffB[0], voffB[1]);
        PG8_STA(PG8_SA(0, 0), cA, 0, oc); PG8_STA(PG8_SA(0, 1), cA, 1, oc);
        if (wr == 1) PG8_BAR;
        PG8_WAIT_V(2); PG8_BAR;
        PG8_STAGE(PG8_SB(1, 0), b1, voffB[0], voffB[1]); PG8_STA(PG8_SA(1, 0), cA + 128, 0, oc); PG8_STAGE(PG8_SB(1, 1), b1 + hstepB, voffB[0], voffB[1]);
        PG8_WAIT_V(6); PG8_BAR;
    }
    for (;;) {
        const bool has_next = S.next(ui + 1, nxt);
        if (!has_next) nxt = cur;
        if constexpr (P::GATHER) { unsigned on[2][2]; p.a_offs(nxt, on); *(LAS u32x4*)(lds + ONOFF + tid * 16) = (u32x4){on[0][0], on[0][1], on[1][0], on[1][1]}; } else { nA = p.Abase + (size_t)nxt.pm * 2 * hstepA; }
#pragma unroll 1
        for (int t = 0; t < nt; t += 2) {
            const bool last = (t == nt - 2);
            if constexpr (P::HAS_MID) { if (t == (nt >> 1)) p.mid(acc, cur, wr, wc, fr, fq); }
            const char* a1 = cA + (size_t)(t + 1) * 128;
            const char* a2 = last ? nA : cA + (size_t)(t + 2) * 128; const char* a3 = a2 + 128;
            unsigned o2[2][2];
            if constexpr (P::GATHER) { const u32x4 onv = *(const LAS u32x4*)(lds + ONOFF + tid * 16);
                o2[0][0] = last ? onv.x : oc[0][0]; o2[0][1] = last ? onv.y : oc[0][1]; o2[1][0] = last ? onv.z : oc[1][0]; o2[1][1] = last ? onv.w : oc[1][1]; }
            const char* b2 = last ? p.b_tile(nxt, 0) : p.b_tile(cur, t + 2); const char* b3 = last ? p.b_tile(nxt, 1) : p.b_tile(cur, t + 3);
            PG8_LDB(B0, 0, 0); PG8_LDB(B1, 0, 1); PG8_SCHED; PG8_LDA(At, 0, 0); PG8_STA(PG8_SA(1, 1), a1, 1, oc);
            PG8_WAIT_V(8); PG8_WAIT_L(0); PG8_BAR; PG8_MMA(0, 0, At, B0); PG8_MMA(0, 1, At, B1); PG8_BAR; PG8_SCHED;
            PG8_LDA(At, 0, 1); PG8_STAGE(PG8_SB(0, 0), b2, voffB[0], voffB[1]); PG8_STAGE(PG8_SB(0, 1), b2 + hstepB, voffB[0], voffB[1]); PG8_STA(PG8_SA(0, 0), a2, 0, o2);
            PG8_WAIT_V(8); PG8_WAIT_L(0); PG8_BAR; PG8_MMA(1, 0, At, B0); PG8_MMA(1, 1, At, B1); PG8_BAR; PG8_SCHED;
            PG8_LDB(B0, 1, 0); PG8_LDB(B1, 1, 1); PG8_SCHED; PG8_LDA(At, 1, 0); PG8_STA(PG8_SA(0, 1), a2, 1, o2);
            PG8_WAIT_V(8); PG8_WAIT_L(0); PG8_BAR; PG8_MMA(0, 0, At, B0); PG8_MMA(0, 1, At, B1); PG8_BAR; PG8_SCHED;
            PG8_LDA(At, 1, 1); PG8_STAGE(PG8_SB(1, 0), b3, voffB[0], voffB[1]); PG8_STAGE(PG8_SB(1, 1), b3 + hstepB, voffB[0], voffB[1]); PG8_STA(PG8_SA(1, 0), a3, 0, o2);
            PG8_WAIT_V(8); PG8_WAIT_L(0); PG8_BAR; PG8_MMA(1, 0, At, B0); PG8_MMA(1, 1, At, B1); PG8_BAR; PG8_SCHED;
        }
        if constexpr (ALIGN_EPI) { if (wr == 0) PG8_BAR; }
        if constexpr (P::FP8) { asm volatile("s_nop 15\n\ts_nop 15" ::: "memory"); }
        p.epi(acc, cur, wr, wc, fr, fq);
        if (!has_next) break;
#pragma unroll
        for (int a = 0; a < 2; ++a)
#pragma unroll
            for (int b = 0; b < 2; ++b)
#pragma unroll
                for (int m = 0; m < 4; ++m)
#pragma unroll
                    for (int n = 0; n < 2; ++n) acc[a][b][m][n] = (f32x4){0.f, 0.f, 0.f, 0.f};
        cur = nxt; cA = nA; ++ui;
        if constexpr (P::GATHER) { const u32x4 onv = *(const LAS u32x4*)(lds + ONOFF + tid * 16); oc[0][0] = onv.x; oc[0][1] = onv.y; oc[1][0] = onv.z; oc[1][1] = onv.w; }
        if constexpr (ALIGN_EPI) { if (wr == 1) PG8_BAR; }
    }
    PG8_WAIT_V(0);
    if constexpr (!ALIGN_EPI) { if (wr == 0) PG8_BAR; }
    PG8_BAR;
#undef PG8_SA
#undef PG8_SB
#undef PG8_STAGE
#undef PG8_STA
#undef PG8_LDA
#undef PG8_LDB
#undef PG8_LD32
#undef PG8_LOH
#undef PG8_HIH
#undef PG8_MMA
#undef PG8_WAIT_V
#undef PG8_WAIT_L
#undef PG8_BAR
#undef PG8_SCHED
}
}

struct Args { const float* in[17]; float* out; unsigned char* ws; int ph_lo, ph_hi; };
struct Frame {
    const Args* A;
    LAS unsigned char* lds;
    volatile LAS unsigned* MISC;
    int wave, vcu, G;
};

struct TItem { const float* W; void* WT; const float* kscale; int ldw, K, k0, scol0, drow0; float sc; int fp8; };
__device__ __forceinline__ void titem_load(const TItem& t, f32x4 (&vv)[8], int lane) {
#pragma unroll
    for (int i = 0; i < 8; ++i) { const int kk = 8 * i + (lane >> 3); vv[i] = *(const f32x4*)(t.W + (size_t)(t.k0 + kk) * t.ldw + t.scol0 + 4 * (lane & 7)); }
}
__device__ __forceinline__ void titem_store(const TItem& t, const f32x4 (&vv)[8], LAS float* scr, int lane) {
#pragma unroll
    for (int i = 0; i < 8; ++i) { const int kk = 8 * i + (lane >> 3); float sc = t.sc; if (t.kscale) sc *= t.kscale[t.k0 + kk]; LAS float* d = scr + kk * 33 + 4 * (lane & 7);
        d[0] = vv[i].x * sc; d[1] = vv[i].y * sc; d[2] = vv[i].z * sc; d[3] = vv[i].w * sc; }
    LDS_WAIT(); asm volatile("" ::: "memory");
    const int c = lane & 7;
#pragma unroll
    for (int j = 0; j < 4; ++j) { const int n = (lane >> 3) + 8 * j; const LAS float* s = scr + (8 * c) * 33 + n;
        if (t.fp8) { u32x2 o; o.x = pk_fp8x4(s[0 * 33], s[1 * 33], s[2 * 33], s[3 * 33]); o.y = pk_fp8x4(s[4 * 33], s[5 * 33], s[6 * 33], s[7 * 33]);
            *(u32x2*)((unsigned char*)t.WT + (size_t)(t.drow0 + n) * t.K + t.k0 + 8 * c) = o; }
        else { u32x4 o; o.x = cvt_pk_bf16(s[0 * 33], s[1 * 33]); o.y = cvt_pk_bf16(s[2 * 33], s[3 * 33]); o.z = cvt_pk_bf16(s[4 * 33], s[5 * 33]); o.w = cvt_pk_bf16(s[6 * 33], s[7 * 33]);
            *(u32x4*)((bf16*)t.WT + (size_t)(t.drow0 + n) * t.K + t.k0 + 8 * c) = o; } }
    LDS_WAIT(); asm volatile("" ::: "memory");
}
__device__ __forceinline__ float log_sigmoid(float x) { return fminf(x, 0.f) - log1pf(__expf(-fabsf(x))); }

__device__ __forceinline__ void p0_prologue(Frame& F) {
    const int gw = F.vcu * NWAVES + F.wave, NGW = F.G * NWAVES, lane = ((int)(threadIdx.x & 63));
    const int gt = F.vcu * 512 + ((int)threadIdx.x), NGT = F.G * 512;
    {
        LAS float* scr = (LAS float*)(F.lds + F.wave * 16384);
        const float* w_in = F.A->in[3]; const float* w_out = F.A->in[7]; const float* w_gate = F.A->in[13]; const float* w_up = F.A->in[14]; const float* w_down = F.A->in[15];
        bf16* WINT = (bf16*)(F.A->ws + WS_WINT); bf16* WOUTT = (bf16*)(F.A->ws + WS_WOUTT); unsigned char* WGU = (unsigned char*)(F.A->ws + WS_WGU); unsigned char* WD = (unsigned char*)(F.A->ws + WS_WD);
        constexpr int I_IN = 32 * 224, I_OUT = 32 * 64, I_G = 16 * 32 * 32, I_D = 16 * 16 * 64;
        constexpr int NITEMS = I_IN + I_OUT + 2 * I_G + I_D;
        auto decode = [&](int it) -> TItem {
            TItem t; t.kscale = nullptr; t.sc = 1.f; t.fp8 = 0; int r = it;
            if (r < I_IN) { const int kb = r / 224, nb = r % 224, n0 = nb * 32; t.W = w_in; t.ldw = INC; t.K = DM; t.WT = WINT; t.k0 = kb * 64; t.scol0 = n0 + (n0 >= 3072 ? 8 : 0); t.drow0 = n0; return t; } r -= I_IN;
            if (r < I_OUT) { const int kb = r / 64, nb = r % 64; t.W = w_out; t.ldw = DM; t.K = DM; t.WT = WOUTT; t.k0 = kb * 64; t.scol0 = nb * 32; t.drow0 = nb * 32; t.kscale = (kb < 16) ? F.A->in[5] : (F.A->in[6] - 1024); return t; } r -= I_OUT;
            if (r < 2 * I_G) { const int up = r >= I_G; if (up) r -= I_G; const int e = r / 1024, q = r % 1024, kb = q / 32, nb = q % 32, n0 = nb * 32;
                t.W = (up ? w_up : w_gate) + (size_t)e * DM * DE; t.ldw = DE; t.K = DM; t.WT = WGU + (size_t)e * 2048 * DM; t.k0 = kb * 64; t.scol0 = n0; t.drow0 = (n0 >> 7) * 256 + up * 128 + (n0 & 127); t.sc = SW1; t.fp8 = 1; return t; } r -= 2 * I_G;
            { const int e = r / 1024, q = r % 1024, kb = q / 64, nb = q % 64; t.W = w_down + (size_t)e * DE * DM; t.ldw = DM; t.K = DE; t.WT = WD + (size_t)e * DM * DE; t.k0 = kb * 64; t.scol0 = nb * 32; t.drow0 = nb * 32; t.sc = SW2; t.fp8 = 1; return t; }
        };
        f32x4 va[8], vb[8];
        int it = gw;
        if (it < NITEMS) {
            TItem ta = decode(it); titem_load(ta, va, lane);
            for (;;) {
                const int itb = it + NGW; TItem tb = ta; const bool hb = itb < NITEMS;
                if (hb) { tb = decode(itb); titem_load(tb, vb, lane); }
                titem_store(ta, va, scr, lane);
                if (!hb) break;
                const int ita = itb + NGW; const bool ha = ita < NITEMS;
                if (ha) { ta = decode(ita); titem_load(ta, va, lane); }
                titem_store(tb, vb, scr, lane);
                if (!ha) break;
                it = ita;
            }
        }
    }
    {
        float* WRT = (float*)(F.A->ws + WS_WRT); const float* g2 = F.A->in[8]; const float* wrg = F.A->in[9]; const float* wre = F.A->in[11];
        for (int i = gt; i < 32 * DM; i += NGT) { const int j = i / DM, k = i % DM; WRT[i] = (j < 20) ? g2[k] * (j < 4 ? wrg[k * 4 + j] : wre[k * 16 + (j - 4)]) : 0.f; }
        f32x2* ROPE = (f32x2*)(F.A->ws + WS_ROPE);
        for (int i = gt; i < 4112 * 64; i += NGT) { const int pos = i >> 6, k = i & 63;
            const float lin = (float)k * (1.0f / 63.0f); const float ang = 1.0f / exp2f(lin * 13.287712379549449f);
            const float ph = (float)pos * ang; const double rev = (double)ph * 0.15915494309189535; const float fr = (float)(rev - floor(rev));
            ROPE[i] = (f32x2){__builtin_amdgcn_cosf(fr), __builtin_amdgcn_sinf(fr)}; }
        bf16* U = (bf16*)(F.A->ws + WS_U);
        for (int i = gt; i < 4 * NB * PADN * 128; i += NGT) { const int c8 = i & 127, row = (i >> 7) % PADN, bb = ((i >> 7) / PADN) % NB, cl = (i >> 7) / (PADN * NB);
            const int cls = (cl == 0) ? 1 : (cl == 1) ? 2 : (cl == 2) ? 4 : 5;
            *(u32x4*)(U + cls * USTR + ((size_t)(bb * PP + row)) * 1024 + c8 * 8) = (u32x4){0u, 0u, 0u, 0u}; }
        float* LOGF = (float*)(F.A->ws + WS_LOGF);
        for (int i = gt; i < 32 * PADN; i += NGT) LOGF[(i / PADN) * PP + (i % PADN)] = 0.f;
    }
    __syncthreads();
    {
        LAS float* WF = (LAS float*)F.lds; const float* w_in = F.A->in[3]; const float* g1 = F.A->in[2];
        for (int i = ((int)threadIdx.x); i < 8 * DM; i += 512) { const int k = i >> 3, h = i & 7; WF[h * DM + k] = g1[k] * w_in[(size_t)k * INC + 3072 + h]; }
        __syncthreads();
        f32x4 gv[8];
#pragma unroll
        for (int j = 0; j < 8; ++j) gv[j] = *((const f32x4*)g1 + lane + 64 * j);
        bf16* HN = (bf16*)(F.A->ws + WS_HN); bf16* HNMETA = (bf16*)(F.A->ws + WS_HNMETA); float* LOGF = (float*)(F.A->ws + WS_LOGF); const float* bfv = F.A->in[4];
        for (int row = gw; row < MTOK + NMETA; row += NGW) {
            const bool meta = row >= MTOK; const int mj = row - MTOK;
            const float* xr = meta ? (F.A->in[1] + (size_t)mj * DM) : (F.A->in[0] + (size_t)row * DM);
            f32x4 v[8]; float ss = 0.f;
#pragma unroll
            for (int j = 0; j < 8; ++j) { v[j] = *((const f32x4*)xr + lane + 64 * j); ss += (v[j].x * v[j].x + v[j].y * v[j].y) + (v[j].z * v[j].z + v[j].w * v[j].w); }
            const float rs = 1.0f / sqrtf(wave_sum(ss) * (1.0f / DM) + EPS);
            float fl[8];
#pragma unroll
            for (int h = 0; h < 8; ++h) { float s = 0.f;
#pragma unroll
                for (int j = 0; j < 8; ++j) { const f32x4 w = *((const LAS f32x4*)(WF + h * DM) + lane + 64 * j); s += (v[j].x * w.x + v[j].y * w.y) + (v[j].z * w.z + v[j].w * w.w); }
                fl[h] = wave_sum(s) * rs; }
            bf16* orow = meta ? (HNMETA + (size_t)mj * DM) : (HN + (size_t)row * DM);
#pragma unroll
            for (int j = 0; j < 8; ++j) { const f32x4 y = v[j] * rs * gv[j]; u32x2 w; w.x = cvt_pk_bf16(y.x, y.y); w.y = cvt_pk_bf16(y.z, y.w); *((u32x2*)orow + lane + 64 * j) = w; }
            if (lane < 8) { float f = fl[0];
#pragma unroll
                for (int h = 1; h < 8; ++h) f = (lane == h) ? fl[h] : f;
                const float lf = log_sigmoid(f + bfv[lane]);
                if (meta) { for (int bb = 0; bb < NB; ++bb) LOGF[(bb * NH + lane) * PP + PADN + mj] = lf; }
                else { const int bb = row >> 12, t = row & 4095; LOGF[(bb * NH + lane) * PP + 128 + t] = lf; } }
        }
    }
}

__device__ __forceinline__ void p1_cumsum(Frame& F) {
    const int gw = F.vcu * NWAVES + F.wave, NGW = F.G * NWAVES, lane = ((int)(threadIdx.x & 63));
    const float* LOGF = (const float*)(F.A->ws + WS_LOGF); float* CUM = (float*)(F.A->ws + WS_CUM);
    for (int s = gw; s < NB * NH; s += NGW) {
        const float* src = LOGF + (size_t)s * PP + lane * 66; float* dst = CUM + (size_t)s * PP + lane * 66;
        float loc = 0.f; for (int i = 0; i < 66; ++i) loc += src[i];
        float inc = loc;
#pragma unroll
        for (int o = 1; o < 64; o <<= 1) { const float t = __shfl_up(inc, o); if (lane >= o) inc += t; }
        float run = inc - loc;
        for (int i = 0; i < 66; ++i) { run += src[i]; dst[i] = run; }
    }
}
__device__ __forceinline__ void p1_meta_kv(Frame& F) {
    const int lane = ((int)(threadIdx.x & 63)), w = F.wave;
    const bf16* HNMETA = (const bf16*)(F.A->ws + WS_HNMETA); const bf16* WINT = (const bf16*)(F.A->ws + WS_WINT); bf16* U = (bf16*)(F.A->ws + WS_U);
    const f32x2* ROPE = (const f32x2*)(F.A->ws + WS_ROPE);
    LAS float* red = (LAS float*)F.lds;
    for (int blk = blockIdx.x; blk < 256; blk += F.G) {
        const int kv0 = blk * 16, q = kv0 >> 10, col0 = kv0 & 1023;
        const int cls = (q == 0) ? 1 : (q == 1) ? 2 : (q == 2) ? 4 : 5;
        const int nrow0 = ((q == 0) ? 1024 : (q == 1) ? 2048 : (q == 2) ? 4096 : 5120) + col0;
        f32x4 acc = (f32x4){0.f, 0.f, 0.f, 0.f};
#pragma unroll
        for (int s = 0; s < 8; ++s) { const int k0 = w * 256 + s * 32 + 8 * (lane >> 4);
            const bf16x8 a = *(const bf16x8*)(HNMETA + (size_t)(lane & 15) * DM + k0);
            const bf16x8 b = *(const bf16x8*)(WINT + (size_t)(nrow0 + (lane & 15)) * DM + k0);
            acc = __builtin_amdgcn_mfma_f32_16x16x32_bf16(a, b, acc, 0, 0, 0); }
#pragma unroll
        for (int r = 0; r < 4; ++r) red[w * 256 + ((lane >> 4) * 4 + r) * 16 + (lane & 15)] = acc[r];
        __syncthreads();
        if (((int)threadIdx.x) < 256) { const int row = ((int)threadIdx.x) >> 4, col = ((int)threadIdx.x) & 15;
            float v = 0.f, vp = 0.f;
#pragma unroll
            for (int ww = 0; ww < 8; ++ww) { v += red[ww * 256 + row * 16 + col]; vp += red[ww * 256 + row * 16 + (col ^ 1)]; }
            float o = v;
            if (q == 2) { const int d = (col0 + col) & 127; const f32x2 cs = ROPE[row * 64 + (d >> 1)];
                const int hh = (col0 + col) >> 7; const float lg2h = log2f(1.0f - exp2f(-5.0f - (float)hh));
                o = ((col & 1) ? (v * cs.x + vp * cs.y) : (v * cs.x - vp * cs.y)) * SCALE * exp2f(-(float)(PADN + row + 1) * lg2h); }
            if (q == 0) { float s2 = o * o; s2 += __shfl_xor(s2, 1); s2 += __shfl_xor(s2, 2); s2 += __shfl_xor(s2, 4); s2 += __shfl_xor(s2, 8);
                if (col == 0) atomicAdd((float*)((unsigned*)F.A->ws + CW_MNRM) + ((col0 >> 7) * 16 + row), s2); }
            const unsigned short ob = (unsigned short)(cvt_pk_bf16(o, 0.f) & 0xffffu);
            for (int bb = 0; bb < NB; ++bb) U[cls * USTR + ((size_t)(bb * PP + PADN + row)) * 1024 + col0 + col] = ob; }
        __syncthreads();
    }
}

struct PInProj {
    static constexpr bool PERM = true, HAS_MID = false, FP8 = false, GATHER = false;
    int nt; const char* Abase; unsigned lda2, ldb2; const char* Bt; bf16* U; const f32x2* ROPE; unsigned* NRM;
    __device__ __forceinline__ void a_offs(const g8::Unit&, unsigned (&)[2][2]) const {}
    __device__ __forceinline__ const char* b_tile(const g8::Unit& u, int t) const { return Bt + (size_t)u.pn * 256 * ldb2 + (size_t)t * 128; }
    __device__ __forceinline__ void mid(f32x4 (&)[2][2][4][2], const g8::Unit&, int, int, int, int) const {}
    __device__ __forceinline__ void epi(const f32x4 (&acc)[2][2][4][2], const g8::Unit& u, int wr, int wc, int fr, int fq) const {
        const int cls = u.pn >> 2;
        bf16* base = U + (size_t)cls * USTR;
        const int ccol0 = (u.pn & 3) * 256 + wc * 32 + 8 * fq;
        const int bb = u.pm >> 4;
        float nmx[2] = {0.f, 0.f};
#pragma unroll
        for (int ai = 0; ai < 2; ++ai)
#pragma unroll
            for (int m = 0; m < 4; ++m) {
                const int t = ((u.pm & 15) << 8) + ai * 128 + wr * 64 + m * 16 + fr;
                bf16* rowp = base + ((size_t)(bb * PP + 128 + t)) * 1024 + ccol0;
                f32x4 c0 = (f32x4){1.f, 0.f, 1.f, 0.f}, c1 = c0;
                if (cls == 3 || cls == 4) { const f32x4* rp = (const f32x4*)(ROPE + (size_t)(t + 16) * 64 + wc * 16 + fq * 4); c0 = rp[0]; c1 = rp[1]; }
#pragma unroll
                for (int bj = 0; bj < 2; ++bj) {
                    f32x4 v0 = acc[ai][bj][m][0], v1 = acc[ai][bj][m][1];
                    if (cls == 3 || cls == 4) {
                        f32x4 r0, r1;
                        r0.x = v0.x * c0.x - v0.y * c0.y; r0.y = v0.y * c0.x + v0.x * c0.y; r0.z = v0.z * c0.z - v0.w * c0.w; r0.w = v0.w * c0.z + v0.z * c0.w;
                        r1.x = v1.x * c1.x - v1.y * c1.y; r1.y = v1.y * c1.x + v1.x * c1.y; r1.z = v1.z * c1.z - v1.w * c1.w; r1.w = v1.w * c1.z + v1.z * c1.w;
                        const int hh = (u.pn & 3) * 2 + bj; const float lg2h = log2f(1.0f - exp2f(-5.0f - (float)hh)); const float ip1 = (float)((t & 127) + 1);
                        const float sc = (cls == 4) ? SCALE * exp2f(-ip1 * lg2h) : exp2f(ip1 * lg2h); v0 = r0 * sc; v1 = r1 * sc;
                    } else if (cls == 6) {
#pragma unroll
                        for (int e = 0; e < 4; ++e) { v0[e] = v0[e] / (1.f + __expf(-v0[e])); v1[e] = v1[e] / (1.f + __expf(-v1[e])); }
                    }
                    u32x4 w; w.x = cvt_pk_bf16(v0[0], v0[1]); w.y = cvt_pk_bf16(v0[2], v0[3]); w.z = cvt_pk_bf16(v1[0], v1[1]); w.w = cvt_pk_bf16(v1[2], v1[3]);
                    *(u32x4*)(rowp + bj * 128) = w;
                    if (cls <= 1) { float sq = (v0[0] * v0[0] + v0[1] * v0[1]) + (v0[2] * v0[2] + v0[3] * v0[3]) + (v1[0] * v1[0] + v1[1] * v1[1]) + (v1[2] * v1[2] + v1[3] * v1[3]);
                        sq += __shfl_xor(sq, 16); sq += __shfl_xor(sq, 32); nmx[bj] = fmaxf(nmx[bj], sq); }
                }
            }
        if (cls <= 1) {
#pragma unroll
            for (int bj = 0; bj < 2; ++bj) { float v = nmx[bj]; v = fmaxf(v, __shfl_xor(v, 1)); v = fmaxf(v, __shfl_xor(v, 2)); v = fmaxf(v, __shfl_xor(v, 4)); v = fmaxf(v, __shfl_xor(v, 8));
                if ((threadIdx.x & 63) == 0) atomicMax(NRM + ((cls * 32 + bb * 8 + (u.pn & 3) * 2 + bj) * 4 + wc), __float_as_uint(v)); }
        }
    }
};

template <bool RET>
__device__ __forceinline__ void attn_simple(Frame& F) {
    const int gw = F.vcu * NWAVES + F.wave, NGW = F.G * NWAVES, lane = ((int)(threadIdx.x & 63));
    LAS float* wl = (LAS float*)(F.lds + F.wave * 1024);
    const bf16* U = (const bf16*)(F.A->ws + WS_U); const float* CUM = (const float*)(F.A->ws + WS_CUM);
    bf16* OA = (bf16*)(F.A->ws + WS_HN); float* SSQ = (float*)(F.A->ws + WS_SSQ);
    for (int row = gw; row < NB * NH * SEQ; row += NGW) {
        const int t = row & 4095, bh = row >> 12, b = bh >> 3, h = bh & 7, p = 128 + t, m = b * SEQ + t;
        const bf16* Qb = U + (RET ? 3 : 0) * USTR + ((size_t)(b * PP + p)) * 1024 + h * 128;
        const bf16* Kb = U + (RET ? 4 : 1) * USTR + ((size_t)b * PP) * 1024 + h * 128;
        const bf16* Vb = U + (RET ? 5 : 2) * USTR + ((size_t)b * PP) * 1024 + h * 128;
        { const unsigned qw = *(const unsigned*)(Qb + 2 * lane); wl[2 * lane] = bf_lo(qw); wl[2 * lane + 1] = bf_hi(qw); }
        LDS_WAIT(); asm volatile("" ::: "memory");
        float m_run = -1e30f, l_run = 0.f, o0 = 0.f, o1 = 0.f;
        const float ct = RET ? 0.f : CUM[(size_t)bh * PP + p];
        const float lg2 = RET ? log2f(1.0f - exp2f(-5.0f - (float)h)) : 0.f;
        for (int s0 = 64; s0 <= p; s0 += 64) {
            const int s = s0 + lane;
            const bf16* kr = Kb + (size_t)s * 1024;
            float sc = 0.f;
#pragma unroll
            for (int c = 0; c < 16; ++c) { const u32x4 kv = *(const u32x4*)(kr + 8 * c); const f32x4 qa = *(const LAS f32x4*)(wl + 8 * c), qb = *(const LAS f32x4*)(wl + 8 * c + 4);
                sc += bf_lo(kv.x) * qa.x + bf_hi(kv.x) * qa.y + bf_lo(kv.y) * qa.z + bf_hi(kv.y) * qa.w + bf_lo(kv.z) * qb.x + bf_hi(kv.z) * qb.y + bf_lo(kv.w) * qb.z + bf_hi(kv.w) * qb.w; }
            const bool valid = (s <= p) && (s >= PADN);
            float pw;
            if constexpr (RET) { pw = valid ? sc * exp2f((float)(((p >> 7) - (s >> 7)) * 128) * lg2) : 0.f; }
            else {
                const float lg = valid ? (sc * SCALE + (ct - CUM[(size_t)bh * PP + s])) : -__builtin_inff();
                const float mn = fmaxf(m_run, wave_max(lg)); const float alpha = __expf(m_run - mn);
                pw = valid ? __expf(lg - mn) : 0.f;
                l_run = l_run * alpha + wave_sum(pw); o0 *= alpha; o1 *= alpha; m_run = mn;
            }
            asm volatile("" ::: "memory");
            wl[128 + lane] = pw;
            LDS_WAIT(); asm volatile("" ::: "memory");
#pragma unroll 8
            for (int k = 0; k < 64; ++k) { const float pk = wl[128 + k]; const unsigned vw = *(const unsigned*)(Vb + (size_t)(s0 + k) * 1024 + 2 * lane); o0 += pk * bf_lo(vw); o1 += pk * bf_hi(vw); }
            LDS_WAIT(); asm volatile("" ::: "memory");
        }
        if constexpr (RET) {
            const float mu = wave_sum(o0 + o1) * (1.0f / HD); const float d0 = o0 - mu, d1 = o1 - mu;
            const float var = wave_sum(d0 * d0 + d1 * d1) * (1.0f / HD); const float r = 1.0f / sqrtf(var + EPS);
            const unsigned gw2 = *(const unsigned*)(U + 6 * USTR + ((size_t)(b * PP + p)) * 1024 + h * 128 + 2 * lane);
            *(unsigned*)(OA + (size_t)m * DM + 1024 + h * 128 + 2 * lane) = cvt_pk_bf16(d0 * r * bf_lo(gw2), d1 * r * bf_hi(gw2));
        } else {
            const float il = 1.0f / l_run; o0 *= il; o1 *= il;
            *(unsigned*)(OA + (size_t)m * DM + h * 128 + 2 * lane) = cvt_pk_bf16(o0, o1);
            const float sq = wave_sum(o0 * o0 + o1 * o1); if (lane == 0) SSQ[(size_t)m * 8 + h] = sq;
        }
        asm volatile("" ::: "memory");
    }
}


namespace fox {
constexpr int NW = 8, QBLK = 32, KVBLK = 64, QB = 256, D = 128, LDQ = 1024, LDO = 2048;
constexpr int SHM_V = KVBLK * D * 2, SHM_K = KVBLK * D * 2;
constexpr int OFF_WS = 2 * SHM_V + 2 * SHM_K, OFF_CUM = OFF_WS + 2048, LDS_NEED = OFF_CUM + PP * 4;
static_assert(LDS_NEED <= RING_BYTES, "fox lds");
constexpr float THR = 8.f;
constexpr float INVS = 11.313708498984761f;
typedef float f32x16 __attribute__((ext_vector_type(16)));
typedef short s16x4 __attribute__((ext_vector_type(4)));
#define KSWZ(row, colB) ((row) * 256 + ((colB) ^ (((row) & 7) << 4)))
#define SBAR() __builtin_amdgcn_sched_barrier(0)
__device__ __forceinline__ int v_st(int k, int c) { const int kk = (k & ~0xC) | ((k & 4) << 1) | ((k & 8) >> 1); return ((kk >> 3) * 4 + (c >> 5)) * 512 + ((kk & 7) * 32 + (c & 31)) * 2; }
__device__ __forceinline__ int v_rd_base(int lane) { return ((lane & 3) << 3) | (((lane >> 2) & 3) << 6) | (((lane >> 4) & 1) << 5) | (((lane >> 5) & 1) << 8); }
constexpr int v_rd_off(int d0, int ks, int half) { return d0 * 512 + ks * 4096 + half * 2048; }
__device__ __forceinline__ int crow(int r, int hi) { return (r & 3) + 8 * (r >> 2) + 4 * hi; }
__device__ __forceinline__ unsigned cvtpk(float lo, float hi) { unsigned r; asm volatile("v_cvt_pk_bf16_f32 %0, %1, %2" : "=v"(r) : "v"(lo), "v"(hi)); return r; }
__device__ __forceinline__ bf16x8 load8(const bf16* p) { return *reinterpret_cast<const bf16x8*>(p); }
__device__ __forceinline__ void mask_causal(f32x16& p0, f32x16& p1, int dq) {
    const float NEG = -__builtin_inff();
#pragma unroll
    for (int r = 0; r < 16; ++r) { const int c = (r & 3) + 8 * (r >> 2); if (dq - c < 0) p0[r] = NEG; if (dq - c - 32 < 0) p1[r] = NEG; }
}
__device__ __forceinline__ void mask_pad(f32x16& p0, f32x16& p1, int hi) {
    const float NEG = -__builtin_inff();
#pragma unroll
    for (int r = 0; r < 16; ++r) { const int c = (r & 3) + 8 * (r >> 2); p0[r] = NEG; if (c + 4 * hi < 16) p1[r] = NEG; }
}
__device__ __forceinline__ void partialSM(f32x16& p0, f32x16& p1, float& m_reg, float& mn, float& alpha) {
    float pmax = p0[0]; for (int r = 1; r < 16; ++r) pmax = fmaxf(pmax, p0[r]); for (int r = 0; r < 16; ++r) pmax = fmaxf(pmax, p1[r]);
    { auto rr = __builtin_amdgcn_permlane32_swap(__float_as_uint(pmax), __float_as_uint(pmax), false, false);
      pmax = fmaxf(__uint_as_float(rr[0]), __uint_as_float(rr[1])); }
    constexpr float C2 = 1.4426950408889634f * SCALE;
    if (__builtin_expect(__all((pmax - m_reg) * SCALE <= THR), 1)) { mn = m_reg; alpha = 1.f; }
    else { mn = fmaxf(m_reg, pmax); alpha = __builtin_amdgcn_exp2f((m_reg - mn) * C2); m_reg = mn; }
    const float mnL = -mn * C2;
    for (int r = 0; r < 16; ++r) p0[r] = fmaf(p0[r], C2, mnL); for (int r = 0; r < 16; ++r) p1[r] = fmaf(p1[r], C2, mnL);
    for (int r = 0; r < 16; ++r) p0[r] = __builtin_amdgcn_exp2f(p0[r]);
}
__device__ __forceinline__ void finishSM(f32x16& p0, f32x16& p1, float alpha, float& l_reg, bf16x8& pa0, bf16x8& pa1, bf16x8& pa2, bf16x8& pa3) {
    for (int r = 0; r < 16; ++r) p1[r] = __builtin_amdgcn_exp2f(p1[r]);
    float ps = 0; for (int r = 0; r < 16; ++r) ps += p0[r]; for (int r = 0; r < 16; ++r) ps += p1[r];
    { auto rr = __builtin_amdgcn_permlane32_swap(__float_as_uint(ps), __float_as_uint(ps), false, false);
      ps = __uint_as_float(rr[0]) + __uint_as_float(rr[1]); }
    l_reg = l_reg * alpha + ps;
#define PK4(P, B_, OUT) do { unsigned a0 = cvtpk(P[B_+0], P[B_+1]), a1 = cvtpk(P[B_+2], P[B_+3]);                          \
        unsigned b0 = cvtpk(P[B_+4], P[B_+5]), b1 = cvtpk(P[B_+6], P[B_+7]);                                             \
        auto r0 = __builtin_amdgcn_permlane32_swap(a0, b0, false, false); auto r1 = __builtin_amdgcn_permlane32_swap(a1, b1, false, false); \
        u32x4 w = {r0[0], r1[0], r0[1], r1[1]}; OUT = *reinterpret_cast<bf16x8*>(&w); } while (0)
    PK4(p0, 0, pa0); PK4(p0, 8, pa1); PK4(p1, 0, pa2); PK4(p1, 8, pa3);
#undef PK4
}
template <int KB>
__device__ __forceinline__ void qkt(f32x16& p0, f32x16& p1, const LAS char* K_lds, int r32, int hi, const bf16x8* qr, const LAS float* cs) {
#pragma unroll
    for (int g = 0; g < 4; ++g) { const f32x4 a = *(const LAS f32x4*)(cs + 8 * g), b = *(const LAS f32x4*)(cs + 32 + 8 * g);
        p0[4 * g] = a[0]; p0[4 * g + 1] = a[1]; p0[4 * g + 2] = a[2]; p0[4 * g + 3] = a[3]; p1[4 * g] = b[0]; p1[4 * g + 1] = b[1]; p1[4 * g + 2] = b[2]; p1[4 * g + 3] = b[3]; }
    const LAS char* kb[4];
#pragma unroll
    for (int dd = 0; dd < 4; ++dd) kb[dd] = K_lds + KB * SHM_K + KSWZ(r32, (dd * 16 + hi * 8) * 2);
#pragma unroll
    for (int d0 = 0; d0 < 8; ++d0) { const LAS char* a = kb[d0 & 3] + (d0 >> 2) * 128;
        bf16x8 b0 = *reinterpret_cast<const LAS bf16x8*>(a);
        bf16x8 b1 = *reinterpret_cast<const LAS bf16x8*>(a + 32 * 256);
        p0 = __builtin_amdgcn_mfma_f32_32x32x16_bf16(b0, qr[d0], p0, 0, 0, 0);
        p1 = __builtin_amdgcn_mfma_f32_32x32x16_bf16(b1, qr[d0], p1, 0, 0, 0); }
}
template <int VB>
__device__ __forceinline__ void pv_tile(f32x16* o, int vb0, bf16x8 pa0, bf16x8 pa1, bf16x8 pa2, bf16x8 pa3) {
#define TRRD(dst, off) asm volatile("ds_read_b64_tr_b16 %0, %1 offset:%2" : "=&v"(dst) : "v"(vb0), "i"(off) : "memory")
#define PV_D0(d0) do { s16x4 l0, l1, l2, l3, h0, h1, h2, h3; constexpr int b_ = VB * SHM_V + v_rd_off(d0, 0, 0); \
        TRRD(l0, b_); TRRD(h0, b_ + 2048); TRRD(l1, b_ + 4096); TRRD(h1, b_ + 6144); TRRD(l2, b_ + 8192); TRRD(h2, b_ + 10240); TRRD(l3, b_ + 12288); TRRD(h3, b_ + 14336); \
        asm volatile("s_waitcnt lgkmcnt(0)" ::: "memory"); SBAR();   \
        o[d0] = __builtin_amdgcn_mfma_f32_32x32x16_bf16(pa0, (bf16x8){l0[0], l0[1], l0[2], l0[3], h0[0], h0[1], h0[2], h0[3]}, o[d0], 0, 0, 0);   \
        o[d0] = __builtin_amdgcn_mfma_f32_32x32x16_bf16(pa1, (bf16x8){l1[0], l1[1], l1[2], l1[3], h1[0], h1[1], h1[2], h1[3]}, o[d0], 0, 0, 0);   \
        o[d0] = __builtin_amdgcn_mfma_f32_32x32x16_bf16(pa2, (bf16x8){l2[0], l2[1], l2[2], l2[3], h2[0], h2[1], h2[2], h2[3]}, o[d0], 0, 0, 0);   \
        o[d0] = __builtin_amdgcn_mfma_f32_32x32x16_bf16(pa3, (bf16x8){l3[0], l3[1], l3[2], l3[3], h3[0], h3[1], h3[2], h3[3]}, o[d0], 0, 0, 0); } while (0)
    PV_D0(0); PV_D0(1); PV_D0(2); PV_D0(3);
#undef PV_D0
#undef TRRD
}
struct BlockRef { int bh, qb; };
struct Bases { const bf16* U; bf16* OA; float* SSQ; const float* CUM; };
__device__ __forceinline__ int blk_p0(const BlockRef& r) { return 128 + r.qb * 256; }
__device__ __forceinline__ const bf16* blk_q(const Bases& B, const BlockRef& r) { return B.U + ((size_t)((r.bh >> 3) * PP + blk_p0(r))) * 1024 + (r.bh & 7) * 128; }
__device__ __forceinline__ const bf16* blk_k(const Bases& B, const BlockRef& r) { return B.U + 1 * USTR + ((size_t)(r.bh >> 3) * PP) * 1024 + (r.bh & 7) * 128; }
__device__ __forceinline__ const bf16* blk_v(const Bases& B, const BlockRef& r) { return B.U + 2 * USTR + ((size_t)(r.bh >> 3) * PP) * 1024 + (r.bh & 7) * 128; }
struct Seam { bf16x8 qr[8]; bf16x8 st_v0, st_v1, st_k0, st_k1; };
#define ROW(p, k0, rr) ((p) + (size_t)((k0) + (rr)) * LDQ + sc)
#define VMW() asm volatile("s_waitcnt vmcnt(0)" ::: "memory")
#define VMWN(n) asm volatile("s_waitcnt vmcnt(%0)" :: "i"(n) : "memory")
#define SLOAD_H(Kp, Vp, k0) do { S.st_v0 = load8(ROW(Vp, k0, sr)); S.st_v1 = load8(ROW(Vp, k0, 32 + sr));              \
                         S.st_k0 = load8(ROW(Kp, k0, sr)); S.st_k1 = load8(ROW(Kp, k0, 32 + sr)); } while (0)
#define SWRITE_HK(bf) do { *(LAS bf16x8*)(K_lds + (bf) * SHM_K + kws) = S.st_k0; *(LAS bf16x8*)(K_lds + (bf) * SHM_K + kws + 32 * 256) = S.st_k1; } while (0)
#define SWRITE_HV(bf) do { *(LAS bf16x8*)(V_lds + (bf) * SHM_V + vst0) = S.st_v0; *(LAS bf16x8*)(V_lds + (bf) * SHM_V + vst1) = S.st_v1; } while (0)
#define SWRITE_H(bf) do { SWRITE_HV(bf); SWRITE_HK(bf); } while (0)
__device__ __forceinline__ void prime(const Bases& B, const BlockRef& cur, int j_lo, LAS char* lds, Seam& S, int tid) {
    const int wid = __builtin_amdgcn_readfirstlane(tid >> 6), lane = tid & 63, r32 = lane & 31, hi = lane >> 5;
    const int sr = tid >> 4, sc = (tid & 15) * 8, kws = KSWZ(sr, sc * 2); LAS char* K_lds = lds + 2 * SHM_V;
    const int kb0 = j_lo * KVBLK;
#pragma unroll
    for (int d0 = 0; d0 < 8; ++d0) S.qr[d0] = load8(blk_q(B, cur) + (size_t)(wid * QBLK + r32) * LDQ + d0 * 16 + hi * 8);
    { const bf16* Kp = blk_k(B, cur); const bf16* Vp = blk_v(B, cur); SLOAD_H(Kp, Vp, kb0); } VMW(); SWRITE_HK(0);
    __syncthreads();
}
__device__ __forceinline__ void stage_cum(const Bases& B, const BlockRef& cur, LAS char* lds) {
    const int tid = threadIdx.x, P0 = blk_p0(cur); LAS float* cumS = (LAS float*)(lds + OFF_CUM);
    const float* CUMG = B.CUM + (size_t)cur.bh * PP; const float cref = CUMG[P0]; const int n4 = (P0 + QB) >> 2;
    for (int i = tid; i < n4; i += 512) { const f32x4 c = *((const f32x4*)CUMG + i); *((LAS f32x4*)cumS + i) = (cref - c) * INVS; }
}
__device__ __forceinline__ void block(const Bases& B, const BlockRef& cur, const BlockRef& nxt, int j_lo, LAS char* lds, Seam& S, int tid) {
    const int wid = __builtin_amdgcn_readfirstlane(tid >> 6), lane = tid & 63, r32 = lane & 31, hi = lane >> 5;
    const int P0 = blk_p0(cur);
    const int j_hi = (P0 + QB - 1) / KVBLK + 1;
    const int NT = j_hi - j_lo;
    const int kbn = j_lo * KVBLK;
    const int qlo = P0 + wid * QBLK, qm = qlo + r32 - 4 * hi;
    LAS char* V_lds = lds; LAS char* K_lds = lds + 2 * SHM_V;
    LAS float* ws = (LAS float*)(lds + OFF_WS) + wid * 64; LAS float* li_l = ws; LAS float* al_l = ws + 32;
    LAS float* cumS = (LAS float*)(lds + OFF_CUM);
    float m_reg = -1e30f, l_reg = 0; f32x16 o[4] = {};
    const int sr = tid >> 4, sc = (tid & 15) * 8, vst0 = v_st(sr, sc), vst1 = v_st(32 + sr, sc), kws = KSWZ(sr, sc * 2);
    const int vb0 = (int)(uintptr_t)V_lds + v_rd_base(lane);
    const bf16* Kh = blk_k(B, cur); const bf16* Vh = blk_v(B, cur);
#define RESC(a) do { if (__any((a) < 1.f)) { if (hi == 0) al_l[r32] = (a); asm volatile("s_waitcnt lgkmcnt(0)" ::: "memory");              \
                     for (int d_ = 0; d_ < 4; ++d_) for (int r = 0; r < 16; ++r) o[d_][r] *= al_l[crow(r, hi)]; } } while (0)
#define KBASE(t) ((j_lo + (t)) * KVBLK)
#define CSP(t) (cumS + KBASE(t) + 4 * hi)
#define MASKT(P0_, P1_, t) do { const int kb_ = KBASE(t); if (kb_ + KVBLK - 1 > qlo) mask_causal(P0_, P1_, qm - kb_); if (kb_ == KVBLK) mask_pad(P0_, P1_, hi); } while (0)
#define SEAM_K0() do { VMWN(8); SWRITE_HK(0); SBAR(); } while (0)
    f32x16 pA0, pA1, pB0, pB1; float mnA, mnB, alA, alB; bf16x8 pa0, pa1, pa2, pa3;
    SWRITE_HV(0); SBAR();
    if (NT > 1) { SLOAD_H(Kh, Vh, KBASE(1)); }
    SBAR(); qkt<0>(pA0, pA1, K_lds, r32, hi, S.qr, CSP(0));
    MASKT(pA0, pA1, 0); partialSM(pA0, pA1, m_reg, mnA, alA);
    if (NT > 1) { VMW(); SWRITE_H(1); }
    __syncthreads();
#define HALF_STEP(PX0, PX1, mnX, alX, PY0, PY1, alY, t, KB, VB, SB) do {                                                      \
        SBAR(); qkt<KB>(PX0, PX1, K_lds, r32, hi, S.qr, CSP(t));                                             \
        finishSM(PY0, PY1, alY, l_reg, pa0, pa1, pa2, pa3); SBAR();                                                           \
        if ((t) + 1 < NT) { SLOAD_H(Kh, Vh, KBASE((t) + 1)); SBAR(); }                                               \
        pv_tile<VB>(o, vb0, pa0, pa1, pa2, pa3); MASKT(PX0, PX1, (t)); partialSM(PX0, PX1, m_reg, mnX, alX);                                        \
        __syncthreads();                                                                                                      \
        if ((t) + 1 < NT) { VMW(); SWRITE_H(SB); }                                                                          \
        RESC(alX); __syncthreads(); } while (0)
    for (int t = 1; t + 1 < NT; t += 2) {
        HALF_STEP(pB0, pB1, mnB, alB, pA0, pA1, alA, t, 1, 0, 0);
        HALF_STEP(pA0, pA1, mnA, alA, pB0, pB1, alB, t + 1, 0, 1, 1);
    }
    const bool even = (NT & 1) == 0;
    if (even) { SBAR(); qkt<1>(pB0, pB1, K_lds, r32, hi, S.qr, CSP(NT - 1)); SBAR(); }
    { const bf16* Kn = blk_k(B, nxt); const bf16* Vn = blk_v(B, nxt); SLOAD_H(Kn, Vn, kbn); } SBAR();
    { const bf16* Qn = blk_q(B, nxt);
#pragma unroll
    for (int d0 = 0; d0 < 8; ++d0) S.qr[d0] = load8(Qn + (size_t)(wid * QBLK + r32) * LDQ + d0 * 16 + hi * 8); }
    SBAR();
    finishSM(pA0, pA1, alA, l_reg, pa0, pa1, pa2, pa3); SBAR();
    pv_tile<0>(o, vb0, pa0, pa1, pa2, pa3);
    if (even) { MASKT(pB0, pB1, NT - 1); partialSM(pB0, pB1, m_reg, mnB, alB); __syncthreads(); RESC(alB);
        finishSM(pB0, pB1, alB, l_reg, pa0, pa1, pa2, pa3); SBAR(); pv_tile<1>(o, vb0, pa0, pa1, pa2, pa3); }
    SBAR(); SEAM_K0();
    if (hi == 0) li_l[r32] = l_reg; asm volatile("s_waitcnt lgkmcnt(0)" ::: "memory");
    float rli[16];
#pragma unroll
    for (int r = 0; r < 16; ++r) rli[r] = __builtin_amdgcn_rcpf(li_l[crow(r, hi)]);
    int r32e = r32, hie = hi; asm volatile("" : "+v"(r32e), "+v"(hie));
    const size_t m0 = (size_t)(cur.bh >> 3) * SEQ + cur.qb * 256 + wid * QBLK + 4 * hie;
    bf16* Ow = B.OA + m0 * LDO + (cur.bh & 7) * 128 + r32e; float* Sw = B.SSQ + m0 * 8 + (cur.bh & 7);
#pragma unroll
    for (int r = 0; r < 16; ++r) { const int orow = (r & 3) + 8 * (r >> 2); float sq = 0.f;
#pragma unroll
        for (int d0 = 0; d0 < 4; ++d0) { const float v = o[d0][r] * rli[r]; sq += v * v;
            const float vn = __shfl_xor(v, 1);
            if ((r32e & 1) == 0) *(unsigned*)(Ow + (size_t)orow * LDO + d0 * 32) = cvtpk(v, vn); }
        sq += __shfl_xor(sq, 1); sq += __shfl_xor(sq, 2); sq += __shfl_xor(sq, 4); sq += __shfl_xor(sq, 8); sq += __shfl_xor(sq, 16);
        if (r32e == 0) Sw[(size_t)orow * 8] = sq; }
    __syncthreads();
#undef RESC
#undef KBASE
#undef CSP
#undef MASKT
#undef SEAM_K0
#undef HALF_STEP
}
#undef ROW
#undef VMW
#undef VMWN
#undef SLOAD_H
#undef SWRITE_HK
#undef SWRITE_HV
#undef SWRITE_H
#undef KSWZ
#undef SBAR
}

constexpr int FOXQ_OFF = 98304;
__device__ __forceinline__ void fox_phase(Frame& F) {
    const int tid = (int)threadIdx.x;
    const fox::Bases B{(const bf16*)(F.A->ws + WS_U), (bf16*)(F.A->ws + WS_HN), (float*)(F.A->ws + WS_SSQ), (const float*)(F.A->ws + WS_CUM)};
    LAS float* est = (LAS float*)(F.lds + FOXQ_OFF); LAS int* order = (LAS int*)(F.lds + FOXQ_OFF + 2048); LAS float* XS = (LAS float*)(F.lds + FOXQ_OFF + 4096); LAS int* misc = (LAS int*)(F.lds + FOXQ_OFF + 4096 + 256);
    unsigned* ctl = (unsigned*)F.A->ws;
    {
        const int bh = tid >> 4, qb = tid & 15, h = bh & 7;
        float q2 = 0.f, k2 = 0.f;
#pragma unroll
        for (int p = 0; p < 4; ++p) { q2 += __uint_as_float(__hip_atomic_load(ctl + CW_NRM + (bh * 4 + p), __ATOMIC_RELAXED, __HIP_MEMORY_SCOPE_AGENT)); k2 += __uint_as_float(__hip_atomic_load(ctl + CW_NRM + ((32 + bh) * 4 + p), __ATOMIC_RELAXED, __HIP_MEMORY_SCOPE_AGENT)); }
        float km = 0.f;
        for (int r = 0; r < 16; ++r) km = fmaxf(km, __uint_as_float(__hip_atomic_load(ctl + CW_MNRM + h * 16 + r, __ATOMIC_RELAXED, __HIP_MEMORY_SCOPE_AGENT)));
        k2 = fmaxf(k2, km);
        const float X = 45.0f + 2.0f * 1.03f * SCALE * sqrtf(q2 * k2);
        const float rate = -B.CUM[(size_t)bh * PP + PP - 1] * (1.0f / 4112.0f);
        const float full = (float)(4 * qb + 5), win = X / fmaxf(rate, 1e-6f) * (1.0f / 64.0f) + 5.0f;
        est[tid] = fminf(full, win) + 1e-3f * (float)qb;
        if (qb == 0) XS[bh] = X;
    }
    __syncthreads();
    { const float e = est[tid]; int rank = 0;
      for (int u = 0; u < 512; ++u) { const float o = est[u]; rank += (o > e || (o == e && u < tid)) ? 1 : 0; }
      order[rank] = tid; }
    __syncthreads();
    fox::Seam S;
    for (;;) {
        if (tid == 0) misc[0] = (int)__hip_atomic_fetch_add(ctl + CW_QHEAD, 1u, __ATOMIC_RELAXED, __HIP_MEMORY_SCOPE_AGENT);
        __syncthreads();
        const int idx = __builtin_amdgcn_readfirstlane(misc[0]);
        if (idx >= 512) break;
        const int blk = __builtin_amdgcn_readfirstlane(order[idx]);
        const fox::BlockRef cur{blk >> 4, blk & 15};
        fox::stage_cum(B, cur, (LAS char*)F.lds);
        if (tid == 0) misc[1] = 0;
        __syncthreads();
        {
            const int nfull = 4 * cur.qb + 5; const float thr = -XS[cur.bh] * fox::INVS; const LAS float* cumS = (const LAS float*)(F.lds + fox::OFF_CUM);
            if (tid < nfull - 4) { if (cumS[64 * (1 + tid) + 63] < thr) __hip_atomic_fetch_add((LAS int*)misc + 1, 1, __ATOMIC_RELAXED, __HIP_MEMORY_SCOPE_WORKGROUP); }
        }
        __syncthreads();
        const int j_lo = 1 + __builtin_amdgcn_readfirstlane(misc[1]);
        int tq = (int)threadIdx.x; asm volatile("" : "+v"(tq));
        fox::prime(B, cur, j_lo, (LAS char*)F.lds, S, tq);
        fox::block(B, cur, cur, j_lo, (LAS char*)F.lds, S, tq);
    }
}

namespace ret {
typedef short s16x4 __attribute__((ext_vector_type(4)));
typedef short v4i16_t __attribute__((ext_vector_type(4)));
__device__ __forceinline__ s16x4 vtr(const LAS char* p) { return __builtin_bit_cast(s16x4, __builtin_amdgcn_ds_read_tr16_b64_v4i16((LAS v4i16_t*)p)); }
__device__ __forceinline__ int kswz(int row, int colB) { return row * 256 + (colB ^ ((row & 7) << 4)); }
__device__ __forceinline__ int vswz(int row, int colB) { return row * 256 + (colB ^ ((row & 7) << 5)); }
__device__ __forceinline__ int aswz(int row, int colB) { return row * 256 + (colB ^ ((((row & 3) | ((row >> 1) & 4))) << 5)); }
constexpr int A_KB = 32768, A_VB = 4096, A_OFF_V = 2 * A_KB;
__device__ __forceinline__ void states(Frame& F) {
    const int tid = ((int)threadIdx.x), lane = ((int)(threadIdx.x & 63)), w = F.wave, g = lane >> 4, q = (lane & 15) >> 2, pp = lane & 3;
    const bf16* U = (const bf16*)(F.A->ws + WS_U); bf16* ST = (bf16*)(F.A->ws + WS_ST);
    LAS char* lds = (LAS char*)F.lds;
    for (int unit = F.vcu; unit < NB * NH * 8; unit += F.G) {
        const int bh = unit >> 3, es = unit & 7, b = bh >> 3, h = bh & 7;
        const bf16* Kg = U + 4 * USTR + ((size_t)b * PP) * 1024 + h * 128;
        const bf16* Vg = U + 5 * USTR + ((size_t)b * PP) * 1024 + h * 128 + es * 16;
        const float wdec = exp2f(128.0f * log2f(1.0f - exp2f(-5.0f - (float)h)));
        f32x4 S = (f32x4){0.f, 0.f, 0.f, 0.f};
        u32x4 krA[4], vrA, krB[4], vrB, krC[4], vrC, krD[4], vrD;
#define RA_LOAD(kr, vr, n) do { _Pragma("unroll") for (int i = 0; i < 4; ++i) { const int pc = tid + 512 * i, row = pc >> 4, c16 = pc & 15; kr[i] = *(const u32x4*)(Kg + (size_t)((n) * 128 + row) * 1024 + c16 * 8); } \
        if (tid < 256) { const int row = tid >> 1, c16 = tid & 1; vr = *(const u32x4*)(Vg + (size_t)((n) * 128 + row) * 1024 + c16 * 8); } } while (0)
#define RA_WRITE(kr, vr, bf) do { _Pragma("unroll") for (int i = 0; i < 4; ++i) { const int pc = tid + 512 * i, row = pc >> 4, c16 = pc & 15; *(LAS u32x4*)(lds + (bf) * A_KB + aswz(row, c16 * 16)) = kr[i]; } \
        if (tid < 256) { const int row = tid >> 1, c16 = tid & 1; *(LAS u32x4*)(lds + A_OFF_V + (bf) * A_VB + row * 32 + c16 * 16) = vr; } } while (0)
#define RA_STEP(n, bf) do { f32x4 acc = (f32x4){0.f, 0.f, 0.f, 0.f}; \
            _Pragma("unroll") for (int s = 0; s < 4; ++s) { const int r0 = 32 * s + 8 * g + q; \
                const s16x4 a0 = vtr(lds + (bf) * A_KB + aswz(r0, (16 * w + 4 * pp) * 2)), a1 = vtr(lds + (bf) * A_KB + aswz(r0 + 4, (16 * w + 4 * pp) * 2)); \
                const s16x4 b0 = vtr(lds + A_OFF_V + (bf) * A_VB + r0 * 32 + pp * 8), b1 = vtr(lds + A_OFF_V + (bf) * A_VB + (r0 + 4) * 32 + pp * 8); \
                acc = __builtin_amdgcn_mfma_f32_16x16x32_bf16((bf16x8){a0[0], a0[1], a0[2], a0[3], a1[0], a1[1], a1[2], a1[3]}, (bf16x8){b0[0], b0[1], b0[2], b0[3], b1[0], b1[1], b1[2], b1[3]}, acc, 0, 0, 0); } \
            S = (S + acc) * wdec; \
            { u32x2 o; o.x = cvt_pk_bf16(S[0], S[1]); o.y = cvt_pk_bf16(S[2], S[3]); \
              *(u32x2*)(ST + (((size_t)bh * 32 + (n)) * 128 + es * 16 + (lane & 15)) * 128 + 16 * w + 4 * g) = o; } } while (0)
        RA_LOAD(krA, vrA, 0); RA_WRITE(krA, vrA, 0); RA_LOAD(krB, vrB, 1); RA_LOAD(krC, vrC, 2); RA_LOAD(krD, vrD, 3);
        __syncthreads();
#define RA_BAR() asm volatile("s_waitcnt lgkmcnt(0)\n\ts_barrier" ::: "memory")
        for (int n = 0; n < 32; n += 4) {
            if (n + 4 < 32) RA_LOAD(krA, vrA, n + 4);
            RA_STEP(n, 0); RA_WRITE(krB, vrB, 1); RA_BAR();
            if (n + 5 < 32) RA_LOAD(krB, vrB, n + 5);
            RA_STEP(n + 1, 1); RA_WRITE(krC, vrC, 0); RA_BAR();
            if (n + 6 < 32) RA_LOAD(krC, vrC, n + 6);
            RA_STEP(n + 2, 0); RA_WRITE(krD, vrD, 1); RA_BAR();
            if (n + 7 < 32) RA_LOAD(krD, vrD, n + 7);
            RA_STEP(n + 3, 1); if (n + 4 < 32) RA_WRITE(krA, vrA, 0); RA_BAR();
        }
        __syncthreads();
#undef RA_BAR
#undef RA_STEP
#undef RA_LOAD
#undef RA_WRITE
    }
}
constexpr int B_K = 0, B_V = 32768, B_S = 65536;
__device__ __forceinline__ void outputs(Frame& F) {
    int tid = (int)threadIdx.x; asm volatile("" : "+v"(tid));
    const int lane = tid & 63, w = F.wave, g = lane >> 4, il = lane & 15, q = il >> 2, pp = lane & 3;
    const bf16* U = (const bf16*)(F.A->ws + WS_U); const bf16* ST = (const bf16*)(F.A->ws + WS_ST); bf16* OA = (bf16*)(F.A->ws + WS_HN);
    LAS char* lds = (LAS char*)F.lds;
    u32x4 pk[4], pv[4], ps[4];
#define RB_LOAD(unit) do { const int bh_ = (unit) >> 5, n_ = ((unit) & 31) + 1, b_ = bh_ >> 3, h_ = bh_ & 7; \
        const bf16* Kg = U + 4 * USTR + ((size_t)(b_ * PP + n_ * 128)) * 1024 + h_ * 128; const bf16* Vg = U + 5 * USTR + ((size_t)(b_ * PP + n_ * 128)) * 1024 + h_ * 128; \
        const bf16* Sg = ST + ((size_t)bh_ * 32 + (n_ - 1)) * 16384; \
        _Pragma("unroll") for (int i = 0; i < 4; ++i) { const int pc = tid + 512 * i, row = pc >> 4, c16 = pc & 15; pk[i] = *(const u32x4*)(Kg + (size_t)row * 1024 + c16 * 8); pv[i] = *(const u32x4*)(Vg + (size_t)row * 1024 + c16 * 8); \
            ps[i] = *(const u32x4*)(Sg + (size_t)row * 128 + c16 * 8); } } while (0)
#define RB_WRITE() do { _Pragma("unroll") for (int i = 0; i < 4; ++i) { const int pc = tid + 512 * i, row = pc >> 4, c16 = pc & 15; *(LAS u32x4*)(lds + B_K + kswz(row, c16 * 16)) = pk[i]; \
            *(LAS u32x4*)(lds + B_V + vswz(row, c16 * 16)) = pv[i]; *(LAS u32x4*)(lds + B_S + kswz(row, c16 * 16)) = ps[i]; } } while (0)
    int unit = F.vcu; if (unit >= NB * NH * 32) return;
    RB_LOAD(unit); RB_WRITE();
    __syncthreads();
    for (;;) {
        const int nu = unit + F.G; const bool more = nu < NB * NH * 32;
        const int bh = unit >> 5, n = (unit & 31) + 1, b = bh >> 3, h = bh & 7;
        const size_t urow = (size_t)(b * PP + n * 128 + 16 * w + il);
        bf16x8 qx[4];
#pragma unroll
        for (int s = 0; s < 4; ++s) qx[s] = *(const bf16x8*)(U + 3 * USTR + urow * 1024 + h * 128 + 32 * s + 8 * g);
        if (more) RB_LOAD(nu);
        u32x2 P[8];
#pragma unroll
        for (int jb = 0; jb < 8; ++jb) {
            P[jb] = (u32x2){0u, 0u};
            if (jb <= w) {
                f32x4 d = (f32x4){0.f, 0.f, 0.f, 0.f};
#pragma unroll
                for (int s = 0; s < 4; ++s) { const bf16x8 a = *(const LAS bf16x8*)(lds + B_K + kswz(16 * jb + il, 64 * s + 16 * g)); d = __builtin_amdgcn_mfma_f32_16x16x32_bf16(a, qx[s], d, 0, 0, 0); }
                if (jb == w) {
#pragma unroll
                    for (int r = 0; r < 4; ++r) if (4 * g + r > il) d[r] = 0.f; }
                P[jb].x = cvt_pk_bf16(d[0], d[1]); P[jb].y = cvt_pk_bf16(d[2], d[3]);
            }
        }
        f32x4 o[8];
#pragma unroll
        for (int eb = 0; eb < 8; ++eb) { f32x4 acc = (f32x4){0.f, 0.f, 0.f, 0.f};
#pragma unroll
            for (int s = 0; s < 4; ++s) { const bf16x8 a = *(const LAS bf16x8*)(lds + B_S + kswz(16 * eb + il, 64 * s + 16 * g)); acc = __builtin_amdgcn_mfma_f32_16x16x32_bf16(a, qx[s], acc, 0, 0, 0); }
#pragma unroll
            for (int t = 0; t < 4; ++t) { if (2 * t <= w) {
                const int r0 = 32 * t + 4 * g + q;
                const s16x4 a0 = vtr(lds + B_V + vswz(r0, (16 * eb + 4 * pp) * 2)), a1 = vtr(lds + B_V + vswz(r0 + 16, (16 * eb + 4 * pp) * 2));
                const u32x4 bw = (u32x4){P[2 * t].x, P[2 * t].y, P[2 * t + 1].x, P[2 * t + 1].y};
                acc = __builtin_amdgcn_mfma_f32_16x16x32_bf16((bf16x8){a0[0], a0[1], a0[2], a0[3], a1[0], a1[1], a1[2], a1[3]}, __builtin_bit_cast(bf16x8, bw), acc, 0, 0, 0); } }
            o[eb] = acc; }
        float sm = 0.f;
#pragma unroll
        for (int eb = 0; eb < 8; ++eb) sm += (o[eb][0] + o[eb][1]) + (o[eb][2] + o[eb][3]);
        sm += __shfl_xor(sm, 16); sm += __shfl_xor(sm, 32);
        const float mu = sm * (1.0f / HD); float sv = 0.f;
#pragma unroll
        for (int eb = 0; eb < 8; ++eb) { o[eb] = o[eb] - mu; sv += (o[eb][0] * o[eb][0] + o[eb][1] * o[eb][1]) + (o[eb][2] * o[eb][2] + o[eb][3] * o[eb][3]); }
        sv += __shfl_xor(sv, 16); sv += __shfl_xor(sv, 32);
        const float rstd = 1.0f / sqrtf(sv * (1.0f / HD) + EPS);
        const size_t m = (size_t)b * SEQ + (n - 1) * 128 + 16 * w + il;
#pragma unroll
        for (int eb = 0; eb < 8; ++eb) { const int e0 = 16 * eb + 4 * g;
            const u32x2 gg = *(const u32x2*)(U + 6 * USTR + urow * 1024 + h * 128 + e0);
            u32x2 ov; ov.x = cvt_pk_bf16(o[eb][0] * rstd * bf_lo(gg.x), o[eb][1] * rstd * bf_hi(gg.x)); ov.y = cvt_pk_bf16(o[eb][2] * rstd * bf_lo(gg.y), o[eb][3] * rstd * bf_hi(gg.y));
            *(u32x2*)(OA + m * DM + 1024 + h * 128 + e0) = ov; }
        __syncthreads();
        if (!more) break;
        RB_WRITE();
        __syncthreads();
        unit = nu;
    }
#undef RB_LOAD
#undef RB_WRITE
}
}

struct POutProj {
    static constexpr bool PERM = false, HAS_MID = true, FP8 = false, GATHER = false;
    int nt; const char* Abase; unsigned lda2, ldb2; const char* Bt; const float* x; float* out; const float* SSQ;
    __device__ __forceinline__ void a_offs(const g8::Unit&, unsigned (&)[2][2]) const {}
    __device__ __forceinline__ const char* b_tile(const g8::Unit& u, int t) const { return Bt + (size_t)u.pn * 256 * ldb2 + (size_t)t * 128; }
    __device__ __forceinline__ void mid(f32x4 (&acc)[2][2][4][2], const g8::Unit& u, int wr, int wc, int fr, int fq) const {
#pragma unroll
        for (int ai = 0; ai < 2; ++ai)
#pragma unroll
            for (int m = 0; m < 4; ++m) { const int r = u.pm * 256 + ai * 128 + wr * 64 + m * 16 + fr;
                const f32x4 s0 = *(const f32x4*)(SSQ + (size_t)r * 8), s1 = *(const f32x4*)(SSQ + (size_t)r * 8 + 4);
                const float rs = 1.0f / sqrtf(((s0.x + s0.y) + (s0.z + s0.w) + (s1.x + s1.y) + (s1.z + s1.w)) * (1.0f / 1024.0f) + EPS);
#pragma unroll
                for (int bj = 0; bj < 2; ++bj)
#pragma unroll
                    for (int n = 0; n < 2; ++n) acc[ai][bj][m][n] = acc[ai][bj][m][n] * rs; }
    }
    __device__ __forceinline__ void epi(const f32x4 (&acc)[2][2][4][2], const g8::Unit& u, int wr, int wc, int fr, int fq) const {
        const int row0 = u.pm * 256 + wr * 64 + fr, col0 = u.pn * 256 + wc * 32 + 4 * fq;
#pragma unroll
        for (int ai = 0; ai < 2; ++ai)
#pragma unroll
            for (int m = 0; m < 4; ++m) { const size_t off = (size_t)(row0 + ai * 128 + m * 16) * DM + col0;
#pragma unroll
                for (int bj = 0; bj < 2; ++bj)
#pragma unroll
                    for (int n = 0; n < 2; ++n) *(f32x4*)(out + off + bj * 128 + n * 16) = *(const f32x4*)(x + off + bj * 128 + n * 16) + acc[ai][bj][m][n]; }
    }
};

__device__ __forceinline__ void p4_router(Frame& F) {
    const int lane = ((int)(threadIdx.x & 63)), w = F.wave, blk = w & 3, kh = w >> 2, row = lane & 15, kq = lane >> 4;
    const float* H1 = F.A->out; const float* g2 = F.A->in[8]; const float* WRT = (const float*)(F.A->ws + WS_WRT);
    const float* brg = F.A->in[10]; const float* bre = F.A->in[12];
    unsigned char* HN2 = (unsigned char*)(F.A->ws + WS_HN); int* TOK = (int*)(F.A->ws + WS_TOK); float* WLO = (float*)(F.A->ws + WS_WLO); float* WHI = (float*)(F.A->ws + WS_WHI); float* RSS = (float*)(F.A->ws + WS_RSS);
    LAS float* part = (LAS float*)F.lds;
    LAS float* pss = part + 2 * 64 * 32;
    for (int rb = F.vcu; rb < MTOK / 64; rb += F.G) {
        const int m0 = rb * 64 + blk * 16;
        const float* xp = H1 + (size_t)(m0 + row) * DM + kh * 1024 + 4 * kq;
        const float* w0p = WRT + (size_t)row * DM + kh * 1024 + 4 * kq; const float* w1p = w0p + 16 * DM; const float* gp = g2 + kh * 1024 + 4 * kq;
        unsigned* op = (unsigned*)(HN2 + (size_t)(m0 + row) * DM + kh * 1024 + 4 * kq);
        f32x4 acc0 = (f32x4){0.f, 0.f, 0.f, 0.f}, acc1 = acc0; float ss = 0.f;
#pragma unroll 4
        for (int s = 0; s < 64; ++s) {
            const f32x4 xa = *(const f32x4*)(xp + 16 * s), b0 = *(const f32x4*)(w0p + 16 * s), b1 = *(const f32x4*)(w1p + 16 * s), gg = *(const f32x4*)(gp + 16 * s);
#pragma unroll
            for (int j = 0; j < 4; ++j) { acc0 = __builtin_amdgcn_mfma_f32_16x16x4f32(xa[j], b0[j], acc0, 0, 0, 0); acc1 = __builtin_amdgcn_mfma_f32_16x16x4f32(xa[j], b1[j], acc1, 0, 0, 0); }
            ss += (xa.x * xa.x + xa.y * xa.y) + (xa.z * xa.z + xa.w * xa.w);
            const f32x4 y = xa * gg * SA1; op[4 * s] = pk_fp8x4(y.x, y.y, y.z, y.w);
        }
        ss += __shfl_xor(ss, 16); ss += __shfl_xor(ss, 32);
#pragma unroll
        for (int r = 0; r < 4; ++r) { part[(kh * 64 + blk * 16 + 4 * kq + r) * 32 + row] = acc0[r]; part[(kh * 64 + blk * 16 + 4 * kq + r) * 32 + 16 + row] = acc1[r]; }
        if (kq == 0) pss[kh * 64 + blk * 16 + row] = ss;
        __syncthreads();
        if (((int)threadIdx.x) < 64) {
            const int r = ((int)threadIdx.x), m = rb * 64 + r;
            const float rs = 1.0f / sqrtf((pss[r] + pss[64 + r]) * (1.0f / DM) + EPS);
            float lgt[20];
#pragma unroll
            for (int j = 0; j < 20; ++j) lgt[j] = (part[r * 32 + j] + part[(64 + r) * 32 + j]) * rs + (j < 4 ? brg[j] : bre[j - 4]);
            int gs = 0; float gm = lgt[0];
#pragma unroll
            for (int i = 1; i < 4; ++i) if (lgt[i] > gm) { gm = lgt[i]; gs = i; }
            float den = 0.f;
#pragma unroll
            for (int i = 0; i < 4; ++i) den += __expf(lgt[i] - gm);
            const float pg = 1.0f / den;
            float e4[4];
#pragma unroll
            for (int i = 0; i < 4; ++i) { float a = lgt[4 + i];
#pragma unroll
                for (int g = 1; g < 4; ++g) a = (gs == g) ? lgt[4 + 4 * g + i] : a;
                e4[i] = a; }
            int i1 = 0; float v1 = e4[0];
#pragma unroll
            for (int i = 1; i < 4; ++i) if (e4[i] > v1) { v1 = e4[i]; i1 = i; }
            int i2 = -1; float v2 = -__builtin_inff();
#pragma unroll
            for (int i = 0; i < 4; ++i) if (i != i1 && e4[i] > v2) { v2 = e4[i]; i2 = i; }
            const float ex = __expf(v2 - v1); const float w1 = pg / (1.f + ex), w2 = pg * ex / (1.f + ex);
            const int lo = i1 < i2 ? i1 : i2, hi = i1 < i2 ? i2 : i1; const float wlo = i1 < i2 ? w1 : w2, whi = i1 < i2 ? w2 : w1;
            const int pair = (lo == 0) ? (hi - 1) : (lo == 1) ? (hi + 1) : 5;
            const int cls = gs * 6 + pair;
            const unsigned pos = __hip_atomic_fetch_add(((unsigned*)F.A->ws) + CW_CNT + 64 * cls, 1u, __ATOMIC_RELAXED, __HIP_MEMORY_SCOPE_AGENT);
            TOK[cls * CLS_CAP + pos] = m; WLO[cls * CLS_CAP + pos] = wlo; WHI[cls * CLS_CAP + pos] = whi; RSS[cls * CLS_CAP + pos] = rs;
        }
        __syncthreads();
    }
}

__device__ __forceinline__ void cls_experts(int cls, int& elo, int& ehi) { const int g = cls / 6, pr = cls % 6; const int lo = pr < 3 ? 0 : (pr < 5 ? 1 : 2), hi = pr < 3 ? pr + 1 : (pr < 5 ? pr - 1 : 3); elo = 4 * g + lo; ehi = 4 * g + hi; }
__device__ __forceinline__ void moe_tables(Frame& F) {
    volatile LAS int* T = (volatile LAS int*)(F.lds + TBL_OFF);
    if (((int)threadIdx.x) == 0) {
        int base = 0;
        for (int c = 0; c < NCLS; ++c) { int n = (int)__hip_atomic_load(((unsigned*)F.A->ws) + CW_CNT + 64 * c, __ATOMIC_RELAXED, __HIP_MEMORY_SCOPE_AGENT); if (n > CLS_CAP) n = CLS_CAP; T[c] = n; T[32 + c] = base; const int nt = (n + 255) >> 8;
            for (int i = 0; i < nt; ++i) T[96 + base + i] = c; base += nt; }
        T[64] = base;
        int ne = 0;
        for (int e = 0; e < NEXP; ++e) { T[72 + e] = ne;
            for (int c = (e >> 2) * 6; c < (e >> 2) * 6 + 6; ++c) { int elo, ehi; cls_experts(c, elo, ehi); if (elo != e && ehi != e) continue; const int slot = (ehi == e) ? 1 : 0;
                const int nt = (T[c] + 255) >> 8; for (int i = 0; i < nt; ++i) { T[192 + ne] = (T[32 + c] + i) | (slot << 8) | (c << 16) | (i << 24); ++ne; } } }
        T[72 + NEXP] = ne; T[65] = ne;
    }
    __syncthreads();
}
struct SchedGU {
    const LAS int* T; int G, c;
    __device__ bool next(int i, g8::Unit& u) const {
        const int L = i * G + c; const int ne = __builtin_amdgcn_readfirstlane(T[65]); if (L >= ne * 8) return false;
        int e = 0;
#pragma unroll
        for (int k = 1; k < NEXP; ++k) { const int o = __builtin_amdgcn_readfirstlane(T[72 + k]); if (L >= o * 8) e = k; }
        const int e0 = __builtin_amdgcn_readfirstlane(T[72 + e]), e1 = __builtin_amdgcn_readfirstlane(T[72 + e + 1]); const int cnt = e1 - e0, loc = L - e0 * 8;
        const int ntile = loc / cnt, mt = loc - ntile * cnt; const int ent = __builtin_amdgcn_readfirstlane(T[192 + e0 + mt]);
        u.pm = ent & 0xff; u.pn = ntile; u.a0 = e; u.a1 = (ent >> 8) & 1; u.a2 = (ent >> 16) & 0xff; u.a3 = (ent >> 24) & 0xff; return true;
    }
};
struct SchedDown {
    const LAS int* T; int G, c;
    __device__ bool next(int i, g8::Unit& u) const {
        const int L = i * G + c; const int NT = __builtin_amdgcn_readfirstlane(T[64]); if (L >= NT * 8) return false;
        const int tl = L >> 3; const int cls = __builtin_amdgcn_readfirstlane(T[96 + tl]); const int tb = __builtin_amdgcn_readfirstlane(T[32 + cls]);
        int elo, ehi; cls_experts(cls, elo, ehi);
        u.pm = tl; u.pn = L & 7; u.a0 = elo; u.a1 = ehi; u.a2 = cls; u.a3 = tl - tb; return true;
    }
};

struct PGateUp {
    static constexpr bool PERM = true, HAS_MID = false, FP8 = true, GATHER = true;
    int nt; const char* Abase; unsigned lda2, ldb2; const char* WGU; const int* TOK; const float* WLO; const float* WHI; const float* RSS; const LAS int* T; unsigned char* ACT;
    __device__ __forceinline__ void a_offs(const g8::Unit& u, unsigned (&o)[2][2]) const {
        const int cnt = T[u.a2];
#pragma unroll
        for (int i = 0; i < 2; ++i) { int R, C; g8::stage_rc((int)threadIdx.x * 16 + i * 8192, R, C);
#pragma unroll
            for (int h = 0; h < 2; ++h) { int pos = u.a3 * 256 + h * 128 + R; if (pos >= cnt) pos = 0; const int tok = TOK[u.a2 * CLS_CAP + pos]; o[h][i] = (unsigned)(tok * DM + C * 2); } }
    }
    __device__ __forceinline__ const char* b_tile(const g8::Unit& u, int t) const { return WGU + ((size_t)u.a0 * 2048 + (size_t)u.pn * 256) * ldb2 + (size_t)t * 128; }
    __device__ __forceinline__ void mid(f32x4 (&)[2][2][4][2], const g8::Unit&, int, int, int, int) const {}
    __device__ __forceinline__ void epi(const f32x4 (&acc)[2][2][4][2], const g8::Unit& u, int wr, int wc, int fr, int fq) const {
        const int cnt = T[u.a2]; const float* WS = u.a1 ? WHI : WLO; constexpr float INV = 1.0f / (SA1 * SW1);
#pragma unroll
        for (int ai = 0; ai < 2; ++ai)
#pragma unroll
            for (int m = 0; m < 4; ++m) { const int rl = ai * 128 + wr * 64 + m * 16 + fr; const int pos = u.a3 * 256 + rl;
                const float w = ((pos < cnt) ? WS[u.a2 * CLS_CAP + pos] : 0.f) * SA2; const float rsi = ((pos < cnt) ? RSS[u.a2 * CLS_CAP + pos] : 0.f) * INV;
                const f32x4 g0 = acc[ai][0][m][0] * rsi, g1 = acc[ai][0][m][1] * rsi, u0 = acc[ai][1][m][0] * rsi, u1 = acc[ai][1][m][1] * rsi;
                f32x4 a0, a1;
#pragma unroll
                for (int e = 0; e < 4; ++e) { a0[e] = g0[e] / (1.f + __expf(-g0[e])) * u0[e] * w; a1[e] = g1[e] / (1.f + __expf(-g1[e])) * u1[e] * w; }
                u32x2 o; o.x = pk_fp8x4(a0[0], a0[1], a0[2], a0[3]); o.y = pk_fp8x4(a1[0], a1[1], a1[2], a1[3]);
                *(u32x2*)(ACT + ((size_t)u.pm * 256 + rl) * 2048 + u.a1 * 1024 + u.pn * 128 + wc * 32 + 8 * fq) = o; }
    }
};
struct PDown {
    static constexpr bool PERM = true, HAS_MID = false, FP8 = true, GATHER = false;
    int nt; const char* Abase; unsigned lda2, ldb2; const char* WD; const int* TOK; const LAS int* T; bf16* Y;
    __device__ __forceinline__ void a_offs(const g8::Unit&, unsigned (&)[2][2]) const {}
    __device__ __forceinline__ const char* b_tile(const g8::Unit& u, int t) const { const int e = (t < 8) ? u.a0 : u.a1; return WD + ((size_t)e * 2048 + (size_t)u.pn * 256) * ldb2 + (size_t)(t & 7) * 128; }
    __device__ __forceinline__ void mid(f32x4 (&)[2][2][4][2], const g8::Unit&, int, int, int, int) const {}
    __device__ __forceinline__ void epi(const f32x4 (&acc)[2][2][4][2], const g8::Unit& u, int wr, int wc, int fr, int fq) const {
        const int cnt = T[u.a2]; const int col0 = u.pn * 256 + wc * 32 + 8 * fq; constexpr float INV = 1.0f / (SA2 * SW2);
#pragma unroll
        for (int ai = 0; ai < 2; ++ai)
#pragma unroll
            for (int m = 0; m < 4; ++m) { const int pos = u.a3 * 256 + ai * 128 + wr * 64 + m * 16 + fr;
                if (pos < cnt) { const int tok = TOK[u.a2 * CLS_CAP + pos]; bf16* rowp = Y + (size_t)tok * DM + col0;
#pragma unroll
                    for (int bj = 0; bj < 2; ++bj) { const f32x4 v0 = acc[ai][bj][m][0] * INV, v1 = acc[ai][bj][m][1] * INV;
                        u32x4 w; w.x = cvt_pk_bf16(v0[0], v0[1]); w.y = cvt_pk_bf16(v0[2], v0[3]); w.z = cvt_pk_bf16(v1[0], v1[1]); w.w = cvt_pk_bf16(v1[2], v1[3]);
                        *(u32x4*)(rowp + bj * 128) = w; } } }
    }
};

__device__ __forceinline__ void p7_final(Frame& F) {
    const int gw = F.vcu * NWAVES + F.wave, NGW = F.G * NWAVES, lane = ((int)(threadIdx.x & 63)); const float* gf = F.A->in[16];
    const bf16* Y = (const bf16*)(F.A->ws + WS_Y);
    f32x4 gv[8];
#pragma unroll
    for (int j = 0; j < 8; ++j) gv[j] = *((const f32x4*)gf + lane + 64 * j);
    for (int row = gw; row < MTOK; row += NGW) {
        float* xr = F.A->out + (size_t)row * DM; const u32x2* yr = (const u32x2*)(Y + (size_t)row * DM); f32x4 v[8]; float ss = 0.f;
#pragma unroll
        for (int j = 0; j < 8; ++j) { v[j] = *((const f32x4*)xr + lane + 64 * j); const u32x2 y = yr[lane + 64 * j];
            v[j].x += bf_lo(y.x); v[j].y += bf_hi(y.x); v[j].z += bf_lo(y.y); v[j].w += bf_hi(y.y);
            ss += (v[j].x * v[j].x + v[j].y * v[j].y) + (v[j].z * v[j].z + v[j].w * v[j].w); }
        const float rs = 1.0f / sqrtf(wave_sum(ss) * (1.0f / DM) + EPS);
#pragma unroll
        for (int j = 0; j < 8; ++j) *((f32x4*)xr + lane + 64 * j) = v[j] * rs * gv[j];
    }
}

__global__ void __launch_bounds__(NWAVES * 64, 2) fwd_kernel(Args args) {
    extern __shared__ __attribute__((aligned(16))) unsigned char lds[];
    Frame F;
    F.lds = (LAS unsigned char*)lds;
    F.MISC = (volatile LAS unsigned*)(F.lds + MISC_OFF);
    F.wave = __builtin_amdgcn_readfirstlane((int)threadIdx.x >> 6);
    F.G = gridDim.x; { const int bx = blockIdx.x; F.vcu = (F.G % 8 == 0) ? (bx % 8) * (F.G / 8) + bx / 8 : bx; }
    F.A = &args;
    { int t0 = (int)threadIdx.x; asm volatile("" : "+v"(t0));
      for (int u = t0; u < (LDS_BYTES - RING_BYTES) / 4; u += NWAVES * 64) ((LAS unsigned*)(F.lds + RING_BYTES))[u] = 0u; }
    __syncthreads();
    (void)xcd_barrier_post((unsigned*)args.ws + CW_BAR, F.MISC + 8);
#define MKBAR() XcdBarrier bar; bar.bar = (unsigned*)args.ws + CW_BAR; bar.x = xb_xcc_id(); bar.st = (volatile LAS unsigned*)(F.lds + MISC_OFF) + 8
    const int lo = args.ph_lo, hi = args.ph_hi;
#define IN(k) (lo <= (k) && (k) < hi)
#define GRID_BAR(k) do { if (IN(k) && IN((k) + 1)) { MKBAR(); xcd_barrier(bar); } } while (0)
    bf16* U = (bf16*)(F.A->ws + WS_U);
#define PHASE(k, ...) do { if (IN(k)) { __VA_ARGS__ if constexpr (REPP == (k)) { { MKBAR(); xcd_barrier(bar); } __VA_ARGS__ } } GRID_BAR(k); } while (0)
    PHASE(0, p0_prologue(F););
    PHASE(1,
        p1_cumsum(F); p1_meta_kv(F);
        { PInProj p{DM / 64, (const char*)(F.A->ws + WS_HN), (unsigned)(DM * 2), (unsigned)(DM * 2), (const char*)(F.A->ws + WS_WINT), U, (const f32x2*)(F.A->ws + WS_ROPE), (unsigned*)F.A->ws + CW_NRM};
        g8::StaticOrder S; S.init(MTOK, NIN, F.G, (int)blockIdx.x);
        g8::gemm_phase<PInProj, g8::StaticOrder, true>(F.lds, p, S); });
    PHASE(2, ret::states(F); __syncthreads();
        if constexpr (REPP == 21) { ret::states(F); __syncthreads(); }
        fox_phase(F);
        if constexpr (REPP == 20) { __syncthreads(); fox_phase(F); }
        { MKBAR(); xcd_barrier(bar); } ret::outputs(F);
        if constexpr (REPP == 22) { __syncthreads(); ret::outputs(F); });
    PHASE(3,
        { POutProj p{DM / 64, (const char*)(F.A->ws + WS_HN), (unsigned)(DM * 2), (unsigned)(DM * 2), (const char*)(F.A->ws + WS_WOUTT), F.A->in[0], F.A->out, (const float*)(F.A->ws + WS_SSQ)};
        g8::StaticOrder S; S.init(MTOK, DM, F.G, (int)blockIdx.x);
        g8::gemm_phase<POutProj, g8::StaticOrder, true>(F.lds, p, S); });
    PHASE(4, p4_router(F););
    PHASE(5,
        moe_tables(F);
        { PGateUp p{DM / 128, (const char*)(F.A->ws + WS_HN), (unsigned)DM, (unsigned)DM, (const char*)(F.A->ws + WS_WGU), (const int*)(F.A->ws + WS_TOK), (const float*)(F.A->ws + WS_WLO), (const float*)(F.A->ws + WS_WHI), (const float*)(F.A->ws + WS_RSS),
                  (const LAS int*)(F.lds + TBL_OFF), (unsigned char*)U};
        SchedGU S{(const LAS int*)(F.lds + TBL_OFF), F.G, F.vcu};
        g8::gemm_phase<PGateUp, SchedGU, true>(F.lds, p, S); });
    PHASE(6,
        if (!IN(5)) moe_tables(F);
        { PDown p{2048 / 128, (const char*)U, 2048u, (unsigned)DE, (const char*)(F.A->ws + WS_WD), (const int*)(F.A->ws + WS_TOK), (const LAS int*)(F.lds + TBL_OFF), (bf16*)(F.A->ws + WS_Y)};
        SchedDown S{(const LAS int*)(F.lds + TBL_OFF), F.G, F.vcu};
        g8::gemm_phase<PDown, SchedDown, true>(F.lds, p, S); });
    PHASE(7, p7_final(F););
#undef PHASE
#undef IN
#undef GRID_BAR
}

extern "C" void kernel_launch(void* const* d_in, const int* in_sizes, int n_in, void* d_out, int out_size, void* d_ws, size_t ws_size, hipStream_t stream) {
    static int grid = 0;
    if (grid == 0) {
        if (n_in != 17 || out_size != MTOK * DM || ws_size < WS_END) { fprintf(stderr, "kernel_launch: unexpected shapes (n_in %d out %d ws %zu)\n", n_in, out_size, ws_size); grid = -1; return; }
        int dev = 0, cus = 0, per_cu = 0;
        if (hipGetDevice(&dev) != hipSuccess || hipDeviceGetAttribute(&cus, hipDeviceAttributeMultiprocessorCount, dev) != hipSuccess) { grid = -1; return; }
        if (hipFuncSetAttribute((const void*)fwd_kernel, hipFuncAttributeMaxDynamicSharedMemorySize, LDS_BYTES) != hipSuccess) { fprintf(stderr, "kernel_launch: hipFuncSetAttribute failed\n"); grid = -1; return; }
        if (hipOccupancyMaxActiveBlocksPerMultiprocessor(&per_cu, (const void*)fwd_kernel, NWAVES * 64, LDS_BYTES) != hipSuccess || per_cu < 1) fprintf(stderr, "kernel_launch: occupancy query says %d\n", per_cu);
        (void)hipGetLastError();
        grid = cus;
    }
    if (grid < 0) return;
    (void)hipMemsetAsync((char*)d_ws + WS_CTL, 0, CTL_ZERO_BYTES, stream);
    Args a{};
    for (int i = 0; i < 17; ++i) a.in[i] = (const float*)d_in[i];
    a.out = (float*)d_out; a.ws = (unsigned char*)d_ws; a.ph_lo = 0; a.ph_hi = 8;
    hipLaunchKernelGGL(fwd_kernel, dim3(grid), dim3(NWAVES * 64), LDS_BYTES, stream, a);
}
```

```cpp
#include <hip/hip_runtime.h>
#include <cstdio>
#include <cstdint>

#define LAS __attribute__((address_space(3)))
#define GAS __attribute__((address_space(1)))
typedef unsigned short bf16;
typedef short bf16x8 __attribute__((ext_vector_type(8)));
typedef float f32x4 __attribute__((ext_vector_type(4)));
typedef float f32x2 __attribute__((ext_vector_type(2)));
typedef unsigned u32x4 __attribute__((ext_vector_type(4)));
typedef unsigned u32x2 __attribute__((ext_vector_type(2)));

constexpr int NB = 4, SEQ = 4096, DM = 2048, PADN = 112, NMETA = 16, PP = SEQ + 128, HD = 128, NH = 8;
constexpr int MTOK = NB * SEQ;
constexpr int INC = 7176;
constexpr int NIN = 7168;
constexpr int NEXP = 16, DE = 1024, NCLS = 24, CLS_CAP = 16384;
constexpr float EPS = 1e-6f;
constexpr float SCALE = 0.08838834764831845f;

constexpr size_t MiB = 1u << 20;
constexpr size_t WS_CTL = 0, CTL_ZERO_BYTES = 1 * MiB;
constexpr size_t WS_LOGF = 1 * MiB;
constexpr size_t WS_CUM = WS_LOGF + 1 * MiB;
constexpr size_t WS_SSQ = WS_CUM + 1 * MiB;
constexpr size_t WS_ROPE = WS_SSQ + 1 * MiB;
constexpr size_t WS_WRT = WS_ROPE + 3 * MiB;
constexpr size_t WS_HNMETA = WS_WRT + 1 * MiB;
constexpr size_t WS_TOK = WS_HNMETA + 1 * MiB;
constexpr size_t WS_WLO = WS_TOK + 2 * MiB;
constexpr size_t WS_WHI = WS_WLO + 2 * MiB;
constexpr size_t WS_WINT = 16 * MiB;
constexpr size_t WS_WOUTT = 44 * MiB;
constexpr size_t WS_WGU = 52 * MiB;
constexpr size_t WS_WD = 180 * MiB;
constexpr size_t WS_HN = 244 * MiB;
constexpr size_t WS_U = 308 * MiB;
constexpr size_t WS_Y = WS_U + 64 * MiB;
constexpr size_t WS_H1B = WS_U + 128 * MiB;
constexpr size_t USTR = (size_t)NB * PP * 1024;
constexpr size_t WS_ST = WS_U + 7 * 33 * MiB;
constexpr size_t WS_RSS = WS_ST + 32 * MiB;
constexpr size_t WS_END = WS_RSS + 2 * MiB;
static_assert(WS_WHI + 2 * MiB <= WS_WINT && USTR * 2 == 33 * MiB, "ws map");
constexpr int CW_BAR = 4096;
constexpr int CW_CNT = 16384;
constexpr int CW_NRM = 20480;
constexpr int CW_MNRM = 20480 + 256;
constexpr int CW_QHEAD = 24576;

constexpr int RING_BYTES = 131072;
constexpr int MISC_OFF = RING_BYTES + 320;
constexpr int TBL_OFF = RING_BYTES + 1024;
constexpr int LDS_BYTES = 147456;
constexpr int NWAVES = 8;
#ifndef REPP_V
#define REPP_V (-1)
#endif
constexpr int REPP = REPP_V;

__device__ __forceinline__ unsigned cvt_pk_bf16(float lo, float hi) { unsigned r; asm volatile("v_cvt_pk_bf16_f32 %0, %1, %2" : "=v"(r) : "v"(lo), "v"(hi)); return r; }
__device__ __forceinline__ unsigned pk_fp8x4(float a, float b, float c, float d) {
    a = __builtin_amdgcn_fmed3f(a, -448.f, 448.f); b = __builtin_amdgcn_fmed3f(b, -448.f, 448.f); c = __builtin_amdgcn_fmed3f(c, -448.f, 448.f); d = __builtin_amdgcn_fmed3f(d, -448.f, 448.f);
    int w = 0; w = __builtin_amdgcn_cvt_pk_fp8_f32(a, b, w, false); w = __builtin_amdgcn_cvt_pk_fp8_f32(c, d, w, true); return (unsigned)w; }
constexpr float SA1 = 16.f, SW1 = 1024.f, SA2 = 32.f, SW2 = 512.f;
__device__ __forceinline__ float bf_lo(unsigned w) { return __uint_as_float(w << 16); }
__device__ __forceinline__ float bf_hi(unsigned w) { return __uint_as_float(w & 0xffff0000u); }
__device__ __forceinline__ float wave_sum(float v) {
#pragma unroll
    for (int o = 1; o < 64; o <<= 1) v += __shfl_xor(v, o);
    return v;
}
__device__ __forceinline__ float wave_max(float v) {
#pragma unroll
    for (int o = 1; o < 64; o <<= 1) v = fmaxf(v, __shfl_xor(v, o));
    return v;
}
#define LDS_WAIT() asm volatile("s_waitcnt lgkmcnt(0)" ::: "memory")
#define VM_WAIT() asm volatile("s_waitcnt vmcnt(0)" ::: "memory")

#define XB_TMO      128
#define XB_XCNT(j)  (256  + 64 * (j))
#define XB_XSUB(j)  (1280 + 64 * (j))
#define XB_XGEN(j)  (2304 + 64 * (j))
#define XB_TOP      3328
#define XB_TOPGEN   3392
#define XCD_BAR_WORDS 3456
#define XB_SPIN_CAP (1u << 21)
__device__ __forceinline__ unsigned xb_ld(unsigned* p)              { return __hip_atomic_load(p, __ATOMIC_RELAXED, __HIP_MEMORY_SCOPE_AGENT); }
__device__ __forceinline__ unsigned xb_add(unsigned* p, unsigned v) { return __hip_atomic_fetch_add(p, v, __ATOMIC_RELAXED, __HIP_MEMORY_SCOPE_AGENT); }
__device__ __forceinline__ unsigned xb_xcc_id() { return (unsigned)__builtin_amdgcn_s_getreg((3 << 11) | 20) & 0xFu; }
#define XB_SPIN(cond, bar) do { unsigned _sp = 0; while (cond) { __builtin_amdgcn_s_sleep(1); \
    if ((++_sp & 255u) == 0u) { if (xb_ld(&(bar)[XB_TMO])) break; if (_sp > XB_SPIN_CAP) { atomicAdd(&(bar)[XB_TMO], 1u); break; } } } } while (0)
struct XcdBarrier { unsigned* bar; unsigned x; volatile LAS unsigned* st; };
__device__ __forceinline__ XcdBarrier xcd_barrier_post(unsigned* bar, volatile LAS unsigned* st) {
    XcdBarrier b; b.bar = bar; b.x = xb_xcc_id(); b.st = st;
    if (threadIdx.x == 0) (void)xb_add(&bar[XB_XCNT(b.x)], 1u);
    return b;
}
__device__ __forceinline__ void xcd_barrier_complete(unsigned* bar, unsigned x, unsigned& nloc, unsigned& nx) {
    const unsigned G = gridDim.x * gridDim.y * gridDim.z;
    unsigned sum, cnt, mine, sp = 0u;
    for (;;) {
        sum = 0u; cnt = 0u; mine = 0u;
#pragma unroll
        for (unsigned j = 0; j < 16; ++j) { const unsigned c = xb_ld(&bar[XB_XCNT(j)]); sum += c; cnt += (c > 0u) ? 1u : 0u; mine = (j == x) ? c : mine; }
        if (sum == G) break;
        __builtin_amdgcn_s_sleep(1);
        if ((++sp & 255u) == 0u) { if (xb_ld(&bar[XB_TMO])) break; if (sp > XB_SPIN_CAP) { atomicAdd(&bar[XB_TMO], 1u); break; } }
    }
    nloc = mine > 0u ? mine : 1u; nx = cnt > 0u ? cnt : 1u;
}
__device__ __forceinline__ void xcd_barrier(const XcdBarrier& b) {
    asm volatile("s_waitcnt vmcnt(0)" ::: "memory");
    __syncthreads();
    if (threadIdx.x == 0) {
        unsigned* bar = b.bar;
        __builtin_amdgcn_s_waitcnt(0);
        unsigned nloc = b.st[0], nx = b.st[1];
        if (nloc == 0u) { xcd_barrier_complete(bar, b.x, nloc, nx); b.st[0] = nloc; b.st[1] = nx; }
        const unsigned old = xb_add(&bar[XB_XSUB(b.x)], 1u);
        const unsigned gen = old / nloc;
        if (old + 1u == (gen + 1u) * nloc) {
            __builtin_amdgcn_fence(__ATOMIC_RELEASE, "agent");
            asm volatile("s_waitcnt vmcnt(0)" ::: "memory");
            const unsigned og = xb_add(&bar[XB_TOP], 1u);
            const unsigned tg = og / nx;
            if (og + 1u == (tg + 1u) * nx) xb_add(&bar[XB_TOPGEN], 1u);
            else XB_SPIN(xb_ld(&bar[XB_TOPGEN]) == tg, bar);
            __builtin_amdgcn_fence(__ATOMIC_ACQUIRE, "agent");
            xb_add(&bar[XB_XGEN(b.x)], 1u);
            asm volatile("s_waitcnt vmcnt(0)" ::: "memory");
        } else {
            XB_SPIN(xb_ld(&bar[XB_XGEN(b.x)]) == gen, bar);
            __builtin_amdgcn_fence(__ATOMIC_ACQUIRE, "agent");
            asm volatile("s_waitcnt vmcnt(0)" ::: "memory");
        }
    }
    __syncthreads();
}

namespace g8 {
constexpr int BM = 256, BK = 64, HALF = 128, HTB = HALF * BK * 2, NXCD = 8, WGM = 8;
__device__ __forceinline__ int lds_byte(int r, int c) { const int st = (r >> 4) * 2 + (c >> 5), rr = r & 15, cc = c & 31, ob = rr * 64 + cc * 2; return st * 1024 + (ob ^ (((ob >> 9) & 1) << 5)); }
__device__ __forceinline__ void stage_rc(int b, int& R, int& C) { const int st = b / 1024, sb = b % 1024, swz = sb ^ (((sb >> 9) & 1) << 5); R = (st >> 1) * 16 + swz / 64; C = (st & 1) * 32 + (swz % 64) / 2; }
__device__ __forceinline__ int perm32(int rho) { const int n = rho >> 4, i = rho & 15; return 8 * (i >> 2) + 4 * n + (i & 3); }

struct Unit { int pm, pn, a0, a1, a2, a3; };
typedef int v8i_t __attribute__((ext_vector_type(8)));

struct StaticOrder {
    int nM, nN, nwg, G, c;
    __device__ void init(int M, int N, int G_, int c_) { nM = M / BM; nN = N / BM; nwg = nM * nN; G = G_; c = c_; }
    __device__ bool next(int i, Unit& u) const {
        const long L = (long)i * G + c; if (L >= nwg) return false;
        int wgid = (int)L; { const int q = nwg / NXCD, r = nwg % NXCD, xcd = wgid % NXCD, off = wgid / NXCD; wgid = (xcd < r ? xcd * (q + 1) : r * (q + 1) + (xcd - r) * q) + off; }
        const int nig = WGM * nN, gid = wgid / nig, fm = gid * WGM, gsz = (nM - fm) < WGM ? (nM - fm) : WGM;
        u.pm = fm + ((wgid % nig) % gsz); u.pn = (wgid % nig) / gsz; u.a0 = u.a1 = u.a2 = u.a3 = 0; return true;
    }
};

template <class P, class Sched, bool ALIGN_EPI>
__device__ __forceinline__ void gemm_phase(LAS unsigned char* lds, const P& p, const Sched& S) {
    const int tid = threadIdx.x, wid = __builtin_amdgcn_readfirstlane(tid >> 6), lane = tid & 63, wr = wid >> 2, wc = wid & 3, fr = lane & 15, fq = lane >> 4;
    const int nt = p.nt;
    unsigned voffB[2], voffA[2];
#pragma unroll
    for (int i = 0; i < 2; ++i) { int R, C; stage_rc(tid * 16 + i * 8192, R, C); const int Rb = P::PERM ? ((R & ~31) + perm32(R & 31)) : R;
        voffB[i] = (unsigned)Rb * p.ldb2 + (unsigned)C * 2u; voffA[i] = (unsigned)R * p.lda2 + (unsigned)C * 2u; }
    const size_t hstepB = (size_t)HALF * p.ldb2, hstepA = (size_t)HALF * p.lda2;
    const unsigned ldsw = (unsigned)wid * 1024u;
    const int aoff = lds_byte(wr * 64 + fr, fq * 8), boff = lds_byte(wc * 32 + fr, fq * 8);
#define PG8_SA(b, h) (((b) * 2 + (h)) * HTB)
#define PG8_SB(b, h) ((4 + (b) * 2 + (h)) * HTB)
#define PG8_STAGE(bufoff, gbase, v0, v1) do { \
        __builtin_amdgcn_global_load_lds((const unsigned*)((const char*)(gbase) + (v0)), (LAS unsigned*)(lds + (bufoff) + ldsw), 16, 0, 0); \
        __builtin_amdgcn_global_load_lds((const unsigned*)((const char*)(gbase) + (v1)), (LAS unsigned*)(lds + (bufoff) + ldsw + 8192), 16, 0, 0); } while (0)
#define PG8_LD32(p0_, p1_) ({ const u32x4 lo_ = *(const LAS u32x4*)(p0_), hi_ = *(const LAS u32x4*)(p1_); (v8i_t){(int)lo_.x, (int)lo_.y, (int)lo_.z, (int)lo_.w, (int)hi_.x, (int)hi_.y, (int)hi_.z, (int)hi_.w}; })
#define PG8_LDA(dst, b, h) do { _Pragma("unroll") for (int m = 0; m < 4; ++m) dst[m] = PG8_LD32(lds + PG8_SA(b, h) + aoff + m * 2048, lds + PG8_SA(b, h) + aoff + m * 2048 + 1024); } while (0)
#define PG8_LDB(dst, b, h) do { _Pragma("unroll") for (int n = 0; n < 2; ++n) dst[n] = PG8_LD32(lds + PG8_SB(b, h) + boff + n * 2048, lds + PG8_SB(b, h) + boff + n * 2048 + 1024); } while (0)
#define PG8_LOH(v) __builtin_bit_cast(bf16x8, __builtin_shufflevector(v, v, 0, 1, 2, 3))
#define PG8_HIH(v) __builtin_bit_cast(bf16x8, __builtin_shufflevector(v, v, 4, 5, 6, 7))
#define PG8_MMA(ai, bj, At, Bt) do { __builtin_amdgcn_s_setprio(1); _Pragma("unroll") for (int m = 0; m < 4; ++m) _Pragma("unroll") for (int n = 0; n < 2; ++n) { \
        if constexpr (P::FP8) { asm volatile("v_mfma_f32_16x16x128_f8f6f4 %0, %1, %2, %0" : "+v"(acc[ai][bj][m][n]) : "v"(Bt[n]), "v"(At[m])); } \
        else { acc[ai][bj][m][n] = __builtin_amdgcn_mfma_f32_16x16x32_bf16(PG8_LOH(Bt[n]), PG8_LOH(At[m]), acc[ai][bj][m][n], 0, 0, 0); \
               acc[ai][bj][m][n] = __builtin_amdgcn_mfma_f32_16x16x32_bf16(PG8_HIH(Bt[n]), PG8_HIH(At[m]), acc[ai][bj][m][n], 0, 0, 0); } } \
        __builtin_amdgcn_s_setprio(0); } while (0)
#define PG8_WAIT_V(n) asm volatile("s_waitcnt vmcnt(" #n ")" ::: "memory")
#define PG8_WAIT_L(n) asm volatile("s_waitcnt lgkmcnt(" #n ")" ::: "memory")
#define PG8_BAR __builtin_amdgcn_s_barrier()
#define PG8_SCHED __builtin_amdgcn_sched_barrier(0)
    Unit cur, nxt; int ui = 0;
    if (!S.next(0, cur)) return;
    f32x4 acc[2][2][4][2];
#pragma unroll
    for (int a = 0; a < 2; ++a)
#pragma unroll
        for (int b = 0; b < 2; ++b)
#pragma unroll
            for (int m = 0; m < 4; ++m)
#pragma unroll
                for (int n = 0; n < 2; ++n) acc[a][b][m][n] = (f32x4){0.f, 0.f, 0.f, 0.f};
    v8i_t At[4], B0[2], B1[2];
    unsigned oc[2][2];
    constexpr int ONOFF = RING_BYTES + 4096;
    const char* cA = p.Abase; const char* nA = p.Abase;
    if constexpr (P::GATHER) { p.a_offs(cur, oc); } else { cA = p.Abase + (size_t)cur.pm * 2 * hstepA; }
#define PG8_STA(bufoff, base_, h_, O_) do { if constexpr (P::GATHER) { PG8_STAGE(bufoff, base_, O_[h_][0], O_[h_][1]); } else { PG8_STAGE(bufoff, (base_) + (h_) * hstepA, voffA[0], voffA[1]); } } while (0)
    {
        const char* b0 = p.b_tile(cur, 0); const char* b1 = p.b_tile(cur, 1);
        PG8_STAGE(PG8_SB(0, 0), b0, voffB[0], voffB[1]); PG8_STAGE(PG8_SB(0, 1), b0 + hstepB, voffB[0], voffB[1]);
        PG8_STA(PG8_SA(0, 0), cA, 0, oc); PG8_STA(PG8_SA(0, 1), cA, 1, oc);
        if (wr == 1) PG8_BAR;
        PG8_WAIT_V(2); PG8_BAR;
        PG8_STAGE(PG8_SB(1, 0), b1, voffB[0], voffB[1]); PG8_STA(PG8_SA(1, 0), cA + 128, 0, oc); PG8_STAGE(PG8_SB(1, 1), b1 + hstepB, voffB[0], voffB[1]);
        PG8_WAIT_V(6); PG8_BAR;
    }
    for (;;) {
        const bool has_next = S.next(ui + 1, nxt);
        if (!has_next) nxt = cur;
        if constexpr (P::GATHER) { unsigned on[2][2]; p.a_offs(nxt, on); *(LAS u32x4*)(lds + ONOFF + tid * 16) = (u32x4){on[0][0], on[0][1], on[1][0], on[1][1]}; } else { nA = p.Abase + (size_t)nxt.pm * 2 * hstepA; }
#pragma unroll 1
        for (int t = 0; t < nt; t += 2) {
            const bool last = (t == nt - 2);
            if constexpr (P::HAS_MID) { if (t == (nt >> 1)) p.mid(acc, cur, wr, wc, fr, fq); }
            const char* a1 = cA + (size_t)(t + 1) * 128;
            const char* a2 = last ? nA : cA + (size_t)(t + 2) * 128; const char* a3 = a2 + 128;
            unsigned o2[2][2];
            if constexpr (P::GATHER) { const u32x4 onv = *(const LAS u32x4*)(lds + ONOFF + tid * 16);
                o2[0][0] = last ? onv.x : oc[0][0]; o2[0][1] = last ? onv.y : oc[0][1]; o2[1][0] = last ? onv.z : oc[1][0]; o2[1][1] = last ? onv.w : oc[1][1]; }
            const char* b2 = last ? p.b_tile(nxt, 0) : p.b_tile(cur, t + 2); const char* b3 = last ? p.b_tile(nxt, 1) : p.b_tile(cur, t + 3);
            PG8_LDB(B0, 0, 0); PG8_LDB(B1, 0, 1); PG8_SCHED; PG8_LDA(At, 0, 0); PG8_STA(PG8_SA(1, 1), a1, 1, oc);
            PG8_WAIT_V(8); PG8_WAIT_L(0); PG8_BAR; PG8_MMA(0, 0, At, B0); PG8_MMA(0, 1, At, B1); PG8_BAR; PG8_SCHED;
            PG8_LDA(At, 0, 1); PG8_STAGE(PG8_SB(0, 0), b2, voffB[0], voffB[1]); PG8_STAGE(PG8_SB(0, 1), b2 + hstepB, voffB[0], voffB[1]); PG8_STA(PG8_SA(0, 0), a2, 0, o2);
            PG8_WAIT_V(8); PG8_WAIT_L(0); PG8_BAR; PG8_MMA(1, 0, At, B0); PG8_MMA(1, 1, At, B1); PG8_BAR; PG8_SCHED;
            PG8_LDB(B0, 1, 0); PG8_LDB(B1, 1, 1); PG8_SCHED; PG8_LDA(At, 1, 0); PG8_STA(PG8_SA(0, 1), a2, 1, o2);
            PG8_WAIT_V(8); PG8_WAIT_L(0); PG8_BAR; PG8_MMA(0, 0, At, B0); PG8_MMA(0, 1, At, B1); PG8_BAR; PG8_SCHED;
            PG8_LDA(At, 1, 1); PG8_STAGE(PG8_SB(1, 0), b3, voffB[0], voffB[1]); PG8_STAGE(PG8_SB(1, 1), b3 + hstepB, voffB[0], voffB[1]); PG8_STA(PG8_SA(1, 0), a3, 0, o2);
            PG8_WAIT_V(8); PG8_WAIT_L(0); PG8_BAR; PG8_MMA(1, 0, At, B0); PG8_MMA(1, 1, At, B1); PG8_BAR; PG8_SCHED;
        }
        if constexpr (ALIGN_EPI) { if (wr == 0) PG8_BAR; }
        if constexpr (P::FP8) { asm volatile("s_nop 15\n\ts_nop 15" ::: "memory"); }
        p.epi(acc, cur, wr, wc, fr, fq);
        if (!has_next) break;
#pragma unroll
        for (int a = 0; a < 2; ++a)
#pragma unroll
            for (int b = 0; b < 2; ++b)
#pragma unroll
                for (int m = 0; m < 4; ++m)
#pragma unroll
                    for (int n = 0; n < 2; ++n) acc[a][b][m][n] = (f32x4){0.f, 0.f, 0.f, 0.f};
        cur = nxt; cA = nA; ++ui;
        if constexpr (P::GATHER) { const u32x4 onv = *(const LAS u32x4*)(lds + ONOFF + tid * 16); oc[0][0] = onv.x; oc[0][1] = onv.y; oc[1][0] = onv.z; oc[1][1] = onv.w; }
        if constexpr (ALIGN_EPI) { if (wr == 1) PG8_BAR; }
    }
    PG8_WAIT_V(0);
    if constexpr (!ALIGN_EPI) { if (wr == 0) PG8_BAR; }
    PG8_BAR;
#undef PG8_SA
#undef PG8_SB
#undef PG8_STAGE
#undef PG8_STA
#undef PG8_LDA
#undef PG8_LDB
#undef PG8_LD32
#undef PG8_LOH
#undef PG8_HIH
#undef PG8_MMA
#undef PG8_WAIT_V
#undef PG8_WAIT_L
#undef PG8_BAR
#undef PG8_SCHED
}
}

struct Args { const float* in[17]; float* out; unsigned char* ws; int ph_lo, ph_hi; };
struct Frame {
    const Args* A;
    LAS unsigned char* lds;
    volatile LAS unsigned* MISC;
    int wave, vcu, G;
};

struct TItem { const float* W; void* WT; const float* kscale; int ldw, K, k0, scol0, drow0; float sc; int fp8; };
__device__ __forceinline__ void titem_load(const TItem& t, f32x4 (&vv)[8], int lane) {
#pragma unroll
    for (int i = 0; i < 8; ++i) { const int kk = 8 * i + (lane >> 3); vv[i] = *(const f32x4*)(t.W + (size_t)(t.k0 + kk) * t.ldw + t.scol0 + 4 * (lane & 7)); }
}
__device__ __forceinline__ void titem_store(const TItem& t, const f32x4 (&vv)[8], LAS float* scr, int lane) {
#pragma unroll
    for (int i = 0; i < 8; ++i) { const int kk = 8 * i + (lane >> 3); float sc = t.sc; if (t.kscale) sc *= t.kscale[t.k0 + kk]; LAS float* d = scr + kk * 33 + 4 * (lane & 7);
        d[0] = vv[i].x * sc; d[1] = vv[i].y * sc; d[2] = vv[i].z * sc; d[3] = vv[i].w * sc; }
    LDS_WAIT(); asm volatile("" ::: "memory");
    const int c = lane & 7;
#pragma unroll
    for (int j = 0; j < 4; ++j) { const int n = (lane >> 3) + 8 * j; const LAS float* s = scr + (8 * c) * 33 + n;
        if (t.fp8) { u32x2 o; o.x = pk_fp8x4(s[0 * 33], s[1 * 33], s[2 * 33], s[3 * 33]); o.y = pk_fp8x4(s[4 * 33], s[5 * 33], s[6 * 33], s[7 * 33]);
            *(u32x2*)((unsigned char*)t.WT + (size_t)(t.drow0 + n) * t.K + t.k0 + 8 * c) = o; }
        else { u32x4 o; o.x = cvt_pk_bf16(s[0 * 33], s[1 * 33]); o.y = cvt_pk_bf16(s[2 * 33], s[3 * 33]); o.z = cvt_pk_bf16(s[4 * 33], s[5 * 33]); o.w = cvt_pk_bf16(s[6 * 33], s[7 * 33]);
            *(u32x4*)((bf16*)t.WT + (size_t)(t.drow0 + n) * t.K + t.k0 + 8 * c) = o; } }
    LDS_WAIT(); asm volatile("" ::: "memory");
}
__device__ __forceinline__ float log_sigmoid(float x) { return fminf(x, 0.f) - log1pf(__expf(-fabsf(x))); }

__device__ __forceinline__ void p0_prologue(Frame& F) {
    const int gw = F.vcu * NWAVES + F.wave, NGW = F.G * NWAVES, lane = ((int)(threadIdx.x & 63));
    const int gt = F.vcu * 512 + ((int)threadIdx.x), NGT = F.G * 512;
    for (int rep_a = 0; rep_a < (REPP == 100 ? 2 : 1); ++rep_a)
    {
        LAS float* scr = (LAS float*)(F.lds + F.wave * 16384);
        const float* w_in = F.A->in[3]; const float* w_out = F.A->in[7]; const float* w_gate = F.A->in[13]; const float* w_up = F.A->in[14]; const float* w_down = F.A->in[15];
        bf16* WINT = (bf16*)(F.A->ws + WS_WINT); bf16* WOUTT = (bf16*)(F.A->ws + WS_WOUTT); unsigned char* WGU = (unsigned char*)(F.A->ws + WS_WGU); unsigned char* WD = (unsigned char*)(F.A->ws + WS_WD);
        constexpr int I_IN = 32 * 224, I_OUT = 32 * 64, I_G = 16 * 32 * 32, I_D = 16 * 16 * 64;
        constexpr int NITEMS = I_IN + I_OUT + 2 * I_G + I_D;
        auto decode = [&](int it) -> TItem {
            TItem t; t.kscale = nullptr; t.sc = 1.f; t.fp8 = 0; int r = it;
            if (r < I_IN) { const int kb = r / 224, nb = r % 224, n0 = nb * 32; t.W = w_in; t.ldw = INC; t.K = DM; t.WT = WINT; t.k0 = kb * 64; t.scol0 = n0 + (n0 >= 3072 ? 8 : 0); t.drow0 = n0; return t; } r -= I_IN;
            if (r < I_OUT) { const int kb = r / 64, nb = r % 64; t.W = w_out; t.ldw = DM; t.K = DM; t.WT = WOUTT; t.k0 = kb * 64; t.scol0 = nb * 32; t.drow0 = nb * 32; t.kscale = (kb < 16) ? F.A->in[5] : (F.A->in[6] - 1024); return t; } r -= I_OUT;
            if (r < 2 * I_G) { const int up = r >= I_G; if (up) r -= I_G; const int e = r / 1024, q = r % 1024, kb = q / 32, nb = q % 32, n0 = nb * 32;
                t.W = (up ? w_up : w_gate) + (size_t)e * DM * DE; t.ldw = DE; t.K = DM; t.WT = WGU + (size_t)e * 2048 * DM; t.k0 = kb * 64; t.scol0 = n0; t.drow0 = (n0 >> 7) * 256 + up * 128 + (n0 & 127); t.sc = SW1; t.fp8 = 1; return t; } r -= 2 * I_G;
            { const int e = r / 1024, q = r % 1024, kb = q / 64, nb = q % 64; t.W = w_down + (size_t)e * DE * DM; t.ldw = DM; t.K = DE; t.WT = WD + (size_t)e * DM * DE; t.k0 = kb * 64; t.scol0 = nb * 32; t.drow0 = nb * 32; t.sc = SW2; t.fp8 = 1; return t; }
        };
        f32x4 va[8], vb[8];
        int it = gw;
        if (it < NITEMS) {
            TItem ta = decode(it); titem_load(ta, va, lane);
            for (;;) {
                const int itb = it + NGW; TItem tb = ta; const bool hb = itb < NITEMS;
                if (hb) { tb = decode(itb); titem_load(tb, vb, lane); }
                titem_store(ta, va, scr, lane);
                if (!hb) break;
                const int ita = itb + NGW; const bool ha = ita < NITEMS;
                if (ha) { ta = decode(ita); titem_load(ta, va, lane); }
                titem_store(tb, vb, scr, lane);
                if (!ha) break;
                it = ita;
            }
        }
    }
    {
        float* WRT = (float*)(F.A->ws + WS_WRT); const float* g2 = F.A->in[8]; const float* wrg = F.A->in[9]; const float* wre = F.A->in[11];
        for (int i = gt; i < 32 * DM; i += NGT) { const int j = i / DM, k = i % DM; WRT[i] = (j < 20) ? g2[k] * (j < 4 ? wrg[k * 4 + j] : wre[k * 16 + (j - 4)]) : 0.f; }
        f32x2* ROPE = (f32x2*)(F.A->ws + WS_ROPE);
        for (int i = gt; i < 4112 * 64; i += NGT) { const int pos = i >> 6, k = i & 63;
            const float lin = (float)k * (1.0f / 63.0f); const float ang = 1.0f / exp2f(lin * 13.287712379549449f);
            const float ph = (float)pos * ang; const double rev = (double)ph * 0.15915494309189535; const float fr = (float)(rev - floor(rev));
            ROPE[i] = (f32x2){__builtin_amdgcn_cosf(fr), __builtin_amdgcn_sinf(fr)}; }
        bf16* U = (bf16*)(F.A->ws + WS_U);
        for (int i = gt; i < 4 * NB * PADN * 128; i += NGT) { const int c8 = i & 127, row = (i >> 7) % PADN, bb = ((i >> 7) / PADN) % NB, cl = (i >> 7) / (PADN * NB);
            const int cls = (cl == 0) ? 1 : (cl == 1) ? 2 : (cl == 2) ? 4 : 5;
            *(u32x4*)(U + cls * USTR + ((size_t)(bb * PP + row)) * 1024 + c8 * 8) = (u32x4){0u, 0u, 0u, 0u}; }
        float* LOGF = (float*)(F.A->ws + WS_LOGF);
        for (int i = gt; i < 32 * PADN; i += NGT) LOGF[(i / PADN) * PP + (i % PADN)] = 0.f;
    }
    __syncthreads();
    for (int rep_c = 0; rep_c < (REPP == 101 ? 2 : 1); ++rep_c)
    {
        LAS float* WF = (LAS float*)F.lds; const float* w_in = F.A->in[3]; const float* g1 = F.A->in[2];
        for (int i = ((int)threadIdx.x); i < 8 * DM; i += 512) { const int k = i >> 3, h = i & 7; WF[h * DM + k] = g1[k] * w_in[(size_t)k * INC + 3072 + h]; }
        __syncthreads();
        f32x4 gv[8];
#pragma unroll
        for (int j = 0; j < 8; ++j) gv[j] = *((const f32x4*)g1 + lane + 64 * j);
        bf16* HN = (bf16*)(F.A->ws + WS_HN); bf16* HNMETA = (bf16*)(F.A->ws + WS_HNMETA); float* LOGF = (float*)(F.A->ws + WS_LOGF); const float* bfv = F.A->in[4];
        for (int row = gw; row < MTOK + NMETA; row += NGW) {
            const bool meta = row >= MTOK; const int mj = row - MTOK;
            const float* xr = meta ? (F.A->in[1] + (size_t)mj * DM) : (F.A->in[0] + (size_t)row * DM);
            f32x4 v[8]; float ss = 0.f;
#pragma unroll
            for (int j = 0; j < 8; ++j) { v[j] = *((const f32x4*)xr + lane + 64 * j); ss += (v[j].x * v[j].x + v[j].y * v[j].y) + (v[j].z * v[j].z + v[j].w * v[j].w); }
            const float rs = 1.0f / sqrtf(wave_sum(ss) * (1.0f / DM) + EPS);
            float fl[8];
#pragma unroll
            for (int h = 0; h < 8; ++h) { float s = 0.f;
#pragma unroll
                for (int j = 0; j < 8; ++j) { const f32x4 w = *((const LAS f32x4*)(WF + h * DM) + lane + 64 * j); s += (v[j].x * w.x + v[j].y * w.y) + (v[j].z * w.z + v[j].w * w.w); }
                fl[h] = wave_sum(s) * rs; }
            bf16* orow = meta ? (HNMETA + (size_t)mj * DM) : (HN + (size_t)row * DM);
#pragma unroll
            for (int j = 0; j < 8; ++j) { const f32x4 y = v[j] * rs * gv[j]; u32x2 w; w.x = cvt_pk_bf16(y.x, y.y); w.y = cvt_pk_bf16(y.z, y.w); *((u32x2*)orow + lane + 64 * j) = w; }
            if (lane < 8) { float f = fl[0];
#pragma unroll
                for (int h = 1; h < 8; ++h) f = (lane == h) ? fl[h] : f;
                const float lf = log_sigmoid(f + bfv[lane]);
                if (meta) { for (int bb = 0; bb < NB; ++bb) LOGF[(bb * NH + lane) * PP + PADN + mj] = lf; }
                else { const int bb = row >> 12, t = row & 4095; LOGF[(bb * NH + lane) * PP + 128 + t] = lf; } }
        }
    }
}

__device__ __forceinline__ void p1_cumsum(Frame& F) {
    const int gw = F.vcu * NWAVES + F.wave, NGW = F.G * NWAVES, lane = ((int)(threadIdx.x & 63));
    const float* LOGF = (const float*)(F.A->ws + WS_LOGF); float* CUM = (float*)(F.A->ws + WS_CUM);
    for (int s = gw; s < NB * NH; s += NGW) {
        const float* src = LOGF + (size_t)s * PP + lane * 66; float* dst = CUM + (size_t)s * PP + lane * 66;
        float loc = 0.f; for (int i = 0; i < 66; ++i) loc += src[i];
        float inc = loc;
#pragma unroll
        for (int o = 1; o < 64; o <<= 1) { const float t = __shfl_up(inc, o); if (lane >= o) inc += t; }
        float run = inc - loc;
        for (int i = 0; i < 66; ++i) { run += src[i]; dst[i] = run; }
    }
}
__device__ __forceinline__ void p1_meta_kv(Frame& F) {
    const int lane = ((int)(threadIdx.x & 63)), w = F.wave;
    const bf16* HNMETA = (const bf16*)(F.A->ws + WS_HNMETA); const bf16* WINT = (const bf16*)(F.A->ws + WS_WINT); bf16* U = (bf16*)(F.A->ws + WS_U);
    const f32x2* ROPE = (const f32x2*)(F.A->ws + WS_ROPE);
    LAS float* red = (LAS float*)F.lds;
    for (int blk = blockIdx.x; blk < 256; blk += F.G) {
        const int kv0 = blk * 16, q = kv0 >> 10, col0 = kv0 & 1023;
        const int cls = (q == 0) ? 1 : (q == 1) ? 2 : (q == 2) ? 4 : 5;
        const int nrow0 = ((q == 0) ? 1024 : (q == 1) ? 2048 : (q == 2) ? 4096 : 5120) + col0;
        f32x4 acc = (f32x4){0.f, 0.f, 0.f, 0.f};
#pragma unroll
        for (int s = 0; s < 8; ++s) { const int k0 = w * 256 + s * 32 + 8 * (lane >> 4);
            const bf16x8 a = *(const bf16x8*)(HNMETA + (size_t)(lane & 15) * DM + k0);
            const bf16x8 b = *(const bf16x8*)(WINT + (size_t)(nrow0 + (lane & 15)) * DM + k0);
            acc = __builtin_amdgcn_mfma_f32_16x16x32_bf16(a, b, acc, 0, 0, 0); }
#pragma unroll
        for (int r = 0; r < 4; ++r) red[w * 256 + ((lane >> 4) * 4 + r) * 16 + (lane & 15)] = acc[r];
        __syncthreads();
        if (((int)threadIdx.x) < 256) { const int row = ((int)threadIdx.x) >> 4, col = ((int)threadIdx.x) & 15;
            float v = 0.f, vp = 0.f;
#pragma unroll
            for (int ww = 0; ww < 8; ++ww) { v += red[ww * 256 + row * 16 + col]; vp += red[ww * 256 + row * 16 + (col ^ 1)]; }
            float o = v;
            if (q == 2) { const int d = (col0 + col) & 127; const f32x2 cs = ROPE[row * 64 + (d >> 1)];
                const int hh = (col0 + col) >> 7; const float lg2h = log2f(1.0f - exp2f(-5.0f - (float)hh));
                o = ((col & 1) ? (v * cs.x + vp * cs.y) : (v * cs.x - vp * cs.y)) * SCALE * exp2f(-(float)(PADN + row + 1) * lg2h); }
            if (q == 0) { float s2 = o * o; s2 += __shfl_xor(s2, 1); s2 += __shfl_xor(s2, 2); s2 += __shfl_xor(s2, 4); s2 += __shfl_xor(s2, 8);
                if (col == 0) atomicAdd((float*)((unsigned*)F.A->ws + CW_MNRM) + ((col0 >> 7) * 16 + row), s2); }
            const unsigned short ob = (unsigned short)(cvt_pk_bf16(o, 0.f) & 0xffffu);
            for (int bb = 0; bb < NB; ++bb) U[cls * USTR + ((size_t)(bb * PP + PADN + row)) * 1024 + col0 + col] = ob; }
        __syncthreads();
    }
}

struct PInProj {
    static constexpr bool PERM = true, HAS_MID = false, FP8 = false, GATHER = false;
    int nt; const char* Abase; unsigned lda2, ldb2; const char* Bt; bf16* U; const f32x2* ROPE; unsigned* NRM;
    __device__ __forceinline__ void a_offs(const g8::Unit&, unsigned (&)[2][2]) const {}
    __device__ __forceinline__ const char* b_tile(const g8::Unit& u, int t) const { return Bt + (size_t)u.pn * 256 * ldb2 + (size_t)t * 128; }
    __device__ __forceinline__ void mid(f32x4 (&)[2][2][4][2], const g8::Unit&, int, int, int, int) const {}
    __device__ __forceinline__ void epi(const f32x4 (&acc)[2][2][4][2], const g8::Unit& u, int wr, int wc, int fr, int fq) const {
        const int cls = u.pn >> 2;
        bf16* base = U + (size_t)cls * USTR;
        const int ccol0 = (u.pn & 3) * 256 + wc * 32 + 8 * fq;
        const int bb = u.pm >> 4;
        float nmx[2] = {0.f, 0.f};
#pragma unroll
        for (int ai = 0; ai < 2; ++ai)
#pragma unroll
            for (int m = 0; m < 4; ++m) {
                const int t = ((u.pm & 15) << 8) + ai * 128 + wr * 64 + m * 16 + fr;
                bf16* rowp = base + ((size_t)(bb * PP + 128 + t)) * 1024 + ccol0;
                f32x4 c0 = (f32x4){1.f, 0.f, 1.f, 0.f}, c1 = c0;
                if (cls == 3 || cls == 4) { const f32x4* rp = (const f32x4*)(ROPE + (size_t)(t + 16) * 64 + wc * 16 + fq * 4); c0 = rp[0]; c1 = rp[1]; }
#pragma unroll
                for (int bj = 0; bj < 2; ++bj) {
                    f32x4 v0 = acc[ai][bj][m][0], v1 = acc[ai][bj][m][1];
                    if (cls == 3 || cls == 4) {
                        f32x4 r0, r1;
                        r0.x = v0.x * c0.x - v0.y * c0.y; r0.y = v0.y * c0.x + v0.x * c0.y; r0.z = v0.z * c0.z - v0.w * c0.w; r0.w = v0.w * c0.z + v0.z * c0.w;
                        r1.x = v1.x * c1.x - v1.y * c1.y; r1.y = v1.y * c1.x + v1.x * c1.y; r1.z = v1.z * c1.z - v1.w * c1.w; r1.w = v1.w * c1.z + v1.z * c1.w;
                        const int hh = (u.pn & 3) * 2 + bj; const float lg2h = log2f(1.0f - exp2f(-5.0f - (float)hh)); const float ip1 = (float)((t & 127) + 1);
                        const float sc = (cls == 4) ? SCALE * exp2f(-ip1 * lg2h) : exp2f(ip1 * lg2h); v0 = r0 * sc; v1 = r1 * sc;
                    } else if (cls == 6) {
#pragma unroll
                        for (int e = 0; e < 4; ++e) { v0[e] = v0[e] / (1.f + __expf(-v0[e])); v1[e] = v1[e] / (1.f + __expf(-v1[e])); }
                    }
                    u32x4 w; w.x = cvt_pk_bf16(v0[0], v0[1]); w.y = cvt_pk_bf16(v0[2], v0[3]); w.z = cvt_pk_bf16(v1[0], v1[1]); w.w = cvt_pk_bf16(v1[2], v1[3]);
                    *(u32x4*)(rowp + bj * 128) = w;
                    if (cls <= 1) { float sq = (v0[0] * v0[0] + v0[1] * v0[1]) + (v0[2] * v0[2] + v0[3] * v0[3]) + (v1[0] * v1[0] + v1[1] * v1[1]) + (v1[2] * v1[2] + v1[3] * v1[3]);
                        sq += __shfl_xor(sq, 16); sq += __shfl_xor(sq, 32); nmx[bj] = fmaxf(nmx[bj], sq); }
                }
            }
        if (cls <= 1) {
#pragma unroll
            for (int bj = 0; bj < 2; ++bj) { float v = nmx[bj]; v = fmaxf(v, __shfl_xor(v, 1)); v = fmaxf(v, __shfl_xor(v, 2)); v = fmaxf(v, __shfl_xor(v, 4)); v = fmaxf(v, __shfl_xor(v, 8));
                if ((threadIdx.x & 63) == 0) atomicMax(NRM + ((cls * 32 + bb * 8 + (u.pn & 3) * 2 + bj) * 4 + wc), __float_as_uint(v)); }
        }
    }
};

template <bool RET>
__device__ __forceinline__ void attn_simple(Frame& F) {
    const int gw = F.vcu * NWAVES + F.wave, NGW = F.G * NWAVES, lane = ((int)(threadIdx.x & 63));
    LAS float* wl = (LAS float*)(F.lds + F.wave * 1024);
    const bf16* U = (const bf16*)(F.A->ws + WS_U); const float* CUM = (const float*)(F.A->ws + WS_CUM);
    bf16* OA = (bf16*)(F.A->ws + WS_HN); float* SSQ = (float*)(F.A->ws + WS_SSQ);
    for (int row = gw; row < NB * NH * SEQ; row += NGW) {
        const int t = row & 4095, bh = row >> 12, b = bh >> 3, h = bh & 7, p = 128 + t, m = b * SEQ + t;
        const bf16* Qb = U + (RET ? 3 : 0) * USTR + ((size_t)(b * PP + p)) * 1024 + h * 128;
        const bf16* Kb = U + (RET ? 4 : 1) * USTR + ((size_t)b * PP) * 1024 + h * 128;
        const bf16* Vb = U + (RET ? 5 : 2) * USTR + ((size_t)b * PP) * 1024 + h * 128;
        { const unsigned qw = *(const unsigned*)(Qb + 2 * lane); wl[2 * lane] = bf_lo(qw); wl[2 * lane + 1] = bf_hi(qw); }
        LDS_WAIT(); asm volatile("" ::: "memory");
        float m_run = -1e30f, l_run = 0.f, o0 = 0.f, o1 = 0.f;
        const float ct = RET ? 0.f : CUM[(size_t)bh * PP + p];
        const float lg2 = RET ? log2f(1.0f - exp2f(-5.0f - (float)h)) : 0.f;
        for (int s0 = 64; s0 <= p; s0 += 64) {
            const int s = s0 + lane;
            const bf16* kr = Kb + (size_t)s * 1024;
            float sc = 0.f;
#pragma unroll
            for (int c = 0; c < 16; ++c) { const u32x4 kv = *(const u32x4*)(kr + 8 * c); const f32x4 qa = *(const LAS f32x4*)(wl + 8 * c), qb = *(const LAS f32x4*)(wl + 8 * c + 4);
                sc += bf_lo(kv.x) * qa.x + bf_hi(kv.x) * qa.y + bf_lo(kv.y) * qa.z + bf_hi(kv.y) * qa.w + bf_lo(kv.z) * qb.x + bf_hi(kv.z) * qb.y + bf_lo(kv.w) * qb.z + bf_hi(kv.w) * qb.w; }
            const bool valid = (s <= p) && (s >= PADN);
            float pw;
            if constexpr (RET) { pw = valid ? sc * exp2f((float)(((p >> 7) - (s >> 7)) * 128) * lg2) : 0.f; }
            else {
                const float lg = valid ? (sc * SCALE + (ct - CUM[(size_t)bh * PP + s])) : -__builtin_inff();
                const float mn = fmaxf(m_run, wave_max(lg)); const float alpha = __expf(m_run - mn);
                pw = valid ? __expf(lg - mn) : 0.f;
                l_run = l_run * alpha + wave_sum(pw); o0 *= alpha; o1 *= alpha; m_run = mn;
            }
            asm volatile("" ::: "memory");
            wl[128 + lane] = pw;
            LDS_WAIT(); asm volatile("" ::: "memory");
#pragma unroll 8
            for (int k = 0; k < 64; ++k) { const float pk = wl[128 + k]; const unsigned vw = *(const unsigned*)(Vb + (size_t)(s0 + k) * 1024 + 2 * lane); o0 += pk * bf_lo(vw); o1 += pk * bf_hi(vw); }
            LDS_WAIT(); asm volatile("" ::: "memory");
        }
        if constexpr (RET) {
            const float mu = wave_sum(o0 + o1) * (1.0f / HD); const float d0 = o0 - mu, d1 = o1 - mu;
            const float var = wave_sum(d0 * d0 + d1 * d1) * (1.0f / HD); const float r = 1.0f / sqrtf(var + EPS);
            const unsigned gw2 = *(const unsigned*)(U + 6 * USTR + ((size_t)(b * PP + p)) * 1024 + h * 128 + 2 * lane);
            *(unsigned*)(OA + (size_t)m * DM + 1024 + h * 128 + 2 * lane) = cvt_pk_bf16(d0 * r * bf_lo(gw2), d1 * r * bf_hi(gw2));
        } else {
            const float il = 1.0f / l_run; o0 *= il; o1 *= il;
            *(unsigned*)(OA + (size_t)m * DM + h * 128 + 2 * lane) = cvt_pk_bf16(o0, o1);
            const float sq = wave_sum(o0 * o0 + o1 * o1); if (lane == 0) SSQ[(size_t)m * 8 + h] = sq;
        }
        asm volatile("" ::: "memory");
    }
}


namespace fox {
constexpr int NW = 8, QBLK = 32, KVBLK = 64, QB = 256, D = 128, LDQ = 1024, LDO = 2048;
constexpr int SHM_V = KVBLK * D * 2, SHM_K = KVBLK * D * 2;
constexpr int OFF_WS = 2 * SHM_V + 2 * SHM_K, OFF_CUM = OFF_WS + 2048, LDS_NEED = OFF_CUM + PP * 4;
static_assert(LDS_NEED <= RING_BYTES, "fox lds");
constexpr float THR = 8.f;
constexpr float INVS = 11.313708498984761f;
typedef float f32x16 __attribute__((ext_vector_type(16)));
typedef short s16x4 __attribute__((ext_vector_type(4)));
#define KSWZ(row, colB) ((row) * 256 + ((colB) ^ (((row) & 7) << 4)))
#define SBAR() __builtin_amdgcn_sched_barrier(0)
__device__ __forceinline__ int v_st(int k, int c) { const int kk = (k & ~0xC) | ((k & 4) << 1) | ((k & 8) >> 1); return ((kk >> 3) * 4 + (c >> 5)) * 512 + ((kk & 7) * 32 + (c & 31)) * 2; }
__device__ __forceinline__ int v_rd_base(int lane) { return ((lane & 3) << 3) | (((lane >> 2) & 3) << 6) | (((lane >> 4) & 1) << 5) | (((lane >> 5) & 1) << 8); }
constexpr int v_rd_off(int d0, int ks, int half) { return d0 * 512 + ks * 4096 + half * 2048; }
__device__ __forceinline__ int crow(int r, int hi) { return (r & 3) + 8 * (r >> 2) + 4 * hi; }
__device__ __forceinline__ unsigned cvtpk(float lo, float hi) { unsigned r; asm volatile("v_cvt_pk_bf16_f32 %0, %1, %2" : "=v"(r) : "v"(lo), "v"(hi)); return r; }
__device__ __forceinline__ bf16x8 load8(const bf16* p) { return *reinterpret_cast<const bf16x8*>(p); }
__device__ __forceinline__ void mask_causal(f32x16& p0, f32x16& p1, int dq) {
    const float NEG = -__builtin_inff();
#pragma unroll
    for (int r = 0; r < 16; ++r) { const int c = (r & 3) + 8 * (r >> 2); if (dq - c < 0) p0[r] = NEG; if (dq - c - 32 < 0) p1[r] = NEG; }
}
__device__ __forceinline__ void mask_pad(f32x16& p0, f32x16& p1, int hi) {
    const float NEG = -__builtin_inff();
#pragma unroll
    for (int r = 0; r < 16; ++r) { const int c = (r & 3) + 8 * (r >> 2); p0[r] = NEG; if (c + 4 * hi < 16) p1[r] = NEG; }
}
__device__ __forceinline__ void partialSM(f32x16& p0, f32x16& p1, float& m_reg, float& mn, float& alpha) {
    float pmax = p0[0]; for (int r = 1; r < 16; ++r) pmax = fmaxf(pmax, p0[r]); for (int r = 0; r < 16; ++r) pmax = fmaxf(pmax, p1[r]);
    { auto rr = __builtin_amdgcn_permlane32_swap(__float_as_uint(pmax), __float_as_uint(pmax), false, false);
      pmax = fmaxf(__uint_as_float(rr[0]), __uint_as_float(rr[1])); }
    constexpr float C2 = 1.4426950408889634f * SCALE;
    if (__builtin_expect(__all((pmax - m_reg) * SCALE <= THR), 1)) { mn = m_reg; alpha = 1.f; }
    else { mn = fmaxf(m_reg, pmax); alpha = __builtin_amdgcn_exp2f((m_reg - mn) * C2); m_reg = mn; }
    const float mnL = -mn * C2;
    for (int r = 0; r < 16; ++r) p0[r] = fmaf(p0[r], C2, mnL); for (int r = 0; r < 16; ++r) p1[r] = fmaf(p1[r], C2, mnL);
    for (int r = 0; r < 16; ++r) p0[r] = __builtin_amdgcn_exp2f(p0[r]);
}
__device__ __forceinline__ void finishSM(f32x16& p0, f32x16& p1, float alpha, float& l_reg, bf16x8& pa0, bf16x8& pa1, bf16x8& pa2, bf16x8& pa3) {
    for (int r = 0; r < 16; ++r) p1[r] = __builtin_amdgcn_exp2f(p1[r]);
    float ps = 0; for (int r = 0; r < 16; ++r) ps += p0[r]; for (int r = 0; r < 16; ++r) ps += p1[r];
    { auto rr = __builtin_amdgcn_permlane32_swap(__float_as_uint(ps), __float_as_uint(ps), false, false);
      ps = __uint_as_float(rr[0]) + __uint_as_float(rr[1]); }
    l_reg = l_reg * alpha + ps;
#define PK4(P, B_, OUT) do { unsigned a0 = cvtpk(P[B_+0], P[B_+1]), a1 = cvtpk(P[B_+2], P[B_+3]);                          \
        unsigned b0 = cvtpk(P[B_+4], P[B_+5]), b1 = cvtpk(P[B_+6], P[B_+7]);                                             \
        auto r0 = __builtin_amdgcn_permlane32_swap(a0, b0, false, false); auto r1 = __builtin_amdgcn_permlane32_swap(a1, b1, false, false); \
        u32x4 w = {r0[0], r1[0], r0[1], r1[1]}; OUT = *reinterpret_cast<bf16x8*>(&w); } while (0)
    PK4(p0, 0, pa0); PK4(p0, 8, pa1); PK4(p1, 0, pa2); PK4(p1, 8, pa3);
#undef PK4
}
template <int KB>
__device__ __forceinline__ void qkt(f32x16& p0, f32x16& p1, const LAS char* K_lds, int r32, int hi, const bf16x8* qr, const LAS float* cs) {
#pragma unroll
    for (int g = 0; g < 4; ++g) { const f32x4 a = *(const LAS f32x4*)(cs + 8 * g), b = *(const LAS f32x4*)(cs + 32 + 8 * g);
        p0[4 * g] = a[0]; p0[4 * g + 1] = a[1]; p0[4 * g + 2] = a[2]; p0[4 * g + 3] = a[3]; p1[4 * g] = b[0]; p1[4 * g + 1] = b[1]; p1[4 * g + 2] = b[2]; p1[4 * g + 3] = b[3]; }
    const LAS char* kb[4];
#pragma unroll
    for (int dd = 0; dd < 4; ++dd) kb[dd] = K_lds + KB * SHM_K + KSWZ(r32, (dd * 16 + hi * 8) * 2);
#pragma unroll
    for (int d0 = 0; d0 < 8; ++d0) { const LAS char* a = kb[d0 & 3] + (d0 >> 2) * 128;
        bf16x8 b0 = *reinterpret_cast<const LAS bf16x8*>(a);
        bf16x8 b1 = *reinterpret_cast<const LAS bf16x8*>(a + 32 * 256);
        p0 = __builtin_amdgcn_mfma_f32_32x32x16_bf16(b0, qr[d0], p0, 0, 0, 0);
        p1 = __builtin_amdgcn_mfma_f32_32x32x16_bf16(b1, qr[d0], p1, 0, 0, 0); }
}
template <int VB>
__device__ __forceinline__ void pv_tile(f32x16* o, int vb0, bf16x8 pa0, bf16x8 pa1, bf16x8 pa2, bf16x8 pa3) {
#define TRRD(dst, off) asm volatile("ds_read_b64_tr_b16 %0, %1 offset:%2" : "=&v"(dst) : "v"(vb0), "i"(off) : "memory")
#define PV_D0(d0) do { s16x4 l0, l1, l2, l3, h0, h1, h2, h3; constexpr int b_ = VB * SHM_V + v_rd_off(d0, 0, 0); \
        TRRD(l0, b_); TRRD(h0, b_ + 2048); TRRD(l1, b_ + 4096); TRRD(h1, b_ + 6144); TRRD(l2, b_ + 8192); TRRD(h2, b_ + 10240); TRRD(l3, b_ + 12288); TRRD(h3, b_ + 14336); \
        asm volatile("s_waitcnt lgkmcnt(0)" ::: "memory"); SBAR();   \
        o[d0] = __builtin_amdgcn_mfma_f32_32x32x16_bf16(pa0, (bf16x8){l0[0], l0[1], l0[2], l0[3], h0[0], h0[1], h0[2], h0[3]}, o[d0], 0, 0, 0);   \
        o[d0] = __builtin_amdgcn_mfma_f32_32x32x16_bf16(pa1, (bf16x8){l1[0], l1[1], l1[2], l1[3], h1[0], h1[1], h1[2], h1[3]}, o[d0], 0, 0, 0);   \
        o[d0] = __builtin_amdgcn_mfma_f32_32x32x16_bf16(pa2, (bf16x8){l2[0], l2[1], l2[2], l2[3], h2[0], h2[1], h2[2], h2[3]}, o[d0], 0, 0, 0);   \
        o[d0] = __builtin_amdgcn_mfma_f32_32x32x16_bf16(pa3, (bf16x8){l3[0], l3[1], l3[2], l3[3], h3[0], h3[1], h3[2], h3[3]}, o[d0], 0, 0, 0); } while (0)
    PV_D0(0); PV_D0(1); PV_D0(2); PV_D0(3);
#undef PV_D0
#undef TRRD
}
struct BlockRef { int bh, qb; };
struct Bases { const bf16* U; bf16* OA; float* SSQ; const float* CUM; };
__device__ __forceinline__ int blk_p0(const BlockRef& r) { return 128 + r.qb * 256; }
__device__ __forceinline__ const bf16* blk_q(const Bases& B, const BlockRef& r) { return B.U + ((size_t)((r.bh >> 3) * PP + blk_p0(r))) * 1024 + (r.bh & 7) * 128; }
__device__ __forceinline__ const bf16* blk_k(const Bases& B, const BlockRef& r) { return B.U + 1 * USTR + ((size_t)(r.bh >> 3) * PP) * 1024 + (r.bh & 7) * 128; }
__device__ __forceinline__ const bf16* blk_v(const Bases& B, const BlockRef& r) { return B.U + 2 * USTR + ((size_t)(r.bh >> 3) * PP) * 1024 + (r.bh & 7) * 128; }
struct Seam { bf16x8 qr[8]; bf16x8 st_v0, st_v1, st_k0, st_k1; };
#define ROW(p, k0, rr) ((p) + (size_t)((k0) + (rr)) * LDQ + sc)
#define VMW() asm volatile("s_waitcnt vmcnt(0)" ::: "memory")
#define VMWN(n) asm volatile("s_waitcnt vmcnt(%0)" :: "i"(n) : "memory")
#define SLOAD_H(Kp, Vp, k0) do { S.st_v0 = load8(ROW(Vp, k0, sr)); S.st_v1 = load8(ROW(Vp, k0, 32 + sr));              \
                         S.st_k0 = load8(ROW(Kp, k0, sr)); S.st_k1 = load8(ROW(Kp, k0, 32 + sr)); } while (0)
#define SWRITE_HK(bf) do { *(LAS bf16x8*)(K_lds + (bf) * SHM_K + kws) = S.st_k0; *(LAS bf16x8*)(K_lds + (bf) * SHM_K + kws + 32 * 256) = S.st_k1; } while (0)
#define SWRITE_HV(bf) do { *(LAS bf16x8*)(V_lds + (bf) * SHM_V + vst0) = S.st_v0; *(LAS bf16x8*)(V_lds + (bf) * SHM_V + vst1) = S.st_v1; } while (0)
#define SWRITE_H(bf) do { SWRITE_HV(bf); SWRITE_HK(bf); } while (0)
__device__ __forceinline__ void prime(const Bases& B, const BlockRef& cur, int j_lo, LAS char* lds, Seam& S, int tid) {
    const int wid = __builtin_amdgcn_readfirstlane(tid >> 6), lane = tid & 63, r32 = lane & 31, hi = lane >> 5;
    const int sr = tid >> 4, sc = (tid & 15) * 8, kws = KSWZ(sr, sc * 2); LAS char* K_lds = lds + 2 * SHM_V;
    const int kb0 = j_lo * KVBLK;
#pragma unroll
    for (int d0 = 0; d0 < 8; ++d0) S.qr[d0] = load8(blk_q(B, cur) + (size_t)(wid * QBLK + r32) * LDQ + d0 * 16 + hi * 8);
    { const bf16* Kp = blk_k(B, cur); const bf16* Vp = blk_v(B, cur); SLOAD_H(Kp, Vp, kb0); } VMW(); SWRITE_HK(0);
    __syncthreads();
}
__device__ __forceinline__ void stage_cum(const Bases& B, const BlockRef& cur, LAS char* lds) {
    const int tid = threadIdx.x, P0 = blk_p0(cur); LAS float* cumS = (LAS float*)(lds + OFF_CUM);
    const float* CUMG = B.CUM + (size_t)cur.bh * PP; const float cref = CUMG[P0]; const int n4 = (P0 + QB) >> 2;
    for (int i = tid; i < n4; i += 512) { const f32x4 c = *((const f32x4*)CUMG + i); *((LAS f32x4*)cumS + i) = (cref - c) * INVS; }
}
__device__ __forceinline__ void block(const Bases& B, const BlockRef& cur, const BlockRef& nxt, int j_lo, LAS char* lds, Seam& S, int tid) {
    const int wid = __builtin_amdgcn_readfirstlane(tid >> 6), lane = tid & 63, r32 = lane & 31, hi = lane >> 5;
    const int P0 = blk_p0(cur);
    const int j_hi = (P0 + QB - 1) / KVBLK + 1;
    const int NT = j_hi - j_lo;
    const int kbn = j_lo * KVBLK;
    const int qlo = P0 + wid * QBLK, qm = qlo + r32 - 4 * hi;
    LAS char* V_lds = lds; LAS char* K_lds = lds + 2 * SHM_V;
    LAS float* ws = (LAS float*)(lds + OFF_WS) + wid * 64; LAS float* li_l = ws; LAS float* al_l = ws + 32;
    LAS float* cumS = (LAS float*)(lds + OFF_CUM);
    float m_reg = -1e30f, l_reg = 0; f32x16 o[4] = {};
    const int sr = tid >> 4, sc = (tid & 15) * 8, vst0 = v_st(sr, sc), vst1 = v_st(32 + sr, sc), kws = KSWZ(sr, sc * 2);
    const int vb0 = (int)(uintptr_t)V_lds + v_rd_base(lane);
    const bf16* Kh = blk_k(B, cur); const bf16* Vh = blk_v(B, cur);
#define RESC(a) do { if (__any((a) < 1.f)) { if (hi == 0) al_l[r32] = (a); asm volatile("s_waitcnt lgkmcnt(0)" ::: "memory");              \
                     for (int d_ = 0; d_ < 4; ++d_) for (int r = 0; r < 16; ++r) o[d_][r] *= al_l[crow(r, hi)]; } } while (0)
#define KBASE(t) ((j_lo + (t)) * KVBLK)
#define CSP(t) (cumS + KBASE(t) + 4 * hi)
#define MASKT(P0_, P1_, t) do { const int kb_ = KBASE(t); if (kb_ + KVBLK - 1 > qlo) mask_causal(P0_, P1_, qm - kb_); if (kb_ == KVBLK) mask_pad(P0_, P1_, hi); } while (0)
#define SEAM_K0() do { VMWN(8); SWRITE_HK(0); SBAR(); } while (0)
    f32x16 pA0, pA1, pB0, pB1; float mnA, mnB, alA, alB; bf16x8 pa0, pa1, pa2, pa3;
    SWRITE_HV(0); SBAR();
    if (NT > 1) { SLOAD_H(Kh, Vh, KBASE(1)); }
    SBAR(); qkt<0>(pA0, pA1, K_lds, r32, hi, S.qr, CSP(0));
    MASKT(pA0, pA1, 0); partialSM(pA0, pA1, m_reg, mnA, alA);
    if (NT > 1) { VMW(); SWRITE_H(1); }
    __syncthreads();
#define HALF_STEP(PX0, PX1, mnX, alX, PY0, PY1, alY, t, KB, VB, SB) do {                                                      \
        SBAR(); qkt<KB>(PX0, PX1, K_lds, r32, hi, S.qr, CSP(t));                                             \
        finishSM(PY0, PY1, alY, l_reg, pa0, pa1, pa2, pa3); SBAR();                                                           \
        if ((t) + 1 < NT) { SLOAD_H(Kh, Vh, KBASE((t) + 1)); SBAR(); }                                               \
        pv_tile<VB>(o, vb0, pa0, pa1, pa2, pa3); MASKT(PX0, PX1, (t)); partialSM(PX0, PX1, m_reg, mnX, alX);                                        \
        __syncthreads();                                                                                                      \
        if ((t) + 1 < NT) { VMW(); SWRITE_H(SB); }                                                                          \
        RESC(alX); __syncthreads(); } while (0)
    for (int t = 1; t + 1 < NT; t += 2) {
        HALF_STEP(pB0, pB1, mnB, alB, pA0, pA1, alA, t, 1, 0, 0);
        HALF_STEP(pA0, pA1, mnA, alA, pB0, pB1, alB, t + 1, 0, 1, 1);
    }
    const bool even = (NT & 1) == 0;
    if (even) { SBAR(); qkt<1>(pB0, pB1, K_lds, r32, hi, S.qr, CSP(NT - 1)); SBAR(); }
    { const bf16* Kn = blk_k(B, nxt); const bf16* Vn = blk_v(B, nxt); SLOAD_H(Kn, Vn, kbn); } SBAR();
    { const bf16* Qn = blk_q(B, nxt);
#pragma unroll
    for (int d0 = 0; d0 < 8; ++d0) S.qr[d0] = load8(Qn + (size_t)(wid * QBLK + r32) * LDQ + d0 * 16 + hi * 8); }
    SBAR();
    finishSM(pA0, pA1, alA, l_reg, pa0, pa1, pa2, pa3); SBAR();
    pv_tile<0>(o, vb0, pa0, pa1, pa2, pa3);
    if (even) { MASKT(pB0, pB1, NT - 1); partialSM(pB0, pB1, m_reg, mnB, alB); __syncthreads(); RESC(alB);
        finishSM(pB0, pB1, alB, l_reg, pa0, pa1, pa2, pa3); SBAR(); pv_tile<1>(o, vb0, pa0, pa1, pa2, pa3); }
    SBAR(); SEAM_K0();
    if (hi == 0) li_l[r32] = l_reg; asm volatile("s_waitcnt lgkmcnt(0)" ::: "memory");
    float rli[16];
#pragma unroll
    for (int r = 0; r < 16; ++r) rli[r] = __builtin_amdgcn_rcpf(li_l[crow(r, hi)]);
    int r32e = r32, hie = hi; asm volatile("" : "+v"(r32e), "+v"(hie));
    const size_t m0 = (size_t)(cur.bh >> 3) * SEQ + cur.qb * 256 + wid * QBLK + 4 * hie;
    bf16* Ow = B.OA + m0 * LDO + (cur.bh & 7) * 128 + r32e; float* Sw = B.SSQ + m0 * 8 + (cur.bh & 7);
#pragma unroll
    for (int r = 0; r < 16; ++r) { const int orow = (r & 3) + 8 * (r >> 2); float sq = 0.f;
#pragma unroll
        for (int d0 = 0; d0 < 4; ++d0) { const float v = o[d0][r] * rli[r]; sq += v * v;
            const float vn = __shfl_xor(v, 1);
            if ((r32e & 1) == 0) *(unsigned*)(Ow + (size_t)orow * LDO + d0 * 32) = cvtpk(v, vn); }
        sq += __shfl_xor(sq, 1); sq += __shfl_xor(sq, 2); sq += __shfl_xor(sq, 4); sq += __shfl_xor(sq, 8); sq += __shfl_xor(sq, 16);
        if (r32e == 0) Sw[(size_t)orow * 8] = sq; }
    __syncthreads();
#undef RESC
#undef KBASE
#undef CSP
#undef MASKT
#undef SEAM_K0
#undef HALF_STEP
}
#undef ROW
#undef VMW
#undef VMWN
#undef SLOAD_H
#undef SWRITE_HK
#undef SWRITE_HV
#undef SWRITE_H
#undef KSWZ
#undef SBAR
}

constexpr int FOXQ_OFF = 98304;
__device__ __forceinline__ void fox_phase(Frame& F) {
    const int tid = (int)threadIdx.x;
    const fox::Bases B{(const bf16*)(F.A->ws + WS_U), (bf16*)(F.A->ws + WS_HN), (float*)(F.A->ws + WS_SSQ), (const float*)(F.A->ws + WS_CUM)};
    LAS float* est = (LAS float*)(F.lds + FOXQ_OFF); LAS int* order = (LAS int*)(F.lds + FOXQ_OFF + 2048); LAS float* XS = (LAS float*)(F.lds + FOXQ_OFF + 4096); LAS int* misc = (LAS int*)(F.lds + FOXQ_OFF + 4096 + 256);
    unsigned* ctl = (unsigned*)F.A->ws;
    {
        const int bh = tid >> 4, qb = tid & 15, h = bh & 7;
        float q2 = 0.f, k2 = 0.f;
#pragma unroll
        for (int p = 0; p < 4; ++p) { q2 += __uint_as_float(__hip_atomic_load(ctl + CW_NRM + (bh * 4 + p), __ATOMIC_RELAXED, __HIP_MEMORY_SCOPE_AGENT)); k2 += __uint_as_float(__hip_atomic_load(ctl + CW_NRM + ((32 + bh) * 4 + p), __ATOMIC_RELAXED, __HIP_MEMORY_SCOPE_AGENT)); }
        float km = 0.f;
        for (int r = 0; r < 16; ++r) km = fmaxf(km, __uint_as_float(__hip_atomic_load(ctl + CW_MNRM + h * 16 + r, __ATOMIC_RELAXED, __HIP_MEMORY_SCOPE_AGENT)));
        k2 = fmaxf(k2, km);
        const float X = 45.0f + 2.0f * 1.03f * SCALE * sqrtf(q2 * k2);
        const float rate = -B.CUM[(size_t)bh * PP + PP - 1] * (1.0f / 4112.0f);
        const float full = (float)(4 * qb + 5), win = X / fmaxf(rate, 1e-6f) * (1.0f / 64.0f) + 5.0f;
        est[tid] = fminf(full, win) + 1e-3f * (float)qb;
        if (qb == 0) XS[bh] = X;
    }
    __syncthreads();
    { const float e = est[tid]; int rank = 0;
      for (int u = 0; u < 512; ++u) { const float o = est[u]; rank += (o > e || (o == e && u < tid)) ? 1 : 0; }
      order[rank] = tid; }
    __syncthreads();
    fox::Seam S;
    for (;;) {
        if (tid == 0) misc[0] = (int)__hip_atomic_fetch_add(ctl + CW_QHEAD, 1u, __ATOMIC_RELAXED, __HIP_MEMORY_SCOPE_AGENT);
        __syncthreads();
        const int idx = __builtin_amdgcn_readfirstlane(misc[0]);
        if (idx >= (REPP == 20 ? 1024 : 512)) break;
        const int blk = __builtin_amdgcn_readfirstlane(order[idx & 511]);
        const fox::BlockRef cur{blk >> 4, blk & 15};
        fox::stage_cum(B, cur, (LAS char*)F.lds);
        if (tid == 0) misc[1] = 0;
        __syncthreads();
        {
            const int nfull = 4 * cur.qb + 5; const float thr = -XS[cur.bh] * fox::INVS; const LAS float* cumS = (const LAS float*)(F.lds + fox::OFF_CUM);
            if (tid < nfull - 4) { if (cumS[64 * (1 + tid) + 63] < thr) __hip_atomic_fetch_add((LAS int*)misc + 1, 1, __ATOMIC_RELAXED, __HIP_MEMORY_SCOPE_WORKGROUP); }
        }
        __syncthreads();
        const int j_lo = 1 + __builtin_amdgcn_readfirstlane(misc[1]);
        int tq = (int)threadIdx.x; asm volatile("" : "+v"(tq));
        fox::prime(B, cur, j_lo, (LAS char*)F.lds, S, tq);
        fox::block(B, cur, cur, j_lo, (LAS char*)F.lds, S, tq);
    }
}

namespace ret {
typedef short s16x4 __attribute__((ext_vector_type(4)));
typedef short v4i16_t __attribute__((ext_vector_type(4)));
__device__ __forceinline__ s16x4 vtr(const LAS char* p) { return __builtin_bit_cast(s16x4, __builtin_amdgcn_ds_read_tr16_b64_v4i16((LAS v4i16_t*)p)); }
__device__ __forceinline__ int kswz(int row, int colB) { return row * 256 + (colB ^ ((row & 7) << 4)); }
__device__ __forceinline__ int vswz(int row, int colB) { return row * 256 + (colB ^ ((row & 7) << 5)); }
__device__ __forceinline__ int aswz(int row, int colB) { return row * 256 + (colB ^ ((((row & 3) | ((row >> 1) & 4))) << 5)); }
constexpr int A_KB = 32768, A_VB = 4096, A_OFF_V = 2 * A_KB;
__device__ __forceinline__ void states(Frame& F) {
    const int tid = ((int)threadIdx.x), lane = ((int)(threadIdx.x & 63)), w = F.wave, g = lane >> 4, q = (lane & 15) >> 2, pp = lane & 3;
    const bf16* U = (const bf16*)(F.A->ws + WS_U); bf16* ST = (bf16*)(F.A->ws + WS_ST);
    LAS char* lds = (LAS char*)F.lds;
    for (int unit = F.vcu; unit < NB * NH * 8; unit += F.G) {
        const int bh = unit >> 3, es = unit & 7, b = bh >> 3, h = bh & 7;
        const bf16* Kg = U + 4 * USTR + ((size_t)b * PP) * 1024 + h * 128;
        const bf16* Vg = U + 5 * USTR + ((size_t)b * PP) * 1024 + h * 128 + es * 16;
        const float wdec = exp2f(128.0f * log2f(1.0f - exp2f(-5.0f - (float)h)));
        f32x4 S = (f32x4){0.f, 0.f, 0.f, 0.f};
        u32x4 krA[4], vrA, krB[4], vrB, krC[4], vrC, krD[4], vrD;
#define RA_LOAD(kr, vr, n) do { _Pragma("unroll") for (int i = 0; i < 4; ++i) { const int pc = tid + 512 * i, row = pc >> 4, c16 = pc & 15; kr[i] = *(const u32x4*)(Kg + (size_t)((n) * 128 + row) * 1024 + c16 * 8); } \
        if (tid < 256) { const int row = tid >> 1, c16 = tid & 1; vr = *(const u32x4*)(Vg + (size_t)((n) * 128 + row) * 1024 + c16 * 8); } } while (0)
#define RA_WRITE(kr, vr, bf) do { _Pragma("unroll") for (int i = 0; i < 4; ++i) { const int pc = tid + 512 * i, row = pc >> 4, c16 = pc & 15; *(LAS u32x4*)(lds + (bf) * A_KB + aswz(row, c16 * 16)) = kr[i]; } \
        if (tid < 256) { const int row = tid >> 1, c16 = tid & 1; *(LAS u32x4*)(lds + A_OFF_V + (bf) * A_VB + row * 32 + c16 * 16) = vr; } } while (0)
#define RA_STEP(n, bf) do { f32x4 acc = (f32x4){0.f, 0.f, 0.f, 0.f}; \
            _Pragma("unroll") for (int s = 0; s < 4; ++s) { const int r0 = 32 * s + 8 * g + q; \
                const s16x4 a0 = vtr(lds + (bf) * A_KB + aswz(r0, (16 * w + 4 * pp) * 2)), a1 = vtr(lds + (bf) * A_KB + aswz(r0 + 4, (16 * w + 4 * pp) * 2)); \
                const s16x4 b0 = vtr(lds + A_OFF_V + (bf) * A_VB + r0 * 32 + pp * 8), b1 = vtr(lds + A_OFF_V + (bf) * A_VB + (r0 + 4) * 32 + pp * 8); \
                acc = __builtin_amdgcn_mfma_f32_16x16x32_bf16((bf16x8){a0[0], a0[1], a0[2], a0[3], a1[0], a1[1], a1[2], a1[3]}, (bf16x8){b0[0], b0[1], b0[2], b0[3], b1[0], b1[1], b1[2], b1[3]}, acc, 0, 0, 0); } \
            S = (S + acc) * wdec; \
            { u32x2 o; o.x = cvt_pk_bf16(S[0], S[1]); o.y = cvt_pk_bf16(S[2], S[3]); \
              *(u32x2*)(ST + (((size_t)bh * 32 + (n)) * 128 + es * 16 + (lane & 15)) * 128 + 16 * w + 4 * g) = o; } } while (0)
        RA_LOAD(krA, vrA, 0); RA_WRITE(krA, vrA, 0); RA_LOAD(krB, vrB, 1); RA_LOAD(krC, vrC, 2); RA_LOAD(krD, vrD, 3);
        __syncthreads();
#define RA_BAR() asm volatile("s_waitcnt lgkmcnt(0)\n\ts_barrier" ::: "memory")
        for (int n = 0; n < 32; n += 4) {
            if (n + 4 < 32) RA_LOAD(krA, vrA, n + 4);
            RA_STEP(n, 0); RA_WRITE(krB, vrB, 1); RA_BAR();
            if (n + 5 < 32) RA_LOAD(krB, vrB, n + 5);
            RA_STEP(n + 1, 1); RA_WRITE(krC, vrC, 0); RA_BAR();
            if (n + 6 < 32) RA_LOAD(krC, vrC, n + 6);
            RA_STEP(n + 2, 0); RA_WRITE(krD, vrD, 1); RA_BAR();
            if (n + 7 < 32) RA_LOAD(krD, vrD, n + 7);
            RA_STEP(n + 3, 1); if (n + 4 < 32) RA_WRITE(krA, vrA, 0); RA_BAR();
        }
        __syncthreads();
#undef RA_BAR
#undef RA_STEP
#undef RA_LOAD
#undef RA_WRITE
    }
}
constexpr int B_K = 0, B_V = 32768, B_S = 65536;
__device__ __forceinline__ void outputs(Frame& F) {
    int tid = (int)threadIdx.x; asm volatile("" : "+v"(tid));
    const int lane = tid & 63, w = F.wave, g = lane >> 4, il = lane & 15, q = il >> 2, pp = lane & 3;
    const bf16* U = (const bf16*)(F.A->ws + WS_U); const bf16* ST = (const bf16*)(F.A->ws + WS_ST); bf16* OA = (bf16*)(F.A->ws + WS_HN);
    LAS char* lds = (LAS char*)F.lds;
    u32x4 pk[4], pv[4], ps[4];
#define RB_LOAD(unit) do { const int bh_ = (unit) >> 5, n_ = ((unit) & 31) + 1, b_ = bh_ >> 3, h_ = bh_ & 7; \
        const bf16* Kg = U + 4 * USTR + ((size_t)(b_ * PP + n_ * 128)) * 1024 + h_ * 128; const bf16* Vg = U + 5 * USTR + ((size_t)(b_ * PP + n_ * 128)) * 1024 + h_ * 128; \
        const bf16* Sg = ST + ((size_t)bh_ * 32 + (n_ - 1)) * 16384; \
        _Pragma("unroll") for (int i = 0; i < 4; ++i) { const int pc = tid + 512 * i, row = pc >> 4, c16 = pc & 15; pk[i] = *(const u32x4*)(Kg + (size_t)row * 1024 + c16 * 8); pv[i] = *(const u32x4*)(Vg + (size_t)row * 1024 + c16 * 8); \
            ps[i] = *(const u32x4*)(Sg + (size_t)row * 128 + c16 * 8); } } while (0)
#define RB_WRITE() do { _Pragma("unroll") for (int i = 0; i < 4; ++i) { const int pc = tid + 512 * i, row = pc >> 4, c16 = pc & 15; *(LAS u32x4*)(lds + B_K + kswz(row, c16 * 16)) = pk[i]; \
            *(LAS u32x4*)(lds + B_V + vswz(row, c16 * 16)) = pv[i]; *(LAS u32x4*)(lds + B_S + kswz(row, c16 * 16)) = ps[i]; } } while (0)
    int unit = F.vcu; if (unit >= NB * NH * 32) return;
    RB_LOAD(unit); RB_WRITE();
    __syncthreads();
    for (;;) {
        const int nu = unit + F.G; const bool more = nu < NB * NH * 32;
        const int bh = unit >> 5, n = (unit & 31) + 1, b = bh >> 3, h = bh & 7;
        const size_t urow = (size_t)(b * PP + n * 128 + 16 * w + il);
        bf16x8 qx[4];
#pragma unroll
        for (int s = 0; s < 4; ++s) qx[s] = *(const bf16x8*)(U + 3 * USTR + urow * 1024 + h * 128 + 32 * s + 8 * g);
        if (more) RB_LOAD(nu);
        u32x2 P[8];
#pragma unroll
        for (int jb = 0; jb < 8; ++jb) {
            P[jb] = (u32x2){0u, 0u};
            if (jb <= w) {
                f32x4 d = (f32x4){0.f, 0.f, 0.f, 0.f};
#pragma unroll
                for (int s = 0; s < 4; ++s) { const bf16x8 a = *(const LAS bf16x8*)(lds + B_K + kswz(16 * jb + il, 64 * s + 16 * g)); d = __builtin_amdgcn_mfma_f32_16x16x32_bf16(a, qx[s], d, 0, 0, 0); }
                if (jb == w) {
#pragma unroll
                    for (int r = 0; r < 4; ++r) if (4 * g + r > il) d[r] = 0.f; }
                P[jb].x = cvt_pk_bf16(d[0], d[1]); P[jb].y = cvt_pk_bf16(d[2], d[3]);
            }
        }
        f32x4 o[8];
#pragma unroll
        for (int eb = 0; eb < 8; ++eb) { f32x4 acc = (f32x4){0.f, 0.f, 0.f, 0.f};
#pragma unroll
            for (int s = 0; s < 4; ++s) { const bf16x8 a = *(const LAS bf16x8*)(lds + B_S + kswz(16 * eb + il, 64 * s + 16 * g)); acc = __builtin_amdgcn_mfma_f32_16x16x32_bf16(a, qx[s], acc, 0, 0, 0); }
#pragma unroll
            for (int t = 0; t < 4; ++t) { if (2 * t <= w) {
                const int r0 = 32 * t + 4 * g + q;
                const s16x4 a0 = vtr(lds + B_V + vswz(r0, (16 * eb + 4 * pp) * 2)), a1 = vtr(lds + B_V + vswz(r0 + 16, (16 * eb + 4 * pp) * 2));
                const u32x4 bw = (u32x4){P[2 * t].x, P[2 * t].y, P[2 * t + 1].x, P[2 * t + 1].y};
                acc = __builtin_amdgcn_mfma_f32_16x16x32_bf16((bf16x8){a0[0], a0[1], a0[2], a0[3], a1[0], a1[1], a1[2], a1[3]}, __builtin_bit_cast(bf16x8, bw), acc, 0, 0, 0); } }
            o[eb] = acc; }
        float sm = 0.f;
#pragma unroll
        for (int eb = 0; eb < 8; ++eb) sm += (o[eb][0] + o[eb][1]) + (o[eb][2] + o[eb][3]);
        sm += __shfl_xor(sm, 16); sm += __shfl_xor(sm, 32);
        const float mu = sm * (1.0f / HD); float sv = 0.f;
#pragma unroll
        for (int eb = 0; eb < 8; ++eb) { o[eb] = o[eb] - mu; sv += (o[eb][0] * o[eb][0] + o[eb][1] * o[eb][1]) + (o[eb][2] * o[eb][2] + o[eb][3] * o[eb][3]); }
        sv += __shfl_xor(sv, 16); sv += __shfl_xor(sv, 32);
        const float rstd = 1.0f / sqrtf(sv * (1.0f / HD) + EPS);
        const size_t m = (size_t)b * SEQ + (n - 1) * 128 + 16 * w + il;
#pragma unroll
        for (int eb = 0; eb < 8; ++eb) { const int e0 = 16 * eb + 4 * g;
            const u32x2 gg = *(const u32x2*)(U + 6 * USTR + urow * 1024 + h * 128 + e0);
            u32x2 ov; ov.x = cvt_pk_bf16(o[eb][0] * rstd * bf_lo(gg.x), o[eb][1] * rstd * bf_hi(gg.x)); ov.y = cvt_pk_bf16(o[eb][2] * rstd * bf_lo(gg.y), o[eb][3] * rstd * bf_hi(gg.y));
            *(u32x2*)(OA + m * DM + 1024 + h * 128 + e0) = ov; }
        __syncthreads();
        if (!more) break;
        RB_WRITE();
        __syncthreads();
        unit = nu;
    }
#undef RB_LOAD
#undef RB_WRITE
}
}

struct POutProj {
    static constexpr bool PERM = true, HAS_MID = true, FP8 = false, GATHER = false;
    int nt; const char* Abase; unsigned lda2, ldb2; const char* Bt; const float* x; bf16* H1B; const float* SSQ;
    __device__ __forceinline__ void a_offs(const g8::Unit&, unsigned (&)[2][2]) const {}
    __device__ __forceinline__ const char* b_tile(const g8::Unit& u, int t) const { return Bt + (size_t)u.pn * 256 * ldb2 + (size_t)t * 128; }
    __device__ __forceinline__ void mid(f32x4 (&acc)[2][2][4][2], const g8::Unit& u, int wr, int wc, int fr, int fq) const {
#pragma unroll
        for (int ai = 0; ai < 2; ++ai)
#pragma unroll
            for (int m = 0; m < 4; ++m) { const int r = u.pm * 256 + ai * 128 + wr * 64 + m * 16 + fr;
                const f32x4 s0 = *(const f32x4*)(SSQ + (size_t)r * 8), s1 = *(const f32x4*)(SSQ + (size_t)r * 8 + 4);
                const float rs = 1.0f / sqrtf(((s0.x + s0.y) + (s0.z + s0.w) + (s1.x + s1.y) + (s1.z + s1.w)) * (1.0f / 1024.0f) + EPS);
#pragma unroll
                for (int bj = 0; bj < 2; ++bj)
#pragma unroll
                    for (int n = 0; n < 2; ++n) acc[ai][bj][m][n] = acc[ai][bj][m][n] * rs; }
    }
    __device__ __forceinline__ void epi(const f32x4 (&acc)[2][2][4][2], const g8::Unit& u, int wr, int wc, int fr, int fq) const {
        const int row0 = u.pm * 256 + wr * 64 + fr, col0 = u.pn * 256 + wc * 32 + 8 * fq;
#pragma unroll
        for (int ai = 0; ai < 2; ++ai)
#pragma unroll
            for (int m = 0; m < 4; ++m) { const size_t off = (size_t)(row0 + ai * 128 + m * 16) * DM + col0;
#pragma unroll
                for (int bj = 0; bj < 2; ++bj) { const f32x4 v0 = *(const f32x4*)(x + off + bj * 128) + acc[ai][bj][m][0], v1 = *(const f32x4*)(x + off + bj * 128 + 4) + acc[ai][bj][m][1];
                    u32x4 w; w.x = cvt_pk_bf16(v0[0], v0[1]); w.y = cvt_pk_bf16(v0[2], v0[3]); w.z = cvt_pk_bf16(v1[0], v1[1]); w.w = cvt_pk_bf16(v1[2], v1[3]);
                    *(u32x4*)(H1B + off + bj * 128) = w; } }
    }
};

__device__ __forceinline__ void p4_router(Frame& F) {
    const int lane = ((int)(threadIdx.x & 63)), w = F.wave, blk = w & 3, kh = w >> 2, row = lane & 15, kq = lane >> 4;
    const bf16* H1 = (const bf16*)(F.A->ws + WS_H1B); const float* g2 = F.A->in[8]; const float* WRT = (const float*)(F.A->ws + WS_WRT);
    const float* brg = F.A->in[10]; const float* bre = F.A->in[12];
    unsigned char* HN2 = (unsigned char*)(F.A->ws + WS_HN); int* TOK = (int*)(F.A->ws + WS_TOK); float* WLO = (float*)(F.A->ws + WS_WLO); float* WHI = (float*)(F.A->ws + WS_WHI); float* RSS = (float*)(F.A->ws + WS_RSS);
    LAS float* part = (LAS float*)F.lds;
    LAS float* pss = part + 2 * 64 * 32;
    for (int rb = F.vcu; rb < MTOK / 64; rb += F.G) {
        const int m0 = rb * 64 + blk * 16;
        const bf16* xp = H1 + (size_t)(m0 + row) * DM + kh * 1024 + 16 * kq;
        const float* w0p = WRT + (size_t)row * DM + kh * 1024 + 16 * kq; const float* w1p = w0p + 16 * DM; const float* gp = g2 + kh * 1024 + 16 * kq;
        u32x4* op = (u32x4*)(HN2 + (size_t)(m0 + row) * DM + kh * 1024 + 16 * kq);
        f32x4 acc0 = (f32x4){0.f, 0.f, 0.f, 0.f}, acc1 = acc0; float ss = 0.f;
#pragma unroll 2
        for (int s = 0; s < 16; ++s) {
            f32x4 xa[4], b0[4], b1[4], gg[4];
            const u32x4 xl = *(const u32x4*)(xp + 64 * s), xh = *(const u32x4*)(xp + 64 * s + 8);
            xa[0] = (f32x4){bf_lo(xl.x), bf_hi(xl.x), bf_lo(xl.y), bf_hi(xl.y)}; xa[1] = (f32x4){bf_lo(xl.z), bf_hi(xl.z), bf_lo(xl.w), bf_hi(xl.w)};
            xa[2] = (f32x4){bf_lo(xh.x), bf_hi(xh.x), bf_lo(xh.y), bf_hi(xh.y)}; xa[3] = (f32x4){bf_lo(xh.z), bf_hi(xh.z), bf_lo(xh.w), bf_hi(xh.w)};
#pragma unroll
            for (int j = 0; j < 4; ++j) { b0[j] = *(const f32x4*)(w0p + 64 * s + 4 * j); b1[j] = *(const f32x4*)(w1p + 64 * s + 4 * j); gg[j] = *(const f32x4*)(gp + 64 * s + 4 * j); }
            u32x4 o;
#pragma unroll
            for (int j = 0; j < 4; ++j) {
#pragma unroll
                for (int e = 0; e < 4; ++e) { acc0 = __builtin_amdgcn_mfma_f32_16x16x4f32(xa[j][e], b0[j][e], acc0, 0, 0, 0); acc1 = __builtin_amdgcn_mfma_f32_16x16x4f32(xa[j][e], b1[j][e], acc1, 0, 0, 0); }
                ss += (xa[j].x * xa[j].x + xa[j].y * xa[j].y) + (xa[j].z * xa[j].z + xa[j].w * xa[j].w);
                const f32x4 y = xa[j] * gg[j] * SA1; o[j] = pk_fp8x4(y.x, y.y, y.z, y.w); }
            op[4 * s] = o;
        }
        ss += __shfl_xor(ss, 16); ss += __shfl_xor(ss, 32);
#pragma unroll
        for (int r = 0; r < 4; ++r) { part[(kh * 64 + blk * 16 + 4 * kq + r) * 32 + row] = acc0[r]; part[(kh * 64 + blk * 16 + 4 * kq + r) * 32 + 16 + row] = acc1[r]; }
        if (kq == 0) pss[kh * 64 + blk * 16 + row] = ss;
        __syncthreads();
        if (((int)threadIdx.x) < 64) {
            const int r = ((int)threadIdx.x), m = rb * 64 + r;
            const float rs = 1.0f / sqrtf((pss[r] + pss[64 + r]) * (1.0f / DM) + EPS);
            float lgt[20];
#pragma unroll
            for (int j = 0; j < 20; ++j) lgt[j] = (part[r * 32 + j] + part[(64 + r) * 32 + j]) * rs + (j < 4 ? brg[j] : bre[j - 4]);
            int gs = 0; float gm = lgt[0];
#pragma unroll
            for (int i = 1; i < 4; ++i) if (lgt[i] > gm) { gm = lgt[i]; gs = i; }
            float den = 0.f;
#pragma unroll
            for (int i = 0; i < 4; ++i) den += __expf(lgt[i] - gm);
            const float pg = 1.0f / den;
            float e4[4];
#pragma unroll
            for (int i = 0; i < 4; ++i) { float a = lgt[4 + i];
#pragma unroll
                for (int g = 1; g < 4; ++g) a = (gs == g) ? lgt[4 + 4 * g + i] : a;
                e4[i] = a; }
            int i1 = 0; float v1 = e4[0];
#pragma unroll
            for (int i = 1; i < 4; ++i) if (e4[i] > v1) { v1 = e4[i]; i1 = i; }
            int i2 = -1; float v2 = -__builtin_inff();
#pragma unroll
            for (int i = 0; i < 4; ++i) if (i != i1 && e4[i] > v2) { v2 = e4[i]; i2 = i; }
            const float ex = __expf(v2 - v1); const float w1 = pg / (1.f + ex), w2 = pg * ex / (1.f + ex);
            const int lo = i1 < i2 ? i1 : i2, hi = i1 < i2 ? i2 : i1; const float wlo = i1 < i2 ? w1 : w2, whi = i1 < i2 ? w2 : w1;
            const int pair = (lo == 0) ? (hi - 1) : (lo == 1) ? (hi + 1) : 5;
            const int cls = gs * 6 + pair;
            const unsigned pos = __hip_atomic_fetch_add(((unsigned*)F.A->ws) + CW_CNT + 64 * cls, 1u, __ATOMIC_RELAXED, __HIP_MEMORY_SCOPE_AGENT);
            TOK[cls * CLS_CAP + pos] = m; WLO[cls * CLS_CAP + pos] = wlo; WHI[cls * CLS_CAP + pos] = whi; RSS[cls * CLS_CAP + pos] = rs;
        }
        __syncthreads();
    }
}

__device__ __forceinline__ void cls_experts(int cls, int& elo, int& ehi) { const int g = cls / 6, pr = cls % 6; const int lo = pr < 3 ? 0 : (pr < 5 ? 1 : 2), hi = pr < 3 ? pr + 1 : (pr < 5 ? pr - 1 : 3); elo = 4 * g + lo; ehi = 4 * g + hi; }
__device__ __forceinline__ void moe_tables(Frame& F) {
    volatile LAS int* T = (volatile LAS int*)(F.lds + TBL_OFF);
    if (((int)threadIdx.x) == 0) {
        int base = 0;
        for (int c = 0; c < NCLS; ++c) { int n = (int)__hip_atomic_load(((unsigned*)F.A->ws) + CW_CNT + 64 * c, __ATOMIC_RELAXED, __HIP_MEMORY_SCOPE_AGENT); if (n > CLS_CAP) n = CLS_CAP; T[c] = n; T[32 + c] = base; const int nt = (n + 255) >> 8;
            for (int i = 0; i < nt; ++i) T[96 + base + i] = c; base += nt; }
        T[64] = base;
        int ne = 0;
        for (int e = 0; e < NEXP; ++e) { T[72 + e] = ne;
            for (int c = (e >> 2) * 6; c < (e >> 2) * 6 + 6; ++c) { int elo, ehi; cls_experts(c, elo, ehi); if (elo != e && ehi != e) continue; const int slot = (ehi == e) ? 1 : 0;
                const int nt = (T[c] + 255) >> 8; for (int i = 0; i < nt; ++i) { T[192 + ne] = (T[32 + c] + i) | (slot << 8) | (c << 16) | (i << 24); ++ne; } } }
        T[72 + NEXP] = ne; T[65] = ne;
    }
    __syncthreads();
}
struct SchedGU {
    const LAS int* T; int G, c;
    __device__ bool next(int i, g8::Unit& u) const {
        const int L = i * G + c; const int ne = __builtin_amdgcn_readfirstlane(T[65]); if (L >= ne * 8) return false;
        int e = 0;
#pragma unroll
        for (int k = 1; k < NEXP; ++k) { const int o = __builtin_amdgcn_readfirstlane(T[72 + k]); if (L >= o * 8) e = k; }
        const int e0 = __builtin_amdgcn_readfirstlane(T[72 + e]), e1 = __builtin_amdgcn_readfirstlane(T[72 + e + 1]); const int cnt = e1 - e0, loc = L - e0 * 8;
        const int ntile = loc / cnt, mt = loc - ntile * cnt; const int ent = __builtin_amdgcn_readfirstlane(T[192 + e0 + mt]);
        u.pm = ent & 0xff; u.pn = ntile; u.a0 = e; u.a1 = (ent >> 8) & 1; u.a2 = (ent >> 16) & 0xff; u.a3 = (ent >> 24) & 0xff; return true;
    }
};
struct SchedDown {
    const LAS int* T; int G, c;
    __device__ bool next(int i, g8::Unit& u) const {
        const int L = i * G + c; const int NT = __builtin_amdgcn_readfirstlane(T[64]); if (L >= NT * 8) return false;
        const int tl = L >> 3; const int cls = __builtin_amdgcn_readfirstlane(T[96 + tl]); const int tb = __builtin_amdgcn_readfirstlane(T[32 + cls]);
        int elo, ehi; cls_experts(cls, elo, ehi);
        u.pm = tl; u.pn = L & 7; u.a0 = elo; u.a1 = ehi; u.a2 = cls; u.a3 = tl - tb; return true;
    }
};

struct PGateUp {
    static constexpr bool PERM = true, HAS_MID = false, FP8 = true, GATHER = true;
    int nt; const char* Abase; unsigned lda2, ldb2; const char* WGU; const int* TOK; const float* WLO; const float* WHI; const float* RSS; const LAS int* T; unsigned char* ACT;
    __device__ __forceinline__ void a_offs(const g8::Unit& u, unsigned (&o)[2][2]) const {
        const int cnt = T[u.a2];
#pragma unroll
        for (int i = 0; i < 2; ++i) { int R, C; g8::stage_rc((int)threadIdx.x * 16 + i * 8192, R, C);
#pragma unroll
            for (int h = 0; h < 2; ++h) { int pos = u.a3 * 256 + h * 128 + R; if (pos >= cnt) pos = 0; const int tok = TOK[u.a2 * CLS_CAP + pos]; o[h][i] = (unsigned)(tok * DM + C * 2); } }
    }
    __device__ __forceinline__ const char* b_tile(const g8::Unit& u, int t) const { return WGU + ((size_t)u.a0 * 2048 + (size_t)u.pn * 256) * ldb2 + (size_t)t * 128; }
    __device__ __forceinline__ void mid(f32x4 (&)[2][2][4][2], const g8::Unit&, int, int, int, int) const {}
    __device__ __forceinline__ void epi(const f32x4 (&acc)[2][2][4][2], const g8::Unit& u, int wr, int wc, int fr, int fq) const {
        const int cnt = T[u.a2]; const float* WS = u.a1 ? WHI : WLO; constexpr float INV = 1.0f / (SA1 * SW1);
#pragma unroll
        for (int ai = 0; ai < 2; ++ai)
#pragma unroll
            for (int m = 0; m < 4; ++m) { const int rl = ai * 128 + wr * 64 + m * 16 + fr; const int pos = u.a3 * 256 + rl;
                const float w = ((pos < cnt) ? WS[u.a2 * CLS_CAP + pos] : 0.f) * SA2; const float rsi = ((pos < cnt) ? RSS[u.a2 * CLS_CAP + pos] : 0.f) * INV;
                const f32x4 g0 = acc[ai][0][m][0] * rsi, g1 = acc[ai][0][m][1] * rsi, u0 = acc[ai][1][m][0] * rsi, u1 = acc[ai][1][m][1] * rsi;
                f32x4 a0, a1;
#pragma unroll
                for (int e = 0; e < 4; ++e) { a0[e] = g0[e] / (1.f + __expf(-g0[e])) * u0[e] * w; a1[e] = g1[e] / (1.f + __expf(-g1[e])) * u1[e] * w; }
                u32x2 o; o.x = pk_fp8x4(a0[0], a0[1], a0[2], a0[3]); o.y = pk_fp8x4(a1[0], a1[1], a1[2], a1[3]);
                *(u32x2*)(ACT + ((size_t)u.pm * 256 + rl) * 2048 + u.a1 * 1024 + u.pn * 128 + wc * 32 + 8 * fq) = o; }
    }
};
struct PDown {
    static constexpr bool PERM = true, HAS_MID = false, FP8 = true, GATHER = false;
    int nt; const char* Abase; unsigned lda2, ldb2; const char* WD; const int* TOK; const LAS int* T; bf16* Y;
    __device__ __forceinline__ void a_offs(const g8::Unit&, unsigned (&)[2][2]) const {}
    __device__ __forceinline__ const char* b_tile(const g8::Unit& u, int t) const { const int e = (t < 8) ? u.a0 : u.a1; return WD + ((size_t)e * 2048 + (size_t)u.pn * 256) * ldb2 + (size_t)(t & 7) * 128; }
    __device__ __forceinline__ void mid(f32x4 (&)[2][2][4][2], const g8::Unit&, int, int, int, int) const {}
    __device__ __forceinline__ void epi(const f32x4 (&acc)[2][2][4][2], const g8::Unit& u, int wr, int wc, int fr, int fq) const {
        const int cnt = T[u.a2]; const int col0 = u.pn * 256 + wc * 32 + 8 * fq; constexpr float INV = 1.0f / (SA2 * SW2);
#pragma unroll
        for (int ai = 0; ai < 2; ++ai)
#pragma unroll
            for (int m = 0; m < 4; ++m) { const int pos = u.a3 * 256 + ai * 128 + wr * 64 + m * 16 + fr;
                if (pos < cnt) { const int tok = TOK[u.a2 * CLS_CAP + pos]; bf16* rowp = Y + (size_t)tok * DM + col0;
#pragma unroll
                    for (int bj = 0; bj < 2; ++bj) { const f32x4 v0 = acc[ai][bj][m][0] * INV, v1 = acc[ai][bj][m][1] * INV;
                        u32x4 w; w.x = cvt_pk_bf16(v0[0], v0[1]); w.y = cvt_pk_bf16(v0[2], v0[3]); w.z = cvt_pk_bf16(v1[0], v1[1]); w.w = cvt_pk_bf16(v1[2], v1[3]);
                        *(u32x4*)(rowp + bj * 128) = w; } } }
    }
};

__device__ __forceinline__ void p7_final(Frame& F) {
    const int gw = F.vcu * NWAVES + F.wave, NGW = F.G * NWAVES, lane = ((int)(threadIdx.x & 63)); const float* gf = F.A->in[16];
    const bf16* Y = (const bf16*)(F.A->ws + WS_Y); const bf16* H1 = (const bf16*)(F.A->ws + WS_H1B);
    for (int row = gw; row < MTOK; row += NGW) {
        float* xr = F.A->out + (size_t)row * DM; const u32x4* yr = (const u32x4*)(Y + (size_t)row * DM); const u32x4* hr = (const u32x4*)(H1 + (size_t)row * DM);
        f32x4 v[8]; float ss = 0.f;
#pragma unroll
        for (int j = 0; j < 4; ++j) { const u32x4 y = yr[lane + 64 * j], h = hr[lane + 64 * j];
            v[2 * j] = (f32x4){bf_lo(h.x) + bf_lo(y.x), bf_hi(h.x) + bf_hi(y.x), bf_lo(h.y) + bf_lo(y.y), bf_hi(h.y) + bf_hi(y.y)};
            v[2 * j + 1] = (f32x4){bf_lo(h.z) + bf_lo(y.z), bf_hi(h.z) + bf_hi(y.z), bf_lo(h.w) + bf_lo(y.w), bf_hi(h.w) + bf_hi(y.w)};
            ss += (v[2 * j].x * v[2 * j].x + v[2 * j].y * v[2 * j].y) + (v[2 * j].z * v[2 * j].z + v[2 * j].w * v[2 * j].w) + (v[2 * j + 1].x * v[2 * j + 1].x + v[2 * j + 1].y * v[2 * j + 1].y) + (v[2 * j + 1].z * v[2 * j + 1].z + v[2 * j + 1].w * v[2 * j + 1].w); }
        const float rs = 1.0f / sqrtf(wave_sum(ss) * (1.0f / DM) + EPS);
#pragma unroll
        for (int j = 0; j < 4; ++j) { const f32x4 g0 = *((const f32x4*)gf + 2 * (lane + 64 * j)), g1 = *((const f32x4*)gf + 2 * (lane + 64 * j) + 1);
            *((f32x4*)xr + 2 * (lane + 64 * j)) = v[2 * j] * rs * g0; *((f32x4*)xr + 2 * (lane + 64 * j) + 1) = v[2 * j + 1] * rs * g1; }
    }
}

__global__ void __launch_bounds__(NWAVES * 64, 2) fwd_kernel(Args args) {
    extern __shared__ __attribute__((aligned(16))) unsigned char lds[];
    Frame F;
    F.lds = (LAS unsigned char*)lds;
    F.MISC = (volatile LAS unsigned*)(F.lds + MISC_OFF);
    F.wave = __builtin_amdgcn_readfirstlane((int)threadIdx.x >> 6);
    F.G = gridDim.x; { const int bx = blockIdx.x; F.vcu = (F.G % 8 == 0) ? (bx % 8) * (F.G / 8) + bx / 8 : bx; }
    F.A = &args;
    { int t0 = (int)threadIdx.x; asm volatile("" : "+v"(t0));
      for (int u = t0; u < (LDS_BYTES - RING_BYTES) / 4; u += NWAVES * 64) ((LAS unsigned*)(F.lds + RING_BYTES))[u] = 0u; }
    __syncthreads();
    (void)xcd_barrier_post((unsigned*)args.ws + CW_BAR, F.MISC + 8);
#define MKBAR() XcdBarrier bar; bar.bar = (unsigned*)args.ws + CW_BAR; bar.x = xb_xcc_id(); bar.st = (volatile LAS unsigned*)(F.lds + MISC_OFF) + 8
    const int lo = args.ph_lo, hi = args.ph_hi;
#define IN(k) (lo <= (k) && (k) < hi)
#define GRID_BAR(k) do { if (IN(k) && IN((k) + 1)) { MKBAR(); xcd_barrier(bar); } } while (0)
    bf16* U = (bf16*)(F.A->ws + WS_U);
#define PHASE(k, ...) do { if (IN(k)) { __VA_ARGS__ if constexpr (REPP == (k)) { { MKBAR(); xcd_barrier(bar); } __VA_ARGS__ } } GRID_BAR(k); } while (0)
    PHASE(0, p0_prologue(F););
    PHASE(1,
        p1_cumsum(F); p1_meta_kv(F);
        { PInProj p{DM / 64, (const char*)(F.A->ws + WS_HN), (unsigned)(DM * 2), (unsigned)(DM * 2), (const char*)(F.A->ws + WS_WINT), U, (const f32x2*)(F.A->ws + WS_ROPE), (unsigned*)F.A->ws + CW_NRM};
        g8::StaticOrder S; S.init(MTOK, NIN, F.G, (int)blockIdx.x);
        g8::gemm_phase<PInProj, g8::StaticOrder, true>(F.lds, p, S); });
    PHASE(2, ret::states(F); __syncthreads();
        if constexpr (REPP == 21) { ret::states(F); __syncthreads(); }
        fox_phase(F);
        { MKBAR(); xcd_barrier(bar); } ret::outputs(F);
        if constexpr (REPP == 22) { __syncthreads(); ret::outputs(F); });
    PHASE(3,
        { POutProj p{DM / 64, (const char*)(F.A->ws + WS_HN), (unsigned)(DM * 2), (unsigned)(DM * 2), (const char*)(F.A->ws + WS_WOUTT), F.A->in[0], (bf16*)(F.A->ws + WS_H1B), (const float*)(F.A->ws + WS_SSQ)};
        g8::StaticOrder S; S.init(MTOK, DM, F.G, (int)blockIdx.x);
        g8::gemm_phase<POutProj, g8::StaticOrder, true>(F.lds, p, S); });
    PHASE(4, p4_router(F);
        if constexpr (REPP == 40) { { MKBAR(); xcd_barrier(bar); } if (blockIdx.x == 0 && threadIdx.x < NCLS) ((unsigned*)F.A->ws)[CW_CNT + 64 * threadIdx.x] = 0u; { MKBAR(); xcd_barrier(bar); } p4_router(F); });
    PHASE(5,
        moe_tables(F);
        { PGateUp p{DM / 128, (const char*)(F.A->ws + WS_HN), (unsigned)DM, (unsigned)DM, (const char*)(F.A->ws + WS_WGU), (const int*)(F.A->ws + WS_TOK), (const float*)(F.A->ws + WS_WLO), (const float*)(F.A->ws + WS_WHI), (const float*)(F.A->ws + WS_RSS),
                  (const LAS int*)(F.lds + TBL_OFF), (unsigned char*)U};
        SchedGU S{(const LAS int*)(F.lds + TBL_OFF), F.G, F.vcu};
        g8::gemm_phase<PGateUp, SchedGU, true>(F.lds, p, S); });
    PHASE(6,
        if (!IN(5)) moe_tables(F);
        { PDown p{2048 / 128, (const char*)U, 2048u, (unsigned)DE, (const char*)(F.A->ws + WS_WD), (const int*)(F.A->ws + WS_TOK), (const LAS int*)(F.lds + TBL_OFF), (bf16*)(F.A->ws + WS_Y)};
        SchedDown S{(const LAS int*)(F.lds + TBL_OFF), F.G, F.vcu};
        g8::gemm_phase<PDown, SchedDown, true>(F.lds, p, S); });
    PHASE(7, p7_final(F););
#undef PHASE
#undef IN
#undef GRID_BAR
}

extern "C" void kernel_launch(void* const* d_in, const int* in_sizes, int n_in, void* d_out, int out_size, void* d_ws, size_t ws_size, hipStream_t stream) {
    static int grid = 0;
    if (grid == 0) {
        if (n_in != 17 || out_size != MTOK * DM || ws_size < WS_END) { fprintf(stderr, "kernel_launch: unexpected shapes (n_in %d out %d ws %zu)\n", n_in, out_size, ws_size); grid = -1; return; }
        int dev = 0, cus = 0, per_cu = 0;
        if (hipGetDevice(&dev) != hipSuccess || hipDeviceGetAttribute(&cus, hipDeviceAttributeMultiprocessorCount, dev) != hipSuccess) { grid = -1; return; }
        if (hipFuncSetAttribute((const void*)fwd_kernel, hipFuncAttributeMaxDynamicSharedMemorySize, LDS_BYTES) != hipSuccess) { fprintf(stderr, "kernel_launch: hipFuncSetAttribute failed\n"); grid = -1; return; }
        if (hipOccupancyMaxActiveBlocksPerMultiprocessor(&per_cu, (const void*)fwd_kernel, NWAVES * 64, LDS_BYTES) != hipSuccess || per_cu < 1) fprintf(stderr, "kernel_launch: occupancy query says %d\n", per_cu);
        (void)hipGetLastError();
        grid = cus;
    }
    if (grid < 0) return;
    (void)hipMemsetAsync((char*)d_ws + WS_CTL, 0, CTL_ZERO_BYTES, stream);
    Args a{};
    for (int i = 0; i < 17; ++i) a.in[i] = (const float*)d_in[i];
    a.out = (float*)d_out; a.ws = (unsigned char*)d_ws; a.ph_lo = 0; a.ph_hi = 8;
    hipLaunchKernelGGL(fwd_kernel, dim3(grid), dim3(NWAVES * 64), LDS_BYTES, stream, a);
}
```

```cpp
#include <hip/hip_runtime.h>
#include <cstdio>
#include <cstdint>

#define LAS __attribute__((address_space(3)))
#define GAS __attribute__((address_space(1)))
typedef unsigned short bf16;
typedef short bf16x8 __attribute__((ext_vector_type(8)));
typedef float f32x4 __attribute__((ext_vector_type(4)));
typedef float f32x2 __attribute__((ext_vector_type(2)));
typedef unsigned u32x4 __attribute__((ext_vector_type(4)));
typedef unsigned u32x2 __attribute__((ext_vector_type(2)));

constexpr int NB = 4, SEQ = 4096, DM = 2048, PADN = 112, NMETA = 16, PP = SEQ + 128, HD = 128, NH = 8;
constexpr int MTOK = NB * SEQ;
constexpr int INC = 7176;
constexpr int NIN = 7168;
constexpr int NEXP = 16, DE = 1024, NCLS = 24, CLS_CAP = 16384;
constexpr float EPS = 1e-6f;
constexpr float SCALE = 0.08838834764831845f;

constexpr size_t MiB = 1u << 20;
constexpr size_t WS_CTL = 0, CTL_ZERO_BYTES = 1 * MiB;
constexpr size_t WS_LOGF = 1 * MiB;
constexpr size_t WS_CUM = WS_LOGF + 1 * MiB;
constexpr size_t WS_SSQ = WS_CUM + 1 * MiB;
constexpr size_t WS_ROPE = WS_SSQ + 1 * MiB;
constexpr size_t WS_WRT = WS_ROPE + 3 * MiB;
constexpr size_t WS_HNMETA = WS_WRT + 1 * MiB;
constexpr size_t WS_TOK = WS_HNMETA + 1 * MiB;
constexpr size_t WS_WLO = WS_TOK + 2 * MiB;
constexpr size_t WS_WHI = WS_WLO + 2 * MiB;
constexpr size_t WS_WINT = 16 * MiB;
constexpr size_t WS_WOUTT = 44 * MiB;
constexpr size_t WS_WGU = 52 * MiB;
constexpr size_t WS_PART = 116 * MiB;
constexpr size_t WS_WD = 180 * MiB;
constexpr size_t WS_HN = 244 * MiB;
constexpr size_t WS_U = 308 * MiB;
constexpr size_t WS_Y = WS_U + 64 * MiB;
constexpr size_t WS_H1B = WS_U + 128 * MiB;
constexpr size_t USTR = (size_t)NB * PP * 1024;
constexpr size_t WS_ST = WS_U + 7 * 33 * MiB;
constexpr size_t WS_RSS = WS_ST + 32 * MiB;
constexpr size_t WS_END = WS_RSS + 2 * MiB;
static_assert(WS_WHI + 2 * MiB <= WS_WINT && USTR * 2 == 33 * MiB, "ws map");
constexpr int CW_BAR = 4096;
constexpr int CW_CNT = 16384;
constexpr int CW_NRM = 20480;
constexpr int CW_MNRM = 20480 + 256;
constexpr int CW_QHEAD = 24576;

constexpr int RING_BYTES = 131072;
constexpr int MISC_OFF = RING_BYTES + 320;
constexpr int TBL_OFF = RING_BYTES + 1024;
constexpr int LDS_BYTES = 147456;
constexpr int NWAVES = 8;
#ifndef REPP_V
#define REPP_V (-1)
#endif
constexpr int REPP = REPP_V;

__device__ __forceinline__ unsigned cvt_pk_bf16(float lo, float hi) { unsigned r; asm volatile("v_cvt_pk_bf16_f32 %0, %1, %2" : "=v"(r) : "v"(lo), "v"(hi)); return r; }
__device__ __forceinline__ unsigned pk_fp8x4(float a, float b, float c, float d) {
    a = __builtin_amdgcn_fmed3f(a, -448.f, 448.f); b = __builtin_amdgcn_fmed3f(b, -448.f, 448.f); c = __builtin_amdgcn_fmed3f(c, -448.f, 448.f); d = __builtin_amdgcn_fmed3f(d, -448.f, 448.f);
    int w = 0; w = __builtin_amdgcn_cvt_pk_fp8_f32(a, b, w, false); w = __builtin_amdgcn_cvt_pk_fp8_f32(c, d, w, true); return (unsigned)w; }
constexpr float SA1 = 16.f, SW1 = 1024.f, SA2 = 32.f, SW2 = 512.f;
__device__ __forceinline__ float bf_lo(unsigned w) { return __uint_as_float(w << 16); }
__device__ __forceinline__ float bf_hi(unsigned w) { return __uint_as_float(w & 0xffff0000u); }
__device__ __forceinline__ float wave_sum(float v) {
#pragma unroll
    for (int o = 1; o < 64; o <<= 1) v += __shfl_xor(v, o);
    return v;
}
__device__ __forceinline__ float wave_max(float v) {
#pragma unroll
    for (int o = 1; o < 64; o <<= 1) v = fmaxf(v, __shfl_xor(v, o));
    return v;
}
#define LDS_WAIT() asm volatile("s_waitcnt lgkmcnt(0)" ::: "memory")
#define VM_WAIT() asm volatile("s_waitcnt vmcnt(0)" ::: "memory")

#define XB_TMO      128
#define XB_XCNT(j)  (256  + 64 * (j))
#define XB_XSUB(j)  (1280 + 64 * (j))
#define XB_XGEN(j)  (2304 + 64 * (j))
#define XB_TOP      3328
#define XB_TOPGEN   3392
#define XCD_BAR_WORDS 3456
#define XB_SPIN_CAP (1u << 21)
__device__ __forceinline__ unsigned xb_ld(unsigned* p)              { return __hip_atomic_load(p, __ATOMIC_RELAXED, __HIP_MEMORY_SCOPE_AGENT); }
__device__ __forceinline__ unsigned xb_add(unsigned* p, unsigned v) { return __hip_atomic_fetch_add(p, v, __ATOMIC_RELAXED, __HIP_MEMORY_SCOPE_AGENT); }
__device__ __forceinline__ unsigned xb_xcc_id() { return (unsigned)__builtin_amdgcn_s_getreg((3 << 11) | 20) & 0xFu; }
#define XB_SPIN(cond, bar) do { unsigned _sp = 0; while (cond) { __builtin_amdgcn_s_sleep(1); \
    if ((++_sp & 255u) == 0u) { if (xb_ld(&(bar)[XB_TMO])) break; if (_sp > XB_SPIN_CAP) { atomicAdd(&(bar)[XB_TMO], 1u); break; } } } } while (0)
struct XcdBarrier { unsigned* bar; unsigned x; volatile LAS unsigned* st; };
__device__ __forceinline__ XcdBarrier xcd_barrier_post(unsigned* bar, volatile LAS unsigned* st) {
    XcdBarrier b; b.bar = bar; b.x = xb_xcc_id(); b.st = st;
    if (threadIdx.x == 0) (void)xb_add(&bar[XB_XCNT(b.x)], 1u);
    return b;
}
__device__ __forceinline__ void xcd_barrier_complete(unsigned* bar, unsigned x, unsigned& nloc, unsigned& nx) {
    const unsigned G = gridDim.x * gridDim.y * gridDim.z;
    unsigned sum, cnt, mine, sp = 0u;
    for (;;) {
        sum = 0u; cnt = 0u; mine = 0u;
#pragma unroll
        for (unsigned j = 0; j < 16; ++j) { const unsigned c = xb_ld(&bar[XB_XCNT(j)]); sum += c; cnt += (c > 0u) ? 1u : 0u; mine = (j == x) ? c : mine; }
        if (sum == G) break;
        __builtin_amdgcn_s_sleep(1);
        if ((++sp & 255u) == 0u) { if (xb_ld(&bar[XB_TMO])) break; if (sp > XB_SPIN_CAP) { atomicAdd(&bar[XB_TMO], 1u); break; } }
    }
    nloc = mine > 0u ? mine : 1u; nx = cnt > 0u ? cnt : 1u;
}
__device__ __forceinline__ void xcd_barrier(const XcdBarrier& b) {
    asm volatile("s_waitcnt vmcnt(0)" ::: "memory");
    __syncthreads();
    if (threadIdx.x == 0) {
        unsigned* bar = b.bar;
        __builtin_amdgcn_s_waitcnt(0);
        unsigned nloc = b.st[0], nx = b.st[1];
        if (nloc == 0u) { xcd_barrier_complete(bar, b.x, nloc, nx); b.st[0] = nloc; b.st[1] = nx; }
        const unsigned old = xb_add(&bar[XB_XSUB(b.x)], 1u);
        const unsigned gen = old / nloc;
        if (old + 1u == (gen + 1u) * nloc) {
            __builtin_amdgcn_fence(__ATOMIC_RELEASE, "agent");
            asm volatile("s_waitcnt vmcnt(0)" ::: "memory");
            const unsigned og = xb_add(&bar[XB_TOP], 1u);
            const unsigned tg = og / nx;
            if (og + 1u == (tg + 1u) * nx) xb_add(&bar[XB_TOPGEN], 1u);
            else XB_SPIN(xb_ld(&bar[XB_TOPGEN]) == tg, bar);
            __builtin_amdgcn_fence(__ATOMIC_ACQUIRE, "agent");
            xb_add(&bar[XB_XGEN(b.x)], 1u);
            asm volatile("s_waitcnt vmcnt(0)" ::: "memory");
        } else {
            XB_SPIN(xb_ld(&bar[XB_XGEN(b.x)]) == gen, bar);
            __builtin_amdgcn_fence(__ATOMIC_ACQUIRE, "agent");
            asm volatile("s_waitcnt vmcnt(0)" ::: "memory");
        }
    }
    __syncthreads();
}

namespace g8 {
constexpr int BM = 256, BK = 64, HALF = 128, HTB = HALF * BK * 2, NXCD = 8, WGM = 8;
__device__ __forceinline__ int lds_byte(int r, int c) { const int st = (r >> 4) * 2 + (c >> 5), rr = r & 15, cc = c & 31, ob = rr * 64 + cc * 2; return st * 1024 + (ob ^ (((ob >> 9) & 1) << 5)); }
__device__ __forceinline__ void stage_rc(int b, int& R, int& C) { const int st = b / 1024, sb = b % 1024, swz = sb ^ (((sb >> 9) & 1) << 5); R = (st >> 1) * 16 + swz / 64; C = (st & 1) * 32 + (swz % 64) / 2; }
__device__ __forceinline__ int perm32(int rho) { const int n = rho >> 4, i = rho & 15; return 8 * (i >> 2) + 4 * n + (i & 3); }

struct Unit { int pm, pn, a0, a1, a2, a3; };
typedef int v8i_t __attribute__((ext_vector_type(8)));

struct StaticOrder {
    int nM, nN, nwg, G, c;
    __device__ void init(int M, int N, int G_, int c_) { nM = M / BM; nN = N / BM; nwg = nM * nN; G = G_; c = c_; }
    __device__ bool next(int i, Unit& u) const {
        const long L = (long)i * G + c; if (L >= nwg) return false;
        int wgid = (int)L; { const int q = nwg / NXCD, r = nwg % NXCD, xcd = wgid % NXCD, off = wgid / NXCD; wgid = (xcd < r ? xcd * (q + 1) : r * (q + 1) + (xcd - r) * q) + off; }
        const int nig = WGM * nN, gid = wgid / nig, fm = gid * WGM, gsz = (nM - fm) < WGM ? (nM - fm) : WGM;
        u.pm = fm + ((wgid % nig) % gsz); u.pn = (wgid % nig) / gsz; u.a0 = u.a1 = u.a2 = u.a3 = 0; return true;
    }
};

template <class P, class Sched, bool ALIGN_EPI>
__device__ __forceinline__ void gemm_phase(LAS unsigned char* lds, const P& p, const Sched& S) {
    const int tid = threadIdx.x, wid = __builtin_amdgcn_readfirstlane(tid >> 6), lane = tid & 63, wr = wid >> 2, wc = wid & 3, fr = lane & 15, fq = lane >> 4;
    const int nt = p.nt;
    unsigned voffB[2], voffA[2];
#pragma unroll
    for (int i = 0; i < 2; ++i) { int R, C; stage_rc(tid * 16 + i * 8192, R, C); const int Rb = P::PERM ? ((R & ~31) + perm32(R & 31)) : R;
        voffB[i] = (unsigned)Rb * p.ldb2 + (unsigned)C * 2u; voffA[i] = (unsigned)R * p.lda2 + (unsigned)C * 2u; }
    const size_t hstepB = (size_t)HALF * p.ldb2, hstepA = (size_t)HALF * p.lda2;
    const unsigned ldsw = (unsigned)wid * 1024u;
    const int aoff = lds_byte(wr * 64 + fr, fq * 8), boff = lds_byte(wc * 32 + fr, fq * 8);
#define PG8_SA(b, h) (((b) * 2 + (h)) * HTB)
#define PG8_SB(b, h) ((4 + (b) * 2 + (h)) * HTB)
#define PG8_STAGE(bufoff, gbase, v0, v1) do { \
        __builtin_amdgcn_global_load_lds((const unsigned*)((const char*)(gbase) + (v0)), (LAS unsigned*)(lds + (bufoff) + ldsw), 16, 0, 0); \
        __builtin_amdgcn_global_load_lds((const unsigned*)((const char*)(gbase) + (v1)), (LAS unsigned*)(lds + (bufoff) + ldsw + 8192), 16, 0, 0); } while (0)
#define PG8_LD32(p0_, p1_) ({ const u32x4 lo_ = *(const LAS u32x4*)(p0_), hi_ = *(const LAS u32x4*)(p1_); (v8i_t){(int)lo_.x, (int)lo_.y, (int)lo_.z, (int)lo_.w, (int)hi_.x, (int)hi_.y, (int)hi_.z, (int)hi_.w}; })
#define PG8_LDA(dst, b, h) do { _Pragma("unroll") for (int m = 0; m < 4; ++m) dst[m] = PG8_LD32(lds + PG8_SA(b, h) + aoff + m * 2048, lds + PG8_SA(b, h) + aoff + m * 2048 + 1024); } while (0)
#define PG8_LDB(dst, b, h) do { _Pragma("unroll") for (int n = 0; n < 2; ++n) dst[n] = PG8_LD32(lds + PG8_SB(b, h) + boff + n * 2048, lds + PG8_SB(b, h) + boff + n * 2048 + 1024); } while (0)
#define PG8_LOH(v) __builtin_bit_cast(bf16x8, __builtin_shufflevector(v, v, 0, 1, 2, 3))
#define PG8_HIH(v) __builtin_bit_cast(bf16x8, __builtin_shufflevector(v, v, 4, 5, 6, 7))
#define PG8_MMA(ai, bj, At, Bt) do { __builtin_amdgcn_s_setprio(1); _Pragma("unroll") for (int m = 0; m < 4; ++m) _Pragma("unroll") for (int n = 0; n < 2; ++n) { \
        if constexpr (P::FP8) { asm volatile("v_mfma_f32_16x16x128_f8f6f4 %0, %1, %2, %0" : "+v"(acc[ai][bj][m][n]) : "v"(Bt[n]), "v"(At[m])); } \
        else { acc[ai][bj][m][n] = __builtin_amdgcn_mfma_f32_16x16x32_bf16(PG8_LOH(Bt[n]), PG8_LOH(At[m]), acc[ai][bj][m][n], 0, 0, 0); \
               acc[ai][bj][m][n] = __builtin_amdgcn_mfma_f32_16x16x32_bf16(PG8_HIH(Bt[n]), PG8_HIH(At[m]), acc[ai][bj][m][n], 0, 0, 0); } } \
        __builtin_amdgcn_s_setprio(0); } while (0)
#define PG8_WAIT_V(n) asm volatile("s_waitcnt vmcnt(" #n ")" ::: "memory")
#define PG8_WAIT_L(n) asm volatile("s_waitcnt lgkmcnt(" #n ")" ::: "memory")
#define PG8_BAR __builtin_amdgcn_s_barrier()
#define PG8_SCHED __builtin_amdgcn_sched_barrier(0)
    Unit cur, nxt; int ui = 0;
    if (!S.next(0, cur)) return;
    f32x4 acc[2][2][4][2];
#pragma unroll
    for (int a = 0; a < 2; ++a)
#pragma unroll
        for (int b = 0; b < 2; ++b)
#pragma unroll
            for (int m = 0; m < 4; ++m)
#pragma unroll
                for (int n = 0; n < 2; ++n) acc[a][b][m][n] = (f32x4){0.f, 0.f, 0.f, 0.f};
    v8i_t At[4], B0[2], B1[2];
    unsigned oc[2][2];
    constexpr int ONOFF = RING_BYTES + 4096;
    const char* cA = p.Abase; const char* nA = p.Abase;
    if constexpr (P::GATHER) { p.a_offs(cur, oc); } else { cA = p.Abase + (size_t)cur.pm * 2 * hstepA; }
#define PG8_STA(bufoff, base_, h_, O_) do { if constexpr (P::GATHER) { PG8_STAGE(bufoff, base_, O_[h_][0], O_[h_][1]); } else { PG8_STAGE(bufoff, (base_) + (h_) * hstepA, voffA[0], voffA[1]); } } while (0)
    {
        const char* b0 = p.b_tile(cur, 0); const char* b1 = p.b_tile(cur, 1);
        PG8_STAGE(PG8_SB(0, 0), b0, voffB[0], voffB[1]); PG8_STAGE(PG8_SB(0, 1), b0 + hstepB, voffB[0], voffB[1]);
        PG8_STA(PG8_SA(0, 0), cA, 0, oc); PG8_STA(PG8_SA(0, 1), cA, 1, oc);
        if (wr == 1) PG8_BAR;
        PG8_WAIT_V(2); PG8_BAR;
        PG8_STAGE(PG8_SB(1, 0), b1, voffB[0], voffB[1]); PG8_STA(PG8_SA(1, 0), cA + 128, 0, oc); PG8_STAGE(PG8_SB(1, 1), b1 + hstepB, voffB[0], voffB[1]);
        PG8_WAIT_V(6); PG8_BAR;
    }
    for (;;) {
        const bool has_next = S.next(ui + 1, nxt);
        if (!has_next) nxt = cur;
        if constexpr (P::GATHER) { unsigned on[2][2]; p.a_offs(nxt, on); *(LAS u32x4*)(lds + ONOFF + tid * 16) = (u32x4){on[0][0], on[0][1], on[1][0], on[1][1]}; } else { nA = p.Abase + (size_t)nxt.pm * 2 * hstepA; }
#pragma unroll 1
        for (int t = 0; t < nt; t += 2) {
            const bool last = (t == nt - 2);
            if constexpr (P::HAS_MID) { if (t == (nt >> 1)) p.mid(acc, cur, wr, wc, fr, fq); }
            const char* a1 = cA + (size_t)(t + 1) * 128;
            const char* a2 = last ? nA : cA + (size_t)(t + 2) * 128; const char* a3 = a2 + 128;
            unsigned o2[2][2];
            if constexpr (P::GATHER) { const u32x4 onv = *(const LAS u32x4*)(lds + ONOFF + tid * 16);
                o2[0][0] = last ? onv.x : oc[0][0]; o2[0][1] = last ? onv.y : oc[0][1]; o2[1][0] = last ? onv.z : oc[1][0]; o2[1][1] = last ? onv.w : oc[1][1]; }
            const char* b2 = last ? p.b_tile(nxt, 0) : p.b_tile(cur, t + 2); const char* b3 = last ? p.b_tile(nxt, 1) : p.b_tile(cur, t + 3);
            PG8_LDB(B0, 0, 0); PG8_LDB(B1, 0, 1); PG8_SCHED; PG8_LDA(At, 0, 0); PG8_STA(PG8_SA(1, 1), a1, 1, oc);
            PG8_WAIT_V(8); PG8_WAIT_L(0); PG8_BAR; PG8_MMA(0, 0, At, B0); PG8_MMA(0, 1, At, B1); PG8_BAR; PG8_SCHED;
            PG8_LDA(At, 0, 1); PG8_STAGE(PG8_SB(0, 0), b2, voffB[0], voffB[1]); PG8_STAGE(PG8_SB(0, 1), b2 + hstepB, voffB[0], voffB[1]); PG8_STA(PG8_SA(0, 0), a2, 0, o2);
            PG8_WAIT_V(8); PG8_WAIT_L(0); PG8_BAR; PG8_MMA(1, 0, At, B0); PG8_MMA(1, 1, At, B1); PG8_BAR; PG8_SCHED;
            PG8_LDB(B0, 1, 0); PG8_LDB(B1, 1, 1); PG8_SCHED; PG8_LDA(At, 1, 0); PG8_STA(PG8_SA(0, 1), a2, 1, o2);
            PG8_WAIT_V(8); PG8_WAIT_L(0); PG8_BAR; PG8_MMA(0, 0, At, B0); PG8_MMA(0, 1, At, B1); PG8_BAR; PG8_SCHED;
            PG8_LDA(At, 1, 1); PG8_STAGE(PG8_SB(1, 0), b3, voffB[0], voffB[1]); PG8_STAGE(PG8_SB(1, 1), b3 + hstepB, voffB[0], voffB[1]); PG8_STA(PG8_SA(1, 0), a3, 0, o2);
            PG8_WAIT_V(8); PG8_WAIT_L(0); PG8_BAR; PG8_MMA(1, 0, At, B0); PG8_MMA(1, 1, At, B1); PG8_BAR; PG8_SCHED;
        }
        if constexpr (ALIGN_EPI) { if (wr == 0) PG8_BAR; }
        if constexpr (P::FP8) { asm volatile("s_nop 15\n\ts_nop 15" ::: "memory"); }
        p.epi(acc, cur, wr, wc, fr, fq);
        if (!has_next) break;
#pragma unroll
        for (int a = 0; a < 2; ++a)
#pragma unroll
            for (int b = 0; b < 2; ++b)
#pragma unroll
                for (int m = 0; m < 4; ++m)
#pragma unroll
                    for (int n = 0; n < 2; ++n) acc[a][b][m][n] = (f32x4){0.f, 0.f, 0.f, 0.f};
        cur = nxt; cA = nA; ++ui;
        if constexpr (P::GATHER) { const u32x4 onv = *(const LAS u32x4*)(lds + ONOFF + tid * 16); oc[0][0] = onv.x; oc[0][1] = onv.y; oc[1][0] = onv.z; oc[1][1] = onv.w; }
        if constexpr (ALIGN_EPI) { if (wr == 1) PG8_BAR; }
    }
    PG8_WAIT_V(0);
    if constexpr (!ALIGN_EPI) { if (wr == 0) PG8_BAR; }
    PG8_BAR;
#undef PG8_SA
#undef PG8_SB
#undef PG8_STAGE
#undef PG8_STA
#undef PG8_LDA
#undef PG8_LDB
#undef PG8_LD32
#undef PG8_LOH
#undef PG8_HIH
#undef PG8_MMA
#undef PG8_WAIT_V
#undef PG8_WAIT_L
#undef PG8_BAR
#undef PG8_SCHED
}
}

struct Args { const float* in[17]; float* out; unsigned char* ws; int ph_lo, ph_hi; };
struct Frame {
    const Args* A;
    LAS unsigned char* lds;
    volatile LAS unsigned* MISC;
    int wave, vcu, G;
};

struct TItem { const float* W; void* WT; const float* kscale; int ldw, K, k0, scol0, drow0; float sc; int fp8; };
__device__ __forceinline__ void titem_load(const TItem& t, f32x4 (&vv)[8], int lane) {
#pragma unroll
    for (int i = 0; i < 8; ++i) { const int kk = 8 * i + (lane >> 3); vv[i] = *(const f32x4*)(t.W + (size_t)(t.k0 + kk) * t.ldw + t.scol0 + 4 * (lane & 7)); }
}
__device__ __forceinline__ void titem_store(const TItem& t, const f32x4 (&vv)[8], LAS float* scr, int lane) {
#pragma unroll
    for (int i = 0; i < 8; ++i) { const int kk = 8 * i + (lane >> 3); float sc = t.sc; if (t.kscale) sc *= t.kscale[t.k0 + kk]; LAS float* d = scr + kk * 33 + 4 * (lane & 7);
        d[0] = vv[i].x * sc; d[1] = vv[i].y * sc; d[2] = vv[i].z * sc; d[3] = vv[i].w * sc; }
    LDS_WAIT(); asm volatile("" ::: "memory");
    const int c = lane & 7;
#pragma unroll
    for (int j = 0; j < 4; ++j) { const int n = (lane >> 3) + 8 * j; const LAS float* s = scr + (8 * c) * 33 + n;
        if (t.fp8) { u32x2 o; o.x = pk_fp8x4(s[0 * 33], s[1 * 33], s[2 * 33], s[3 * 33]); o.y = pk_fp8x4(s[4 * 33], s[5 * 33], s[6 * 33], s[7 * 33]);
            *(u32x2*)((unsigned char*)t.WT + (size_t)(t.drow0 + n) * t.K + t.k0 + 8 * c) = o; }
        else { u32x4 o; o.x = cvt_pk_bf16(s[0 * 33], s[1 * 33]); o.y = cvt_pk_bf16(s[2 * 33], s[3 * 33]); o.z = cvt_pk_bf16(s[4 * 33], s[5 * 33]); o.w = cvt_pk_bf16(s[6 * 33], s[7 * 33]);
            *(u32x4*)((bf16*)t.WT + (size_t)(t.drow0 + n) * t.K + t.k0 + 8 * c) = o; } }
    LDS_WAIT(); asm volatile("" ::: "memory");
}
__device__ __forceinline__ float log_sigmoid(float x) { return fminf(x, 0.f) - log1pf(__expf(-fabsf(x))); }

__device__ __forceinline__ void p0_prologue(Frame& F) {
    const int gw = F.vcu * NWAVES + F.wave, NGW = F.G * NWAVES, lane = ((int)(threadIdx.x & 63));
    const int gt = F.vcu * 512 + ((int)threadIdx.x), NGT = F.G * 512;
    for (int rep_a = 0; rep_a < (REPP == 100 ? 2 : 1); ++rep_a)
    {
        LAS float* scr = (LAS float*)(F.lds + F.wave * 16384);
        const float* w_in = F.A->in[3]; const float* w_out = F.A->in[7]; const float* w_gate = F.A->in[13]; const float* w_up = F.A->in[14]; const float* w_down = F.A->in[15];
        bf16* WINT = (bf16*)(F.A->ws + WS_WINT); bf16* WOUTT = (bf16*)(F.A->ws + WS_WOUTT); unsigned char* WGU = (unsigned char*)(F.A->ws + WS_WGU); unsigned char* WD = (unsigned char*)(F.A->ws + WS_WD);
        constexpr int I_IN = 32 * 224, I_OUT = 32 * 64, I_G = 16 * 32 * 32, I_D = 16 * 16 * 64;
        constexpr int NITEMS = I_IN + I_OUT + 2 * I_G + I_D;
        auto decode = [&](int it) -> TItem {
            TItem t; t.kscale = nullptr; t.sc = 1.f; t.fp8 = 0; int r = it;
            if (r < I_IN) { const int kb = r / 224, nb = r % 224, n0 = nb * 32; t.W = w_in; t.ldw = INC; t.K = DM; t.WT = WINT; t.k0 = kb * 64; t.scol0 = n0 + (n0 >= 3072 ? 8 : 0); t.drow0 = n0; return t; } r -= I_IN;
            if (r < I_OUT) { const int kb = r / 64, nb = r % 64; t.W = w_out; t.ldw = DM; t.K = DM; t.WT = WOUTT; t.k0 = kb * 64; t.scol0 = nb * 32; t.drow0 = nb * 32; t.kscale = (kb < 16) ? F.A->in[5] : (F.A->in[6] - 1024); return t; } r -= I_OUT;
            if (r < 2 * I_G) { const int up = r >= I_G; if (up) r -= I_G; const int e = r / 1024, q = r % 1024, kb = q / 32, nb = q % 32, n0 = nb * 32;
                t.W = (up ? w_up : w_gate) + (size_t)e * DM * DE; t.ldw = DE; t.K = DM; t.WT = WGU + (size_t)e * 2048 * DM; t.k0 = kb * 64; t.scol0 = n0; t.drow0 = (n0 >> 7) * 256 + up * 128 + (n0 & 127); t.sc = SW1; t.fp8 = 1; return t; } r -= 2 * I_G;
            { const int e = r / 1024, q = r % 1024, kb = q / 64, nb = q % 64; t.W = w_down + (size_t)e * DE * DM; t.ldw = DM; t.K = DE; t.WT = WD + (size_t)e * DM * DE; t.k0 = kb * 64; t.scol0 = nb * 32; t.drow0 = nb * 32; t.sc = SW2; t.fp8 = 1; return t; }
        };
        f32x4 va[8], vb[8];
        int it = gw;
        if (it < NITEMS) {
            TItem ta = decode(it); titem_load(ta, va, lane);
            for (;;) {
                const int itb = it + NGW; TItem tb = ta; const bool hb = itb < NITEMS;
                if (hb) { tb = decode(itb); titem_load(tb, vb, lane); }
                titem_store(ta, va, scr, lane);
                if (!hb) break;
                const int ita = itb + NGW; const bool ha = ita < NITEMS;
                if (ha) { ta = decode(ita); titem_load(ta, va, lane); }
                titem_store(tb, vb, scr, lane);
                if (!ha) break;
                it = ita;
            }
        }
    }
    {
        float* WRT = (float*)(F.A->ws + WS_WRT); const float* g2 = F.A->in[8]; const float* wrg = F.A->in[9]; const float* wre = F.A->in[11];
        for (int i = gt; i < 32 * DM; i += NGT) { const int j = i / DM, k = i % DM; WRT[i] = (j < 20) ? g2[k] * (j < 4 ? wrg[k * 4 + j] : wre[k * 16 + (j - 4)]) : 0.f; }
        f32x2* ROPE = (f32x2*)(F.A->ws + WS_ROPE);
        for (int i = gt; i < 4112 * 64; i += NGT) { const int pos = i >> 6, k = i & 63;
            const float lin = (float)k * (1.0f / 63.0f); const float ang = 1.0f / exp2f(lin * 13.287712379549449f);
            const float ph = (float)pos * ang; const double rev = (double)ph * 0.15915494309189535; const float fr = (float)(rev - floor(rev));
            ROPE[i] = (f32x2){__builtin_amdgcn_cosf(fr), __builtin_amdgcn_sinf(fr)}; }
        bf16* U = (bf16*)(F.A->ws + WS_U);
        for (int i = gt; i < 4 * NB * PADN * 128; i += NGT) { const int c8 = i & 127, row = (i >> 7) % PADN, bb = ((i >> 7) / PADN) % NB, cl = (i >> 7) / (PADN * NB);
            const int cls = (cl == 0) ? 1 : (cl == 1) ? 2 : (cl == 2) ? 4 : 5;
            *(u32x4*)(U + cls * USTR + ((size_t)(bb * PP + row)) * 1024 + c8 * 8) = (u32x4){0u, 0u, 0u, 0u}; }
        float* LOGF = (float*)(F.A->ws + WS_LOGF);
        for (int i = gt; i < 32 * PADN; i += NGT) LOGF[(i / PADN) * PP + (i % PADN)] = 0.f;
    }
    __syncthreads();
    for (int rep_c = 0; rep_c < (REPP == 101 ? 2 : 1); ++rep_c)
    {
        LAS float* WF = (LAS float*)F.lds; const float* w_in = F.A->in[3]; const float* g1 = F.A->in[2];
        for (int i = ((int)threadIdx.x); i < 8 * DM; i += 512) { const int k = i >> 3, h = i & 7; WF[h * DM + k] = g1[k] * w_in[(size_t)k * INC + 3072 + h]; }
        __syncthreads();
        f32x4 gv[8];
#pragma unroll
        for (int j = 0; j < 8; ++j) gv[j] = *((const f32x4*)g1 + lane + 64 * j);
        bf16* HN = (bf16*)(F.A->ws + WS_HN); bf16* HNMETA = (bf16*)(F.A->ws + WS_HNMETA); float* LOGF = (float*)(F.A->ws + WS_LOGF); const float* bfv = F.A->in[4];
        for (int row = gw; row < MTOK + NMETA; row += NGW) {
            const bool meta = row >= MTOK; const int mj = row - MTOK;
            const float* xr = meta ? (F.A->in[1] + (size_t)mj * DM) : (F.A->in[0] + (size_t)row * DM);
            f32x4 v[8]; float ss = 0.f;
#pragma unroll
            for (int j = 0; j < 8; ++j) { v[j] = *((const f32x4*)xr + lane + 64 * j); ss += (v[j].x * v[j].x + v[j].y * v[j].y) + (v[j].z * v[j].z + v[j].w * v[j].w); }
            const float rs = 1.0f / sqrtf(wave_sum(ss) * (1.0f / DM) + EPS);
            float fl[8];
#pragma unroll
            for (int h = 0; h < 8; ++h) { float s = 0.f;
#pragma unroll
                for (int j = 0; j < 8; ++j) { const f32x4 w = *((const LAS f32x4*)(WF + h * DM) + lane + 64 * j); s += (v[j].x * w.x + v[j].y * w.y) + (v[j].z * w.z + v[j].w * w.w); }
                fl[h] = wave_sum(s) * rs; }
            bf16* orow = meta ? (HNMETA + (size_t)mj * DM) : (HN + (size_t)row * DM);
#pragma unroll
            for (int j = 0; j < 8; ++j) { const f32x4 y = v[j] * rs * gv[j]; u32x2 w; w.x = cvt_pk_bf16(y.x, y.y); w.y = cvt_pk_bf16(y.z, y.w); *((u32x2*)orow + lane + 64 * j) = w; }
            if (lane < 8) { float f = fl[0];
#pragma unroll
                for (int h = 1; h < 8; ++h) f = (lane == h) ? fl[h] : f;
                const float lf = log_sigmoid(f + bfv[lane]);
                if (meta) { for (int bb = 0; bb < NB; ++bb) LOGF[(bb * NH + lane) * PP + PADN + mj] = lf; }
                else { const int bb = row >> 12, t = row & 4095; LOGF[(bb * NH + lane) * PP + 128 + t] = lf; } }
        }
    }
}

__device__ __forceinline__ void p1_cumsum(Frame& F) {
    const int gw = F.vcu * NWAVES + F.wave, NGW = F.G * NWAVES, lane = ((int)(threadIdx.x & 63));
    const float* LOGF = (const float*)(F.A->ws + WS_LOGF); float* CUM = (float*)(F.A->ws + WS_CUM);
    for (int s = gw; s < NB * NH; s += NGW) {
        const float* src = LOGF + (size_t)s * PP + lane * 66; float* dst = CUM + (size_t)s * PP + lane * 66;
        float loc = 0.f; for (int i = 0; i < 66; ++i) loc += src[i];
        float inc = loc;
#pragma unroll
        for (int o = 1; o < 64; o <<= 1) { const float t = __shfl_up(inc, o); if (lane >= o) inc += t; }
        float run = inc - loc;
        for (int i = 0; i < 66; ++i) { run += src[i]; dst[i] = run; }
    }
}
__device__ __forceinline__ void p1_meta_kv(Frame& F) {
    const int lane = ((int)(threadIdx.x & 63)), w = F.wave;
    const bf16* HNMETA = (const bf16*)(F.A->ws + WS_HNMETA); const bf16* WINT = (const bf16*)(F.A->ws + WS_WINT); bf16* U = (bf16*)(F.A->ws + WS_U);
    const f32x2* ROPE = (const f32x2*)(F.A->ws + WS_ROPE);
    LAS float* red = (LAS float*)F.lds;
    for (int blk = blockIdx.x; blk < 256; blk += F.G) {
        const int kv0 = blk * 16, q = kv0 >> 10, col0 = kv0 & 1023;
        const int cls = (q == 0) ? 1 : (q == 1) ? 2 : (q == 2) ? 4 : 5;
        const int nrow0 = ((q == 0) ? 1024 : (q == 1) ? 2048 : (q == 2) ? 4096 : 5120) + col0;
        f32x4 acc = (f32x4){0.f, 0.f, 0.f, 0.f};
#pragma unroll
        for (int s = 0; s < 8; ++s) { const int k0 = w * 256 + s * 32 + 8 * (lane >> 4);
            const bf16x8 a = *(const bf16x8*)(HNMETA + (size_t)(lane & 15) * DM + k0);
            const bf16x8 b = *(const bf16x8*)(WINT + (size_t)(nrow0 + (lane & 15)) * DM + k0);
            acc = __builtin_amdgcn_mfma_f32_16x16x32_bf16(a, b, acc, 0, 0, 0); }
#pragma unroll
        for (int r = 0; r < 4; ++r) red[w * 256 + ((lane >> 4) * 4 + r) * 16 + (lane & 15)] = acc[r];
        __syncthreads();
        if (((int)threadIdx.x) < 256) { const int row = ((int)threadIdx.x) >> 4, col = ((int)threadIdx.x) & 15;
            float v = 0.f, vp = 0.f;
#pragma unroll
            for (int ww = 0; ww < 8; ++ww) { v += red[ww * 256 + row * 16 + col]; vp += red[ww * 256 + row * 16 + (col ^ 1)]; }
            float o = v;
            if (q == 2) { const int d = (col0 + col) & 127; const f32x2 cs = ROPE[row * 64 + (d >> 1)];
                const int hh = (col0 + col) >> 7; const float lg2h = log2f(1.0f - exp2f(-5.0f - (float)hh));
                o = ((col & 1) ? (v * cs.x + vp * cs.y) : (v * cs.x - vp * cs.y)) * SCALE * exp2f(-(float)(PADN + row + 1) * lg2h); }
            if (q == 0) { float s2 = o * o; s2 += __shfl_xor(s2, 1); s2 += __shfl_xor(s2, 2); s2 += __shfl_xor(s2, 4); s2 += __shfl_xor(s2, 8);
                if (col == 0) atomicAdd((float*)((unsigned*)F.A->ws + CW_MNRM) + ((col0 >> 7) * 16 + row), s2); }
            const unsigned short ob = (unsigned short)(cvt_pk_bf16(o, 0.f) & 0xffffu);
            for (int bb = 0; bb < NB; ++bb) U[cls * USTR + ((size_t)(bb * PP + PADN + row)) * 1024 + col0 + col] = ob; }
        __syncthreads();
    }
}

struct PInProj {
    static constexpr bool PERM = true, HAS_MID = false, FP8 = false, GATHER = false;
    int nt; const char* Abase; unsigned lda2, ldb2; const char* Bt; bf16* U; const f32x2* ROPE; unsigned* NRM;
    __device__ __forceinline__ void a_offs(const g8::Unit&, unsigned (&)[2][2]) const {}
    __device__ __forceinline__ const char* b_tile(const g8::Unit& u, int t) const { return Bt + (size_t)u.pn * 256 * ldb2 + (size_t)t * 128; }
    __device__ __forceinline__ void mid(f32x4 (&)[2][2][4][2], const g8::Unit&, int, int, int, int) const {}
    __device__ __forceinline__ void epi(const f32x4 (&acc)[2][2][4][2], const g8::Unit& u, int wr, int wc, int fr, int fq) const {
        const int cls = u.pn >> 2;
        bf16* base = U + (size_t)cls * USTR;
        const int ccol0 = (u.pn & 3) * 256 + wc * 32 + 8 * fq;
        const int bb = u.pm >> 4;
        float nmx[2] = {0.f, 0.f};
#pragma unroll
        for (int ai = 0; ai < 2; ++ai)
#pragma unroll
            for (int m = 0; m < 4; ++m) {
                const int t = ((u.pm & 15) << 8) + ai * 128 + wr * 64 + m * 16 + fr;
                bf16* rowp = base + ((size_t)(bb * PP + 128 + t)) * 1024 + ccol0;
                f32x4 c0 = (f32x4){1.f, 0.f, 1.f, 0.f}, c1 = c0;
                if (cls == 3 || cls == 4) { const f32x4* rp = (const f32x4*)(ROPE + (size_t)(t + 16) * 64 + wc * 16 + fq * 4); c0 = rp[0]; c1 = rp[1]; }
#pragma unroll
                for (int bj = 0; bj < 2; ++bj) {
                    f32x4 v0 = acc[ai][bj][m][0], v1 = acc[ai][bj][m][1];
                    if (cls == 3 || cls == 4) {
                        f32x4 r0, r1;
                        r0.x = v0.x * c0.x - v0.y * c0.y; r0.y = v0.y * c0.x + v0.x * c0.y; r0.z = v0.z * c0.z - v0.w * c0.w; r0.w = v0.w * c0.z + v0.z * c0.w;
                        r1.x = v1.x * c1.x - v1.y * c1.y; r1.y = v1.y * c1.x + v1.x * c1.y; r1.z = v1.z * c1.z - v1.w * c1.w; r1.w = v1.w * c1.z + v1.z * c1.w;
                        const int hh = (u.pn & 3) * 2 + bj; const float lg2h = log2f(1.0f - exp2f(-5.0f - (float)hh)); const float ip1 = (float)((t & 127) + 1);
                        const float sc = (cls == 4) ? SCALE * exp2f(-ip1 * lg2h) : exp2f(ip1 * lg2h); v0 = r0 * sc; v1 = r1 * sc;
                    } else if (cls == 6) {
#pragma unroll
                        for (int e = 0; e < 4; ++e) { v0[e] = v0[e] / (1.f + __expf(-v0[e])); v1[e] = v1[e] / (1.f + __expf(-v1[e])); }
                    }
                    u32x4 w; w.x = cvt_pk_bf16(v0[0], v0[1]); w.y = cvt_pk_bf16(v0[2], v0[3]); w.z = cvt_pk_bf16(v1[0], v1[1]); w.w = cvt_pk_bf16(v1[2], v1[3]);
                    *(u32x4*)(rowp + bj * 128) = w;
                    if (cls <= 1) { float sq = (v0[0] * v0[0] + v0[1] * v0[1]) + (v0[2] * v0[2] + v0[3] * v0[3]) + (v1[0] * v1[0] + v1[1] * v1[1]) + (v1[2] * v1[2] + v1[3] * v1[3]);
                        sq += __shfl_xor(sq, 16); sq += __shfl_xor(sq, 32); nmx[bj] = fmaxf(nmx[bj], sq); }
                }
            }
        if (cls <= 1) {
#pragma unroll
            for (int bj = 0; bj < 2; ++bj) { float v = nmx[bj]; v = fmaxf(v, __shfl_xor(v, 1)); v = fmaxf(v, __shfl_xor(v, 2)); v = fmaxf(v, __shfl_xor(v, 4)); v = fmaxf(v, __shfl_xor(v, 8));
                if ((threadIdx.x & 63) == 0) atomicMax(NRM + ((cls * 32 + bb * 8 + (u.pn & 3) * 2 + bj) * 4 + wc), __float_as_uint(v)); }
        }
    }
};

template <bool RET>
__device__ __forceinline__ void attn_simple(Frame& F) {
    const int gw = F.vcu * NWAVES + F.wave, NGW = F.G * NWAVES, lane = ((int)(threadIdx.x & 63));
    LAS float* wl = (LAS float*)(F.lds + F.wave * 1024);
    const bf16* U = (const bf16*)(F.A->ws + WS_U); const float* CUM = (const float*)(F.A->ws + WS_CUM);
    bf16* OA = (bf16*)(F.A->ws + WS_HN); float* SSQ = (float*)(F.A->ws + WS_SSQ);
    for (int row = gw; row < NB * NH * SEQ; row += NGW) {
        const int t = row & 4095, bh = row >> 12, b = bh >> 3, h = bh & 7, p = 128 + t, m = b * SEQ + t;
        const bf16* Qb = U + (RET ? 3 : 0) * USTR + ((size_t)(b * PP + p)) * 1024 + h * 128;
        const bf16* Kb = U + (RET ? 4 : 1) * USTR + ((size_t)b * PP) * 1024 + h * 128;
        const bf16* Vb = U + (RET ? 5 : 2) * USTR + ((size_t)b * PP) * 1024 + h * 128;
        { const unsigned qw = *(const unsigned*)(Qb + 2 * lane); wl[2 * lane] = bf_lo(qw); wl[2 * lane + 1] = bf_hi(qw); }
        LDS_WAIT(); asm volatile("" ::: "memory");
        float m_run = -1e30f, l_run = 0.f, o0 = 0.f, o1 = 0.f;
        const float ct = RET ? 0.f : CUM[(size_t)bh * PP + p];
        const float lg2 = RET ? log2f(1.0f - exp2f(-5.0f - (float)h)) : 0.f;
        for (int s0 = 64; s0 <= p; s0 += 64) {
            const int s = s0 + lane;
            const bf16* kr = Kb + (size_t)s * 1024;
            float sc = 0.f;
#pragma unroll
            for (int c = 0; c < 16; ++c) { const u32x4 kv = *(const u32x4*)(kr + 8 * c); const f32x4 qa = *(const LAS f32x4*)(wl + 8 * c), qb = *(const LAS f32x4*)(wl + 8 * c + 4);
                sc += bf_lo(kv.x) * qa.x + bf_hi(kv.x) * qa.y + bf_lo(kv.y) * qa.z + bf_hi(kv.y) * qa.w + bf_lo(kv.z) * qb.x + bf_hi(kv.z) * qb.y + bf_lo(kv.w) * qb.z + bf_hi(kv.w) * qb.w; }
            const bool valid = (s <= p) && (s >= PADN);
            float pw;
            if constexpr (RET) { pw = valid ? sc * exp2f((float)(((p >> 7) - (s >> 7)) * 128) * lg2) : 0.f; }
            else {
                const float lg = valid ? (sc * SCALE + (ct - CUM[(size_t)bh * PP + s])) : -__builtin_inff();
                const float mn = fmaxf(m_run, wave_max(lg)); const float alpha = __expf(m_run - mn);
                pw = valid ? __expf(lg - mn) : 0.f;
                l_run = l_run * alpha + wave_sum(pw); o0 *= alpha; o1 *= alpha; m_run = mn;
            }
            asm volatile("" ::: "memory");
            wl[128 + lane] = pw;
            LDS_WAIT(); asm volatile("" ::: "memory");
#pragma unroll 8
            for (int k = 0; k < 64; ++k) { const float pk = wl[128 + k]; const unsigned vw = *(const unsigned*)(Vb + (size_t)(s0 + k) * 1024 + 2 * lane); o0 += pk * bf_lo(vw); o1 += pk * bf_hi(vw); }
            LDS_WAIT(); asm volatile("" ::: "memory");
        }
        if constexpr (RET) {
            const float mu = wave_sum(o0 + o1) * (1.0f / HD); const float d0 = o0 - mu, d1 = o1 - mu;
            const float var = wave_sum(d0 * d0 + d1 * d1) * (1.0f / HD); const float r = 1.0f / sqrtf(var + EPS);
            const unsigned gw2 = *(const unsigned*)(U + 6 * USTR + ((size_t)(b * PP + p)) * 1024 + h * 128 + 2 * lane);
            *(unsigned*)(OA + (size_t)m * DM + 1024 + h * 128 + 2 * lane) = cvt_pk_bf16(d0 * r * bf_lo(gw2), d1 * r * bf_hi(gw2));
        } else {
            const float il = 1.0f / l_run; o0 *= il; o1 *= il;
            *(unsigned*)(OA + (size_t)m * DM + h * 128 + 2 * lane) = cvt_pk_bf16(o0, o1);
            const float sq = wave_sum(o0 * o0 + o1 * o1); if (lane == 0) SSQ[(size_t)m * 8 + h] = sq;
        }
        asm volatile("" ::: "memory");
    }
}


namespace fox {
constexpr int NW = 8, QBLK = 32, KVBLK = 64, QB = 256, D = 128, LDQ = 1024, LDO = 2048;
constexpr int SHM_V = KVBLK * D * 2, SHM_K = KVBLK * D * 2;
constexpr int OFF_WS = 2 * SHM_V + 2 * SHM_K, OFF_CUM = OFF_WS + 2048, LDS_NEED = OFF_CUM + PP * 4;
static_assert(LDS_NEED <= RING_BYTES, "fox lds");
constexpr float THR = 8.f;
constexpr float INVS = 11.313708498984761f;
typedef float f32x16 __attribute__((ext_vector_type(16)));
typedef short s16x4 __attribute__((ext_vector_type(4)));
#define KSWZ(row, colB) ((row) * 256 + ((colB) ^ (((row) & 7) << 4)))
#define SBAR() __builtin_amdgcn_sched_barrier(0)
__device__ __forceinline__ int v_st(int k, int c) { const int kk = (k & ~0xC) | ((k & 4) << 1) | ((k & 8) >> 1); return ((kk >> 3) * 4 + (c >> 5)) * 512 + ((kk & 7) * 32 + (c & 31)) * 2; }
__device__ __forceinline__ int v_rd_base(int lane) { return ((lane & 3) << 3) | (((lane >> 2) & 3) << 6) | (((lane >> 4) & 1) << 5) | (((lane >> 5) & 1) << 8); }
constexpr int v_rd_off(int d0, int ks, int half) { return d0 * 512 + ks * 4096 + half * 2048; }
__device__ __forceinline__ int crow(int r, int hi) { return (r & 3) + 8 * (r >> 2) + 4 * hi; }
__device__ __forceinline__ unsigned cvtpk(float lo, float hi) { unsigned r; asm volatile("v_cvt_pk_bf16_f32 %0, %1, %2" : "=v"(r) : "v"(lo), "v"(hi)); return r; }
__device__ __forceinline__ bf16x8 load8(const bf16* p) { return *reinterpret_cast<const bf16x8*>(p); }
__device__ __forceinline__ void mask_causal(f32x16& p0, f32x16& p1, int dq) {
    const float NEG = -__builtin_inff();
#pragma unroll
    for (int r = 0; r < 16; ++r) { const int c = (r & 3) + 8 * (r >> 2); if (dq - c < 0) p0[r] = NEG; if (dq - c - 32 < 0) p1[r] = NEG; }
}
__device__ __forceinline__ void mask_pad(f32x16& p0, f32x16& p1, int hi) {
    const float NEG = -__builtin_inff();
#pragma unroll
    for (int r = 0; r < 16; ++r) { const int c = (r & 3) + 8 * (r >> 2); p0[r] = NEG; if (c + 4 * hi < 16) p1[r] = NEG; }
}
__device__ __forceinline__ void partialSM(f32x16& p0, f32x16& p1, float& m_reg, float& mn, float& alpha) {
    float pmax = p0[0]; for (int r = 1; r < 16; ++r) pmax = fmaxf(pmax, p0[r]); for (int r = 0; r < 16; ++r) pmax = fmaxf(pmax, p1[r]);
    { auto rr = __builtin_amdgcn_permlane32_swap(__float_as_uint(pmax), __float_as_uint(pmax), false, false);
      pmax = fmaxf(__uint_as_float(rr[0]), __uint_as_float(rr[1])); }
    constexpr float C2 = 1.4426950408889634f * SCALE;
    if (__builtin_expect(__all((pmax - m_reg) * SCALE <= THR), 1)) { mn = m_reg; alpha = 1.f; }
    else { mn = fmaxf(m_reg, pmax); alpha = __builtin_amdgcn_exp2f((m_reg - mn) * C2); m_reg = mn; }
    const float mnL = -mn * C2;
    for (int r = 0; r < 16; ++r) p0[r] = fmaf(p0[r], C2, mnL); for (int r = 0; r < 16; ++r) p1[r] = fmaf(p1[r], C2, mnL);
    for (int r = 0; r < 16; ++r) p0[r] = __builtin_amdgcn_exp2f(p0[r]);
}
__device__ __forceinline__ void finishSM(f32x16& p0, f32x16& p1, float alpha, float& l_reg, bf16x8& pa0, bf16x8& pa1, bf16x8& pa2, bf16x8& pa3) {
    for (int r = 0; r < 16; ++r) p1[r] = __builtin_amdgcn_exp2f(p1[r]);
    float ps = 0; for (int r = 0; r < 16; ++r) ps += p0[r]; for (int r = 0; r < 16; ++r) ps += p1[r];
    { auto rr = __builtin_amdgcn_permlane32_swap(__float_as_uint(ps), __float_as_uint(ps), false, false);
      ps = __uint_as_float(rr[0]) + __uint_as_float(rr[1]); }
    l_reg = l_reg * alpha + ps;
#define PK4(P, B_, OUT) do { unsigned a0 = cvtpk(P[B_+0], P[B_+1]), a1 = cvtpk(P[B_+2], P[B_+3]);                          \
        unsigned b0 = cvtpk(P[B_+4], P[B_+5]), b1 = cvtpk(P[B_+6], P[B_+7]);                                             \
        auto r0 = __builtin_amdgcn_permlane32_swap(a0, b0, false, false); auto r1 = __builtin_amdgcn_permlane32_swap(a1, b1, false, false); \
        u32x4 w = {r0[0], r1[0], r0[1], r1[1]}; OUT = *reinterpret_cast<bf16x8*>(&w); } while (0)
    PK4(p0, 0, pa0); PK4(p0, 8, pa1); PK4(p1, 0, pa2); PK4(p1, 8, pa3);
#undef PK4
}
template <int KB>
__device__ __forceinline__ void qkt(f32x16& p0, f32x16& p1, const LAS char* K_lds, int r32, int hi, const bf16x8* qr, const LAS float* cs) {
#pragma unroll
    for (int g = 0; g < 4; ++g) { const f32x4 a = *(const LAS f32x4*)(cs + 8 * g), b = *(const LAS f32x4*)(cs + 32 + 8 * g);
        p0[4 * g] = a[0]; p0[4 * g + 1] = a[1]; p0[4 * g + 2] = a[2]; p0[4 * g + 3] = a[3]; p1[4 * g] = b[0]; p1[4 * g + 1] = b[1]; p1[4 * g + 2] = b[2]; p1[4 * g + 3] = b[3]; }
    const LAS char* kb[4];
#pragma unroll
    for (int dd = 0; dd < 4; ++dd) kb[dd] = K_lds + KB * SHM_K + KSWZ(r32, (dd * 16 + hi * 8) * 2);
#pragma unroll
    for (int d0 = 0; d0 < 8; ++d0) { const LAS char* a = kb[d0 & 3] + (d0 >> 2) * 128;
        bf16x8 b0 = *reinterpret_cast<const LAS bf16x8*>(a);
        bf16x8 b1 = *reinterpret_cast<const LAS bf16x8*>(a + 32 * 256);
        p0 = __builtin_amdgcn_mfma_f32_32x32x16_bf16(b0, qr[d0], p0, 0, 0, 0);
        p1 = __builtin_amdgcn_mfma_f32_32x32x16_bf16(b1, qr[d0], p1, 0, 0, 0); }
}
template <int VB>
__device__ __forceinline__ void pv_tile(f32x16* o, int vb0, bf16x8 pa0, bf16x8 pa1, bf16x8 pa2, bf16x8 pa3) {
#define TRRD(dst, off) asm volatile("ds_read_b64_tr_b16 %0, %1 offset:%2" : "=&v"(dst) : "v"(vb0), "i"(off) : "memory")
#define PV_D0(d0) do { s16x4 l0, l1, l2, l3, h0, h1, h2, h3; constexpr int b_ = VB * SHM_V + v_rd_off(d0, 0, 0); \
        TRRD(l0, b_); TRRD(h0, b_ + 2048); TRRD(l1, b_ + 4096); TRRD(h1, b_ + 6144); TRRD(l2, b_ + 8192); TRRD(h2, b_ + 10240); TRRD(l3, b_ + 12288); TRRD(h3, b_ + 14336); \
        asm volatile("s_waitcnt lgkmcnt(0)" ::: "memory"); SBAR();   \
        o[d0] = __builtin_amdgcn_mfma_f32_32x32x16_bf16(pa0, (bf16x8){l0[0], l0[1], l0[2], l0[3], h0[0], h0[1], h0[2], h0[3]}, o[d0], 0, 0, 0);   \
        o[d0] = __builtin_amdgcn_mfma_f32_32x32x16_bf16(pa1, (bf16x8){l1[0], l1[1], l1[2], l1[3], h1[0], h1[1], h1[2], h1[3]}, o[d0], 0, 0, 0);   \
        o[d0] = __builtin_amdgcn_mfma_f32_32x32x16_bf16(pa2, (bf16x8){l2[0], l2[1], l2[2], l2[3], h2[0], h2[1], h2[2], h2[3]}, o[d0], 0, 0, 0);   \
        o[d0] = __builtin_amdgcn_mfma_f32_32x32x16_bf16(pa3, (bf16x8){l3[0], l3[1], l3[2], l3[3], h3[0], h3[1], h3[2], h3[3]}, o[d0], 0, 0, 0); } while (0)
    PV_D0(0); PV_D0(1); PV_D0(2); PV_D0(3);
#undef PV_D0
#undef TRRD
}
struct BlockRef { int bh, qb; };
struct Bases { const bf16* U; bf16* OA; float* SSQ; const float* CUM; };
__device__ __forceinline__ int blk_p0(const BlockRef& r) { return 128 + r.qb * 256; }
__device__ __forceinline__ const bf16* blk_q(const Bases& B, const BlockRef& r) { return B.U + ((size_t)((r.bh >> 3) * PP + blk_p0(r))) * 1024 + (r.bh & 7) * 128; }
__device__ __forceinline__ const bf16* blk_k(const Bases& B, const BlockRef& r) { return B.U + 1 * USTR + ((size_t)(r.bh >> 3) * PP) * 1024 + (r.bh & 7) * 128; }
__device__ __forceinline__ const bf16* blk_v(const Bases& B, const BlockRef& r) { return B.U + 2 * USTR + ((size_t)(r.bh >> 3) * PP) * 1024 + (r.bh & 7) * 128; }
struct Seam { bf16x8 qr[8]; bf16x8 st_v0, st_v1, st_k0, st_k1; };
#define ROW(p, k0, rr) ((p) + (size_t)((k0) + (rr)) * LDQ + sc)
#define VMW() asm volatile("s_waitcnt vmcnt(0)" ::: "memory")
#define VMWN(n) asm volatile("s_waitcnt vmcnt(%0)" :: "i"(n) : "memory")
#define SLOAD_H(Kp, Vp, k0) do { S.st_v0 = load8(ROW(Vp, k0, sr)); S.st_v1 = load8(ROW(Vp, k0, 32 + sr));              \
                         S.st_k0 = load8(ROW(Kp, k0, sr)); S.st_k1 = load8(ROW(Kp, k0, 32 + sr)); } while (0)
#define SWRITE_HK(bf) do { *(LAS bf16x8*)(K_lds + (bf) * SHM_K + kws) = S.st_k0; *(LAS bf16x8*)(K_lds + (bf) * SHM_K + kws + 32 * 256) = S.st_k1; } while (0)
#define SWRITE_HV(bf) do { *(LAS bf16x8*)(V_lds + (bf) * SHM_V + vst0) = S.st_v0; *(LAS bf16x8*)(V_lds + (bf) * SHM_V + vst1) = S.st_v1; } while (0)
#define SWRITE_H(bf) do { SWRITE_HV(bf); SWRITE_HK(bf); } while (0)
__device__ __forceinline__ void prime(const Bases& B, const BlockRef& cur, int j_lo, LAS char* lds, Seam& S, int tid) {
    const int wid = __builtin_amdgcn_readfirstlane(tid >> 6), lane = tid & 63, r32 = lane & 31, hi = lane >> 5;
    const int sr = tid >> 4, sc = (tid & 15) * 8, kws = KSWZ(sr, sc * 2); LAS char* K_lds = lds + 2 * SHM_V;
    const int kb0 = j_lo * KVBLK;
#pragma unroll
    for (int d0 = 0; d0 < 8; ++d0) S.qr[d0] = load8(blk_q(B, cur) + (size_t)(wid * QBLK + r32) * LDQ + d0 * 16 + hi * 8);
    { const bf16* Kp = blk_k(B, cur); const bf16* Vp = blk_v(B, cur); SLOAD_H(Kp, Vp, kb0); } VMW(); SWRITE_HK(0);
    __syncthreads();
}
__device__ __forceinline__ void stage_cum(const Bases& B, const BlockRef& cur, LAS char* lds) {
    const int tid = threadIdx.x, P0 = blk_p0(cur); LAS float* cumS = (LAS float*)(lds + OFF_CUM);
    const float* CUMG = B.CUM + (size_t)cur.bh * PP; const float cref = CUMG[P0]; const int n4 = (P0 + QB) >> 2;
    for (int i = tid; i < n4; i += 512) { const f32x4 c = *((const f32x4*)CUMG + i); *((LAS f32x4*)cumS + i) = (cref - c) * INVS; }
}
__device__ __forceinline__ void block(const Bases& B, const BlockRef& cur, const BlockRef& nxt, int j_lo, LAS char* lds, Seam& S, int tid) {
    const int wid = __builtin_amdgcn_readfirstlane(tid >> 6), lane = tid & 63, r32 = lane & 31, hi = lane >> 5;
    const int P0 = blk_p0(cur);
    const int j_hi = (P0 + QB - 1) / KVBLK + 1;
    const int NT = j_hi - j_lo;
    const int kbn = j_lo * KVBLK;
    const int qlo = P0 + wid * QBLK, qm = qlo + r32 - 4 * hi;
    LAS char* V_lds = lds; LAS char* K_lds = lds + 2 * SHM_V;
    LAS float* ws = (LAS float*)(lds + OFF_WS) + wid * 64; LAS float* li_l = ws; LAS float* al_l = ws + 32;
    LAS float* cumS = (LAS float*)(lds + OFF_CUM);
    float m_reg = -1e30f, l_reg = 0; f32x16 o[4] = {};
    const int sr = tid >> 4, sc = (tid & 15) * 8, vst0 = v_st(sr, sc), vst1 = v_st(32 + sr, sc), kws = KSWZ(sr, sc * 2);
    const int vb0 = (int)(uintptr_t)V_lds + v_rd_base(lane);
    const bf16* Kh = blk_k(B, cur); const bf16* Vh = blk_v(B, cur);
#define RESC(a) do { if (__any((a) < 1.f)) { if (hi == 0) al_l[r32] = (a); asm volatile("s_waitcnt lgkmcnt(0)" ::: "memory");              \
                     for (int d_ = 0; d_ < 4; ++d_) for (int r = 0; r < 16; ++r) o[d_][r] *= al_l[crow(r, hi)]; } } while (0)
#define KBASE(t) ((j_lo + (t)) * KVBLK)
#define CSP(t) (cumS + KBASE(t) + 4 * hi)
#define MASKT(P0_, P1_, t) do { const int kb_ = KBASE(t); if (kb_ + KVBLK - 1 > qlo) mask_causal(P0_, P1_, qm - kb_); if (kb_ == KVBLK) mask_pad(P0_, P1_, hi); } while (0)
#define SEAM_K0() do { VMWN(8); SWRITE_HK(0); SBAR(); } while (0)
    f32x16 pA0, pA1, pB0, pB1; float mnA, mnB, alA, alB; bf16x8 pa0, pa1, pa2, pa3;
    SWRITE_HV(0); SBAR();
    if (NT > 1) { SLOAD_H(Kh, Vh, KBASE(1)); }
    SBAR(); qkt<0>(pA0, pA1, K_lds, r32, hi, S.qr, CSP(0));
    MASKT(pA0, pA1, 0); partialSM(pA0, pA1, m_reg, mnA, alA);
    if (NT > 1) { VMW(); SWRITE_H(1); }
    __syncthreads();
#define HALF_STEP(PX0, PX1, mnX, alX, PY0, PY1, alY, t, KB, VB, SB) do {                                                      \
        SBAR(); qkt<KB>(PX0, PX1, K_lds, r32, hi, S.qr, CSP(t));                                             \
        finishSM(PY0, PY1, alY, l_reg, pa0, pa1, pa2, pa3); SBAR();                                                           \
        if ((t) + 1 < NT) { SLOAD_H(Kh, Vh, KBASE((t) + 1)); SBAR(); }                                               \
        pv_tile<VB>(o, vb0, pa0, pa1, pa2, pa3); MASKT(PX0, PX1, (t)); partialSM(PX0, PX1, m_reg, mnX, alX);                                        \
        __syncthreads();                                                                                                      \
        if ((t) + 1 < NT) { VMW(); SWRITE_H(SB); }                                                                          \
        RESC(alX); __syncthreads(); } while (0)
    for (int t = 1; t + 1 < NT; t += 2) {
        HALF_STEP(pB0, pB1, mnB, alB, pA0, pA1, alA, t, 1, 0, 0);
        HALF_STEP(pA0, pA1, mnA, alA, pB0, pB1, alB, t + 1, 0, 1, 1);
    }
    const bool even = (NT & 1) == 0;
    if (even) { SBAR(); qkt<1>(pB0, pB1, K_lds, r32, hi, S.qr, CSP(NT - 1)); SBAR(); }
    { const bf16* Kn = blk_k(B, nxt); const bf16* Vn = blk_v(B, nxt); SLOAD_H(Kn, Vn, kbn); } SBAR();
    { const bf16* Qn = blk_q(B, nxt);
#pragma unroll
    for (int d0 = 0; d0 < 8; ++d0) S.qr[d0] = load8(Qn + (size_t)(wid * QBLK + r32) * LDQ + d0 * 16 + hi * 8); }
    SBAR();
    finishSM(pA0, pA1, alA, l_reg, pa0, pa1, pa2, pa3); SBAR();
    pv_tile<0>(o, vb0, pa0, pa1, pa2, pa3);
    if (even) { MASKT(pB0, pB1, NT - 1); partialSM(pB0, pB1, m_reg, mnB, alB); __syncthreads(); RESC(alB);
        finishSM(pB0, pB1, alB, l_reg, pa0, pa1, pa2, pa3); SBAR(); pv_tile<1>(o, vb0, pa0, pa1, pa2, pa3); }
    SBAR(); SEAM_K0();
    if (hi == 0) li_l[r32] = l_reg; asm volatile("s_waitcnt lgkmcnt(0)" ::: "memory");
    float rli[16];
#pragma unroll
    for (int r = 0; r < 16; ++r) rli[r] = __builtin_amdgcn_rcpf(li_l[crow(r, hi)]);
    int r32e = r32, hie = hi; asm volatile("" : "+v"(r32e), "+v"(hie));
    const size_t m0 = (size_t)(cur.bh >> 3) * SEQ + cur.qb * 256 + wid * QBLK + 4 * hie;
    bf16* Ow = B.OA + m0 * LDO + (cur.bh & 7) * 128 + r32e; float* Sw = B.SSQ + m0 * 8 + (cur.bh & 7);
#pragma unroll
    for (int r = 0; r < 16; ++r) { const int orow = (r & 3) + 8 * (r >> 2); float sq = 0.f;
#pragma unroll
        for (int d0 = 0; d0 < 4; ++d0) { const float v = o[d0][r] * rli[r]; sq += v * v;
            const float vn = __shfl_xor(v, 1);
            if ((r32e & 1) == 0) *(unsigned*)(Ow + (size_t)orow * LDO + d0 * 32) = cvtpk(v, vn); }
        sq += __shfl_xor(sq, 1); sq += __shfl_xor(sq, 2); sq += __shfl_xor(sq, 4); sq += __shfl_xor(sq, 8); sq += __shfl_xor(sq, 16);
        if (r32e == 0) Sw[(size_t)orow * 8] = sq; }
    __syncthreads();
#undef RESC
#undef KBASE
#undef CSP
#undef MASKT
#undef SEAM_K0
#undef HALF_STEP
}
#undef ROW
#undef VMW
#undef VMWN
#undef SLOAD_H
#undef SWRITE_HK
#undef SWRITE_HV
#undef SWRITE_H
#undef KSWZ
#undef SBAR
}

constexpr int FOXQ_OFF = 98304;
__device__ __forceinline__ void fox_phase(Frame& F) {
    const int tid = (int)threadIdx.x;
    const fox::Bases B{(const bf16*)(F.A->ws + WS_U), (bf16*)(F.A->ws + WS_HN), (float*)(F.A->ws + WS_SSQ), (const float*)(F.A->ws + WS_CUM)};
    LAS float* est = (LAS float*)(F.lds + FOXQ_OFF); LAS int* order = (LAS int*)(F.lds + FOXQ_OFF + 2048); LAS float* XS = (LAS float*)(F.lds + FOXQ_OFF + 4096); LAS int* misc = (LAS int*)(F.lds + FOXQ_OFF + 4096 + 256);
    unsigned* ctl = (unsigned*)F.A->ws;
    {
        const int bh = tid >> 4, qb = tid & 15, h = bh & 7;
        float q2 = 0.f, k2 = 0.f;
#pragma unroll
        for (int p = 0; p < 4; ++p) { q2 += __uint_as_float(__hip_atomic_load(ctl + CW_NRM + (bh * 4 + p), __ATOMIC_RELAXED, __HIP_MEMORY_SCOPE_AGENT)); k2 += __uint_as_float(__hip_atomic_load(ctl + CW_NRM + ((32 + bh) * 4 + p), __ATOMIC_RELAXED, __HIP_MEMORY_SCOPE_AGENT)); }
        float km = 0.f;
        for (int r = 0; r < 16; ++r) km = fmaxf(km, __uint_as_float(__hip_atomic_load(ctl + CW_MNRM + h * 16 + r, __ATOMIC_RELAXED, __HIP_MEMORY_SCOPE_AGENT)));
        k2 = fmaxf(k2, km);
        const float X = 45.0f + 2.0f * 1.03f * SCALE * sqrtf(q2 * k2);
        const float rate = -B.CUM[(size_t)bh * PP + PP - 1] * (1.0f / 4112.0f);
        const float full = (float)(4 * qb + 5), win = X / fmaxf(rate, 1e-6f) * (1.0f / 64.0f) + 5.0f;
        est[tid] = fminf(full, win) + 1e-3f * (float)qb;
        if (qb == 0) XS[bh] = X;
    }
    __syncthreads();
    { const float e = est[tid]; int rank = 0;
      for (int u = 0; u < 512; ++u) { const float o = est[u]; rank += (o > e || (o == e && u < tid)) ? 1 : 0; }
      order[rank] = tid; }
    __syncthreads();
    fox::Seam S;
    for (;;) {
        if (tid == 0) misc[0] = (int)__hip_atomic_fetch_add(ctl + CW_QHEAD, 1u, __ATOMIC_RELAXED, __HIP_MEMORY_SCOPE_AGENT);
        __syncthreads();
        const int idx = __builtin_amdgcn_readfirstlane(misc[0]);
        if (idx >= (REPP == 20 ? 1024 : 512)) break;
        const int blk = __builtin_amdgcn_readfirstlane(order[idx & 511]);
        const fox::BlockRef cur{blk >> 4, blk & 15};
        fox::stage_cum(B, cur, (LAS char*)F.lds);
        if (tid == 0) misc[1] = 0;
        __syncthreads();
        {
            const int nfull = 4 * cur.qb + 5; const float thr = -XS[cur.bh] * fox::INVS; const LAS float* cumS = (const LAS float*)(F.lds + fox::OFF_CUM);
            if (tid < nfull - 4) { if (cumS[64 * (1 + tid) + 63] < thr) __hip_atomic_fetch_add((LAS int*)misc + 1, 1, __ATOMIC_RELAXED, __HIP_MEMORY_SCOPE_WORKGROUP); }
        }
        __syncthreads();
        const int j_lo = 1 + __builtin_amdgcn_readfirstlane(misc[1]);
        int tq = (int)threadIdx.x; asm volatile("" : "+v"(tq));
        fox::prime(B, cur, j_lo, (LAS char*)F.lds, S, tq);
        fox::block(B, cur, cur, j_lo, (LAS char*)F.lds, S, tq);
    }
}

namespace ret {
typedef short s16x4 __attribute__((ext_vector_type(4)));
typedef short v4i16_t __attribute__((ext_vector_type(4)));
__device__ __forceinline__ s16x4 vtr(const LAS char* p) { return __builtin_bit_cast(s16x4, __builtin_amdgcn_ds_read_tr16_b64_v4i16((LAS v4i16_t*)p)); }
__device__ __forceinline__ int kswz(int row, int colB) { return row * 256 + (colB ^ ((row & 7) << 4)); }
__device__ __forceinline__ int vswz(int row, int colB) { return row * 256 + (colB ^ ((row & 7) << 5)); }
__device__ __forceinline__ int aswz(int row, int colB) { return row * 256 + (colB ^ ((((row & 3) | ((row >> 1) & 4))) << 5)); }
constexpr int A_KB = 32768, A_VB = 4096, A_OFF_V = 2 * A_KB;
__device__ __forceinline__ void states(Frame& F) {
    const int tid = ((int)threadIdx.x), lane = ((int)(threadIdx.x & 63)), w = F.wave, g = lane >> 4, q = (lane & 15) >> 2, pp = lane & 3;
    const bf16* U = (const bf16*)(F.A->ws + WS_U); bf16* ST = (bf16*)(F.A->ws + WS_ST);
    LAS char* lds = (LAS char*)F.lds;
    for (int unit = F.vcu; unit < NB * NH * 8; unit += F.G) {
        const int bh = unit >> 3, es = unit & 7, b = bh >> 3, h = bh & 7;
        const bf16* Kg = U + 4 * USTR + ((size_t)b * PP) * 1024 + h * 128;
        const bf16* Vg = U + 5 * USTR + ((size_t)b * PP) * 1024 + h * 128 + es * 16;
        const float wdec = exp2f(128.0f * log2f(1.0f - exp2f(-5.0f - (float)h)));
        f32x4 S = (f32x4){0.f, 0.f, 0.f, 0.f};
        u32x4 krA[4], vrA, krB[4], vrB, krC[4], vrC, krD[4], vrD;
#define RA_LOAD(kr, vr, n) do { _Pragma("unroll") for (int i = 0; i < 4; ++i) { const int pc = tid + 512 * i, row = pc >> 4, c16 = pc & 15; kr[i] = *(const u32x4*)(Kg + (size_t)((n) * 128 + row) * 1024 + c16 * 8); } \
        if (tid < 256) { const int row = tid >> 1, c16 = tid & 1; vr = *(const u32x4*)(Vg + (size_t)((n) * 128 + row) * 1024 + c16 * 8); } } while (0)
#define RA_WRITE(kr, vr, bf) do { _Pragma("unroll") for (int i = 0; i < 4; ++i) { const int pc = tid + 512 * i, row = pc >> 4, c16 = pc & 15; *(LAS u32x4*)(lds + (bf) * A_KB + aswz(row, c16 * 16)) = kr[i]; } \
        if (tid < 256) { const int row = tid >> 1, c16 = tid & 1; *(LAS u32x4*)(lds + A_OFF_V + (bf) * A_VB + row * 32 + c16 * 16) = vr; } } while (0)
#define RA_STEP(n, bf) do { f32x4 acc = (f32x4){0.f, 0.f, 0.f, 0.f}; \
            _Pragma("unroll") for (int s = 0; s < 4; ++s) { const int r0 = 32 * s + 8 * g + q; \
                const s16x4 a0 = vtr(lds + (bf) * A_KB + aswz(r0, (16 * w + 4 * pp) * 2)), a1 = vtr(lds + (bf) * A_KB + aswz(r0 + 4, (16 * w + 4 * pp) * 2)); \
                const s16x4 b0 = vtr(lds + A_OFF_V + (bf) * A_VB + r0 * 32 + pp * 8), b1 = vtr(lds + A_OFF_V + (bf) * A_VB + (r0 + 4) * 32 + pp * 8); \
                acc = __builtin_amdgcn_mfma_f32_16x16x32_bf16((bf16x8){a0[0], a0[1], a0[2], a0[3], a1[0], a1[1], a1[2], a1[3]}, (bf16x8){b0[0], b0[1], b0[2], b0[3], b1[0], b1[1], b1[2], b1[3]}, acc, 0, 0, 0); } \
            S = (S + acc) * wdec; \
            { u32x2 o; o.x = cvt_pk_bf16(S[0], S[1]); o.y = cvt_pk_bf16(S[2], S[3]); \
              *(u32x2*)(ST + (((size_t)bh * 32 + (n)) * 128 + es * 16 + (lane & 15)) * 128 + 16 * w + 4 * g) = o; } } while (0)
        RA_LOAD(krA, vrA, 0); RA_WRITE(krA, vrA, 0); RA_LOAD(krB, vrB, 1); RA_LOAD(krC, vrC, 2); RA_LOAD(krD, vrD, 3);
        __syncthreads();
#define RA_BAR() asm volatile("s_waitcnt lgkmcnt(0)\n\ts_barrier" ::: "memory")
        for (int n = 0; n < 32; n += 4) {
            if (n + 4 < 32) RA_LOAD(krA, vrA, n + 4);
            RA_STEP(n, 0); RA_WRITE(krB, vrB, 1); RA_BAR();
            if (n + 5 < 32) RA_LOAD(krB, vrB, n + 5);
            RA_STEP(n + 1, 1); RA_WRITE(krC, vrC, 0); RA_BAR();
            if (n + 6 < 32) RA_LOAD(krC, vrC, n + 6);
            RA_STEP(n + 2, 0); RA_WRITE(krD, vrD, 1); RA_BAR();
            if (n + 7 < 32) RA_LOAD(krD, vrD, n + 7);
            RA_STEP(n + 3, 1); if (n + 4 < 32) RA_WRITE(krA, vrA, 0); RA_BAR();
        }
        __syncthreads();
#undef RA_BAR
#undef RA_STEP
#undef RA_LOAD
#undef RA_WRITE
    }
}
constexpr int B_K = 0, B_V = 32768, B_S = 65536;
__device__ __forceinline__ void outputs(Frame& F) {
    int tid = (int)threadIdx.x; asm volatile("" : "+v"(tid));
    const int lane = tid & 63, w = F.wave, g = lane >> 4, il = lane & 15, q = il >> 2, pp = lane & 3;
    const bf16* U = (const bf16*)(F.A->ws + WS_U); const bf16* ST = (const bf16*)(F.A->ws + WS_ST); bf16* OA = (bf16*)(F.A->ws + WS_HN);
    LAS char* lds = (LAS char*)F.lds;
    u32x4 pk[4], pv[4], ps[4];
#define RB_LOAD(unit) do { const int bh_ = (unit) >> 5, n_ = ((unit) & 31) + 1, b_ = bh_ >> 3, h_ = bh_ & 7; \
        const bf16* Kg = U + 4 * USTR + ((size_t)(b_ * PP + n_ * 128)) * 1024 + h_ * 128; const bf16* Vg = U + 5 * USTR + ((size_t)(b_ * PP + n_ * 128)) * 1024 + h_ * 128; \
        const bf16* Sg = ST + ((size_t)bh_ * 32 + (n_ - 1)) * 16384; \
        _Pragma("unroll") for (int i = 0; i < 4; ++i) { const int pc = tid + 512 * i, row = pc >> 4, c16 = pc & 15; pk[i] = *(const u32x4*)(Kg + (size_t)row * 1024 + c16 * 8); pv[i] = *(const u32x4*)(Vg + (size_t)row * 1024 + c16 * 8); \
            ps[i] = *(const u32x4*)(Sg + (size_t)row * 128 + c16 * 8); } } while (0)
#define RB_WRITE() do { _Pragma("unroll") for (int i = 0; i < 4; ++i) { const int pc = tid + 512 * i, row = pc >> 4, c16 = pc & 15; *(LAS u32x4*)(lds + B_K + kswz(row, c16 * 16)) = pk[i]; \
            *(LAS u32x4*)(lds + B_V + vswz(row, c16 * 16)) = pv[i]; *(LAS u32x4*)(lds + B_S + kswz(row, c16 * 16)) = ps[i]; } } while (0)
    int unit = F.vcu; if (unit >= NB * NH * 32) return;
    RB_LOAD(unit); RB_WRITE();
    __syncthreads();
    for (;;) {
        const int nu = unit + F.G; const bool more = nu < NB * NH * 32;
        const int bh = unit >> 5, n = (unit & 31) + 1, b = bh >> 3, h = bh & 7;
        const size_t urow = (size_t)(b * PP + n * 128 + 16 * w + il);
        bf16x8 qx[4];
#pragma unroll
        for (int s = 0; s < 4; ++s) qx[s] = *(const bf16x8*)(U + 3 * USTR + urow * 1024 + h * 128 + 32 * s + 8 * g);
        if (more) RB_LOAD(nu);
        u32x2 P[8];
#pragma unroll
        for (int jb = 0; jb < 8; ++jb) {
            P[jb] = (u32x2){0u, 0u};
            if (jb <= w) {
                f32x4 d = (f32x4){0.f, 0.f, 0.f, 0.f};
#pragma unroll
                for (int s = 0; s < 4; ++s) { const bf16x8 a = *(const LAS bf16x8*)(lds + B_K + kswz(16 * jb + il, 64 * s + 16 * g)); d = __builtin_amdgcn_mfma_f32_16x16x32_bf16(a, qx[s], d, 0, 0, 0); }
                if (jb == w) {
#pragma unroll
                    for (int r = 0; r < 4; ++r) if (4 * g + r > il) d[r] = 0.f; }
                P[jb].x = cvt_pk_bf16(d[0], d[1]); P[jb].y = cvt_pk_bf16(d[2], d[3]);
            }
        }
        f32x4 o[8];
#pragma unroll
        for (int eb = 0; eb < 8; ++eb) { f32x4 acc = (f32x4){0.f, 0.f, 0.f, 0.f};
#pragma unroll
            for (int s = 0; s < 4; ++s) { const bf16x8 a = *(const LAS bf16x8*)(lds + B_S + kswz(16 * eb + il, 64 * s + 16 * g)); acc = __builtin_amdgcn_mfma_f32_16x16x32_bf16(a, qx[s], acc, 0, 0, 0); }
#pragma unroll
            for (int t = 0; t < 4; ++t) { if (2 * t <= w) {
                const int r0 = 32 * t + 4 * g + q;
                const s16x4 a0 = vtr(lds + B_V + vswz(r0, (16 * eb + 4 * pp) * 2)), a1 = vtr(lds + B_V + vswz(r0 + 16, (16 * eb + 4 * pp) * 2));
                const u32x4 bw = (u32x4){P[2 * t].x, P[2 * t].y, P[2 * t + 1].x, P[2 * t + 1].y};
                acc = __builtin_amdgcn_mfma_f32_16x16x32_bf16((bf16x8){a0[0], a0[1], a0[2], a0[3], a1[0], a1[1], a1[2], a1[3]}, __builtin_bit_cast(bf16x8, bw), acc, 0, 0, 0); } }
            o[eb] = acc; }
        float sm = 0.f;
#pragma unroll
        for (int eb = 0; eb < 8; ++eb) sm += (o[eb][0] + o[eb][1]) + (o[eb][2] + o[eb][3]);
        sm += __shfl_xor(sm, 16); sm += __shfl_xor(sm, 32);
        const float mu = sm * (1.0f / HD); float sv = 0.f;
#pragma unroll
        for (int eb = 0; eb < 8; ++eb) { o[eb] = o[eb] - mu; sv += (o[eb][0] * o[eb][0] + o[eb][1] * o[eb][1]) + (o[eb][2] * o[eb][2] + o[eb][3] * o[eb][3]); }
        sv += __shfl_xor(sv, 16); sv += __shfl_xor(sv, 32);
        const float rstd = 1.0f / sqrtf(sv * (1.0f / HD) + EPS);
        const size_t m = (size_t)b * SEQ + (n - 1) * 128 + 16 * w + il;
#pragma unroll
        for (int eb = 0; eb < 8; ++eb) { const int e0 = 16 * eb + 4 * g;
            const u32x2 gg = *(const u32x2*)(U + 6 * USTR + urow * 1024 + h * 128 + e0);
            u32x2 ov; ov.x = cvt_pk_bf16(o[eb][0] * rstd * bf_lo(gg.x), o[eb][1] * rstd * bf_hi(gg.x)); ov.y = cvt_pk_bf16(o[eb][2] * rstd * bf_lo(gg.y), o[eb][3] * rstd * bf_hi(gg.y));
            *(u32x2*)(OA + m * DM + 1024 + h * 128 + e0) = ov; }
        __syncthreads();
        if (!more) break;
        RB_WRITE();
        __syncthreads();
        unit = nu;
    }
#undef RB_LOAD
#undef RB_WRITE
}
}

struct POutProj {
    static constexpr bool PERM = true, HAS_MID = true, FP8 = false, GATHER = false;
    int nt; const char* Abase; unsigned lda2, ldb2; const char* Bt; const float* x; bf16* H1B; const float* SSQ;
    __device__ __forceinline__ void a_offs(const g8::Unit&, unsigned (&)[2][2]) const {}
    __device__ __forceinline__ const char* b_tile(const g8::Unit& u, int t) const { return Bt + (size_t)u.pn * 256 * ldb2 + (size_t)t * 128; }
    __device__ __forceinline__ void mid(f32x4 (&acc)[2][2][4][2], const g8::Unit& u, int wr, int wc, int fr, int fq) const {
#pragma unroll
        for (int ai = 0; ai < 2; ++ai)
#pragma unroll
            for (int m = 0; m < 4; ++m) { const int r = u.pm * 256 + ai * 128 + wr * 64 + m * 16 + fr;
                const f32x4 s0 = *(const f32x4*)(SSQ + (size_t)r * 8), s1 = *(const f32x4*)(SSQ + (size_t)r * 8 + 4);
                const float rs = 1.0f / sqrtf(((s0.x + s0.y) + (s0.z + s0.w) + (s1.x + s1.y) + (s1.z + s1.w)) * (1.0f / 1024.0f) + EPS);
#pragma unroll
                for (int bj = 0; bj < 2; ++bj)
#pragma unroll
                    for (int n = 0; n < 2; ++n) acc[ai][bj][m][n] = acc[ai][bj][m][n] * rs; }
    }
    __device__ __forceinline__ void epi(const f32x4 (&acc)[2][2][4][2], const g8::Unit& u, int wr, int wc, int fr, int fq) const {
        const int row0 = u.pm * 256 + wr * 64 + fr, col0 = u.pn * 256 + wc * 32 + 8 * fq;
#pragma unroll
        for (int ai = 0; ai < 2; ++ai)
#pragma unroll
            for (int m = 0; m < 4; ++m) { const size_t off = (size_t)(row0 + ai * 128 + m * 16) * DM + col0;
#pragma unroll
                for (int bj = 0; bj < 2; ++bj) { const f32x4 v0 = *(const f32x4*)(x + off + bj * 128) + acc[ai][bj][m][0], v1 = *(const f32x4*)(x + off + bj * 128 + 4) + acc[ai][bj][m][1];
                    u32x4 w; w.x = cvt_pk_bf16(v0[0], v0[1]); w.y = cvt_pk_bf16(v0[2], v0[3]); w.z = cvt_pk_bf16(v1[0], v1[1]); w.w = cvt_pk_bf16(v1[2], v1[3]);
                    *(u32x4*)(H1B + off + bj * 128) = w; } }
    }
};

__device__ __forceinline__ void p4_router(Frame& F) {
    const int lane = ((int)(threadIdx.x & 63)), w = F.wave, blk = w & 3, kh = w >> 2, row = lane & 15, kq = lane >> 4;
    const bf16* H1 = (const bf16*)(F.A->ws + WS_H1B); const float* g2 = F.A->in[8]; const float* WRT = (const float*)(F.A->ws + WS_WRT);
    const float* brg = F.A->in[10]; const float* bre = F.A->in[12];
    unsigned char* HN2 = (unsigned char*)(F.A->ws + WS_HN); int* TOK = (int*)(F.A->ws + WS_TOK); float* WLO = (float*)(F.A->ws + WS_WLO); float* WHI = (float*)(F.A->ws + WS_WHI); float* RSS = (float*)(F.A->ws + WS_RSS);
    LAS float* part = (LAS float*)F.lds;
    LAS float* pss = part + 2 * 64 * 32;
    for (int rb = F.vcu; rb < MTOK / 64; rb += F.G) {
        const int m0 = rb * 64 + blk * 16;
        const bf16* xp = H1 + (size_t)(m0 + row) * DM + kh * 1024 + 16 * kq;
        const float* w0p = WRT + (size_t)row * DM + kh * 1024 + 16 * kq; const float* w1p = w0p + 16 * DM; const float* gp = g2 + kh * 1024 + 16 * kq;
        u32x4* op = (u32x4*)(HN2 + (size_t)(m0 + row) * DM + kh * 1024 + 16 * kq);
        f32x4 acc0 = (f32x4){0.f, 0.f, 0.f, 0.f}, acc1 = acc0; float ss = 0.f;
#pragma unroll 2
        for (int s = 0; s < 16; ++s) {
            f32x4 xa[4], b0[4], b1[4], gg[4];
            const u32x4 xl = *(const u32x4*)(xp + 64 * s), xh = *(const u32x4*)(xp + 64 * s + 8);
            xa[0] = (f32x4){bf_lo(xl.x), bf_hi(xl.x), bf_lo(xl.y), bf_hi(xl.y)}; xa[1] = (f32x4){bf_lo(xl.z), bf_hi(xl.z), bf_lo(xl.w), bf_hi(xl.w)};
            xa[2] = (f32x4){bf_lo(xh.x), bf_hi(xh.x), bf_lo(xh.y), bf_hi(xh.y)}; xa[3] = (f32x4){bf_lo(xh.z), bf_hi(xh.z), bf_lo(xh.w), bf_hi(xh.w)};
#pragma unroll
            for (int j = 0; j < 4; ++j) { b0[j] = *(const f32x4*)(w0p + 64 * s + 4 * j); b1[j] = *(const f32x4*)(w1p + 64 * s + 4 * j); gg[j] = *(const f32x4*)(gp + 64 * s + 4 * j); }
            u32x4 o;
#pragma unroll
            for (int j = 0; j < 4; ++j) {
#pragma unroll
                for (int e = 0; e < 4; ++e) { acc0 = __builtin_amdgcn_mfma_f32_16x16x4f32(xa[j][e], b0[j][e], acc0, 0, 0, 0); acc1 = __builtin_amdgcn_mfma_f32_16x16x4f32(xa[j][e], b1[j][e], acc1, 0, 0, 0); }
                ss += (xa[j].x * xa[j].x + xa[j].y * xa[j].y) + (xa[j].z * xa[j].z + xa[j].w * xa[j].w);
                const f32x4 y = xa[j] * gg[j] * SA1; o[j] = pk_fp8x4(y.x, y.y, y.z, y.w); }
            op[4 * s] = o;
        }
        ss += __shfl_xor(ss, 16); ss += __shfl_xor(ss, 32);
#pragma unroll
        for (int r = 0; r < 4; ++r) { part[(kh * 64 + blk * 16 + 4 * kq + r) * 32 + row] = acc0[r]; part[(kh * 64 + blk * 16 + 4 * kq + r) * 32 + 16 + row] = acc1[r]; }
        if (kq == 0) pss[kh * 64 + blk * 16 + row] = ss;
        __syncthreads();
        if (((int)threadIdx.x) < 64) {
            const int r = ((int)threadIdx.x), m = rb * 64 + r;
            const float rs = 1.0f / sqrtf((pss[r] + pss[64 + r]) * (1.0f / DM) + EPS);
            float lgt[20];
#pragma unroll
            for (int j = 0; j < 20; ++j) lgt[j] = (part[r * 32 + j] + part[(64 + r) * 32 + j]) * rs + (j < 4 ? brg[j] : bre[j - 4]);
            int gs = 0; float gm = lgt[0];
#pragma unroll
            for (int i = 1; i < 4; ++i) if (lgt[i] > gm) { gm = lgt[i]; gs = i; }
            float den = 0.f;
#pragma unroll
            for (int i = 0; i < 4; ++i) den += __expf(lgt[i] - gm);
            const float pg = 1.0f / den;
            float e4[4];
#pragma unroll
            for (int i = 0; i < 4; ++i) { float a = lgt[4 + i];
#pragma unroll
                for (int g = 1; g < 4; ++g) a = (gs == g) ? lgt[4 + 4 * g + i] : a;
                e4[i] = a; }
            int i1 = 0; float v1 = e4[0];
#pragma unroll
            for (int i = 1; i < 4; ++i) if (e4[i] > v1) { v1 = e4[i]; i1 = i; }
            int i2 = -1; float v2 = -__builtin_inff();
#pragma unroll
            for (int i = 0; i < 4; ++i) if (i != i1 && e4[i] > v2) { v2 = e4[i]; i2 = i; }
            const float ex = __expf(v2 - v1); const float w1 = pg / (1.f + ex), w2 = pg * ex / (1.f + ex);
            const int lo = i1 < i2 ? i1 : i2, hi = i1 < i2 ? i2 : i1; const float wlo = i1 < i2 ? w1 : w2, whi = i1 < i2 ? w2 : w1;
            const int pair = (lo == 0) ? (hi - 1) : (lo == 1) ? (hi + 1) : 5;
            const int cls = gs * 6 + pair;
            const unsigned pos = __hip_atomic_fetch_add(((unsigned*)F.A->ws) + CW_CNT + 64 * cls, 1u, __ATOMIC_RELAXED, __HIP_MEMORY_SCOPE_AGENT);
            TOK[cls * CLS_CAP + pos] = m; WLO[cls * CLS_CAP + pos] = wlo; WHI[cls * CLS_CAP + pos] = whi; RSS[cls * CLS_CAP + pos] = rs;
        }
        __syncthreads();
    }
}

__device__ __forceinline__ void cls_experts(int cls, int& elo, int& ehi) { const int g = cls / 6, pr = cls % 6; const int lo = pr < 3 ? 0 : (pr < 5 ? 1 : 2), hi = pr < 3 ? pr + 1 : (pr < 5 ? pr - 1 : 3); elo = 4 * g + lo; ehi = 4 * g + hi; }
__device__ __forceinline__ void moe_tables(Frame& F) {
    LAS int* T = (LAS int*)(F.lds + TBL_OFF); const int tid = (int)threadIdx.x;
    if (tid < NCLS) { int n = (int)__hip_atomic_load((unsigned*)F.A->ws + CW_CNT + 64 * tid, __ATOMIC_RELAXED, __HIP_MEMORY_SCOPE_AGENT); if (n > CLS_CAP) n = CLS_CAP; T[tid] = n; }
    __syncthreads();
    if (tid < NCLS) { int base = 0; for (int c = 0; c < tid; ++c) base += (T[c] + 255) >> 8; T[32 + tid] = base; const int nt = (T[tid] + 255) >> 8;
        for (int i = 0; i < nt; ++i) T[96 + base + i] = tid; if (tid == NCLS - 1) T[64] = base + nt; }
    if (tid >= 64 && tid < 64 + NEXP) { const int e = tid - 64; int ne = 0;
        for (int c = (e >> 2) * 6; c < (e >> 2) * 6 + 6; ++c) { int elo, ehi; cls_experts(c, elo, ehi); if (elo == e || ehi == e) ne += (T[c] + 255) >> 8; }
        T[400 + e] = ne; }
    __syncthreads();
    if (tid >= 64 && tid < 64 + NEXP) { const int e = tid - 64; int off = 0; for (int k = 0; k < e; ++k) off += T[400 + k]; T[72 + e] = off; int ne = off;
        for (int c = (e >> 2) * 6; c < (e >> 2) * 6 + 6; ++c) { int elo, ehi; cls_experts(c, elo, ehi); if (elo != e && ehi != e) continue; const int slot = (ehi == e) ? 1 : 0;
            const int nt = (T[c] + 255) >> 8; const int tb = T[32 + c]; for (int i = 0; i < nt; ++i) { T[192 + ne] = (tb + i) | (slot << 8) | (c << 16) | (i << 24); ++ne; } }
        if (e == NEXP - 1) { T[72 + NEXP] = ne; T[65] = ne; } }
    __syncthreads();
}
__device__ __forceinline__ void p4b_permute(Frame& F) {
    const LAS int* T = (const LAS int*)(F.lds + TBL_OFF); const int gw = F.vcu * NWAVES + F.wave, NGW = F.G * NWAVES, lane = ((int)(threadIdx.x & 63));
    const unsigned char* HN2 = (const unsigned char*)(F.A->ws + WS_HN); unsigned char* HN2S = (unsigned char*)(F.A->ws + WS_PART); const int* TOK = (const int*)(F.A->ws + WS_TOK);
    const int nrows = __builtin_amdgcn_readfirstlane(T[64]) * 256;
    for (int r0 = gw * 8; r0 < nrows; r0 += NGW * 8) {
        int tokv = -1;
        if (lane < 8) { const int r = r0 + lane; const int tile = r >> 8; const int cls = T[96 + tile]; const int pos = (tile - T[32 + cls]) * 256 + (r & 255); if (pos < T[cls]) tokv = TOK[cls * CLS_CAP + pos]; }
        u32x4 va[8], vb[8];
#pragma unroll
        for (int j = 0; j < 8; ++j) { const int tok = __builtin_amdgcn_readlane(tokv, j);
            if (tok >= 0) { va[j] = *(const u32x4*)(HN2 + (size_t)tok * DM + lane * 16); vb[j] = *(const u32x4*)(HN2 + (size_t)tok * DM + 1024 + lane * 16); } }
#pragma unroll
        for (int j = 0; j < 8; ++j) { const int tok = __builtin_amdgcn_readlane(tokv, j);
            if (tok >= 0) { *(u32x4*)(HN2S + (size_t)(r0 + j) * DM + lane * 16) = va[j]; *(u32x4*)(HN2S + (size_t)(r0 + j) * DM + 1024 + lane * 16) = vb[j]; } }
    }
}
struct SchedGU {
    const LAS int* T; int G, c;
    __device__ bool next(int i, g8::Unit& u) const {
        int L = i * G + c; const int ne = __builtin_amdgcn_readfirstlane(T[65]); int fk = 0;
        if (REPP == 50) { if (L >= ne * 8) { L -= ne * 8; fk = 2; } }
        if (L >= ne * 8) return false;
        int e = 0;
#pragma unroll
        for (int k = 1; k < NEXP; ++k) { const int o = __builtin_amdgcn_readfirstlane(T[72 + k]); if (L >= o * 8) e = k; }
        const int e0 = __builtin_amdgcn_readfirstlane(T[72 + e]), e1 = __builtin_amdgcn_readfirstlane(T[72 + e + 1]); const int cnt = e1 - e0, loc = L - e0 * 8;
        const int ntile = loc / cnt, mt = loc - ntile * cnt; const int ent = __builtin_amdgcn_readfirstlane(T[192 + e0 + mt]);
        u.pm = ent & 0xff; u.pn = ntile; u.a0 = e; u.a1 = ((ent >> 8) & 1) | fk; u.a2 = (ent >> 16) & 0xff; u.a3 = (ent >> 24) & 0xff; return true;
    }
};
struct SchedDown {
    const LAS int* T; int G, c;
    __device__ bool next(int i, g8::Unit& u) const {
        const int L = i * G + c; const int NT = __builtin_amdgcn_readfirstlane(T[64]); if (L >= NT * 8) return false;
        const int tl = L >> 3; const int cls = __builtin_amdgcn_readfirstlane(T[96 + tl]); const int tb = __builtin_amdgcn_readfirstlane(T[32 + cls]);
        int elo, ehi; cls_experts(cls, elo, ehi);
        u.pm = tl; u.pn = L & 7; u.a0 = elo; u.a1 = ehi; u.a2 = cls; u.a3 = tl - tb; return true;
    }
};

struct PGateUp {
    static constexpr bool PERM = true, HAS_MID = false, FP8 = true, GATHER = false;
    int nt; const char* Abase; unsigned lda2, ldb2; const char* WGU; const int* TOK; const float* WLO; const float* WHI; const float* RSS; const LAS int* T; unsigned char* ACT; int fake;
    __device__ __forceinline__ void a_offs(const g8::Unit&, unsigned (&)[2][2]) const {}
    __device__ __forceinline__ const char* b_tile(const g8::Unit& u, int t) const { return WGU + ((size_t)u.a0 * 2048 + (size_t)u.pn * 256) * ldb2 + (size_t)t * 128; }
    __device__ __forceinline__ void mid(f32x4 (&)[2][2][4][2], const g8::Unit&, int, int, int, int) const {}
    __device__ __forceinline__ void epi(const f32x4 (&acc)[2][2][4][2], const g8::Unit& u, int wr, int wc, int fr, int fq) const {
        const int cnt = T[u.a2]; const int slot = u.a1 & 1; const float* WS = slot ? WHI : WLO; constexpr float INV = 1.0f / (SA1 * SW1);
        unsigned char* ACTp = (REPP == 50 && (u.a1 & 2)) ? ACT + 64 * MiB : ACT;
#pragma unroll
        for (int ai = 0; ai < 2; ++ai)
#pragma unroll
            for (int m = 0; m < 4; ++m) { const int rl = ai * 128 + wr * 64 + m * 16 + fr; const int pos = u.a3 * 256 + rl;
                const float w = ((pos < cnt) ? WS[u.a2 * CLS_CAP + pos] : 0.f) * SA2; const float rsi = ((pos < cnt) ? RSS[u.a2 * CLS_CAP + pos] : 0.f) * INV;
                const f32x4 g0 = acc[ai][0][m][0] * rsi, g1 = acc[ai][0][m][1] * rsi, u0 = acc[ai][1][m][0] * rsi, u1 = acc[ai][1][m][1] * rsi;
                f32x4 a0, a1;
#pragma unroll
                for (int e = 0; e < 4; ++e) { a0[e] = g0[e] / (1.f + __expf(-g0[e])) * u0[e] * w; a1[e] = g1[e] / (1.f + __expf(-g1[e])) * u1[e] * w; }
                u32x2 o; o.x = pk_fp8x4(a0[0], a0[1], a0[2], a0[3]); o.y = pk_fp8x4(a1[0], a1[1], a1[2], a1[3]);
                *(u32x2*)(ACTp + ((size_t)u.pm * 256 + rl) * 2048 + slot * 1024 + u.pn * 128 + wc * 32 + 8 * fq) = o; }
    }
};
struct PDown {
    static constexpr bool PERM = true, HAS_MID = false, FP8 = true, GATHER = false;
    int nt; const char* Abase; unsigned lda2, ldb2; const char* WD; const int* TOK; const LAS int* T; bf16* Y;
    __device__ __forceinline__ void a_offs(const g8::Unit&, unsigned (&)[2][2]) const {}
    __device__ __forceinline__ const char* b_tile(const g8::Unit& u, int t) const { const int e = (t < 8) ? u.a0 : u.a1; return WD + ((size_t)e * 2048 + (size_t)u.pn * 256) * ldb2 + (size_t)(t & 7) * 128; }
    __device__ __forceinline__ void mid(f32x4 (&)[2][2][4][2], const g8::Unit&, int, int, int, int) const {}
    __device__ __forceinline__ void epi(const f32x4 (&acc)[2][2][4][2], const g8::Unit& u, int wr, int wc, int fr, int fq) const {
        const int cnt = T[u.a2]; const int col0 = u.pn * 256 + wc * 32 + 8 * fq; constexpr float INV = 1.0f / (SA2 * SW2);
#pragma unroll
        for (int ai = 0; ai < 2; ++ai)
#pragma unroll
            for (int m = 0; m < 4; ++m) { const int pos = u.a3 * 256 + ai * 128 + wr * 64 + m * 16 + fr;
                if (pos < cnt) { const int tok = TOK[u.a2 * CLS_CAP + pos]; bf16* rowp = Y + (size_t)tok * DM + col0;
#pragma unroll
                    for (int bj = 0; bj < 2; ++bj) { const f32x4 v0 = acc[ai][bj][m][0] * INV, v1 = acc[ai][bj][m][1] * INV;
                        u32x4 w; w.x = cvt_pk_bf16(v0[0], v0[1]); w.y = cvt_pk_bf16(v0[2], v0[3]); w.z = cvt_pk_bf16(v1[0], v1[1]); w.w = cvt_pk_bf16(v1[2], v1[3]);
                        *(u32x4*)(rowp + bj * 128) = w; } } }
    }
};

__device__ __forceinline__ void p7_final(Frame& F) {
    const int gw = F.vcu * NWAVES + F.wave, NGW = F.G * NWAVES, lane = ((int)(threadIdx.x & 63)); const float* gf = F.A->in[16];
    const bf16* Y = (const bf16*)(F.A->ws + WS_Y); const bf16* H1 = (const bf16*)(F.A->ws + WS_H1B);
    for (int row = gw; row < MTOK; row += NGW) {
        float* xr = F.A->out + (size_t)row * DM; const u32x4* yr = (const u32x4*)(Y + (size_t)row * DM); const u32x4* hr = (const u32x4*)(H1 + (size_t)row * DM);
        f32x4 v[8]; float ss = 0.f;
#pragma unroll
        for (int j = 0; j < 4; ++j) { const u32x4 y = yr[lane + 64 * j], h = hr[lane + 64 * j];
            v[2 * j] = (f32x4){bf_lo(h.x) + bf_lo(y.x), bf_hi(h.x) + bf_hi(y.x), bf_lo(h.y) + bf_lo(y.y), bf_hi(h.y) + bf_hi(y.y)};
            v[2 * j + 1] = (f32x4){bf_lo(h.z) + bf_lo(y.z), bf_hi(h.z) + bf_hi(y.z), bf_lo(h.w) + bf_lo(y.w), bf_hi(h.w) + bf_hi(y.w)};
            ss += (v[2 * j].x * v[2 * j].x + v[2 * j].y * v[2 * j].y) + (v[2 * j].z * v[2 * j].z + v[2 * j].w * v[2 * j].w) + (v[2 * j + 1].x * v[2 * j + 1].x + v[2 * j + 1].y * v[2 * j + 1].y) + (v[2 * j + 1].z * v[2 * j + 1].z + v[2 * j + 1].w * v[2 * j + 1].w); }
        const float rs = 1.0f / sqrtf(wave_sum(ss) * (1.0f / DM) + EPS);
#pragma unroll
        for (int j = 0; j < 4; ++j) { const f32x4 g0 = *((const f32x4*)gf + 2 * (lane + 64 * j)), g1 = *((const f32x4*)gf + 2 * (lane + 64 * j) + 1);
            *((f32x4*)xr + 2 * (lane + 64 * j)) = v[2 * j] * rs * g0; *((f32x4*)xr + 2 * (lane + 64 * j) + 1) = v[2 * j + 1] * rs * g1; }
    }
}

__global__ void __launch_bounds__(NWAVES * 64, 2) fwd_kernel(Args args) {
    extern __shared__ __attribute__((aligned(16))) unsigned char lds[];
    Frame F;
    F.lds = (LAS unsigned char*)lds;
    F.MISC = (volatile LAS unsigned*)(F.lds + MISC_OFF);
    F.wave = __builtin_amdgcn_readfirstlane((int)threadIdx.x >> 6);
    F.G = gridDim.x; { const int bx = blockIdx.x; F.vcu = (F.G % 8 == 0) ? (bx % 8) * (F.G / 8) + bx / 8 : bx; }
    F.A = &args;
    { int t0 = (int)threadIdx.x; asm volatile("" : "+v"(t0));
      for (int u = t0; u < (LDS_BYTES - RING_BYTES) / 4; u += NWAVES * 64) ((LAS unsigned*)(F.lds + RING_BYTES))[u] = 0u; }
    __syncthreads();
    (void)xcd_barrier_post((unsigned*)args.ws + CW_BAR, F.MISC + 8);
#define MKBAR() XcdBarrier bar; bar.bar = (unsigned*)args.ws + CW_BAR; bar.x = xb_xcc_id(); bar.st = (volatile LAS unsigned*)(F.lds + MISC_OFF) + 8
    const int lo = args.ph_lo, hi = args.ph_hi;
#define IN(k) (lo <= (k) && (k) < hi)
#define GRID_BAR(k) do { if (IN(k) && IN((k) + 1)) { MKBAR(); xcd_barrier(bar); } } while (0)
    bf16* U = (bf16*)(F.A->ws + WS_U);
#define PHASE(k, ...) do { if (IN(k)) { __VA_ARGS__ if constexpr (REPP == (k)) { { MKBAR(); xcd_barrier(bar); } __VA_ARGS__ } } GRID_BAR(k); } while (0)
    PHASE(0, p0_prologue(F););
    PHASE(1,
        p1_cumsum(F); p1_meta_kv(F);
        { PInProj p{DM / 64, (const char*)(F.A->ws + WS_HN), (unsigned)(DM * 2), (unsigned)(DM * 2), (const char*)(F.A->ws + WS_WINT), U, (const f32x2*)(F.A->ws + WS_ROPE), (unsigned*)F.A->ws + CW_NRM};
        g8::StaticOrder S; S.init(MTOK, NIN, F.G, (int)blockIdx.x);
        g8::gemm_phase<PInProj, g8::StaticOrder, true>(F.lds, p, S); });
    PHASE(2, ret::states(F); __syncthreads();
        if constexpr (REPP == 21) { ret::states(F); __syncthreads(); }
        fox_phase(F);
        { MKBAR(); xcd_barrier(bar); } ret::outputs(F);
        if constexpr (REPP == 22) { __syncthreads(); ret::outputs(F); });
    PHASE(3,
        { POutProj p{DM / 64, (const char*)(F.A->ws + WS_HN), (unsigned)(DM * 2), (unsigned)(DM * 2), (const char*)(F.A->ws + WS_WOUTT), F.A->in[0], (bf16*)(F.A->ws + WS_H1B), (const float*)(F.A->ws + WS_SSQ)};
        g8::StaticOrder S; S.init(MTOK, DM, F.G, (int)blockIdx.x);
        g8::gemm_phase<POutProj, g8::StaticOrder, true>(F.lds, p, S); });
    PHASE(4, p4_router(F);
        if constexpr (REPP == 40) { { MKBAR(); xcd_barrier(bar); } if (blockIdx.x == 0 && threadIdx.x < NCLS) ((unsigned*)F.A->ws)[CW_CNT + 64 * threadIdx.x] = 0u; { MKBAR(); xcd_barrier(bar); } p4_router(F); });
    PHASE(5,
        moe_tables(F); p4b_permute(F); { MKBAR(); xcd_barrier(bar); }
        { PGateUp p{DM / 128, (const char*)(F.A->ws + WS_PART), (unsigned)DM, (unsigned)DM, (const char*)(F.A->ws + WS_WGU), (const int*)(F.A->ws + WS_TOK), (const float*)(F.A->ws + WS_WLO), (const float*)(F.A->ws + WS_WHI), (const float*)(F.A->ws + WS_RSS),
                  (const LAS int*)(F.lds + TBL_OFF), (unsigned char*)U, 0};
        SchedGU S{(const LAS int*)(F.lds + TBL_OFF), F.G, F.vcu};
        g8::gemm_phase<PGateUp, SchedGU, true>(F.lds, p, S); });
    PHASE(6,
        if (!IN(5)) moe_tables(F);
        { PDown p{2048 / 128, (const char*)U, 2048u, (unsigned)DE, (const char*)(F.A->ws + WS_WD), (const int*)(F.A->ws + WS_TOK), (const LAS int*)(F.lds + TBL_OFF), (bf16*)(F.A->ws + WS_Y)};
        SchedDown S{(const LAS int*)(F.lds + TBL_OFF), F.G, F.vcu};
        g8::gemm_phase<PDown, SchedDown, true>(F.lds, p, S); });
    PHASE(7, p7_final(F););
#undef PHASE
#undef IN
#undef GRID_BAR
}

extern "C" void kernel_launch(void* const* d_in, const int* in_sizes, int n_in, void* d_out, int out_size, void* d_ws, size_t ws_size, hipStream_t stream) {
    static int grid = 0;
    if (grid == 0) {
        if (n_in != 17 || out_size != MTOK * DM || ws_size < WS_END) { fprintf(stderr, "kernel_launch: unexpected shapes (n_in %d out %d ws %zu)\n", n_in, out_size, ws_size); grid = -1; return; }
        int dev = 0, cus = 0, per_cu = 0;
        if (hipGetDevice(&dev) != hipSuccess || hipDeviceGetAttribute(&cus, hipDeviceAttributeMultiprocessorCount, dev) != hipSuccess) { grid = -1; return; }
        if (hipFuncSetAttribute((const void*)fwd_kernel, hipFuncAttributeMaxDynamicSharedMemorySize, LDS_BYTES) != hipSuccess) { fprintf(stderr, "kernel_launch: hipFuncSetAttribute failed\n"); grid = -1; return; }
        if (hipOccupancyMaxActiveBlocksPerMultiprocessor(&per_cu, (const void*)fwd_kernel, NWAVES * 64, LDS_BYTES) != hipSuccess || per_cu < 1) fprintf(stderr, "kernel_launch: occupancy query says %d\n", per_cu);
        (void)hipGetLastError();
        grid = cus;
    }
    if (grid < 0) return;
    (void)hipMemsetAsync((char*)d_ws + WS_CTL, 0, CTL_ZERO_BYTES, stream);
    Args a{};
    for (int i = 0; i < 17; ++i) a.in[i] = (const float*)d_in[i];
    a.out = (float*)d_out; a.ws = (unsigned char*)d_ws; a.ph_lo = 0; a.ph_hi = 8;
    hipLaunchKernelGGL(fwd_kernel, dim3(grid), dim3(NWAVES * 64), LDS_BYTES, stream, a);
}
```
